# Optimizing an MI355X kernel written in HIP

```python
import jax, jax.numpy as jnp
from jax import lax
import numpy as np

D_MODEL = 1024
BATCH = 4
SEQ = 4096
DEPTH = 1
DEC_BATCH = 128
DEC_SEQ = 4
PAST_LEN = 16384
PAGE_SIZE = 128

N_HEADS_A = 8
N_KV_A = 2
HD_A = 64
GROUP_A = N_HEADS_A // N_KV_A
WINDOW = 128
BLOCK = WINDOW
ROPE_THETA = 500000.0
ROPE_DIM = HD_A // 4
N_HEADS_R = 4
DK_R = 128
DV_R = 256
RET_CHUNK = 128
RET_THETA = 10000.0
D_FF = 3 * D_MODEL
CONV_W = 3
EPS = 1e-6
NEG_INF = -1e30

Q_A = N_HEADS_A * HD_A
KV_A = N_KV_A * HD_A
QK_R = N_HEADS_R * DK_R
V_R = N_HEADS_R * DV_R
D_IN = Q_A + 2 * KV_A + 2 * QK_R + 2 * V_R + 2 * D_MODEL

kernel_name = 'hybrid_swa_sink_retention_convffn_step'


def split_points():
    sizes = [Q_A, KV_A, KV_A, QK_R, QK_R, V_R, V_R, D_MODEL, D_MODEL]
    return np.cumsum(sizes)[:-1].tolist()


def rms_norm(x, g):
    xf = x.astype(jnp.float32)
    xf = xf * lax.rsqrt(jnp.mean(xf * xf, axis=-1, keepdims=True) + EPS)
    return (xf * g.astype(jnp.float32)).astype(x.dtype)


def head_rms(x):
    return x * lax.rsqrt(jnp.mean(x * x, axis=-1, keepdims=True) + EPS)


def rope_partial(x, pos):
    half = ROPE_DIM // 2
    inv = 1.0 / (ROPE_THETA ** (jnp.arange(half, dtype=jnp.float32) / half))
    ang = pos.astype(jnp.float32)[:, None] * inv[None, :]
    cos = jnp.cos(ang)[:, None, :]
    sin = jnp.sin(ang)[:, None, :]
    xr = x[..., :ROPE_DIM].astype(jnp.float32)
    x1, x2 = xr[..., :half], xr[..., half:]
    rot = jnp.concatenate([x1 * cos - x2 * sin, x2 * cos + x1 * sin], axis=-1)
    return jnp.concatenate([rot.astype(x.dtype), x[..., ROPE_DIM:]], axis=-1)


def rope_ret(x, pos):
    ang = 1.0 / (RET_THETA ** jnp.linspace(0.0, 1.0, DK_R // 2, dtype=jnp.float32))
    ang = jnp.repeat(ang, 2)
    th = pos.astype(jnp.float32)[:, None] * ang[None, :]
    cos = jnp.cos(th)[:, None, :]
    sin = jnp.sin(th)[:, None, :]
    x1 = x[..., ::2]
    x2 = x[..., 1::2]
    rot = jnp.stack([-x2, x1], axis=-1).reshape(x.shape)
    return x * cos + rot * sin


def window_attn(q, k, v, qpos, kpos, sinks):
    B, Tq = q.shape[0], q.shape[1]
    qg = q.reshape(B, Tq, N_KV_A, GROUP_A, HD_A)
    s = jnp.einsum('bqkgd,bskd->bkgqs', qg, k).astype(jnp.float32) * (HD_A ** -0.5)
    valid = ((kpos[None, :] <= qpos[:, None])
             & (kpos[None, :] > qpos[:, None] - WINDOW)
             & (kpos[None, :] >= 0))
    s = jnp.where(valid, s, NEG_INF)
    sink = jnp.broadcast_to(sinks.astype(jnp.float32).reshape(N_KV_A, GROUP_A, 1, 1),
                            s.shape[:-1] + (1,))
    p = jax.nn.softmax(jnp.concatenate([s, sink], axis=-1), axis=-1)[..., :-1]
    o = jnp.einsum('bkgqs,bskd->bqkgd', p.astype(v.dtype), v)
    return o.reshape(B, Tq, N_HEADS_A * HD_A)


def banded_window_attn(q, k, v, pos, sinks):
    B, T = q.shape[0], q.shape[1]
    nb = T // BLOCK
    qb = q.reshape(B, nb, BLOCK, N_HEADS_A, HD_A)
    kb = k.reshape(B, nb, BLOCK, N_KV_A, HD_A)
    vb = v.reshape(B, nb, BLOCK, N_KV_A, HD_A)
    pad = ((0, 0), (1, 0), (0, 0), (0, 0), (0, 0))
    kband = jnp.concatenate([jnp.pad(kb, pad)[:, :-1], kb], axis=2)
    vband = jnp.concatenate([jnp.pad(vb, pad)[:, :-1], vb], axis=2)
    qpos = pos.reshape(nb, BLOCK)
    kpos = jnp.concatenate([qpos - BLOCK, qpos], axis=-1)
    o = jax.vmap(window_attn, in_axes=(1, 1, 1, 0, 0, None), out_axes=1)(
        qb, kband, vband, qpos, kpos, sinks)
    return o.reshape(B, T, N_HEADS_A * HD_A)


def ret_log_decay():
    return jnp.log1p(-jnp.exp2(-5.0 - jnp.arange(N_HEADS_R, dtype=jnp.float32)))


def retention_chunk(q, k, v, s0, log_g):
    L = q.shape[1]
    idx = jnp.arange(L, dtype=jnp.float32)
    diff = idx[:, None] - idx[None, :]
    dmask = jnp.where(diff >= 0, jnp.exp(log_g[:, None, None] * jnp.maximum(diff, 0.0)), 0.0)
    scores = jnp.einsum('bihd,bjhd->bhij', q, k) * dmask[None]
    inner = jnp.einsum('bhij,bjhe->bihe', scores, v)
    q_decay = jnp.exp(log_g[None, :] * (idx[:, None] + 1.0))
    cross = jnp.einsum('bihd,bhde->bihe', q, s0) * q_decay[None, :, :, None]
    k_decay = jnp.exp(log_g[None, :] * (L - 1.0 - idx[:, None]))
    s_new = (jnp.exp(log_g * L)[None, :, None, None] * s0
             + jnp.einsum('bjhd,bjhe->bhde', k * k_decay[None, :, :, None], v))
    return inner + cross, s_new


def retention(q, k, v, s0):
    B, T = q.shape[0], q.shape[1]
    c = RET_CHUNK if T % RET_CHUNK == 0 else T
    nc = T // c
    log_g = ret_log_decay()

    def to_chunks(a):
        return a.reshape((B, nc, c) + a.shape[2:]).swapaxes(0, 1)

    def step(s, qkv):
        o, s = retention_chunk(qkv[0], qkv[1], qkv[2], s, log_g)
        return s, o

    s_final, o = lax.scan(step, s0, (to_chunks(q), to_chunks(k), to_chunks(v)))
    o = o.swapaxes(0, 1).reshape(B, T, N_HEADS_R, DV_R)
    return o, s_final


def conv_ffn(xn, conv_ctx, w_up, conv_w, conv_b, w_down):
    T = xn.shape[1]
    u = xn @ w_up
    u_ext = jnp.concatenate([conv_ctx.astype(u.dtype), u], axis=1)
    c = conv_b
    for tap in range(CONV_W):
        c = c + u_ext[:, tap:tap + T] * conv_w[tap]
    a, b = jnp.split(c, 2, axis=-1)
    h = jax.nn.gelu(a, approximate=True) * b
    return h @ w_down, u_ext[:, -(CONV_W - 1):]


def trunk_layer(x, pos, ctx_k, ctx_v, ctx_pos, ret_s0, conv_ctx,
                w_in, sinks, w_a_proj, w_r_proj, w_o,
                g_pre_mix, g_post_mix, g_pre_ffn, g_post_ffn,
                w_up, conv_w, conv_b, w_down):
    B, T = x.shape[0], x.shape[1]
    xn = rms_norm(x, g_pre_mix)
    h = xn @ w_in
    q_a, k_a, v_a, q_r, k_r, v_r, gate_r, gm_a, gm_r = jnp.split(h, split_points(), axis=-1)
    q_a = rope_partial(q_a.reshape(B, T, N_HEADS_A, HD_A), pos)
    k_a = rope_partial(k_a.reshape(B, T, N_KV_A, HD_A), pos)
    v_a = v_a.reshape(B, T, N_KV_A, HD_A)
    if ctx_k is None:
        o_a = banded_window_attn(q_a, k_a, v_a, pos, sinks)
        new_k, new_v = k_a[:, -WINDOW:], v_a[:, -WINDOW:]
    else:
        k_all = jnp.concatenate([ctx_k.astype(k_a.dtype), k_a], axis=1)
        v_all = jnp.concatenate([ctx_v.astype(v_a.dtype), v_a], axis=1)
        kpos = jnp.concatenate([ctx_pos, pos])
        o_a = window_attn(q_a, k_all, v_all, pos, kpos, sinks)
        new_k, new_v = k_all[:, -WINDOW:], v_all[:, -WINDOW:]
    qr = rope_ret(q_r.reshape(B, T, N_HEADS_R, DK_R).astype(jnp.float32), pos)
    kr = rope_ret(k_r.reshape(B, T, N_HEADS_R, DK_R).astype(jnp.float32), pos) * (DK_R ** -0.5)
    vr = v_r.reshape(B, T, N_HEADS_R, DV_R).astype(jnp.float32)
    o_r, new_s = retention(qr, kr, vr, ret_s0.astype(jnp.float32))
    o_r = head_rms(o_r).reshape(B, T, V_R).astype(x.dtype)
    y_a = o_a @ w_a_proj
    y_r = (jax.nn.silu(gate_r) * o_r) @ w_r_proj
    mixed = (jax.nn.sigmoid(gm_a) * y_a + jax.nn.sigmoid(gm_r) * y_r) @ w_o
    x = x + rms_norm(mixed, g_post_mix)
    f, new_conv = conv_ffn(rms_norm(x, g_pre_ffn), conv_ctx, w_up, conv_w, conv_b, w_down)
    x = x + rms_norm(f, g_post_ffn)
    return x, new_k, new_v, new_s, new_conv


def setup_inputs(seed: int = 0) -> dict:
    key = jax.random.key(seed)
    ks = jax.random.split(key, 20)
    F2 = 2 * D_FF

    def nrm(k, shape, scale):
        return jax.random.normal(k, shape, jnp.float32) * scale

    return {
        'x_prompt': nrm(ks[0], (BATCH, SEQ, D_MODEL), 1.0),
        'x_sample': nrm(ks[1], (DEC_BATCH, DEC_SEQ, D_MODEL), 1.0),
        'cache_k': nrm(ks[2], (DEPTH, DEC_BATCH, WINDOW, N_KV_A, HD_A), 1.0),
        'cache_v': nrm(ks[3], (DEPTH, DEC_BATCH, WINDOW, N_KV_A, HD_A), 1.0),
        'state_ret': nrm(ks[4], (DEPTH, DEC_BATCH, N_HEADS_R, DK_R, DV_R), 0.3),
        'state_conv': nrm(ks[5], (DEPTH, DEC_BATCH, CONV_W - 1, F2), 1.0),
        'w_in': nrm(ks[6], (DEPTH, D_MODEL, D_IN), D_MODEL ** -0.5),
        'attn_sinks': nrm(ks[7], (DEPTH, N_HEADS_A), 0.5),
        'w_a_proj': nrm(ks[8], (DEPTH, Q_A, D_MODEL), Q_A ** -0.5),
        'w_r_proj': nrm(ks[9], (DEPTH, V_R, D_MODEL), V_R ** -0.5),
        'w_o': nrm(ks[10], (DEPTH, D_MODEL, D_MODEL), D_MODEL ** -0.5),
        'g_pre_mix': 1.0 + nrm(ks[11], (DEPTH, D_MODEL), 0.05),
        'g_post_mix': 1.0 + nrm(ks[12], (DEPTH, D_MODEL), 0.05),
        'g_pre_ffn': 1.0 + nrm(ks[13], (DEPTH, D_MODEL), 0.05),
        'g_post_ffn': 1.0 + nrm(ks[14], (DEPTH, D_MODEL), 0.05),
        'w_up': nrm(ks[15], (DEPTH, D_MODEL, F2), D_MODEL ** -0.5),
        'conv_w': nrm(ks[16], (DEPTH, CONV_W, F2), CONV_W ** -0.5),
        'conv_b': nrm(ks[17], (DEPTH, F2), 0.01),
        'w_down': nrm(ks[18], (DEPTH, D_FF, D_MODEL), D_FF ** -0.5),
    }


def reference(x_prompt, x_sample, cache_k, cache_v, state_ret, state_conv,
              w_in, attn_sinks, w_a_proj, w_r_proj, w_o,
              g_pre_mix, g_post_mix, g_pre_ffn, g_post_ffn,
              w_up, conv_w, conv_b, w_down):
    bp, tp = x_prompt.shape[0], x_prompt.shape[1]
    ts = x_sample.shape[1]
    pos_p = jnp.arange(tp, dtype=jnp.int32)
    pos_s = PAST_LEN + jnp.arange(ts, dtype=jnp.int32)
    ctx_pos = PAST_LEN - WINDOW + jnp.arange(WINDOW, dtype=jnp.int32)
    hp, hs = x_prompt, x_sample
    kp_l, vp_l, sp_l, cp_l = [], [], [], []
    ks_l, vs_l, ss_l, cs_l = [], [], [], []
    for l in range(DEPTH):
        w = (w_in[l], attn_sinks[l], w_a_proj[l], w_r_proj[l], w_o[l],
             g_pre_mix[l], g_post_mix[l], g_pre_ffn[l], g_post_ffn[l],
             w_up[l], conv_w[l], conv_b[l], w_down[l])
        ret0 = jnp.zeros((bp, N_HEADS_R, DK_R, DV_R), jnp.float32)
        conv0 = jnp.zeros((bp, CONV_W - 1, 2 * D_FF), x_prompt.dtype)
        hp, kp, vp, sp, cp = trunk_layer(hp, pos_p, None, None, None, ret0, conv0, *w)
        hs, kss, vss, sss, css = trunk_layer(hs, pos_s, cache_k[l], cache_v[l], ctx_pos,
                                             state_ret[l], state_conv[l], *w)
        kp_l.append(kp); vp_l.append(vp); sp_l.append(sp); cp_l.append(cp)
        ks_l.append(kss); vs_l.append(vss); ss_l.append(sss); cs_l.append(css)
    k_prompt = jnp.stack(kp_l)
    v_prompt = jnp.stack(vp_l)
    ret_prompt = jnp.stack(sp_l)
    conv_prompt = jnp.stack(cp_l)
    k_sample = jnp.stack(ks_l)
    v_sample = jnp.stack(vs_l)
    ret_sample = jnp.stack(ss_l)
    conv_sample = jnp.stack(cs_l)
    return (hp, hs, k_prompt, v_prompt, ret_prompt, conv_prompt,
            k_sample, v_sample, ret_sample, conv_sample)
```

```cpp
#include <hip/hip_runtime.h>
#include <hip/hip_cooperative_groups.h>
#include <cstdio>
#include <cstdint>
#include <cmath>
namespace cg = cooperative_groups;
namespace pg8 {
#define PG8_LAS __attribute__((address_space(3)))
typedef unsigned short bf16_t;
typedef short bf16x8 __attribute__((ext_vector_type(8)));
typedef float f32x4 __attribute__((ext_vector_type(4)));
typedef unsigned u32x4 __attribute__((ext_vector_type(4)));
constexpr int BM = 256, BK = 64, HALF = 128, HTB = HALF * BK * 2  , STAGE_BYTES = 8 * HTB, NXCD = 8, WGM = 8;

__host__ __device__ __forceinline__ int lds_byte(int r, int c) { const int st = (r >> 4) * 2 + (c >> 5), rr = r & 15, cc = c & 31, ob = rr * 64 + cc * 2; return st * 1024 + (ob ^ (((ob >> 9) & 1) << 5)); }
__host__ __device__ __forceinline__ void stage_rc(int b, int& R, int& C) { const int st = b / 1024, sb = b % 1024, swz = sb ^ (((sb >> 9) & 1) << 5); R = (st >> 1) * 16 + swz / 64; C = (st & 1) * 32 + (swz % 64) / 2; }
__host__ __device__ __forceinline__ int perm32(int rho) { const int n = rho >> 4, i = rho & 15; return 8 * (i >> 2) + 4 * n + (i & 3); }

struct Unit { int pm, pn; };
struct Gemm { const bf16_t* A; const bf16_t* Bt; int M, N, K, lda; };

struct StaticOrder {
    int nM, nN, nwg, G, c;
    __host__ __device__ void init(int M, int N, int G_, int c_) { nM = M / BM; nN = N / BM; nwg = nM * nN; G = G_; c = c_; }
    __host__ __device__ bool next(int i, Unit& u) const {
        const long L = (long)i * G + c; if (L >= nwg) return false;
        int wgid = (int)L; { const int q = nwg / NXCD, r = nwg % NXCD, xcd = wgid % NXCD, off = wgid / NXCD; wgid = (xcd < r ? xcd * (q + 1) : r * (q + 1) + (xcd - r) * q) + off; }
        const int nig = WGM * nN, gid = wgid / nig, fm = gid * WGM, gsz = (nM - fm) < WGM ? (nM - fm) : WGM;
        u.pm = fm + ((wgid % nig) % gsz); u.pn = (wgid % nig) / gsz; return true;
    }
    __device__ __forceinline__ void a_ready(const Unit&) const {}
    __device__ __forceinline__ void done(const Unit&) const {}
};

__device__ __forceinline__ unsigned cvt_pk_bf16(float lo, float hi) { unsigned r; asm volatile("v_cvt_pk_bf16_f32 %0, %1, %2" : "=v"(r) : "v"(lo), "v"(hi)); return r; }
typedef float f32x2 __attribute__((ext_vector_type(2)));
__device__ __forceinline__ f32x2 gelu_pk(f32x2 v) {
    const f32x2 av = __builtin_elementwise_abs(v), d = av * 0.2316418882f + 1.0f;
    f32x2 t; t.x = __builtin_amdgcn_rcpf(d.x); t.y = __builtin_amdgcn_rcpf(d.y);
    f32x2 q = t * 0.5307027145f + (-0.7265760135f); q = q * t + 0.7107068705f; q = q * t + (-0.142248368f); q = q * t + 0.127414796f; q = q * t;
    const f32x2 s = (v * v) * (-0.72134752044f);
    f32x2 e; e.x = __builtin_amdgcn_exp2f(s.x); e.y = __builtin_amdgcn_exp2f(s.y);
    const f32x2 m = v * (q * e), r = v - m;
    f32x2 o; o.x = v.x < 0.f ? m.x : r.x; o.y = v.y < 0.f ? m.y : r.y; return o;
}

template <int ACT  > struct EpiBf16 {
    static constexpr bool PERM = true, AFTER_DRAIN = false; static_assert(ACT == 0 || ACT == 1, "EpiBf16: ACT is 0 (none) or 1 (gelu_pk)");
    bf16_t* O; int ldc; const float* bias; int split_cols; size_t split_stride; float scale0;
    __device__ __forceinline__ void operator()(const f32x4 (&acc)[2][2][4][2], const Unit& u, int wr, int wc, int fr, int fq) const {
        const int row0 = u.pm * BM + wr * 64 + fr; int colt = u.pn * BM; bf16_t* base = O;
        float sc = 1.f; if (split_cols) { const int t = colt / split_cols; base += (size_t)t * split_stride; colt -= t * split_cols; if (t == 0) sc = scale0; }
        const int col0 = colt + wc * 32 + 8 * fq, bcol0 = u.pn * BM + wc * 32 + 8 * fq;
        f32x4 bv[2][2];
#pragma unroll
        for (int bj = 0; bj < 2; ++bj)
#pragma unroll
            for (int n = 0; n < 2; ++n) bv[bj][n] = bias ? *(const f32x4*)(bias + bcol0 + bj * HALF + 4 * n) : (f32x4){0.f, 0.f, 0.f, 0.f};
#pragma unroll
        for (int ai = 0; ai < 2; ++ai)
#pragma unroll
            for (int m = 0; m < 4; ++m) { bf16_t* rowp = base + (size_t)(row0 + ai * HALF + m * 16) * ldc + col0;
#pragma unroll
                for (int bj = 0; bj < 2; ++bj) { f32x4 v0 = acc[ai][bj][m][0] + bv[bj][0], v1 = acc[ai][bj][m][1] + bv[bj][1];
                    if (ACT == 1) { f32x2 a = gelu_pk((f32x2){v0[0], v0[1]}), b = gelu_pk((f32x2){v0[2], v0[3]}), c = gelu_pk((f32x2){v1[0], v1[1]}), d = gelu_pk((f32x2){v1[2], v1[3]});
                        v0 = (f32x4){a.x, a.y, b.x, b.y}; v1 = (f32x4){c.x, c.y, d.x, d.y}; }
                    v0 = v0 * sc; v1 = v1 * sc; u32x4 w; w.x = cvt_pk_bf16(v0[0], v0[1]); w.y = cvt_pk_bf16(v0[2], v0[3]); w.z = cvt_pk_bf16(v1[0], v1[1]); w.w = cvt_pk_bf16(v1[2], v1[3]);
                    *(u32x4*)(rowp + bj * HALF) = w; } }
    }
};

typedef float f32x2e __attribute__((ext_vector_type(2)));
typedef unsigned u32x2e __attribute__((ext_vector_type(2)));
__device__ __forceinline__ float bf_lo(unsigned w) { return __uint_as_float(w << 16); }
__device__ __forceinline__ float bf_hi(unsigned w) { return __uint_as_float(w & 0xffff0000u); }
__device__ __forceinline__ float sigmoidf_(float x) { return __builtin_amdgcn_rcpf(1.0f + __expf(-x)); }
constexpr int E_MP = 16384, E_DIN = 5888;

struct EpiH {
    static constexpr bool PERM = true, AFTER_DRAIN = false;
    bf16_t* H; const f32x2e* tabA; const f32x2e* tabR;
    __device__ __forceinline__ void operator()(const f32x4 (&acc)[2][2][4][2], const Unit& u, int wr, int wc, int fr, int fq) const {
        const int pn = u.pn;
        const int row0 = u.pm * BM + wr * 64 + fr;
        const int colt = pn * BM + wc * 32 + 8 * fq;
#pragma unroll
        for (int ai = 0; ai < 2; ++ai)
#pragma unroll
            for (int m = 0; m < 4; ++m) {
                const int row = row0 + ai * HALF + m * 16;
                const int tp = row < E_MP ? (row & 4095) : 4096 + (row & 3);
#pragma unroll
                for (int bj = 0; bj < 2; ++bj) {
                    float v[8];
#pragma unroll
                    for (int j = 0; j < 4; ++j) { v[j] = acc[ai][bj][m][0][j]; v[4 + j] = acc[ai][bj][m][1][j]; }
                    int mode = 0; float sc = 1.f;
                    if (pn < 2) { mode = 1; sc = 0.125f; }
                    else if (pn == 2) { mode = (bj == 0) ? 1 : 0; }
                    else if (pn < 5) { mode = 2; }
                    else if (pn < 7) { mode = 2; sc = 0.08838834764831845f; }
                    if (mode == 1) {
                        const bool rot = ((wc & 1) == 0) && (fq < 2);
                        const float sgn = (fq == 0) ? -1.f : 1.f;
#pragma unroll
                        for (int j = 0; j < 8; ++j) {
                            const float partner = __shfl_xor(v[j], 16);
                            const f32x2e cs = tabA[tp * 8 + j];
                            const float o = v[j] * cs.x + sgn * partner * cs.y;
                            v[j] = (rot ? o : v[j]) * sc;
                        }
                    } else if (mode == 2) {
                        const int pi = ((bj * HALF + wc * 32 + 8 * fq) & 127) >> 1;
#pragma unroll
                        for (int p = 0; p < 4; ++p) {
                            const f32x2e cs = tabR[tp * 64 + pi + p];
                            const float x0 = v[2 * p], x1 = v[2 * p + 1];
                            v[2 * p] = (x0 * cs.x - x1 * cs.y) * sc; v[2 * p + 1] = (x1 * cs.x + x0 * cs.y) * sc;
                        }
                    }
                    u32x4 w; w.x = cvt_pk_bf16(v[0], v[1]); w.y = cvt_pk_bf16(v[2], v[3]); w.z = cvt_pk_bf16(v[4], v[5]); w.w = cvt_pk_bf16(v[6], v[7]);
                    *(u32x4*)(H + (size_t)row * E_DIN + colt + bj * HALF) = w;
                }
            }
    }
};

template <bool ADD> struct EpiGate {
    static constexpr bool PERM = true, AFTER_DRAIN = false;
    bf16_t* T; const bf16_t* gate; int ldg;
    __device__ __forceinline__ void operator()(const f32x4 (&acc)[2][2][4][2], const Unit& u, int wr, int wc, int fr, int fq) const {
        const int row0 = u.pm * BM + wr * 64 + fr, col0 = u.pn * BM + wc * 32 + 8 * fq;
#pragma unroll
        for (int ai = 0; ai < 2; ++ai)
#pragma unroll
            for (int m = 0; m < 4; ++m) {
                const int row = row0 + ai * HALF + m * 16;
#pragma unroll
                for (int bj = 0; bj < 2; ++bj) {
                    const u32x4 gw = *(const u32x4*)(gate + (size_t)row * ldg + col0 + bj * HALF);
                    bf16_t* tp = T + (size_t)row * 1024 + col0 + bj * HALF;
                    u32x4 old = (u32x4){0u, 0u, 0u, 0u}; if (ADD) old = *(const u32x4*)tp;
                    float o[8];
#pragma unroll
                    for (int j = 0; j < 4; ++j) {
                        const unsigned g2 = gw[j], o2 = old[j];
                        const float a0 = acc[ai][bj][m][j >> 1][(j & 1) * 2], a1 = acc[ai][bj][m][j >> 1][(j & 1) * 2 + 1];
                        o[2 * j] = bf_lo(o2) + sigmoidf_(bf_lo(g2)) * a0; o[2 * j + 1] = bf_hi(o2) + sigmoidf_(bf_hi(g2)) * a1;
                    }
                    u32x4 w; w.x = cvt_pk_bf16(o[0], o[1]); w.y = cvt_pk_bf16(o[2], o[3]); w.z = cvt_pk_bf16(o[4], o[5]); w.w = cvt_pk_bf16(o[6], o[7]);
                    *(u32x4*)tp = w;
                }
            }
    }
};

struct EpiF32 {
    static constexpr bool PERM = true, AFTER_DRAIN = false;
    float* O;
    __device__ __forceinline__ void operator()(const f32x4 (&acc)[2][2][4][2], const Unit& u, int wr, int wc, int fr, int fq) const {
        const int row0 = u.pm * BM + wr * 64 + fr, col0 = u.pn * BM + wc * 32 + 8 * fq;
#pragma unroll
        for (int ai = 0; ai < 2; ++ai)
#pragma unroll
            for (int m = 0; m < 4; ++m) {
                float* rp = O + (size_t)(row0 + ai * HALF + m * 16) * 1024 + col0;
#pragma unroll
                for (int bj = 0; bj < 2; ++bj) { *(f32x4*)(rp + bj * HALF) = acc[ai][bj][m][0]; *(f32x4*)(rp + bj * HALF + 4) = acc[ai][bj][m][1]; }
            }
    }
};

__device__ __forceinline__ float dpp_ror1(float x) { return __builtin_bit_cast(float, __builtin_amdgcn_update_dpp(0, __builtin_bit_cast(int, x), 0x121, 0xf, 0xf, false)); }
__device__ __forceinline__ float dpp_ror2(float x) { return __builtin_bit_cast(float, __builtin_amdgcn_update_dpp(0, __builtin_bit_cast(int, x), 0x122, 0xf, 0xf, false)); }
__device__ __forceinline__ float gelu_tanh(float x) { const float u2 = 1.5957691216057308f * (x + 0.044715f * x * x * x); return x * __builtin_amdgcn_rcpf(1.0f + __expf(-u2)); }
struct EpiUp {
    static constexpr bool PERM = true, AFTER_DRAIN = false;
    bf16_t* G; bf16_t* UH; bf16_t* US; float* conv_prompt; float* conv_sample; const float* conv_w; const float* conv_b;
    __device__ __forceinline__ void operator()(const f32x4 (&acc)[2][2][4][2], const Unit& u, int wr, int wc, int fr, int fq) const {
        const int row0 = u.pm * BM + wr * 64 + fr;
        const bool sample = u.pm >= 64;
#pragma unroll
        for (int n = 0; n < 2; ++n) {
            const int ch = u.pn * HALF + wc * 32 + 8 * fq + 4 * n;
            const f32x4 wa0 = *(const f32x4*)(conv_w + ch), wa1 = *(const f32x4*)(conv_w + 6144 + ch), wa2 = *(const f32x4*)(conv_w + 12288 + ch), ba = *(const f32x4*)(conv_b + ch);
            const f32x4 wb0 = *(const f32x4*)(conv_w + 3072 + ch), wb1 = *(const f32x4*)(conv_w + 6144 + 3072 + ch), wb2 = *(const f32x4*)(conv_w + 12288 + 3072 + ch), bb = *(const f32x4*)(conv_b + 3072 + ch);
#pragma unroll
            for (int ai = 0; ai < 2; ++ai)
#pragma unroll
                for (int m = 0; m < 4; ++m) {
                    const int row = row0 + ai * HALF + m * 16;
                    const f32x4 ua = acc[ai][0][m][n], ub = acc[ai][1][m][n];
                    const f32x4 pa = acc[ai][0][m > 0 ? m - 1 : 0][n], pb = acc[ai][1][m > 0 ? m - 1 : 0][n];
                    float g[4];
#pragma unroll
                    for (int r = 0; r < 4; ++r) {
                        const float a1c = dpp_ror1(ua[r]), a1p = dpp_ror1(pa[r]), a2c = dpp_ror2(ua[r]), a2p = dpp_ror2(pa[r]);
                        const float b1c = dpp_ror1(ub[r]), b1p = dpp_ror1(pb[r]), b2c = dpp_ror2(ub[r]), b2p = dpp_ror2(pb[r]);
                        const float a1 = fr >= 1 ? a1c : a1p, a2 = fr >= 2 ? a2c : a2p, b1 = fr >= 1 ? b1c : b1p, b2 = fr >= 2 ? b2c : b2p;
                        const float ca = ba[r] + wa0[r] * a2 + wa1[r] * a1 + wa2[r] * ua[r];
                        const float cb = bb[r] + wb0[r] * b2 + wb1[r] * b1 + wb2[r] * ub[r];
                        g[r] = gelu_tanh(ca) * cb;
                    }
                    if (!sample) {
                        if (!(m == 0 && fr < 2)) { u32x2e w; w.x = cvt_pk_bf16(g[0], g[1]); w.y = cvt_pk_bf16(g[2], g[3]); *(u32x2e*)(G + (size_t)row * 3072 + ch) = w; }
                        if ((m == 0 && fr < 2) || (m == 3 && fr >= 14)) {
                            const int hrow = (row >> 6) * 4 + ((row + 2) & 63);
                            u32x2e w; w.x = cvt_pk_bf16(ua[0], ua[1]); w.y = cvt_pk_bf16(ua[2], ua[3]); *(u32x2e*)(UH + (size_t)hrow * 6144 + ch) = w;
                            w.x = cvt_pk_bf16(ub[0], ub[1]); w.y = cvt_pk_bf16(ub[2], ub[3]); *(u32x2e*)(UH + (size_t)hrow * 6144 + 3072 + ch) = w;
                        }
                        if ((row & 4095) >= 4094) {
                            float* cp = conv_prompt + ((size_t)(row >> 12) * 2 + ((row & 4095) - 4094)) * 6144;
                            *(f32x4*)(cp + ch) = ua; *(f32x4*)(cp + 3072 + ch) = ub;
                        }
                    } else {
                        const int sr = row - E_MP;
                        u32x2e w; w.x = cvt_pk_bf16(ua[0], ua[1]); w.y = cvt_pk_bf16(ua[2], ua[3]); *(u32x2e*)(US + (size_t)sr * 6144 + ch) = w;
                        w.x = cvt_pk_bf16(ub[0], ub[1]); w.y = cvt_pk_bf16(ub[2], ub[3]); *(u32x2e*)(US + (size_t)sr * 6144 + 3072 + ch) = w;
                        if ((sr & 3) >= 2) {
                            float* cp = conv_sample + ((size_t)(sr >> 2) * 2 + ((sr & 3) - 2)) * 6144;
                            *(f32x4*)(cp + ch) = ua; *(f32x4*)(cp + 3072 + ch) = ub;
                        }
                    }
                }
        }
    }
};

template <class Epi, class Sched, bool ALIGN_EPI = false, bool SP2 = false>
__device__ __forceinline__ void gemm_phase(PG8_LAS unsigned char* lds, const Gemm g, const Sched& S, const Epi& E) {
    const int tid = threadIdx.x, wid = __builtin_amdgcn_readfirstlane(tid >> 6), lane = tid & 63, wr = wid >> 2, wc = wid & 3, fr = lane & 15, fq = lane >> 4;
    const int K = g.K, nt = K / BK, lda = g.lda;
    unsigned voffA[2], voffB[2];
#pragma unroll
    for (int i = 0; i < 2; ++i) { int R, C; stage_rc(tid * 16 + i * 8192, R, C); const int Rb = Epi::PERM ? ((R & ~31) + perm32(R & 31)) : R;
        voffA[i] = (unsigned)(R * lda + C) * 2u; voffB[i] = (unsigned)(Rb * K + C) * 2u; }
    const size_t kstep = (size_t)(BK * 2);
    const size_t hstepA = (size_t)HALF * lda * 2, hstepB = (size_t)HALF * K * 2;
    const size_t tstepA = 2 * hstepA, tstepB = 2 * hstepB;
    const unsigned ldsw = (unsigned)wid * 1024u;
    const int aoff = lds_byte(wr * 64 + fr, fq * 8), boff = lds_byte(wc * 32 + fr, fq * 8);
#define PG8_SA(b, h) (((b) * 2 + (h)) * HTB)
#define PG8_SB(b, h) ((4 + (b) * 2 + (h)) * HTB)
#define PG8_STAGE(bufoff, gbase, voff) do { _Pragma("unroll") for (int _i = 0; _i < 2; ++_i) \
        __builtin_amdgcn_global_load_lds((const unsigned*)((const char*)(gbase) + (voff)[_i]), (PG8_LAS unsigned*)(lds + (bufoff) + ldsw + _i * 8192), 16, 0, 0); } while (0)
#define PG8_LDA(dst, b, h) do { _Pragma("unroll") for (int m = 0; m < 4; ++m) _Pragma("unroll") for (int k = 0; k < 2; ++k) dst[m][k] = *(const PG8_LAS bf16x8*)(lds + PG8_SA(b, h) + aoff + m * 2048 + k * 1024); } while (0)
#define PG8_LDB(dst, b, h) do { _Pragma("unroll") for (int n = 0; n < 2; ++n) _Pragma("unroll") for (int k = 0; k < 2; ++k) dst[n][k] = *(const PG8_LAS bf16x8*)(lds + PG8_SB(b, h) + boff + n * 2048 + k * 1024); } while (0)
#define PG8_MMA(ai, bj, At, Bt) do { __builtin_amdgcn_s_setprio(1); _Pragma("unroll") for (int m = 0; m < 4; ++m) _Pragma("unroll") for (int n = 0; n < 2; ++n) _Pragma("unroll") for (int k = 0; k < 2; ++k) \
        acc[ai][bj][m][n] = __builtin_amdgcn_mfma_f32_16x16x32_bf16(Bt[n][k], At[m][k], acc[ai][bj][m][n], 0, 0, 0); __builtin_amdgcn_s_setprio(0); } while (0)
#define PG8_WAIT_V(n) asm volatile("s_waitcnt vmcnt(" #n ")" ::: "memory")
#define PG8_WAIT_L(n) asm volatile("s_waitcnt lgkmcnt(" #n ")" ::: "memory")
#define PG8_BAR __builtin_amdgcn_s_barrier()
#define PG8_SCHED __builtin_amdgcn_sched_barrier(0)
    Unit cur, nxt; int ui = 0;
    if (!S.next(0, cur)) return;
    f32x4 acc[2][2][4][2];
#pragma unroll
    for (int a = 0; a < 2; ++a)
#pragma unroll
        for (int b = 0; b < 2; ++b)
#pragma unroll
            for (int m = 0; m < 4; ++m)
#pragma unroll
                for (int n = 0; n < 2; ++n) acc[a][b][m][n] = (f32x4){0.f, 0.f, 0.f, 0.f};
    bf16x8 At[4][2], B0[2][2], B1[2][2];
    const char* cA = (const char*)g.A + (size_t)cur.pm * tstepA; const char* cB = (const char*)g.Bt + (size_t)cur.pn * tstepB;
    S.a_ready(cur);
    if constexpr (SP2) {
        PG8_STAGE(PG8_SB(0, 0), cB, voffB); PG8_STAGE(PG8_SB(0, 1), cB + hstepB, voffB); PG8_STAGE(PG8_SA(0, 0), cA, voffA); PG8_STAGE(PG8_SA(0, 1), cA + hstepA, voffA);
        if (wr == 1) PG8_BAR;
        PG8_WAIT_V(2); PG8_BAR;
        PG8_STAGE(PG8_SB(1, 0), cB + kstep, voffB); PG8_STAGE(PG8_SA(1, 0), cA + kstep, voffA); PG8_STAGE(PG8_SB(1, 1), cB + hstepB + kstep, voffB);
        PG8_WAIT_V(6); PG8_BAR;
    } else {
        PG8_STAGE(PG8_SB(0, 0), cB, voffB); PG8_STAGE(PG8_SA(0, 0), cA, voffA); PG8_STAGE(PG8_SB(0, 1), cB + hstepB, voffB); PG8_STAGE(PG8_SA(0, 1), cA + hstepA, voffA);
        if (wr == 1) PG8_BAR;
        PG8_WAIT_V(4); PG8_BAR;
        PG8_STAGE(PG8_SB(1, 0), cB + kstep, voffB); PG8_STAGE(PG8_SA(1, 0), cA + kstep, voffA); PG8_STAGE(PG8_SB(1, 1), cB + hstepB + kstep, voffB);
        PG8_WAIT_V(6); PG8_BAR;
    }
    for (;;) {
        const bool has_next = S.next(ui + 1, nxt);
        const char* nA = has_next ? (const char*)g.A + (size_t)nxt.pm * tstepA : cA; const char* nB = has_next ? (const char*)g.Bt + (size_t)nxt.pn * tstepB : cB;
        for (int t = 0; t < nt; t += 2) {
            const bool last = (t == nt - 2);
            const char* a1 = cA + (size_t)(t + 1) * kstep;
            const char* a2 = last ? nA : cA + (size_t)(t + 2) * kstep; const char* b2 = last ? nB : cB + (size_t)(t + 2) * kstep;
            const char* a3 = a2 + kstep; const char* b3 = b2 + kstep;
            if (last && has_next) S.a_ready(nxt);
            if constexpr (SP2) {
            PG8_LDB(B0, 0, 0); PG8_LDB(B1, 0, 1); PG8_SCHED; PG8_LDA(At, 0, 0); PG8_STAGE(PG8_SA(1, 1), a1 + hstepA, voffA);
            PG8_WAIT_V(8); PG8_WAIT_L(0); PG8_BAR; PG8_MMA(0, 0, At, B0); PG8_MMA(0, 1, At, B1); PG8_BAR; PG8_SCHED;
            PG8_LDA(At, 0, 1); PG8_STAGE(PG8_SB(0, 0), b2, voffB); PG8_STAGE(PG8_SB(0, 1), b2 + hstepB, voffB); PG8_STAGE(PG8_SA(0, 0), a2, voffA);
            PG8_WAIT_V(8); PG8_WAIT_L(0); PG8_BAR; PG8_MMA(1, 0, At, B0); PG8_MMA(1, 1, At, B1); PG8_BAR; PG8_SCHED;
            PG8_LDB(B0, 1, 0); PG8_LDB(B1, 1, 1); PG8_SCHED; PG8_LDA(At, 1, 0); PG8_STAGE(PG8_SA(0, 1), a2 + hstepA, voffA);
            PG8_WAIT_V(8); PG8_WAIT_L(0); PG8_BAR; PG8_MMA(0, 0, At, B0); PG8_MMA(0, 1, At, B1); PG8_BAR; PG8_SCHED;
            PG8_LDA(At, 1, 1); PG8_STAGE(PG8_SB(1, 0), b3, voffB); PG8_STAGE(PG8_SB(1, 1), b3 + hstepB, voffB); PG8_STAGE(PG8_SA(1, 0), a3, voffA);
            PG8_WAIT_V(8); PG8_WAIT_L(0); PG8_BAR; PG8_MMA(1, 0, At, B0); PG8_MMA(1, 1, At, B1); PG8_BAR; PG8_SCHED;
            } else {
            PG8_LDB(B0, 0, 0); PG8_SCHED; PG8_LDA(At, 0, 0); PG8_STAGE(PG8_SA(1, 1), a1 + hstepA, voffA);
            PG8_WAIT_L(8); PG8_BAR; PG8_WAIT_L(0); PG8_MMA(0, 0, At, B0); PG8_BAR; PG8_SCHED;
            PG8_LDB(B1, 0, 1); PG8_STAGE(PG8_SB(0, 0), b2, voffB);
            PG8_BAR; PG8_WAIT_L(0); PG8_MMA(0, 1, At, B1); PG8_BAR;
            PG8_LDA(At, 0, 1); PG8_STAGE(PG8_SA(0, 0), a2, voffA);
            PG8_BAR; PG8_WAIT_L(0); PG8_MMA(1, 0, At, B0); PG8_BAR; PG8_SCHED;
            PG8_STAGE(PG8_SB(0, 1), b2 + hstepB, voffB);
            PG8_WAIT_V(6); PG8_BAR; PG8_MMA(1, 1, At, B1); PG8_BAR;
            PG8_LDB(B0, 1, 0); PG8_SCHED; PG8_LDA(At, 1, 0); PG8_STAGE(PG8_SA(0, 1), a2 + hstepA, voffA);
            PG8_WAIT_L(8); PG8_BAR; PG8_WAIT_L(0); PG8_MMA(0, 0, At, B0); PG8_BAR; PG8_SCHED;
            PG8_LDB(B1, 1, 1); PG8_STAGE(PG8_SB(1, 0), b3, voffB);
            PG8_BAR; PG8_WAIT_L(0); PG8_MMA(0, 1, At, B1); PG8_BAR;
            PG8_LDA(At, 1, 1); PG8_STAGE(PG8_SA(1, 0), a3, voffA);
            PG8_BAR; PG8_WAIT_L(0); PG8_MMA(1, 0, At, B0); PG8_BAR; PG8_SCHED;
            PG8_STAGE(PG8_SB(1, 1), b3 + hstepB, voffB);
            PG8_WAIT_V(6); PG8_BAR; PG8_MMA(1, 1, At, B1); PG8_BAR;
            }
        }
        if constexpr (ALIGN_EPI) { if (wr == 0) PG8_BAR; }
        if constexpr (!Epi::AFTER_DRAIN) { E(acc, cur, wr, wc, fr, fq); S.done(cur); }
        if (!has_next) break;
#pragma unroll
        for (int a = 0; a < 2; ++a)
#pragma unroll
            for (int b = 0; b < 2; ++b)
#pragma unroll
                for (int m = 0; m < 4; ++m)
#pragma unroll
                    for (int n = 0; n < 2; ++n) acc[a][b][m][n] = (f32x4){0.f, 0.f, 0.f, 0.f};
        cur = nxt; cA = nA; cB = nB; ++ui;
        if constexpr (ALIGN_EPI) { if (wr == 1) PG8_BAR; }
    }
    PG8_WAIT_V(0);
    if constexpr (!ALIGN_EPI) { if (wr == 0) PG8_BAR; }
    PG8_BAR;
    if constexpr (Epi::AFTER_DRAIN) { E.fused(acc, cur, wr, wc, fr, fq, lds, wid, lane); S.done(cur); }
#undef PG8_SA
#undef PG8_SB
#undef PG8_STAGE
#undef PG8_LDA
#undef PG8_LDB
#undef PG8_MMA
#undef PG8_WAIT_V
#undef PG8_WAIT_L
#undef PG8_BAR
#undef PG8_SCHED
}
}

#define LAS __attribute__((address_space(3)))
using pg8::bf16_t; using pg8::bf16x8; using pg8::f32x4; using pg8::u32x4;
typedef float f32x2 __attribute__((ext_vector_type(2)));
typedef unsigned u32x2 __attribute__((ext_vector_type(2)));
typedef short v4i16 __attribute__((ext_vector_type(4)));

constexpr int MP = 16384, MS = 512, M = MP + MS, D = 1024, DIN = 5888, F2 = 6144, DFF = 3072, TSEQ = 4096;
constexpr int C_QA = 0, C_KA = 512, C_VA = 640, C_QR = 768, C_KR = 1280, C_VR = 1792, C_GATE = 2816, C_GMA = 3840, C_GMR = 4864;
constexpr float EPS = 1e-6f;
constexpr int NTHREADS = 512, NWAVES = 8;
constexpr int LDS_BYTES = 147456;

constexpr size_t MiB = 1u << 20;
constexpr size_t WS_TABA = 0, WS_TABR = 512 * 1024;
constexpr size_t WS_WIN = 3 * MiB;
constexpr size_t WS_WUP = WS_WIN + (size_t)DIN * D * 2;
constexpr size_t WS_WDN = WS_WUP + (size_t)F2 * D * 2;
constexpr size_t WS_XN = WS_WDN + (size_t)D * DFF * 2;
constexpr size_t WS_R1 = WS_XN + (size_t)M * D * 2;
constexpr size_t R1_G = 0, R1_F = (size_t)M * DFF * 2, R1_UH = R1_F + (size_t)M * D * 2, R1_US = R1_UH + (size_t)264 * 4 * F2 * 2, R1_X1 = R1_US + (size_t)MS * F2 * 2, R1_END = R1_X1 + (size_t)M * D * 2;
static_assert(R1_END <= (size_t)M * DIN * 2, "R1 overlay");
static_assert(WS_R1 + (size_t)M * DIN * 2 <= 256 * MiB, "ws map");
constexpr size_t O_Y = 0, O_KP = (size_t)M * D, O_VP = O_KP + 65536, O_RP = O_VP + 65536, O_CP = O_RP + 524288, O_KS = O_CP + 49152, O_VS = O_KS + 2097152, O_RS = O_VS + 2097152, O_CS = O_RS + 16777216, O_END = O_CS + 1572864;

struct Args {
    const float *x_prompt, *x_sample, *cache_k, *cache_v, *state_ret, *state_conv, *w_in, *sinks, *w_a, *w_r, *w_o, *g_pre_mix, *g_post_mix, *g_pre_ffn, *g_post_ffn, *w_up, *conv_w, *conv_b, *w_down;
    float* out; unsigned char* ws; int ph_lo, ph_hi;
};

__device__ __forceinline__ float bf2f(bf16_t h) { return __uint_as_float((unsigned)h << 16); }
__device__ __forceinline__ float bflo(unsigned w) { return __uint_as_float(w << 16); }
__device__ __forceinline__ float bfhi(unsigned w) { return __uint_as_float(w & 0xffff0000u); }
__device__ __forceinline__ unsigned pk2(float lo, float hi) { return pg8::cvt_pk_bf16(lo, hi); }
__device__ __forceinline__ float wave_sum(float v) {
#pragma unroll
    for (int o = 1; o < 64; o <<= 1) v += __shfl_xor(v, o);
    return v;
}
__device__ __forceinline__ float wave_max(float v) {
#pragma unroll
    for (int o = 1; o < 64; o <<= 1) v = fmaxf(v, __shfl_xor(v, o));
    return v;
}
__device__ __forceinline__ float ret_log2g(int h) { return log2f(1.0f - exp2f(-5.0f - (float)h)); }
__device__ __forceinline__ bf16x8 tr_pair(const LAS unsigned char* p0, const LAS unsigned char* p1) {
    const v4i16 a = __builtin_amdgcn_ds_read_tr16_b64_v4i16((LAS v4i16*)p0), b = __builtin_amdgcn_ds_read_tr16_b64_v4i16((LAS v4i16*)p1);
    return (bf16x8){a[0], a[1], a[2], a[3], b[0], b[1], b[2], b[3]};
}
__device__ __forceinline__ bf16x8 cat8(u32x2 a, u32x2 b) { const u32x4 w = {a.x, a.y, b.x, b.y}; return __builtin_bit_cast(bf16x8, w); }

__device__ __forceinline__ void p0_transpose_item(const float* W, int K, int N, bf16_t* WT, int k0, int n0, int drow0, LAS float* scr, int lane) {
#pragma unroll 8
    for (int i = 0; i < 32; ++i) { const int kk = 2 * i + (lane >> 5); scr[kk * 33 + (lane & 31)] = W[(size_t)(k0 + kk) * N + n0 + (lane & 31)]; }
    asm volatile("s_waitcnt lgkmcnt(0)" ::: "memory");
    const int c = lane & 7;
#pragma unroll
    for (int j = 0; j < 4; ++j) { const int n = (lane >> 3) + 8 * j; const LAS float* s = scr + (8 * c) * 33 + n;
        u32x4 o; o.x = pk2(s[0 * 33], s[1 * 33]); o.y = pk2(s[2 * 33], s[3 * 33]); o.z = pk2(s[4 * 33], s[5 * 33]); o.w = pk2(s[6 * 33], s[7 * 33]);
        *(u32x4*)(WT + (size_t)(drow0 + n) * K + k0 + 8 * c) = o; }
    asm volatile("s_waitcnt lgkmcnt(0)" ::: "memory");
}
__device__ __forceinline__ void rms_row_to_bf16(const float* xrow, const float* g, bf16_t* orow, int lane) {
    f32x4 v[4]; float s = 0.f;
#pragma unroll
    for (int j = 0; j < 4; ++j) { v[j] = *((const f32x4*)xrow + lane + 64 * j); s += (v[j].x * v[j].x + v[j].y * v[j].y) + (v[j].z * v[j].z + v[j].w * v[j].w); }
    const float rstd = rsqrtf(wave_sum(s) * (1.f / D) + EPS);
#pragma unroll
    for (int j = 0; j < 4; ++j) { const f32x4 gg = *((const f32x4*)g + lane + 64 * j);
        u32x2 w; w.x = pk2(v[j].x * rstd * gg.x, v[j].y * rstd * gg.y); w.y = pk2(v[j].z * rstd * gg.z, v[j].w * rstd * gg.w);
        *((u32x2*)orow + lane + 64 * j) = w; }
}
__device__ __forceinline__ void p0_prologue(const Args& a, LAS unsigned char* lds, int tid, int lane, int wave) {
    unsigned char* ws = a.ws;
    LAS float* scr = (LAS float*)(lds + wave * 16384);
    const int gw = blockIdx.x * NWAVES + wave, NGW = gridDim.x * NWAVES;
    bf16_t* WinT = (bf16_t*)(ws + WS_WIN); bf16_t* WupT = (bf16_t*)(ws + WS_WUP); bf16_t* WdnT = (bf16_t*)(ws + WS_WDN);
    bf16_t* WoT = (bf16_t*)(a.out + O_CS); bf16_t* WaT = WoT + 1024 * 1024; bf16_t* WrT = WaT + 1024 * 512;
    constexpr int I_IN = 16 * (DIN / 32), I_A = 8 * 32, I_R = 16 * 32, I_O = 16 * 32, I_UP = 16 * (F2 / 32), I_DN = 48 * 32;
    constexpr int NITEMS = I_IN + I_A + I_R + I_O + I_UP + I_DN;
    for (int it = gw; it < NITEMS; it += NGW) {
        int r = it;
        if (r < I_IN) { const int nb = r % (DIN / 32), kb = r / (DIN / 32); p0_transpose_item(a.w_in, D, DIN, WinT, 64 * kb, 32 * nb, 32 * nb, scr, lane); continue; } r -= I_IN;
        if (r < I_A) { const int nb = r % 32, kb = r / 32; p0_transpose_item(a.w_a, 512, D, WaT, 64 * kb, 32 * nb, 32 * nb, scr, lane); continue; } r -= I_A;
        if (r < I_R) { const int nb = r % 32, kb = r / 32; p0_transpose_item(a.w_r, D, D, WrT, 64 * kb, 32 * nb, 32 * nb, scr, lane); continue; } r -= I_R;
        if (r < I_O) { const int nb = r % 32, kb = r / 32; p0_transpose_item(a.w_o, D, D, WoT, 64 * kb, 32 * nb, 32 * nb, scr, lane); continue; } r -= I_O;
        if (r < I_UP) { const int nb = r % (F2 / 32), kb = r / (F2 / 32); const int n0 = 32 * nb;
            const int drow = n0 < DFF ? (n0 / 128) * 256 + (n0 % 128) : ((n0 - DFF) / 128) * 256 + 128 + ((n0 - DFF) % 128);
            p0_transpose_item(a.w_up, D, F2, WupT, 64 * kb, n0, drow, scr, lane); continue; } r -= I_UP;
        { const int nb = r % 32, kb = r / 32; p0_transpose_item(a.w_down, DFF, D, WdnT, 64 * kb, 32 * nb, 32 * nb, scr, lane); }
    }
    bf16_t* XN = (bf16_t*)(ws + WS_XN);
    for (int m = gw; m < M; m += NGW) { const float* xr = m < MP ? a.x_prompt + (size_t)m * D : a.x_sample + (size_t)(m - MP) * D; rms_row_to_bf16(xr, a.g_pre_mix, XN + (size_t)m * D, lane); }
    f32x2* tabA = (f32x2*)(ws + WS_TABA); f32x2* tabR = (f32x2*)(ws + WS_TABR);
    __syncthreads();
    LAS float* invs = (LAS float*)lds;
    if (tid < 72) invs[tid] = tid < 8 ? (float)(1.0 / pow(500000.0, (double)((float)tid / 8.0f))) : (float)(1.0 / pow(10000.0, (double)((float)(tid - 8) / 63.0f)));
    __syncthreads();
    const int gt = blockIdx.x * NTHREADS + tid, NGT = gridDim.x * NTHREADS;
    for (int e = gt; e < 4100 * 72; e += NGT) {
        const int tp = e / 72, i = e % 72; const int pos = tp < 4096 ? tp : 16384 + (tp - 4096);
        const float ang = (float)pos * invs[i];
        const double rev = (double)ang * 0.15915494309189535; const float fr = (float)(rev - rint(rev));
        const f32x2 cs = {__builtin_amdgcn_cosf(fr), __builtin_amdgcn_sinf(fr)};
        if (i < 8) tabA[tp * 8 + i] = cs; else tabR[tp * 64 + (i - 8)] = cs;
    }
}

__device__ __forceinline__ void attn_prompt_unit(bf16_t* H, const float* sinks, LAS unsigned char* lds, int b, int qb, int g, int tid, int lane, int wave) {
    const int fr = lane & 15, fq = lane >> 4;
    const size_t rowbase = (size_t)b * TSEQ + (size_t)qb * 128;
    LAS unsigned char* Kimg = lds; LAS unsigned char* Vimg = lds + 36864;
#pragma unroll
    for (int i = 0; i < 4; ++i) {
        const int id = tid + NTHREADS * i, kidx = id >> 3, ch = id & 7;
        u32x4 kv = {0u, 0u, 0u, 0u}, vv = {0u, 0u, 0u, 0u};
        if (qb > 0 || kidx >= 128) { const bf16_t* src = H + (rowbase - 128 + kidx) * DIN; kv = *(const u32x4*)(src + C_KA + g * 64 + ch * 8); vv = *(const u32x4*)(src + C_VA + g * 64 + ch * 8); }
        *(LAS u32x4*)(Kimg + kidx * 144 + ch * 16) = kv; *(LAS u32x4*)(Vimg + kidx * 144 + ch * 16) = vv;
    }
    const size_t qrow = rowbase + 16 * wave + fr;
    __syncthreads();
    const int qi = 16 * wave + fr; const int tq = (lane & 15) >> 2, tpp = lane & 3;
#pragma nounroll
    for (int hh = 0; hh < 4; ++hh) {
        const int head = 4 * g + hh;
        bf16x8 qf[1][2];
#pragma unroll
        for (int ks = 0; ks < 2; ++ks) qf[0][ks] = *(const bf16x8*)(H + qrow * DIN + C_QA + head * 64 + 32 * ks + 8 * fq);
        f32x4 s[10];
#pragma unroll
        for (int nn = 0; nn < 9; ++nn) {
            s[nn] = (f32x4){0.f, 0.f, 0.f, 0.f};
            const int krow = 16 * (wave + nn) + fr;
#pragma unroll
            for (int ks = 0; ks < 2; ++ks) { const bf16x8 kf = *(const LAS bf16x8*)(Kimg + krow * 144 + (32 * ks + 8 * fq) * 2); s[nn] = __builtin_amdgcn_mfma_f32_16x16x32_bf16(kf, qf[0][ks], s[nn], 0, 0, 0); }
        }
        s[9] = (f32x4){0.f, 0.f, 0.f, 0.f};
        const float sink = sinks[head];
        float mx = sink;
#pragma unroll
        for (int nn = 0; nn < 9; ++nn)
#pragma unroll
            for (int r = 0; r < 4; ++r) { const int kidx = 16 * (wave + nn) + 4 * fq + r; const bool valid = (kidx > qi) && (kidx <= qi + 128) && (qb > 0 || kidx >= 128);
                s[nn][r] = valid ? s[nn][r] : -1e30f; mx = fmaxf(mx, s[nn][r]); }
        mx = fmaxf(mx, __shfl_xor(mx, 16)); mx = fmaxf(mx, __shfl_xor(mx, 32));
        float sum = 0.f;
#pragma unroll
        for (int nn = 0; nn < 9; ++nn)
#pragma unroll
            for (int r = 0; r < 4; ++r) { const float p = s[nn][r] > -1e29f ? __expf(s[nn][r] - mx) : 0.f; s[nn][r] = p; sum += p; }
        sum += __shfl_xor(sum, 16); sum += __shfl_xor(sum, 32);
        sum += __expf(sink - mx);
        f32x4 o[4];
#pragma unroll
        for (int db = 0; db < 4; ++db) o[db] = (f32x4){0.f, 0.f, 0.f, 0.f};
#pragma unroll
        for (int G = 0; G < 5; ++G) {
            const u32x4 pw = {pk2(s[2 * G][0], s[2 * G][1]), pk2(s[2 * G][2], s[2 * G][3]), pk2(s[2 * G + 1][0], s[2 * G + 1][1]), pk2(s[2 * G + 1][2], s[2 * G + 1][3])};
            const bf16x8 pf = __builtin_bit_cast(bf16x8, pw);
            int k0 = 16 * (wave + 2 * G) + 4 * fq + tq, k1 = k0 + 16; k0 = k0 > 255 ? 255 : k0; k1 = k1 > 255 ? 255 : k1;
#pragma unroll
            for (int db = 0; db < 4; ++db) {
                const bf16x8 vf = tr_pair(Vimg + k0 * 144 + (16 * db + 4 * tpp) * 2, Vimg + k1 * 144 + (16 * db + 4 * tpp) * 2);
                o[db] = __builtin_amdgcn_mfma_f32_16x16x32_bf16(vf, pf, o[db], 0, 0, 0);
            }
        }
        const float inv = 1.0f / sum;
#pragma unroll
        for (int db = 0; db < 4; ++db) { u32x2 w; w.x = pk2(o[db][0] * inv, o[db][1] * inv); w.y = pk2(o[db][2] * inv, o[db][3] * inv);
            *(u32x2*)(H + qrow * DIN + C_QA + head * 64 + 16 * db + 4 * fq) = w; }
    }
    __syncthreads();
}

__device__ __forceinline__ void attn_sample_unit(const Args& a, bf16_t* H, LAS unsigned char* lds, int b, int g, int tid, int lane, int wave) {
    const int head = 4 * g + (wave & 3), t0 = 2 * (wave >> 2); const size_t r0 = (size_t)MP + 4 * b;
    LAS float* qs = (LAS float*)(lds + wave * 4096); LAS float* ps = qs + 128;
#pragma unroll
    for (int tt = 0; tt < 2; ++tt) qs[tt * 64 + lane] = bf2f(H[(r0 + t0 + tt) * DIN + C_QA + head * 64 + lane]);
    asm volatile("s_waitcnt lgkmcnt(0)" ::: "memory");
    float sc[3][2];
#pragma unroll
    for (int kk = 0; kk < 2; ++kk) {
        const float* kp = a.cache_k + ((size_t)(b * 128 + lane + 64 * kk) * 2 + g) * 64;
        float acc0 = 0.f, acc1 = 0.f;
#pragma nounroll
        for (int hf = 0; hf < 2; ++hf) {
            f32x4 kv[8];
#pragma unroll
            for (int d4 = 0; d4 < 8; ++d4) kv[d4] = *(const f32x4*)(kp + 32 * hf + 4 * d4);
#pragma unroll
            for (int d4 = 0; d4 < 8; ++d4)
#pragma unroll
                for (int e = 0; e < 4; ++e) { const float kx = kv[d4][e]; acc0 += qs[32 * hf + 4 * d4 + e] * kx; acc1 += qs[64 + 32 * hf + 4 * d4 + e] * kx; }
            asm volatile("" ::: "memory");
        }
        sc[kk][0] = acc0; sc[kk][1] = acc1;
    }
    {
        const int tn = lane & 3; const bf16_t* kp = H + (r0 + tn) * DIN + C_KA + g * 64;
        float acc0 = 0.f, acc1 = 0.f;
#pragma nounroll
        for (int hf = 0; hf < 2; ++hf) {
            u32x4 kw[4];
#pragma unroll
            for (int c8 = 0; c8 < 4; ++c8) kw[c8] = *(const u32x4*)(kp + 32 * hf + 8 * c8);
#pragma unroll
            for (int c8 = 0; c8 < 4; ++c8)
#pragma unroll
                for (int q = 0; q < 4; ++q) { const float k0 = bflo(kw[c8][q]), k1 = bfhi(kw[c8][q]); const int d = 32 * hf + 8 * c8 + 2 * q;
                    acc0 += qs[d] * k0 + qs[d + 1] * k1; acc1 += qs[64 + d] * k0 + qs[64 + d + 1] * k1; }
        }
        sc[2][0] = acc0; sc[2][1] = acc1;
    }
    const float sink = a.sinks[head];
    float inv[2];
#pragma unroll
    for (int tt = 0; tt < 2; ++tt) {
        const int t = t0 + tt;
        const bool v0 = lane > t, v2 = (lane < 4) && (lane <= t);
        const float s0 = v0 ? sc[0][tt] : -1e30f, s1 = sc[1][tt], s2 = v2 ? sc[2][tt] : -1e30f;
        const float mx = fmaxf(wave_max(fmaxf(fmaxf(s0, s1), s2)), sink);
        const float p0 = v0 ? __expf(s0 - mx) : 0.f, p1 = __expf(s1 - mx), p2 = v2 ? __expf(s2 - mx) : 0.f;
        const float sum = wave_sum(p0 + p1 + p2) + __expf(sink - mx);
        inv[tt] = 1.0f / sum;
        ps[tt * 136 + lane] = p0; ps[tt * 136 + 64 + lane] = p1; if (lane < 4) ps[tt * 136 + 128 + lane] = p2;
    }
    asm volatile("s_waitcnt lgkmcnt(0)" ::: "memory");
    float o0 = 0.f, o1 = 0.f;
    const float* vp = a.cache_v + ((size_t)(b * 128) * 2 + g) * 64 + lane;
#pragma unroll 16
    for (int r = 0; r < 128; ++r) { const float vx = vp[(size_t)r * 128]; o0 += ps[r] * vx; o1 += ps[136 + r] * vx; }
#pragma unroll
    for (int tn = 0; tn < 4; ++tn) { const float vx = bf2f(H[(r0 + tn) * DIN + C_VA + g * 64 + lane]); o0 += ps[128 + tn] * vx; o1 += ps[136 + 128 + tn] * vx; }
    H[(r0 + t0) * DIN + C_QA + head * 64 + lane] = (bf16_t)(pk2(o0 * inv[0], 0.f) & 0xffffu);
    H[(r0 + t0 + 1) * DIN + C_QA + head * 64 + lane] = (bf16_t)(pk2(o1 * inv[1], 0.f) & 0xffffu);
    float* ko = a.out + O_KS + (size_t)b * 128 * 128 + g * 64; float* vo = a.out + O_VS + (size_t)b * 128 * 128 + g * 64;
    const float* ki = a.cache_k + (size_t)b * 128 * 128 + 4 * 128 + g * 64; const float* vi = a.cache_v + (size_t)b * 128 * 128 + 4 * 128 + g * 64;
    for (int i = tid; i < 124 * 16; i += NTHREADS) { const int r = i >> 4, c4 = i & 15; *(f32x4*)(ko + (size_t)r * 128 + 4 * c4) = *(const f32x4*)(ki + (size_t)r * 128 + 4 * c4); *(f32x4*)(vo + (size_t)r * 128 + 4 * c4) = *(const f32x4*)(vi + (size_t)r * 128 + 4 * c4); }
    if (tid < 256) { const int t = tid >> 6, d = tid & 63;
      ko[(size_t)(124 + t) * 128 + d] = bf2f(H[(r0 + t) * DIN + C_KA + g * 64 + d]); vo[(size_t)(124 + t) * 128 + d] = bf2f(H[(r0 + t) * DIN + C_VA + g * 64 + d]); }
}

__device__ __forceinline__ void ret_u_unit(const bf16_t* H, bf16_t* ST, LAS unsigned char* lds, int b, int c, int h, int tid, int lane, int wave) {
    const size_t rowc = (size_t)b * TSEQ + (size_t)c * 128; const float l2g = ret_log2g(h);
    LAS unsigned char* Kimg = lds; LAS unsigned char* Vimg = lds + 36864;
#pragma unroll
    for (int i = 0; i < 4; ++i) { const int id = tid + NTHREADS * i, j = id >> 4, ch = id & 15;
        const u32x4 kv = *(const u32x4*)(H + (rowc + j) * DIN + C_KR + h * 128 + ch * 8); const float kd = exp2f(l2g * (float)(127 - j));
        u32x4 w; w.x = pk2(bflo(kv.x) * kd, bfhi(kv.x) * kd); w.y = pk2(bflo(kv.y) * kd, bfhi(kv.y) * kd); w.z = pk2(bflo(kv.z) * kd, bfhi(kv.z) * kd); w.w = pk2(bflo(kv.w) * kd, bfhi(kv.w) * kd);
        *(LAS u32x4*)(Kimg + j * 288 + ch * 16) = w; }
#pragma unroll
    for (int i = 0; i < 8; ++i) { const int id = tid + NTHREADS * i, j = id >> 5, ch = id & 31;
        *(LAS u32x4*)(Vimg + j * 544 + ch * 16) = *(const u32x4*)(H + (rowc + j) * DIN + C_VR + h * 256 + ch * 8); }
    __syncthreads();
    const int fr = lane & 15, fq = lane >> 4, tq = fr >> 2, tpp = lane & 3;
    f32x4 acc[2][8];
#pragma unroll
    for (int i = 0; i < 2; ++i)
#pragma unroll
        for (int j = 0; j < 8; ++j) acc[i][j] = (f32x4){0.f, 0.f, 0.f, 0.f};
#pragma unroll
    for (int ks = 0; ks < 4; ++ks) {
        const int j0 = 32 * ks + 4 * fq + tq, j1 = j0 + 16;
        bf16x8 vf[2];
#pragma unroll
        for (int i = 0; i < 2; ++i) { const int col = 16 * (2 * wave + i) + 4 * tpp; vf[i] = tr_pair(Vimg + j0 * 544 + col * 2, Vimg + j1 * 544 + col * 2); }
#pragma unroll
        for (int kb = 0; kb < 8; ++kb) { const int col = 16 * kb + 4 * tpp; const bf16x8 kf = tr_pair(Kimg + j0 * 288 + col * 2, Kimg + j1 * 288 + col * 2);
#pragma unroll
            for (int i = 0; i < 2; ++i) acc[i][kb] = __builtin_amdgcn_mfma_f32_16x16x32_bf16(vf[i], kf, acc[i][kb], 0, 0, 0); }
    }
    bf16_t* U = ST + ((size_t)(b * 32 + c) * 4 + h) * 32768;
#pragma unroll
    for (int i = 0; i < 2; ++i)
#pragma unroll
        for (int kb = 0; kb < 8; ++kb) { u32x2 w; w.x = pk2(acc[i][kb][0], acc[i][kb][1]); w.y = pk2(acc[i][kb][2], acc[i][kb][3]); *(u32x2*)(U + (size_t)(16 * kb + fr) * 256 + 16 * (2 * wave + i) + 4 * fq) = w; }
    __syncthreads();
}

__device__ __forceinline__ void ret_sample_unit(const Args& a, bf16_t* H, LAS unsigned char* lds, int b, int h, int tid, int lane, int wave) {
    const size_t r0 = (size_t)MP + 4 * b; const float g = 1.0f - exp2f(-5.0f - (float)h);
    LAS float* qs = (LAS float*)lds; LAS float* ks = qs + 512; LAS float* po = ks + 512; LAS float* red = po + 2048;
    const int dv = tid & 255, half = tid >> 8;
    for (int i = tid; i < 1024; i += NTHREADS) { const int which = i >> 9, t = (i >> 7) & 3, d = i & 127;
        const float v = bf2f(H[(r0 + t) * DIN + (which ? C_KR : C_QR) + h * 128 + d]); if (which) ks[t * 128 + d] = v; else qs[t * 128 + d] = v; }
    float vt[4], gt[4];
#pragma unroll
    for (int t = 0; t < 4; ++t) { vt[t] = bf2f(H[(r0 + t) * DIN + C_VR + h * 256 + dv]); gt[t] = bf2f(H[(r0 + t) * DIN + C_GATE + h * 256 + dv]); }
    float S[64];
    const float* sp = a.state_ret + ((size_t)(b * 4 + h) * 128 + 64 * half) * 256 + dv;
#pragma unroll
    for (int d = 0; d < 64; ++d) S[d] = sp[(size_t)d * 256];
    __syncthreads();
#pragma unroll
    for (int t = 0; t < 4; ++t) { float o = 0.f;
#pragma unroll
        for (int d = 0; d < 64; ++d) { S[d] = g * S[d] + ks[t * 128 + 64 * half + d] * vt[t]; o += qs[t * 128 + 64 * half + d] * S[d]; }
        po[(half * 4 + t) * 256 + dv] = o; }
    float* so = a.out + O_RS + ((size_t)(b * 4 + h) * 128 + 64 * half) * 256 + dv;
#pragma unroll
    for (int d = 0; d < 64; ++d) so[(size_t)d * 256] = S[d];
    __syncthreads();
    float ot[4];
#pragma unroll
    for (int t = 0; t < 4; ++t) { ot[t] = po[t * 256 + dv] + po[(4 + t) * 256 + dv]; const float sq = wave_sum(half == 0 ? ot[t] * ot[t] : 0.f); if (lane == 0) red[wave * 4 + t] = sq; }
    __syncthreads();
    if (half == 0) {
#pragma unroll
        for (int t = 0; t < 4; ++t) { float ss = 0.f;
#pragma unroll
            for (int w = 0; w < 8; ++w) ss += red[w * 4 + t];
            const float rstd = rsqrtf(ss * (1.f / 256.f) + EPS); const float gv = gt[t]; const float sil = gv / (1.0f + __expf(-gv));
            H[(r0 + t) * DIN + C_VR + h * 256 + dv] = (bf16_t)(pk2(ot[t] * rstd * sil, 0.f) & 0xffffu); }
    }
    __syncthreads();
}

__device__ __forceinline__ void ret_out_unit(bf16_t* H, const bf16_t* ST, LAS unsigned char* lds, int b, int c, int h, int tid, int lane, int wave) {
    const size_t rowc = (size_t)b * TSEQ + (size_t)c * 128; const float l2g = ret_log2g(h);
    LAS unsigned char* Kimg = lds; LAS unsigned char* BIG = lds + 36864;
    const int fr = lane & 15, fq = lane >> 4, tq = fr >> 2, tpp = lane & 3;
    const int qi = 16 * wave + fr; const size_t qrow = rowc + qi;
#pragma unroll
    for (int i = 0; i < 4; ++i) { const int id = tid + NTHREADS * i, j = id >> 4, ch = id & 15;
        *(LAS u32x4*)(Kimg + j * 288 + ch * 16) = *(const u32x4*)(H + (rowc + j) * DIN + C_KR + h * 128 + ch * 8); }
    if (c > 0) {
        const bf16_t* S = ST + ((size_t)(b * 32 + c) * 4 + h) * 32768;
#pragma unroll
        for (int i = 0; i < 8; ++i) { const int id = tid + NTHREADS * i, dk = id >> 5, ch = id & 31;
            *(LAS u32x4*)(BIG + dk * 544 + ch * 16) = *(const u32x4*)(S + (size_t)dk * 256 + ch * 8); }
    }
    bf16x8 qf[4];
#pragma unroll
    for (int ks = 0; ks < 4; ++ks) { const bf16_t* qp = H + qrow * DIN + C_QR + h * 128 + 32 * ks + 4 * fq; qf[ks] = cat8(*(const u32x2*)qp, *(const u32x2*)(qp + 16)); }
    __syncthreads();
    f32x4 acc[16];
#pragma unroll
    for (int k = 0; k < 16; ++k) acc[k] = (f32x4){0.f, 0.f, 0.f, 0.f};
    if (c > 0) {
#pragma unroll
        for (int ks = 0; ks < 4; ++ks) { const int d0 = 32 * ks + 4 * fq + tq, d1 = d0 + 16;
#pragma unroll
            for (int blk = 0; blk < 16; ++blk) { const bf16x8 sf = tr_pair(BIG + d0 * 544 + (16 * blk + 4 * tpp) * 2, BIG + d1 * 544 + (16 * blk + 4 * tpp) * 2);
                acc[blk] = __builtin_amdgcn_mfma_f32_16x16x32_bf16(sf, qf[ks], acc[blk], 0, 0, 0); } }
        const float qd = exp2f(l2g * (float)(qi + 1));
#pragma unroll
        for (int blk = 0; blk < 16; ++blk) acc[blk] = acc[blk] * qd;
    }
    bf16x8 pf[4];
#pragma unroll
    for (int G = 0; G < 4; ++G) {
        f32x4 sc[2];
#pragma unroll
        for (int e = 0; e < 2; ++e) { const int jb = 2 * G + e; sc[e] = (f32x4){0.f, 0.f, 0.f, 0.f};
            if (jb <= wave) {
#pragma unroll
                for (int ks = 0; ks < 4; ++ks) { const LAS unsigned char* kp = Kimg + (16 * jb + fr) * 288 + (32 * ks + 4 * fq) * 2;
                    const bf16x8 kf = cat8(*(const LAS u32x2*)kp, *(const LAS u32x2*)(kp + 32)); sc[e] = __builtin_amdgcn_mfma_f32_16x16x32_bf16(kf, qf[ks], sc[e], 0, 0, 0); }
#pragma unroll
                for (int r = 0; r < 4; ++r) { const int j = 16 * jb + 4 * fq + r; sc[e][r] = (j <= qi) ? sc[e][r] * exp2f(l2g * (float)(qi - j)) : 0.f; }
            } }
        const u32x4 pw = {pk2(sc[0][0], sc[0][1]), pk2(sc[0][2], sc[0][3]), pk2(sc[1][0], sc[1][1]), pk2(sc[1][2], sc[1][3])};
        pf[G] = __builtin_bit_cast(bf16x8, pw);
    }
    __syncthreads();
#pragma unroll
    for (int i = 0; i < 8; ++i) { const int id = tid + NTHREADS * i, j = id >> 5, ch = id & 31;
        *(LAS u32x4*)(BIG + j * 544 + ch * 16) = *(const u32x4*)(H + (rowc + j) * DIN + C_VR + h * 256 + ch * 8); }
    __syncthreads();
#pragma unroll
    for (int G = 0; G < 4; ++G) {
        if (2 * G <= wave) { const int j0 = 32 * G + 4 * fq + tq, j1 = j0 + 16;
#pragma unroll
            for (int blk = 0; blk < 16; ++blk) { const bf16x8 vf = tr_pair(BIG + j0 * 544 + (16 * blk + 4 * tpp) * 2, BIG + j1 * 544 + (16 * blk + 4 * tpp) * 2);
                acc[blk] = __builtin_amdgcn_mfma_f32_16x16x32_bf16(vf, pf[G], acc[blk], 0, 0, 0); } }
    }
    float ss = 0.f;
#pragma unroll
    for (int blk = 0; blk < 16; ++blk) ss += (acc[blk][0] * acc[blk][0] + acc[blk][1] * acc[blk][1]) + (acc[blk][2] * acc[blk][2] + acc[blk][3] * acc[blk][3]);
    ss += __shfl_xor(ss, 16); ss += __shfl_xor(ss, 32);
    const float rstd = rsqrtf(ss * (1.f / 256.f) + EPS);
#pragma unroll
    for (int blk = 0; blk < 16; ++blk) {
        const u32x2 gw = *(const u32x2*)(H + qrow * DIN + C_GATE + h * 256 + 16 * blk + 4 * fq);
        const float g0 = bflo(gw.x), g1 = bfhi(gw.x), g2 = bflo(gw.y), g3 = bfhi(gw.y);
        u32x2 w; w.x = pk2(acc[blk][0] * rstd * g0 / (1.f + __expf(-g0)), acc[blk][1] * rstd * g1 / (1.f + __expf(-g1)));
        w.y = pk2(acc[blk][2] * rstd * g2 / (1.f + __expf(-g2)), acc[blk][3] * rstd * g3 / (1.f + __expf(-g3)));
        *(u32x2*)(H + qrow * DIN + C_VR + h * 256 + 16 * blk + 4 * fq) = w;
    }
    __syncthreads();
}

__global__ void __launch_bounds__(NTHREADS, 2) fwd_megakernel(Args a) {
    extern __shared__ __attribute__((aligned(16))) unsigned char lds_raw[];
    LAS unsigned char* lds = (LAS unsigned char*)lds_raw;
    cg::grid_group grid = cg::this_grid();
    const int tid = threadIdx.x, lane = tid & 63, wave = __builtin_amdgcn_readfirstlane(tid >> 6);
    const int nblk = gridDim.x, blk = blockIdx.x;
    unsigned char* ws = a.ws;
    bf16_t* WinT = (bf16_t*)(ws + WS_WIN); bf16_t* WupT = (bf16_t*)(ws + WS_WUP); bf16_t* WdnT = (bf16_t*)(ws + WS_WDN);
    bf16_t* WoT = (bf16_t*)(a.out + O_CS); bf16_t* WaT = WoT + 1024 * 1024; bf16_t* WrT = WaT + 1024 * 512;
    bf16_t* XN = (bf16_t*)(ws + WS_XN); bf16_t* H = (bf16_t*)(ws + WS_R1);
    bf16_t* MIXb = (bf16_t*)(ws + WS_R1);
    bf16_t* G = (bf16_t*)(ws + WS_R1 + R1_G); bf16_t* Fb = (bf16_t*)(ws + WS_R1 + R1_F); bf16_t* X1b = (bf16_t*)(ws + WS_R1 + R1_X1); bf16_t* UH = (bf16_t*)(ws + WS_R1 + R1_UH); bf16_t* US = (bf16_t*)(ws + WS_R1 + R1_US);
    bf16_t* ST = (bf16_t*)(a.out + O_Y);
    float* Y = a.out + O_Y;
    const int lo = a.ph_lo, hi = a.ph_hi;
#ifndef PROBE_REP_MASK
#define PROBE_REP_MASK 0
#endif
#define IN(k) (lo <= (k) && (k) < hi)
#define REPS(k) (((PROBE_REP_MASK >> (k)) & 1) ? 2 : 1)
#define SEAM(k) do { if (IN(k) && IN((k) + 1)) grid.sync(); } while (0)

    if (IN(0)) for (int rep_ = 0; rep_ < REPS(0); ++rep_) { p0_prologue(a, lds, tid, lane, wave); __syncthreads(); }
    SEAM(0);
    if (IN(1)) for (int rep_ = 0; rep_ < REPS(1); ++rep_) {
        pg8::Gemm g{XN, WinT, M, DIN, D, D}; pg8::StaticOrder S; S.init(M, DIN, nblk, blk);
        pg8::EpiH E{H, (const pg8::f32x2e*)(ws + WS_TABA), (const pg8::f32x2e*)(ws + WS_TABR)};
        pg8::gemm_phase<pg8::EpiH, pg8::StaticOrder, true, true>(lds, g, S, E);
    }
    SEAM(1);
    if (IN(2)) {
        for (int u = blk; u < 256; u += nblk) { const int g = u & 1, qb = (u >> 1) & 31, b = u >> 6; attn_prompt_unit(H, a.sinks, lds, b, qb, g, tid, lane, wave); }
        for (int u = blk; u < 512; u += nblk) { const int h = u & 3, c = (u >> 2) & 31, b = u >> 7; ret_u_unit(H, ST, lds, b, c, h, tid, lane, wave); }
        for (int u = blk; u < 256; u += nblk) { attn_sample_unit(a, H, lds, u >> 1, u & 1, tid, lane, wave); __syncthreads(); }
        for (int u = blk; u < 512; u += nblk) { ret_sample_unit(a, H, lds, u >> 2, u & 3, tid, lane, wave); }
        for (int e = blk * NTHREADS + tid; e < 4 * 128 * 128; e += nblk * NTHREADS) { const int gd = e & 127, r = (e >> 7) & 127, b = e >> 14; const size_t row = (size_t)b * TSEQ + TSEQ - 128 + r;
            a.out[O_KP + e] = bf2f(H[row * DIN + C_KA + gd]); a.out[O_VP + e] = bf2f(H[row * DIN + C_VA + gd]); }
    }
    SEAM(2);
    if (IN(3)) {
        for (int e4 = blk * NTHREADS + tid; e4 < 16 * 8192; e4 += nblk * NTHREADS) {
            const int bh = e4 >> 13, idx = (e4 & 8191) * 4, b = bh >> 2, h = bh & 3;
            const float gL = exp2f(128.f * ret_log2g(h));
            f32x4 S = {0.f, 0.f, 0.f, 0.f};
#pragma unroll 8
            for (int c = 0; c < 32; ++c) { bf16_t* p = ST + ((size_t)(b * 32 + c) * 4 + h) * 32768 + idx; const u32x2 uw = *(const u32x2*)p; u32x2 sw; sw.x = pk2(S.x, S.y); sw.y = pk2(S.z, S.w); *(u32x2*)p = sw;
                const f32x4 uu = {bflo(uw.x), bfhi(uw.x), bflo(uw.y), bfhi(uw.y)}; S = S * gL + uu; }
            *(f32x4*)(a.out + O_RP + (size_t)bh * 32768 + idx) = S;
        }
    }
    SEAM(3);
    if (IN(4)) {
        for (int u = blk; u < 512; u += nblk) { const int h = u & 3, c = (u >> 2) & 31, b = u >> 7; ret_out_unit(H, ST, lds, b, c, h, tid, lane, wave); }
    }
    SEAM(4);
    if (IN(5)) for (int rep_ = 0; rep_ < REPS(5); ++rep_) {
        { pg8::Gemm g{H + C_QA, WaT, M, D, 512, DIN}; pg8::StaticOrder S; S.init(M, D, nblk, blk);
          pg8::EpiGate<false> E{XN, H + C_GMA, DIN}; pg8::gemm_phase<pg8::EpiGate<false>, pg8::StaticOrder, true, true>(lds, g, S, E); }
        __syncthreads();
        { pg8::Gemm g{H + C_VR, WrT, M, D, D, DIN}; pg8::StaticOrder S; S.init(M, D, nblk, blk);
          pg8::EpiGate<true> E{XN, H + C_GMR, DIN}; pg8::gemm_phase<pg8::EpiGate<true>, pg8::StaticOrder, true, true>(lds, g, S, E); }
    }
    SEAM(5);
    if (IN(6)) for (int rep_ = 0; rep_ < REPS(6); ++rep_) {
        pg8::Gemm g{XN, WoT, M, D, D, D}; pg8::StaticOrder S; S.init(M, D, nblk, blk);
        pg8::EpiBf16<0> E{MIXb, D, nullptr, 0, 0, 1.f}; pg8::gemm_phase<pg8::EpiBf16<0>, pg8::StaticOrder, true, true>(lds, g, S, E);
    }
    SEAM(6);
    if (IN(7)) {
        f32x4 gpm[2][2], gpf[2][2];
#pragma unroll
        for (int j = 0; j < 2; ++j)
#pragma unroll
            for (int e = 0; e < 2; ++e) { gpm[j][e] = *((const f32x4*)a.g_post_mix + 2 * (lane + 64 * j) + e); gpf[j][e] = *((const f32x4*)a.g_pre_ffn + 2 * (lane + 64 * j) + e); }
        for (int p = blk * NWAVES + wave; p < M / 2; p += nblk * NWAVES) {
            u32x4 mb[2][2]; f32x4 xx[2][2][2];
#pragma unroll
            for (int rr = 0; rr < 2; ++rr) { const int m = 2 * p + rr; const float* xr = m < MP ? a.x_prompt + (size_t)m * D : a.x_sample + (size_t)(m - MP) * D;
#pragma unroll
                for (int j = 0; j < 2; ++j) { mb[rr][j] = *((const u32x4*)(MIXb + (size_t)m * D) + lane + 64 * j); xx[rr][j][0] = *((const f32x4*)xr + 2 * (lane + 64 * j)); xx[rr][j][1] = *((const f32x4*)xr + 2 * (lane + 64 * j) + 1); } }
            float mv[2][2][8]; float ss[2];
#pragma unroll
            for (int rr = 0; rr < 2; ++rr) { ss[rr] = 0.f;
#pragma unroll
                for (int j = 0; j < 2; ++j)
#pragma unroll
                    for (int q = 0; q < 4; ++q) { const unsigned w = mb[rr][j][q]; mv[rr][j][2 * q] = bflo(w); mv[rr][j][2 * q + 1] = bfhi(w); ss[rr] += mv[rr][j][2 * q] * mv[rr][j][2 * q] + mv[rr][j][2 * q + 1] * mv[rr][j][2 * q + 1]; } }
            ss[0] = wave_sum(ss[0]); ss[1] = wave_sum(ss[1]);
            float s2[2];
#pragma unroll
            for (int rr = 0; rr < 2; ++rr) { const float rstd = rsqrtf(ss[rr] * (1.f / D) + EPS); s2[rr] = 0.f;
#pragma unroll
                for (int j = 0; j < 2; ++j)
#pragma unroll
                    for (int q = 0; q < 8; ++q) { const float x1 = xx[rr][j][q >> 2][q & 3] + mv[rr][j][q] * rstd * gpm[j][q >> 2][q & 3]; mv[rr][j][q] = x1; s2[rr] += x1 * x1; } }
            s2[0] = wave_sum(s2[0]); s2[1] = wave_sum(s2[1]);
#pragma unroll
            for (int rr = 0; rr < 2; ++rr) { const int m = 2 * p + rr; const float rstd2 = rsqrtf(s2[rr] * (1.f / D) + EPS);
#pragma unroll
                for (int j = 0; j < 2; ++j) { u32x4 w1, w2;
#pragma unroll
                    for (int q = 0; q < 4; ++q) { const float a0 = mv[rr][j][2 * q], a1 = mv[rr][j][2 * q + 1]; w1[q] = pk2(a0, a1);
                        w2[q] = pk2(a0 * rstd2 * gpf[j][(2 * q) >> 2][(2 * q) & 3], a1 * rstd2 * gpf[j][(2 * q + 1) >> 2][(2 * q + 1) & 3]); }
                    *((u32x4*)(X1b + (size_t)m * D) + lane + 64 * j) = w1; *((u32x4*)(XN + (size_t)m * D) + lane + 64 * j) = w2; } }
        }
    }
    SEAM(7);
    if (IN(8)) for (int rep_ = 0; rep_ < REPS(8); ++rep_) {
        pg8::Gemm g{XN, WupT, M, F2, D, D}; pg8::StaticOrder S; S.init(M, F2, nblk, blk);
        pg8::EpiUp E{G, UH, US, a.out + O_CP, a.out + O_CS, a.conv_w, a.conv_b};
        pg8::gemm_phase<pg8::EpiUp, pg8::StaticOrder, true, true>(lds, g, S, E);
    }
    SEAM(8);
    if (IN(9)) for (int rep_ = 0; rep_ < REPS(9); ++rep_) {
        for (int task = blk * NWAVES + wave; task < 1024 * 6; task += nblk * NWAVES) {
            const int rt = task / 6, chunk = task % 6; const int ch = chunk * 512 + lane * 8;
            float ua[3][8], ub[3][8];
            int row;
#define LD8BF(dst, ptr) do { const u32x4 _w = *(const u32x4*)(ptr); dst[0] = bflo(_w.x); dst[1] = bfhi(_w.x); dst[2] = bflo(_w.y); dst[3] = bfhi(_w.y); dst[4] = bflo(_w.z); dst[5] = bfhi(_w.z); dst[6] = bflo(_w.w); dst[7] = bfhi(_w.w); } while (0)
#define LD8F(dst, ptr) do { const f32x4 _a = *(const f32x4*)(ptr), _b = *(const f32x4*)((ptr) + 4); dst[0] = _a.x; dst[1] = _a.y; dst[2] = _a.z; dst[3] = _a.w; dst[4] = _b.x; dst[5] = _b.y; dst[6] = _b.z; dst[7] = _b.w; } while (0)
#define ZERO8(dst) do { _Pragma("unroll") for (int _i = 0; _i < 8; ++_i) dst[_i] = 0.f; } while (0)
            if (rt < 512) {
                const int grp = rt >> 1, k = rt & 1; row = grp * 64 + k; const int t = row & 4095;
                const bf16_t* u0 = UH + (size_t)(grp * 4 + 2 + k) * F2;
                LD8BF(ua[2], u0 + ch); LD8BF(ub[2], u0 + DFF + ch);
                if (t >= 1) { const bf16_t* u1 = (k == 0) ? UH + (size_t)((grp - 1) * 4 + 1) * F2 : UH + (size_t)(grp * 4 + 2) * F2; LD8BF(ua[1], u1 + ch); LD8BF(ub[1], u1 + DFF + ch); } else { ZERO8(ua[1]); ZERO8(ub[1]); }
                if (t >= 2) { const bf16_t* u2 = UH + (size_t)((grp - 1) * 4 + k) * F2; LD8BF(ua[0], u2 + ch); LD8BF(ub[0], u2 + DFF + ch); } else { ZERO8(ua[0]); ZERO8(ub[0]); }
            } else {
                const int sr = rt - 512, b = sr >> 2, t = sr & 3; row = MP + sr;
#pragma unroll
                for (int tap = 0; tap < 3; ++tap) { const int e = t + tap;
                    if (e < 2) { const float* cp = a.state_conv + ((size_t)b * 2 + e) * F2; LD8F(ua[tap], cp + ch); LD8F(ub[tap], cp + DFF + ch); }
                    else { const bf16_t* up = US + (size_t)(b * 4 + e - 2) * F2; LD8BF(ua[tap], up + ch); LD8BF(ub[tap], up + DFF + ch); } }
            }
            float wa[3][8], wb[3][8], ba[8], bb[8];
#pragma unroll
            for (int tap = 0; tap < 3; ++tap) { LD8F(wa[tap], a.conv_w + (size_t)tap * F2 + ch); LD8F(wb[tap], a.conv_w + (size_t)tap * F2 + DFF + ch); }
            LD8F(ba, a.conv_b + ch); LD8F(bb, a.conv_b + DFF + ch);
            float gg[8];
#pragma unroll
            for (int i = 0; i < 8; ++i) { const float ca = ba[i] + wa[0][i] * ua[0][i] + wa[1][i] * ua[1][i] + wa[2][i] * ua[2][i], cb = bb[i] + wb[0][i] * ub[0][i] + wb[1][i] * ub[1][i] + wb[2][i] * ub[2][i];
                gg[i] = pg8::gelu_tanh(ca) * cb; }
            u32x4 w; w.x = pk2(gg[0], gg[1]); w.y = pk2(gg[2], gg[3]); w.z = pk2(gg[4], gg[5]); w.w = pk2(gg[6], gg[7]);
            *(u32x4*)(G + (size_t)row * DFF + ch) = w;
        }
    }
    SEAM(9);
    if (IN(10)) for (int rep_ = 0; rep_ < REPS(10); ++rep_) {
        pg8::Gemm g{G, WdnT, M, D, DFF, DFF}; pg8::StaticOrder S; S.init(M, D, nblk, blk);
        pg8::EpiBf16<0> E{Fb, D, nullptr, 0, 0, 1.f}; pg8::gemm_phase<pg8::EpiBf16<0>, pg8::StaticOrder, true, true>(lds, g, S, E);
    }
    SEAM(10);
    if (IN(11)) {
        f32x4 gpo[2][2];
#pragma unroll
        for (int j = 0; j < 2; ++j)
#pragma unroll
            for (int e = 0; e < 2; ++e) gpo[j][e] = *((const f32x4*)a.g_post_ffn + 2 * (lane + 64 * j) + e);
        for (int p = blk * NWAVES + wave; p < M / 2; p += nblk * NWAVES) {
            u32x4 fb[2][2], xb[2][2];
#pragma unroll
            for (int rr = 0; rr < 2; ++rr) { const int m = 2 * p + rr;
#pragma unroll
                for (int j = 0; j < 2; ++j) { fb[rr][j] = *((const u32x4*)(Fb + (size_t)m * D) + lane + 64 * j); xb[rr][j] = *((const u32x4*)(X1b + (size_t)m * D) + lane + 64 * j); } }
            float ss[2];
#pragma unroll
            for (int rr = 0; rr < 2; ++rr) { ss[rr] = 0.f;
#pragma unroll
                for (int j = 0; j < 2; ++j)
#pragma unroll
                    for (int q = 0; q < 4; ++q) { const unsigned w = fb[rr][j][q]; ss[rr] += bflo(w) * bflo(w) + bfhi(w) * bfhi(w); } }
            ss[0] = wave_sum(ss[0]); ss[1] = wave_sum(ss[1]);
#pragma unroll
            for (int rr = 0; rr < 2; ++rr) { const int m = 2 * p + rr; const float rstd = rsqrtf(ss[rr] * (1.f / D) + EPS);
#pragma unroll
                for (int j = 0; j < 2; ++j)
#pragma unroll
                    for (int e = 0; e < 2; ++e) { f32x4 y;
#pragma unroll
                        for (int q = 0; q < 2; ++q) { const unsigned fw = fb[rr][j][2 * e + q], xw = xb[rr][j][2 * e + q];
                            y[2 * q] = bflo(xw) + bflo(fw) * rstd * gpo[j][e][2 * q]; y[2 * q + 1] = bfhi(xw) + bfhi(fw) * rstd * gpo[j][e][2 * q + 1]; }
                        *((f32x4*)(Y + (size_t)m * D) + 2 * (lane + 64 * j) + e) = y; } }
        }
    }
#undef IN
#undef SEAM
}

#ifndef MK_SPLIT
#define MK_SPLIT 0
#endif
extern "C" void kernel_launch(void* const* d_in, const int* in_sizes, int n_in, void* d_out, int out_size, void* d_ws, size_t ws_size, hipStream_t stream) {
    static int grid = 0;
    if (grid == 0) {
        int dev = 0, cus = 0, per_cu = 0;
        if (hipGetDevice(&dev) != hipSuccess || hipDeviceGetAttribute(&cus, hipDeviceAttributeMultiprocessorCount, dev) != hipSuccess) { fprintf(stderr, "kernel_launch: device query failed\n"); grid = -1; return; }
        if (hipFuncSetAttribute((const void*)fwd_megakernel, hipFuncAttributeMaxDynamicSharedMemorySize, LDS_BYTES) != hipSuccess) { fprintf(stderr, "kernel_launch: hipFuncSetAttribute failed\n"); grid = -1; return; }
        if (hipOccupancyMaxActiveBlocksPerMultiprocessor(&per_cu, (const void*)fwd_megakernel, NTHREADS, LDS_BYTES) != hipSuccess || per_cu < 1) { fprintf(stderr, "kernel_launch: occupancy query says %d\n", per_cu); per_cu = 1; }
        (void)hipGetLastError();
        grid = cus * 1;
        if (ws_size < 256 * MiB || out_size != (int)O_END || n_in != 19) fprintf(stderr, "kernel_launch: unexpected sizes ws %zu out %d n_in %d\n", ws_size, out_size, n_in);
    }
    if (grid < 0) return;
    Args a{};
    a.x_prompt = (const float*)d_in[0]; a.x_sample = (const float*)d_in[1]; a.cache_k = (const float*)d_in[2]; a.cache_v = (const float*)d_in[3]; a.state_ret = (const float*)d_in[4];
    a.state_conv = (const float*)d_in[5]; a.w_in = (const float*)d_in[6]; a.sinks = (const float*)d_in[7]; a.w_a = (const float*)d_in[8]; a.w_r = (const float*)d_in[9]; a.w_o = (const float*)d_in[10];
    a.g_pre_mix = (const float*)d_in[11]; a.g_post_mix = (const float*)d_in[12]; a.g_pre_ffn = (const float*)d_in[13]; a.g_post_ffn = (const float*)d_in[14];
    a.w_up = (const float*)d_in[15]; a.conv_w = (const float*)d_in[16]; a.conv_b = (const float*)d_in[17]; a.w_down = (const float*)d_in[18];
    a.out = (float*)d_out; a.ws = (unsigned char*)d_ws;
#if MK_SPLIT
    for (int ph = 0; ph < 12; ++ph) { a.ph_lo = ph; a.ph_hi = ph + 1; hipLaunchKernelGGL(fwd_megakernel, dim3(grid), dim3(NTHREADS), LDS_BYTES, stream, a); }
#else
    a.ph_lo = 0; a.ph_hi = 12;
    void* args[] = {&a};
    const hipError_t e = hipLaunchCooperativeKernel((const void*)fwd_megakernel, dim3(grid), dim3(NTHREADS), args, LDS_BYTES, stream);
    if (e != hipSuccess) fprintf(stderr, "kernel_launch: cooperative launch failed: %s (grid %d)\n", hipGetErrorString(e), grid);
#endif
}
```

```cpp
#include <hip/hip_runtime.h>
#include <hip/hip_cooperative_groups.h>
#include <cstdio>
#include <cstdint>
#include <cmath>
namespace cg = cooperative_groups;
namespace pg8 {
#define PG8_LAS __attribute__((address_space(3)))
typedef unsigned short bf16_t;
typedef short bf16x8 __attribute__((ext_vector_type(8)));
typedef float f32x4 __attribute__((ext_vector_type(4)));
typedef unsigned u32x4 __attribute__((ext_vector_type(4)));
constexpr int BM = 256, BK = 64, HALF = 128, HTB = HALF * BK * 2  , STAGE_BYTES = 8 * HTB, NXCD = 8, WGM = 8;

__host__ __device__ __forceinline__ int lds_byte(int r, int c) { const int st = (r >> 4) * 2 + (c >> 5), rr = r & 15, cc = c & 31, ob = rr * 64 + cc * 2; return st * 1024 + (ob ^ (((ob >> 9) & 1) << 5)); }
__host__ __device__ __forceinline__ void stage_rc(int b, int& R, int& C) { const int st = b / 1024, sb = b % 1024, swz = sb ^ (((sb >> 9) & 1) << 5); R = (st >> 1) * 16 + swz / 64; C = (st & 1) * 32 + (swz % 64) / 2; }
__host__ __device__ __forceinline__ int perm32(int rho) { const int n = rho >> 4, i = rho & 15; return 8 * (i >> 2) + 4 * n + (i & 3); }

struct Unit { int pm, pn; };
struct Gemm { const bf16_t* A; const bf16_t* Bt; int M, N, K, lda; };

struct StaticOrder {
    int nM, nN, nwg, G, c;
    __host__ __device__ void init(int M, int N, int G_, int c_) { nM = M / BM; nN = N / BM; nwg = nM * nN; G = G_; c = c_; }
    __host__ __device__ bool next(int i, Unit& u) const {
        const long L = (long)i * G + c; if (L >= nwg) return false;
        int wgid = (int)L; { const int q = nwg / NXCD, r = nwg % NXCD, xcd = wgid % NXCD, off = wgid / NXCD; wgid = (xcd < r ? xcd * (q + 1) : r * (q + 1) + (xcd - r) * q) + off; }
        const int nig = WGM * nN, gid = wgid / nig, fm = gid * WGM, gsz = (nM - fm) < WGM ? (nM - fm) : WGM;
        u.pm = fm + ((wgid % nig) % gsz); u.pn = (wgid % nig) / gsz; return true;
    }
    __device__ __forceinline__ void a_ready(const Unit&) const {}
    __device__ __forceinline__ void done(const Unit&) const {}
};

__device__ __forceinline__ unsigned cvt_pk_bf16(float lo, float hi) { unsigned r; asm volatile("v_cvt_pk_bf16_f32 %0, %1, %2" : "=v"(r) : "v"(lo), "v"(hi)); return r; }
typedef float f32x2 __attribute__((ext_vector_type(2)));
__device__ __forceinline__ f32x2 gelu_pk(f32x2 v) {
    const f32x2 av = __builtin_elementwise_abs(v), d = av * 0.2316418882f + 1.0f;
    f32x2 t; t.x = __builtin_amdgcn_rcpf(d.x); t.y = __builtin_amdgcn_rcpf(d.y);
    f32x2 q = t * 0.5307027145f + (-0.7265760135f); q = q * t + 0.7107068705f; q = q * t + (-0.142248368f); q = q * t + 0.127414796f; q = q * t;
    const f32x2 s = (v * v) * (-0.72134752044f);
    f32x2 e; e.x = __builtin_amdgcn_exp2f(s.x); e.y = __builtin_amdgcn_exp2f(s.y);
    const f32x2 m = v * (q * e), r = v - m;
    f32x2 o; o.x = v.x < 0.f ? m.x : r.x; o.y = v.y < 0.f ? m.y : r.y; return o;
}

template <int ACT  > struct EpiBf16 {
    static constexpr bool PERM = true, AFTER_DRAIN = false; static_assert(ACT == 0 || ACT == 1, "EpiBf16: ACT is 0 (none) or 1 (gelu_pk)");
    bf16_t* O; int ldc; const float* bias; int split_cols; size_t split_stride; float scale0;
    __device__ __forceinline__ void operator()(const f32x4 (&acc)[2][2][4][2], const Unit& u, int wr, int wc, int fr, int fq) const {
        const int row0 = u.pm * BM + wr * 64 + fr; int colt = u.pn * BM; bf16_t* base = O;
        float sc = 1.f; if (split_cols) { const int t = colt / split_cols; base += (size_t)t * split_stride; colt -= t * split_cols; if (t == 0) sc = scale0; }
        const int col0 = colt + wc * 32 + 8 * fq, bcol0 = u.pn * BM + wc * 32 + 8 * fq;
        f32x4 bv[2][2];
#pragma unroll
        for (int bj = 0; bj < 2; ++bj)
#pragma unroll
            for (int n = 0; n < 2; ++n) bv[bj][n] = bias ? *(const f32x4*)(bias + bcol0 + bj * HALF + 4 * n) : (f32x4){0.f, 0.f, 0.f, 0.f};
#pragma unroll
        for (int ai = 0; ai < 2; ++ai)
#pragma unroll
            for (int m = 0; m < 4; ++m) { bf16_t* rowp = base + (size_t)(row0 + ai * HALF + m * 16) * ldc + col0;
#pragma unroll
                for (int bj = 0; bj < 2; ++bj) { f32x4 v0 = acc[ai][bj][m][0] + bv[bj][0], v1 = acc[ai][bj][m][1] + bv[bj][1];
                    if (ACT == 1) { f32x2 a = gelu_pk((f32x2){v0[0], v0[1]}), b = gelu_pk((f32x2){v0[2], v0[3]}), c = gelu_pk((f32x2){v1[0], v1[1]}), d = gelu_pk((f32x2){v1[2], v1[3]});
                        v0 = (f32x4){a.x, a.y, b.x, b.y}; v1 = (f32x4){c.x, c.y, d.x, d.y}; }
                    v0 = v0 * sc; v1 = v1 * sc; u32x4 w; w.x = cvt_pk_bf16(v0[0], v0[1]); w.y = cvt_pk_bf16(v0[2], v0[3]); w.z = cvt_pk_bf16(v1[0], v1[1]); w.w = cvt_pk_bf16(v1[2], v1[3]);
                    *(u32x4*)(rowp + bj * HALF) = w; } }
    }
};

typedef float f32x2e __attribute__((ext_vector_type(2)));
typedef unsigned u32x2e __attribute__((ext_vector_type(2)));
__device__ __forceinline__ float bf_lo(unsigned w) { return __uint_as_float(w << 16); }
__device__ __forceinline__ float bf_hi(unsigned w) { return __uint_as_float(w & 0xffff0000u); }
__device__ __forceinline__ float sigmoidf_(float x) { return __builtin_amdgcn_rcpf(1.0f + __expf(-x)); }
constexpr int E_MP = 16384, E_DIN = 5888;

struct EpiH {
    static constexpr bool PERM = true, AFTER_DRAIN = false;
    bf16_t* H; const f32x2e* tabA; const f32x2e* tabR;
    __device__ __forceinline__ void operator()(const f32x4 (&acc)[2][2][4][2], const Unit& u, int wr, int wc, int fr, int fq) const {
        const int pn = u.pn;
        const int row0 = u.pm * BM + wr * 64 + fr;
        const int colt = pn * BM + wc * 32 + 8 * fq;
#pragma unroll
        for (int ai = 0; ai < 2; ++ai)
#pragma unroll
            for (int m = 0; m < 4; ++m) {
                const int row = row0 + ai * HALF + m * 16;
                const int tp = row < E_MP ? (row & 4095) : 4096 + (row & 3);
#pragma unroll
                for (int bj = 0; bj < 2; ++bj) {
                    float v[8];
#pragma unroll
                    for (int j = 0; j < 4; ++j) { v[j] = acc[ai][bj][m][0][j]; v[4 + j] = acc[ai][bj][m][1][j]; }
                    int mode = 0; float sc = 1.f;
                    if (pn < 2) { mode = 1; sc = 0.125f; }
                    else if (pn == 2) { mode = (bj == 0) ? 1 : 0; }
                    else if (pn < 5) { mode = 2; }
                    else if (pn < 7) { mode = 2; sc = 0.08838834764831845f; }
                    if (mode == 1) {
                        const bool rot = ((wc & 1) == 0) && (fq < 2);
                        const float sgn = (fq == 0) ? -1.f : 1.f;
#pragma unroll
                        for (int j = 0; j < 8; ++j) {
                            const float partner = __shfl_xor(v[j], 16);
                            const f32x2e cs = tabA[tp * 8 + j];
                            const float o = v[j] * cs.x + sgn * partner * cs.y;
                            v[j] = (rot ? o : v[j]) * sc;
                        }
                    } else if (mode == 2) {
                        const int pi = ((bj * HALF + wc * 32 + 8 * fq) & 127) >> 1;
#pragma unroll
                        for (int p = 0; p < 4; ++p) {
                            const f32x2e cs = tabR[tp * 64 + pi + p];
                            const float x0 = v[2 * p], x1 = v[2 * p + 1];
                            v[2 * p] = (x0 * cs.x - x1 * cs.y) * sc; v[2 * p + 1] = (x1 * cs.x + x0 * cs.y) * sc;
                        }
                    }
                    u32x4 w; w.x = cvt_pk_bf16(v[0], v[1]); w.y = cvt_pk_bf16(v[2], v[3]); w.z = cvt_pk_bf16(v[4], v[5]); w.w = cvt_pk_bf16(v[6], v[7]);
                    *(u32x4*)(H + (size_t)row * E_DIN + colt + bj * HALF) = w;
                }
            }
    }
};

template <bool ADD> struct EpiGate {
    static constexpr bool PERM = true, AFTER_DRAIN = false;
    bf16_t* T; const bf16_t* gate; int ldg;
    __device__ __forceinline__ void operator()(const f32x4 (&acc)[2][2][4][2], const Unit& u, int wr, int wc, int fr, int fq) const {
        const int row0 = u.pm * BM + wr * 64 + fr, col0 = u.pn * BM + wc * 32 + 8 * fq;
#pragma unroll
        for (int ai = 0; ai < 2; ++ai)
#pragma unroll
            for (int m = 0; m < 4; ++m) {
                const int row = row0 + ai * HALF + m * 16;
#pragma unroll
                for (int bj = 0; bj < 2; ++bj) {
                    const u32x4 gw = *(const u32x4*)(gate + (size_t)row * ldg + col0 + bj * HALF);
                    bf16_t* tp = T + (size_t)row * 1024 + col0 + bj * HALF;
                    u32x4 old = (u32x4){0u, 0u, 0u, 0u}; if (ADD) old = *(const u32x4*)tp;
                    float o[8];
#pragma unroll
                    for (int j = 0; j < 4; ++j) {
                        const unsigned g2 = gw[j], o2 = old[j];
                        const float a0 = acc[ai][bj][m][j >> 1][(j & 1) * 2], a1 = acc[ai][bj][m][j >> 1][(j & 1) * 2 + 1];
                        o[2 * j] = bf_lo(o2) + sigmoidf_(bf_lo(g2)) * a0; o[2 * j + 1] = bf_hi(o2) + sigmoidf_(bf_hi(g2)) * a1;
                    }
                    u32x4 w; w.x = cvt_pk_bf16(o[0], o[1]); w.y = cvt_pk_bf16(o[2], o[3]); w.z = cvt_pk_bf16(o[4], o[5]); w.w = cvt_pk_bf16(o[6], o[7]);
                    *(u32x4*)tp = w;
                }
            }
    }
};

struct EpiF32 {
    static constexpr bool PERM = true, AFTER_DRAIN = false;
    float* O;
    __device__ __forceinline__ void operator()(const f32x4 (&acc)[2][2][4][2], const Unit& u, int wr, int wc, int fr, int fq) const {
        const int row0 = u.pm * BM + wr * 64 + fr, col0 = u.pn * BM + wc * 32 + 8 * fq;
#pragma unroll
        for (int ai = 0; ai < 2; ++ai)
#pragma unroll
            for (int m = 0; m < 4; ++m) {
                float* rp = O + (size_t)(row0 + ai * HALF + m * 16) * 1024 + col0;
#pragma unroll
                for (int bj = 0; bj < 2; ++bj) { *(f32x4*)(rp + bj * HALF) = acc[ai][bj][m][0]; *(f32x4*)(rp + bj * HALF + 4) = acc[ai][bj][m][1]; }
            }
    }
};

__device__ __forceinline__ float dpp_ror1(float x) { return __builtin_bit_cast(float, __builtin_amdgcn_update_dpp(0, __builtin_bit_cast(int, x), 0x121, 0xf, 0xf, false)); }
__device__ __forceinline__ float dpp_ror2(float x) { return __builtin_bit_cast(float, __builtin_amdgcn_update_dpp(0, __builtin_bit_cast(int, x), 0x122, 0xf, 0xf, false)); }
__device__ __forceinline__ float gelu_tanh(float x) { const float u2 = 1.5957691216057308f * (x + 0.044715f * x * x * x); return x * __builtin_amdgcn_rcpf(1.0f + __expf(-u2)); }
struct EpiUp {
    static constexpr bool PERM = true, AFTER_DRAIN = false;
    bf16_t* G; bf16_t* UH; bf16_t* US; float* conv_prompt; float* conv_sample; const float* conv_w; const float* conv_b;
    __device__ __forceinline__ void operator()(const f32x4 (&acc)[2][2][4][2], const Unit& u, int wr, int wc, int fr, int fq) const {
        const int row0 = u.pm * BM + wr * 64 + fr;
        const bool sample = u.pm >= 64;
#pragma unroll
        for (int n = 0; n < 2; ++n) {
            const int ch = u.pn * HALF + wc * 32 + 8 * fq + 4 * n;
            const f32x4 wa0 = *(const f32x4*)(conv_w + ch), wa1 = *(const f32x4*)(conv_w + 6144 + ch), wa2 = *(const f32x4*)(conv_w + 12288 + ch), ba = *(const f32x4*)(conv_b + ch);
            const f32x4 wb0 = *(const f32x4*)(conv_w + 3072 + ch), wb1 = *(const f32x4*)(conv_w + 6144 + 3072 + ch), wb2 = *(const f32x4*)(conv_w + 12288 + 3072 + ch), bb = *(const f32x4*)(conv_b + 3072 + ch);
#pragma unroll
            for (int ai = 0; ai < 2; ++ai)
#pragma unroll
                for (int m = 0; m < 4; ++m) {
                    const int row = row0 + ai * HALF + m * 16;
                    const f32x4 ua = acc[ai][0][m][n], ub = acc[ai][1][m][n];
                    const f32x4 pa = acc[ai][0][m > 0 ? m - 1 : 0][n], pb = acc[ai][1][m > 0 ? m - 1 : 0][n];
                    float g[4];
#pragma unroll
                    for (int r = 0; r < 4; ++r) {
                        const float a1c = dpp_ror1(ua[r]), a1p = dpp_ror1(pa[r]), a2c = dpp_ror2(ua[r]), a2p = dpp_ror2(pa[r]);
                        const float b1c = dpp_ror1(ub[r]), b1p = dpp_ror1(pb[r]), b2c = dpp_ror2(ub[r]), b2p = dpp_ror2(pb[r]);
                        const float a1 = fr >= 1 ? a1c : a1p, a2 = fr >= 2 ? a2c : a2p, b1 = fr >= 1 ? b1c : b1p, b2 = fr >= 2 ? b2c : b2p;
                        const float ca = ba[r] + wa0[r] * a2 + wa1[r] * a1 + wa2[r] * ua[r];
                        const float cb = bb[r] + wb0[r] * b2 + wb1[r] * b1 + wb2[r] * ub[r];
                        g[r] = gelu_tanh(ca) * cb;
                    }
                    if (!sample) {
                        if (!(m == 0 && fr < 2)) { u32x2e w; w.x = cvt_pk_bf16(g[0], g[1]); w.y = cvt_pk_bf16(g[2], g[3]); *(u32x2e*)(G + (size_t)row * 3072 + ch) = w; }
                        if ((m == 0 && fr < 2) || (m == 3 && fr >= 14)) {
                            const int hrow = (row >> 6) * 4 + ((row + 2) & 63);
                            u32x2e w; w.x = cvt_pk_bf16(ua[0], ua[1]); w.y = cvt_pk_bf16(ua[2], ua[3]); *(u32x2e*)(UH + (size_t)hrow * 6144 + ch) = w;
                            w.x = cvt_pk_bf16(ub[0], ub[1]); w.y = cvt_pk_bf16(ub[2], ub[3]); *(u32x2e*)(UH + (size_t)hrow * 6144 + 3072 + ch) = w;
                        }
                        if ((row & 4095) >= 4094) {
                            float* cp = conv_prompt + ((size_t)(row >> 12) * 2 + ((row & 4095) - 4094)) * 6144;
                            *(f32x4*)(cp + ch) = ua; *(f32x4*)(cp + 3072 + ch) = ub;
                        }
                    } else {
                        const int sr = row - E_MP;
                        u32x2e w; w.x = cvt_pk_bf16(ua[0], ua[1]); w.y = cvt_pk_bf16(ua[2], ua[3]); *(u32x2e*)(US + (size_t)sr * 6144 + ch) = w;
                        w.x = cvt_pk_bf16(ub[0], ub[1]); w.y = cvt_pk_bf16(ub[2], ub[3]); *(u32x2e*)(US + (size_t)sr * 6144 + 3072 + ch) = w;
                        if ((sr & 3) >= 2) {
                            float* cp = conv_sample + ((size_t)(sr >> 2) * 2 + ((sr & 3) - 2)) * 6144;
                            *(f32x4*)(cp + ch) = ua; *(f32x4*)(cp + 3072 + ch) = ub;
                        }
                    }
                }
        }
    }
};

template <class Epi, class Sched, bool ALIGN_EPI = false, bool SP2 = false>
__device__ __forceinline__ void gemm_phase(PG8_LAS unsigned char* lds, const Gemm g, const Sched& S, const Epi& E) {
    const int tid = threadIdx.x, wid = __builtin_amdgcn_readfirstlane(tid >> 6), lane = tid & 63, wr = wid >> 2, wc = wid & 3, fr = lane & 15, fq = lane >> 4;
    const int K = g.K, nt = K / BK, lda = g.lda;
    unsigned voffA[2], voffB[2];
#pragma unroll
    for (int i = 0; i < 2; ++i) { int R, C; stage_rc(tid * 16 + i * 8192, R, C); const int Rb = Epi::PERM ? ((R & ~31) + perm32(R & 31)) : R;
        voffA[i] = (unsigned)(R * lda + C) * 2u; voffB[i] = (unsigned)(Rb * K + C) * 2u; }
    const size_t kstep = (size_t)(BK * 2);
    const size_t hstepA = (size_t)HALF * lda * 2, hstepB = (size_t)HALF * K * 2;
    const size_t tstepA = 2 * hstepA, tstepB = 2 * hstepB;
    const unsigned ldsw = (unsigned)wid * 1024u;
    const int aoff = lds_byte(wr * 64 + fr, fq * 8), boff = lds_byte(wc * 32 + fr, fq * 8);
#define PG8_SA(b, h) (((b) * 2 + (h)) * HTB)
#define PG8_SB(b, h) ((4 + (b) * 2 + (h)) * HTB)
#define PG8_STAGE(bufoff, gbase, voff) do { _Pragma("unroll") for (int _i = 0; _i < 2; ++_i) \
        __builtin_amdgcn_global_load_lds((const unsigned*)((const char*)(gbase) + (voff)[_i]), (PG8_LAS unsigned*)(lds + (bufoff) + ldsw + _i * 8192), 16, 0, 0); } while (0)
#define PG8_LDA(dst, b, h) do { _Pragma("unroll") for (int m = 0; m < 4; ++m) _Pragma("unroll") for (int k = 0; k < 2; ++k) dst[m][k] = *(const PG8_LAS bf16x8*)(lds + PG8_SA(b, h) + aoff + m * 2048 + k * 1024); } while (0)
#define PG8_LDB(dst, b, h) do { _Pragma("unroll") for (int n = 0; n < 2; ++n) _Pragma("unroll") for (int k = 0; k < 2; ++k) dst[n][k] = *(const PG8_LAS bf16x8*)(lds + PG8_SB(b, h) + boff + n * 2048 + k * 1024); } while (0)
#define PG8_MMA(ai, bj, At, Bt) do { __builtin_amdgcn_s_setprio(1); _Pragma("unroll") for (int m = 0; m < 4; ++m) _Pragma("unroll") for (int n = 0; n < 2; ++n) _Pragma("unroll") for (int k = 0; k < 2; ++k) \
        acc[ai][bj][m][n] = __builtin_amdgcn_mfma_f32_16x16x32_bf16(Bt[n][k], At[m][k], acc[ai][bj][m][n], 0, 0, 0); __builtin_amdgcn_s_setprio(0); } while (0)
#define PG8_WAIT_V(n) asm volatile("s_waitcnt vmcnt(" #n ")" ::: "memory")
#define PG8_WAIT_L(n) asm volatile("s_waitcnt lgkmcnt(" #n ")" ::: "memory")
#define PG8_BAR __builtin_amdgcn_s_barrier()
#define PG8_SCHED __builtin_amdgcn_sched_barrier(0)
    Unit cur, nxt; int ui = 0;
    if (!S.next(0, cur)) return;
    f32x4 acc[2][2][4][2];
#pragma unroll
    for (int a = 0; a < 2; ++a)
#pragma unroll
        for (int b = 0; b < 2; ++b)
#pragma unroll
            for (int m = 0; m < 4; ++m)
#pragma unroll
                for (int n = 0; n < 2; ++n) acc[a][b][m][n] = (f32x4){0.f, 0.f, 0.f, 0.f};
    bf16x8 At[4][2], B0[2][2], B1[2][2];
    const char* cA = (const char*)g.A + (size_t)cur.pm * tstepA; const char* cB = (const char*)g.Bt + (size_t)cur.pn * tstepB;
    S.a_ready(cur);
    if constexpr (SP2) {
        PG8_STAGE(PG8_SB(0, 0), cB, voffB); PG8_STAGE(PG8_SB(0, 1), cB + hstepB, voffB); PG8_STAGE(PG8_SA(0, 0), cA, voffA); PG8_STAGE(PG8_SA(0, 1), cA + hstepA, voffA);
        if (wr == 1) PG8_BAR;
        PG8_WAIT_V(2); PG8_BAR;
        PG8_STAGE(PG8_SB(1, 0), cB + kstep, voffB); PG8_STAGE(PG8_SA(1, 0), cA + kstep, voffA); PG8_STAGE(PG8_SB(1, 1), cB + hstepB + kstep, voffB);
        PG8_WAIT_V(6); PG8_BAR;
    } else {
        PG8_STAGE(PG8_SB(0, 0), cB, voffB); PG8_STAGE(PG8_SA(0, 0), cA, voffA); PG8_STAGE(PG8_SB(0, 1), cB + hstepB, voffB); PG8_STAGE(PG8_SA(0, 1), cA + hstepA, voffA);
        if (wr == 1) PG8_BAR;
        PG8_WAIT_V(4); PG8_BAR;
        PG8_STAGE(PG8_SB(1, 0), cB + kstep, voffB); PG8_STAGE(PG8_SA(1, 0), cA + kstep, voffA); PG8_STAGE(PG8_SB(1, 1), cB + hstepB + kstep, voffB);
        PG8_WAIT_V(6); PG8_BAR;
    }
    for (;;) {
        const bool has_next = S.next(ui + 1, nxt);
        const char* nA = has_next ? (const char*)g.A + (size_t)nxt.pm * tstepA : cA; const char* nB = has_next ? (const char*)g.Bt + (size_t)nxt.pn * tstepB : cB;
        for (int t = 0; t < nt; t += 2) {
            const bool last = (t == nt - 2);
            const char* a1 = cA + (size_t)(t + 1) * kstep;
            const char* a2 = last ? nA : cA + (size_t)(t + 2) * kstep; const char* b2 = last ? nB : cB + (size_t)(t + 2) * kstep;
            const char* a3 = a2 + kstep; const char* b3 = b2 + kstep;
            if (last && has_next) S.a_ready(nxt);
            if constexpr (SP2) {
            PG8_LDB(B0, 0, 0); PG8_LDB(B1, 0, 1); PG8_SCHED; PG8_LDA(At, 0, 0); PG8_STAGE(PG8_SA(1, 1), a1 + hstepA, voffA);
            PG8_WAIT_V(8); PG8_WAIT_L(0); PG8_BAR; PG8_MMA(0, 0, At, B0); PG8_MMA(0, 1, At, B1); PG8_BAR; PG8_SCHED;
            PG8_LDA(At, 0, 1); PG8_STAGE(PG8_SB(0, 0), b2, voffB); PG8_STAGE(PG8_SB(0, 1), b2 + hstepB, voffB); PG8_STAGE(PG8_SA(0, 0), a2, voffA);
            PG8_WAIT_V(8); PG8_WAIT_L(0); PG8_BAR; PG8_MMA(1, 0, At, B0); PG8_MMA(1, 1, At, B1); PG8_BAR; PG8_SCHED;
            PG8_LDB(B0, 1, 0); PG8_LDB(B1, 1, 1); PG8_SCHED; PG8_LDA(At, 1, 0); PG8_STAGE(PG8_SA(0, 1), a2 + hstepA, voffA);
            PG8_WAIT_V(8); PG8_WAIT_L(0); PG8_BAR; PG8_MMA(0, 0, At, B0); PG8_MMA(0, 1, At, B1); PG8_BAR; PG8_SCHED;
            PG8_LDA(At, 1, 1); PG8_STAGE(PG8_SB(1, 0), b3, voffB); PG8_STAGE(PG8_SB(1, 1), b3 + hstepB, voffB); PG8_STAGE(PG8_SA(1, 0), a3, voffA);
            PG8_WAIT_V(8); PG8_WAIT_L(0); PG8_BAR; PG8_MMA(1, 0, At, B0); PG8_MMA(1, 1, At, B1); PG8_BAR; PG8_SCHED;
            } else {
            PG8_LDB(B0, 0, 0); PG8_SCHED; PG8_LDA(At, 0, 0); PG8_STAGE(PG8_SA(1, 1), a1 + hstepA, voffA);
            PG8_WAIT_L(8); PG8_BAR; PG8_WAIT_L(0); PG8_MMA(0, 0, At, B0); PG8_BAR; PG8_SCHED;
            PG8_LDB(B1, 0, 1); PG8_STAGE(PG8_SB(0, 0), b2, voffB);
            PG8_BAR; PG8_WAIT_L(0); PG8_MMA(0, 1, At, B1); PG8_BAR;
            PG8_LDA(At, 0, 1); PG8_STAGE(PG8_SA(0, 0), a2, voffA);
            PG8_BAR; PG8_WAIT_L(0); PG8_MMA(1, 0, At, B0); PG8_BAR; PG8_SCHED;
            PG8_STAGE(PG8_SB(0, 1), b2 + hstepB, voffB);
            PG8_WAIT_V(6); PG8_BAR; PG8_MMA(1, 1, At, B1); PG8_BAR;
            PG8_LDB(B0, 1, 0); PG8_SCHED; PG8_LDA(At, 1, 0); PG8_STAGE(PG8_SA(0, 1), a2 + hstepA, voffA);
            PG8_WAIT_L(8); PG8_BAR; PG8_WAIT_L(0); PG8_MMA(0, 0, At, B0); PG8_BAR; PG8_SCHED;
            PG8_LDB(B1, 1, 1); PG8_STAGE(PG8_SB(1, 0), b3, voffB);
            PG8_BAR; PG8_WAIT_L(0); PG8_MMA(0, 1, At, B1); PG8_BAR;
            PG8_LDA(At, 1, 1); PG8_STAGE(PG8_SA(1, 0), a3, voffA);
            PG8_BAR; PG8_WAIT_L(0); PG8_MMA(1, 0, At, B0); PG8_BAR; PG8_SCHED;
            PG8_STAGE(PG8_SB(1, 1), b3 + hstepB, voffB);
            PG8_WAIT_V(6); PG8_BAR; PG8_MMA(1, 1, At, B1); PG8_BAR;
            }
        }
        if constexpr (ALIGN_EPI) { if (wr == 0) PG8_BAR; }
        if constexpr (!Epi::AFTER_DRAIN) { E(acc, cur, wr, wc, fr, fq); S.done(cur); }
        if (!has_next) break;
#pragma unroll
        for (int a = 0; a < 2; ++a)
#pragma unroll
            for (int b = 0; b < 2; ++b)
#pragma unroll
                for (int m = 0; m < 4; ++m)
#pragma unroll
                    for (int n = 0; n < 2; ++n) acc[a][b][m][n] = (f32x4){0.f, 0.f, 0.f, 0.f};
        cur = nxt; cA = nA; cB = nB; ++ui;
        if constexpr (ALIGN_EPI) { if (wr == 1) PG8_BAR; }
    }
    PG8_WAIT_V(0);
    if constexpr (!ALIGN_EPI) { if (wr == 0) PG8_BAR; }
    PG8_BAR;
    if constexpr (Epi::AFTER_DRAIN) { E.fused(acc, cur, wr, wc, fr, fq, lds, wid, lane); S.done(cur); }
#undef PG8_SA
#undef PG8_SB
#undef PG8_STAGE
#undef PG8_LDA
#undef PG8_LDB
#undef PG8_MMA
#undef PG8_WAIT_V
#undef PG8_WAIT_L
#undef PG8_BAR
#undef PG8_SCHED
}
}

#define LAS __attribute__((address_space(3)))
using pg8::bf16_t; using pg8::bf16x8; using pg8::f32x4; using pg8::u32x4;
typedef float f32x2 __attribute__((ext_vector_type(2)));
typedef unsigned u32x2 __attribute__((ext_vector_type(2)));
typedef short v4i16 __attribute__((ext_vector_type(4)));

constexpr int MP = 16384, MS = 512, M = MP + MS, D = 1024, DIN = 5888, F2 = 6144, DFF = 3072, TSEQ = 4096;
constexpr int C_QA = 0, C_KA = 512, C_VA = 640, C_QR = 768, C_KR = 1280, C_VR = 1792, C_GATE = 2816, C_GMA = 3840, C_GMR = 4864;
constexpr float EPS = 1e-6f;
constexpr int NTHREADS = 512, NWAVES = 8;
constexpr int LDS_BYTES = 147456;

constexpr size_t MiB = 1u << 20;
constexpr size_t WS_TABA = 0, WS_TABR = 512 * 1024;
constexpr size_t WS_WIN = 3 * MiB;
constexpr size_t WS_WUP = WS_WIN + (size_t)DIN * D * 2;
constexpr size_t WS_WDN = WS_WUP + (size_t)F2 * D * 2;
constexpr size_t WS_XN = WS_WDN + (size_t)D * DFF * 2;
constexpr size_t WS_R1 = WS_XN + (size_t)M * D * 2;
constexpr size_t R1_G = 0, R1_F = (size_t)M * DFF * 2, R1_UH = R1_F + (size_t)M * D * 2, R1_US = R1_UH + (size_t)264 * 4 * F2 * 2, R1_X1 = R1_US + (size_t)MS * F2 * 2, R1_END = R1_X1 + (size_t)M * D * 2;
static_assert(R1_END <= (size_t)M * DIN * 2, "R1 overlay");
static_assert(WS_R1 + (size_t)M * DIN * 2 <= 256 * MiB, "ws map");
constexpr size_t O_Y = 0, O_KP = (size_t)M * D, O_VP = O_KP + 65536, O_RP = O_VP + 65536, O_CP = O_RP + 524288, O_KS = O_CP + 49152, O_VS = O_KS + 2097152, O_RS = O_VS + 2097152, O_CS = O_RS + 16777216, O_END = O_CS + 1572864;

struct Args {
    const float *x_prompt, *x_sample, *cache_k, *cache_v, *state_ret, *state_conv, *w_in, *sinks, *w_a, *w_r, *w_o, *g_pre_mix, *g_post_mix, *g_pre_ffn, *g_post_ffn, *w_up, *conv_w, *conv_b, *w_down;
    float* out; unsigned char* ws; int ph_lo, ph_hi;
};

__device__ __forceinline__ float bf2f(bf16_t h) { return __uint_as_float((unsigned)h << 16); }
__device__ __forceinline__ float bflo(unsigned w) { return __uint_as_float(w << 16); }
__device__ __forceinline__ float bfhi(unsigned w) { return __uint_as_float(w & 0xffff0000u); }
__device__ __forceinline__ unsigned pk2(float lo, float hi) { return pg8::cvt_pk_bf16(lo, hi); }
__device__ __forceinline__ float wave_sum(float v) {
#pragma unroll
    for (int o = 1; o < 64; o <<= 1) v += __shfl_xor(v, o);
    return v;
}
__device__ __forceinline__ float wave_max(float v) {
#pragma unroll
    for (int o = 1; o < 64; o <<= 1) v = fmaxf(v, __shfl_xor(v, o));
    return v;
}
__device__ __forceinline__ float ret_log2g(int h) { return log2f(1.0f - exp2f(-5.0f - (float)h)); }
__device__ __forceinline__ bf16x8 tr_pair(const LAS unsigned char* p0, const LAS unsigned char* p1) {
    const v4i16 a = __builtin_amdgcn_ds_read_tr16_b64_v4i16((LAS v4i16*)p0), b = __builtin_amdgcn_ds_read_tr16_b64_v4i16((LAS v4i16*)p1);
    return (bf16x8){a[0], a[1], a[2], a[3], b[0], b[1], b[2], b[3]};
}
__device__ __forceinline__ bf16x8 cat8(u32x2 a, u32x2 b) { const u32x4 w = {a.x, a.y, b.x, b.y}; return __builtin_bit_cast(bf16x8, w); }

__device__ __forceinline__ void p0_transpose_item(const float* W, int K, int N, bf16_t* WT, int k0, int n0, int drow0, LAS float* scr, int lane) {
#pragma unroll 8
    for (int i = 0; i < 32; ++i) { const int kk = 2 * i + (lane >> 5); scr[kk * 33 + (lane & 31)] = W[(size_t)(k0 + kk) * N + n0 + (lane & 31)]; }
    asm volatile("s_waitcnt lgkmcnt(0)" ::: "memory");
    const int c = lane & 7;
#pragma unroll
    for (int j = 0; j < 4; ++j) { const int n = (lane >> 3) + 8 * j; const LAS float* s = scr + (8 * c) * 33 + n;
        u32x4 o; o.x = pk2(s[0 * 33], s[1 * 33]); o.y = pk2(s[2 * 33], s[3 * 33]); o.z = pk2(s[4 * 33], s[5 * 33]); o.w = pk2(s[6 * 33], s[7 * 33]);
        *(u32x4*)(WT + (size_t)(drow0 + n) * K + k0 + 8 * c) = o; }
    asm volatile("s_waitcnt lgkmcnt(0)" ::: "memory");
}
__device__ __forceinline__ void rms_row_to_bf16(const float* xrow, const float* g, bf16_t* orow, int lane) {
    f32x4 v[4]; float s = 0.f;
#pragma unroll
    for (int j = 0; j < 4; ++j) { v[j] = *((const f32x4*)xrow + lane + 64 * j); s += (v[j].x * v[j].x + v[j].y * v[j].y) + (v[j].z * v[j].z + v[j].w * v[j].w); }
    const float rstd = rsqrtf(wave_sum(s) * (1.f / D) + EPS);
#pragma unroll
    for (int j = 0; j < 4; ++j) { const f32x4 gg = *((const f32x4*)g + lane + 64 * j);
        u32x2 w; w.x = pk2(v[j].x * rstd * gg.x, v[j].y * rstd * gg.y); w.y = pk2(v[j].z * rstd * gg.z, v[j].w * rstd * gg.w);
        *((u32x2*)orow + lane + 64 * j) = w; }
}
__device__ __forceinline__ void p0_prologue(const Args& a, LAS unsigned char* lds, int tid, int lane, int wave) {
    unsigned char* ws = a.ws;
    LAS float* scr = (LAS float*)(lds + wave * 16384);
    const int gw = blockIdx.x * NWAVES + wave, NGW = gridDim.x * NWAVES;
    bf16_t* WinT = (bf16_t*)(ws + WS_WIN); bf16_t* WupT = (bf16_t*)(ws + WS_WUP); bf16_t* WdnT = (bf16_t*)(ws + WS_WDN);
    bf16_t* WoT = (bf16_t*)(a.out + O_CS); bf16_t* WaT = WoT + 1024 * 1024; bf16_t* WrT = WaT + 1024 * 512;
    constexpr int I_IN = 16 * (DIN / 32), I_A = 8 * 32, I_R = 16 * 32, I_O = 16 * 32, I_UP = 16 * (F2 / 32), I_DN = 48 * 32;
    constexpr int NITEMS = I_IN + I_A + I_R + I_O + I_UP + I_DN;
    for (int it = gw; it < NITEMS; it += NGW) {
        int r = it;
        if (r < I_IN) { const int nb = r % (DIN / 32), kb = r / (DIN / 32); p0_transpose_item(a.w_in, D, DIN, WinT, 64 * kb, 32 * nb, 32 * nb, scr, lane); continue; } r -= I_IN;
        if (r < I_A) { const int nb = r % 32, kb = r / 32; p0_transpose_item(a.w_a, 512, D, WaT, 64 * kb, 32 * nb, 32 * nb, scr, lane); continue; } r -= I_A;
        if (r < I_R) { const int nb = r % 32, kb = r / 32; p0_transpose_item(a.w_r, D, D, WrT, 64 * kb, 32 * nb, 32 * nb, scr, lane); continue; } r -= I_R;
        if (r < I_O) { const int nb = r % 32, kb = r / 32; p0_transpose_item(a.w_o, D, D, WoT, 64 * kb, 32 * nb, 32 * nb, scr, lane); continue; } r -= I_O;
        if (r < I_UP) { const int nb = r % (F2 / 32), kb = r / (F2 / 32); const int n0 = 32 * nb;
            const int drow = n0 < DFF ? (n0 / 128) * 256 + (n0 % 128) : ((n0 - DFF) / 128) * 256 + 128 + ((n0 - DFF) % 128);
            p0_transpose_item(a.w_up, D, F2, WupT, 64 * kb, n0, drow, scr, lane); continue; } r -= I_UP;
        { const int nb = r % 32, kb = r / 32; p0_transpose_item(a.w_down, DFF, D, WdnT, 64 * kb, 32 * nb, 32 * nb, scr, lane); }
    }
    bf16_t* XN = (bf16_t*)(ws + WS_XN);
    for (int m = gw; m < M; m += NGW) { const float* xr = m < MP ? a.x_prompt + (size_t)m * D : a.x_sample + (size_t)(m - MP) * D; rms_row_to_bf16(xr, a.g_pre_mix, XN + (size_t)m * D, lane); }
    f32x2* tabA = (f32x2*)(ws + WS_TABA); f32x2* tabR = (f32x2*)(ws + WS_TABR);
    __syncthreads();
    LAS float* invs = (LAS float*)lds;
    if (tid < 72) invs[tid] = tid < 8 ? (float)(1.0 / pow(500000.0, (double)((float)tid / 8.0f))) : (float)(1.0 / pow(10000.0, (double)((float)(tid - 8) / 63.0f)));
    __syncthreads();
    const int gt = blockIdx.x * NTHREADS + tid, NGT = gridDim.x * NTHREADS;
    for (int e = gt; e < 4100 * 72; e += NGT) {
        const int tp = e / 72, i = e % 72; const int pos = tp < 4096 ? tp : 16384 + (tp - 4096);
        const float ang = (float)pos * invs[i];
        const double rev = (double)ang * 0.15915494309189535; const float fr = (float)(rev - rint(rev));
        const f32x2 cs = {__builtin_amdgcn_cosf(fr), __builtin_amdgcn_sinf(fr)};
        if (i < 8) tabA[tp * 8 + i] = cs; else tabR[tp * 64 + (i - 8)] = cs;
    }
}

__device__ __forceinline__ void attn_prompt_unit(bf16_t* H, const float* sinks, LAS unsigned char* lds, int b, int qb, int head, int tid, int lane, int wave) {
    const int g = head >> 2, fr = lane & 15, fq = lane >> 4;
    const size_t rowbase = (size_t)b * TSEQ + (size_t)qb * 128;
    LAS unsigned char* Kimg = lds; LAS unsigned char* Vimg = lds + 36864;
#pragma unroll
    for (int i = 0; i < 4; ++i) {
        const int id = tid + NTHREADS * i, kidx = id >> 3, ch = id & 7;
        u32x4 kv = {0u, 0u, 0u, 0u}, vv = {0u, 0u, 0u, 0u};
        if (qb > 0 || kidx >= 128) { const bf16_t* src = H + (rowbase - 128 + kidx) * DIN; kv = *(const u32x4*)(src + C_KA + g * 64 + ch * 8); vv = *(const u32x4*)(src + C_VA + g * 64 + ch * 8); }
        *(LAS u32x4*)(Kimg + kidx * 144 + ch * 16) = kv; *(LAS u32x4*)(Vimg + kidx * 144 + ch * 16) = vv;
    }
    const size_t qrow = rowbase + 16 * wave + fr;
    bf16x8 qf[2];
#pragma unroll
    for (int ks = 0; ks < 2; ++ks) qf[ks] = *(const bf16x8*)(H + qrow * DIN + C_QA + head * 64 + 32 * ks + 8 * fq);
    __syncthreads();
    f32x4 s[10];
#pragma unroll
    for (int nn = 0; nn < 9; ++nn) {
        s[nn] = (f32x4){0.f, 0.f, 0.f, 0.f};
        const int krow = 16 * (wave + nn) + fr;
#pragma unroll
        for (int ks = 0; ks < 2; ++ks) { const bf16x8 kf = *(const LAS bf16x8*)(Kimg + krow * 144 + (32 * ks + 8 * fq) * 2); s[nn] = __builtin_amdgcn_mfma_f32_16x16x32_bf16(kf, qf[ks], s[nn], 0, 0, 0); }
    }
    s[9] = (f32x4){0.f, 0.f, 0.f, 0.f};
    const int qi = 16 * wave + fr; const float sink = sinks[head];
    float mx = sink;
#pragma unroll
    for (int nn = 0; nn < 9; ++nn)
#pragma unroll
        for (int r = 0; r < 4; ++r) { const int kidx = 16 * (wave + nn) + 4 * fq + r; const bool valid = (kidx > qi) && (kidx <= qi + 128) && (qb > 0 || kidx >= 128);
            s[nn][r] = valid ? s[nn][r] : -1e30f; mx = fmaxf(mx, s[nn][r]); }
    mx = fmaxf(mx, __shfl_xor(mx, 16)); mx = fmaxf(mx, __shfl_xor(mx, 32));
    float sum = 0.f;
#pragma unroll
    for (int nn = 0; nn < 9; ++nn)
#pragma unroll
        for (int r = 0; r < 4; ++r) { const float p = s[nn][r] > -1e29f ? __expf(s[nn][r] - mx) : 0.f; s[nn][r] = p; sum += p; }
    sum += __shfl_xor(sum, 16); sum += __shfl_xor(sum, 32);
    sum += __expf(sink - mx);
    f32x4 o[4];
#pragma unroll
    for (int db = 0; db < 4; ++db) o[db] = (f32x4){0.f, 0.f, 0.f, 0.f};
    const int tq = (lane & 15) >> 2, tpp = lane & 3;
#pragma unroll
    for (int G = 0; G < 5; ++G) {
        const u32x4 pw = {pk2(s[2 * G][0], s[2 * G][1]), pk2(s[2 * G][2], s[2 * G][3]), pk2(s[2 * G + 1][0], s[2 * G + 1][1]), pk2(s[2 * G + 1][2], s[2 * G + 1][3])};
        const bf16x8 pf = __builtin_bit_cast(bf16x8, pw);
        int k0 = 16 * (wave + 2 * G) + 4 * fq + tq, k1 = k0 + 16; k0 = k0 > 255 ? 255 : k0; k1 = k1 > 255 ? 255 : k1;
#pragma unroll
        for (int db = 0; db < 4; ++db) {
            const bf16x8 vf = tr_pair(Vimg + k0 * 144 + (16 * db + 4 * tpp) * 2, Vimg + k1 * 144 + (16 * db + 4 * tpp) * 2);
            o[db] = __builtin_amdgcn_mfma_f32_16x16x32_bf16(vf, pf, o[db], 0, 0, 0);
        }
    }
    const float inv = 1.0f / sum;
#pragma unroll
    for (int db = 0; db < 4; ++db) { u32x2 w; w.x = pk2(o[db][0] * inv, o[db][1] * inv); w.y = pk2(o[db][2] * inv, o[db][3] * inv);
        *(u32x2*)(H + qrow * DIN + C_QA + head * 64 + 16 * db + 4 * fq) = w; }
    __syncthreads();
}

__device__ __forceinline__ void attn_sample_unit(const Args& a, bf16_t* H, LAS unsigned char* lds, int b, int tid, int lane, int wave) {
    const int head = wave, g = head >> 2; const size_t r0 = (size_t)MP + 4 * b;
    LAS float* qs = (LAS float*)(lds + wave * 4096); LAS float* ps = qs + 256;
#pragma unroll
    for (int t = 0; t < 4; ++t) qs[t * 64 + lane] = bf2f(H[(r0 + t) * DIN + C_QA + head * 64 + lane]);
    asm volatile("s_waitcnt lgkmcnt(0)" ::: "memory");
    float sc[3][4];
#pragma unroll
    for (int kk = 0; kk < 2; ++kk) {
        const float* kp = a.cache_k + ((size_t)(b * 128 + lane + 64 * kk) * 2 + g) * 64;
        float acc0 = 0.f, acc1 = 0.f, acc2 = 0.f, acc3 = 0.f;
#pragma unroll 4
        for (int d4 = 0; d4 < 16; ++d4) { const f32x4 kv = *(const f32x4*)(kp + 4 * d4);
#pragma unroll
            for (int e = 0; e < 4; ++e) { const float kx = kv[e]; acc0 += qs[0 * 64 + 4 * d4 + e] * kx; acc1 += qs[1 * 64 + 4 * d4 + e] * kx; acc2 += qs[2 * 64 + 4 * d4 + e] * kx; acc3 += qs[3 * 64 + 4 * d4 + e] * kx; } }
        sc[kk][0] = acc0; sc[kk][1] = acc1; sc[kk][2] = acc2; sc[kk][3] = acc3;
    }
    {
        const int tn = lane & 3; const bf16_t* kp = H + (r0 + tn) * DIN + C_KA + g * 64;
        float acc0 = 0.f, acc1 = 0.f, acc2 = 0.f, acc3 = 0.f;
#pragma unroll 4
        for (int d = 0; d < 64; ++d) { const float kx = bf2f(kp[d]); acc0 += qs[0 * 64 + d] * kx; acc1 += qs[1 * 64 + d] * kx; acc2 += qs[2 * 64 + d] * kx; acc3 += qs[3 * 64 + d] * kx; }
        sc[2][0] = acc0; sc[2][1] = acc1; sc[2][2] = acc2; sc[2][3] = acc3;
    }
    const float sink = a.sinks[head];
    float inv[4];
#pragma unroll
    for (int t = 0; t < 4; ++t) {
        const bool v0 = lane > t, v1 = true, v2 = (lane < 4) && (lane <= t);
        const float s0 = v0 ? sc[0][t] : -1e30f, s1 = v1 ? sc[1][t] : -1e30f, s2 = v2 ? sc[2][t] : -1e30f;
        const float mx = fmaxf(wave_max(fmaxf(fmaxf(s0, s1), s2)), sink);
        const float p0 = v0 ? __expf(s0 - mx) : 0.f, p1 = __expf(s1 - mx), p2 = v2 ? __expf(s2 - mx) : 0.f;
        const float sum = wave_sum(p0 + p1 + p2) + __expf(sink - mx);
        inv[t] = 1.0f / sum;
        ps[t * 136 + lane] = p0; ps[t * 136 + 64 + lane] = p1; if (lane < 4) ps[t * 136 + 128 + lane] = p2;
    }
    asm volatile("s_waitcnt lgkmcnt(0)" ::: "memory");
    float o0 = 0.f, o1 = 0.f, o2 = 0.f, o3 = 0.f;
    const float* vp = a.cache_v + ((size_t)(b * 128) * 2 + g) * 64 + lane;
#pragma unroll 8
    for (int r = 0; r < 128; ++r) { const float vx = vp[(size_t)r * 128]; o0 += ps[0 * 136 + r] * vx; o1 += ps[1 * 136 + r] * vx; o2 += ps[2 * 136 + r] * vx; o3 += ps[3 * 136 + r] * vx; }
#pragma unroll
    for (int tn = 0; tn < 4; ++tn) { const float vx = bf2f(H[(r0 + tn) * DIN + C_VA + g * 64 + lane]); o0 += ps[0 * 136 + 128 + tn] * vx; o1 += ps[1 * 136 + 128 + tn] * vx; o2 += ps[2 * 136 + 128 + tn] * vx; o3 += ps[3 * 136 + 128 + tn] * vx; }
    H[(r0 + 0) * DIN + C_QA + head * 64 + lane] = (bf16_t)(pk2(o0 * inv[0], 0.f) & 0xffffu);
    H[(r0 + 1) * DIN + C_QA + head * 64 + lane] = (bf16_t)(pk2(o1 * inv[1], 0.f) & 0xffffu);
    H[(r0 + 2) * DIN + C_QA + head * 64 + lane] = (bf16_t)(pk2(o2 * inv[2], 0.f) & 0xffffu);
    H[(r0 + 3) * DIN + C_QA + head * 64 + lane] = (bf16_t)(pk2(o3 * inv[3], 0.f) & 0xffffu);
    float* ko = a.out + O_KS + (size_t)b * 128 * 128; float* vo = a.out + O_VS + (size_t)b * 128 * 128;
    const float* ki = a.cache_k + (size_t)b * 128 * 128 + 4 * 128; const float* vi = a.cache_v + (size_t)b * 128 * 128 + 4 * 128;
    for (int i = tid; i < 124 * 32; i += NTHREADS) { ((f32x4*)ko)[i] = ((const f32x4*)ki)[i]; ((f32x4*)vo)[i] = ((const f32x4*)vi)[i]; }
    { const int t = tid >> 7, gd = tid & 127;
      ko[(size_t)(124 + t) * 128 + gd] = bf2f(H[(r0 + t) * DIN + C_KA + gd]); vo[(size_t)(124 + t) * 128 + gd] = bf2f(H[(r0 + t) * DIN + C_VA + gd]); }
}

__device__ __forceinline__ void ret_u_unit(const bf16_t* H, bf16_t* ST, LAS unsigned char* lds, int b, int c, int h, int tid, int lane, int wave) {
    const size_t rowc = (size_t)b * TSEQ + (size_t)c * 128; const float l2g = ret_log2g(h);
    LAS unsigned char* Kimg = lds; LAS unsigned char* Vimg = lds + 36864;
#pragma unroll
    for (int i = 0; i < 4; ++i) { const int id = tid + NTHREADS * i, j = id >> 4, ch = id & 15;
        const u32x4 kv = *(const u32x4*)(H + (rowc + j) * DIN + C_KR + h * 128 + ch * 8); const float kd = exp2f(l2g * (float)(127 - j));
        u32x4 w; w.x = pk2(bflo(kv.x) * kd, bfhi(kv.x) * kd); w.y = pk2(bflo(kv.y) * kd, bfhi(kv.y) * kd); w.z = pk2(bflo(kv.z) * kd, bfhi(kv.z) * kd); w.w = pk2(bflo(kv.w) * kd, bfhi(kv.w) * kd);
        *(LAS u32x4*)(Kimg + j * 288 + ch * 16) = w; }
#pragma unroll
    for (int i = 0; i < 8; ++i) { const int id = tid + NTHREADS * i, j = id >> 5, ch = id & 31;
        *(LAS u32x4*)(Vimg + j * 544 + ch * 16) = *(const u32x4*)(H + (rowc + j) * DIN + C_VR + h * 256 + ch * 8); }
    __syncthreads();
    const int fr = lane & 15, fq = lane >> 4, tq = fr >> 2, tpp = lane & 3;
    f32x4 acc[2][8];
#pragma unroll
    for (int i = 0; i < 2; ++i)
#pragma unroll
        for (int j = 0; j < 8; ++j) acc[i][j] = (f32x4){0.f, 0.f, 0.f, 0.f};
#pragma unroll
    for (int ks = 0; ks < 4; ++ks) {
        const int j0 = 32 * ks + 4 * fq + tq, j1 = j0 + 16;
        bf16x8 vf[2];
#pragma unroll
        for (int i = 0; i < 2; ++i) { const int col = 16 * (2 * wave + i) + 4 * tpp; vf[i] = tr_pair(Vimg + j0 * 544 + col * 2, Vimg + j1 * 544 + col * 2); }
#pragma unroll
        for (int kb = 0; kb < 8; ++kb) { const int col = 16 * kb + 4 * tpp; const bf16x8 kf = tr_pair(Kimg + j0 * 288 + col * 2, Kimg + j1 * 288 + col * 2);
#pragma unroll
            for (int i = 0; i < 2; ++i) acc[i][kb] = __builtin_amdgcn_mfma_f32_16x16x32_bf16(vf[i], kf, acc[i][kb], 0, 0, 0); }
    }
    bf16_t* U = ST + ((size_t)(b * 32 + c) * 4 + h) * 32768;
#pragma unroll
    for (int i = 0; i < 2; ++i)
#pragma unroll
        for (int kb = 0; kb < 8; ++kb) { u32x2 w; w.x = pk2(acc[i][kb][0], acc[i][kb][1]); w.y = pk2(acc[i][kb][2], acc[i][kb][3]); *(u32x2*)(U + (size_t)(16 * kb + fr) * 256 + 16 * (2 * wave + i) + 4 * fq) = w; }
    __syncthreads();
}

__device__ __forceinline__ void ret_sample_unit(const Args& a, bf16_t* H, LAS unsigned char* lds, int b, int h, int tid, int lane, int wave) {
    const size_t r0 = (size_t)MP + 4 * b; const float g = 1.0f - exp2f(-5.0f - (float)h);
    LAS float* qs = (LAS float*)lds; LAS float* ks = qs + 512; LAS float* po = ks + 512; LAS float* red = po + 2048;
    const int dv = tid & 255, half = tid >> 8;
    for (int i = tid; i < 1024; i += NTHREADS) { const int which = i >> 9, t = (i >> 7) & 3, d = i & 127;
        const float v = bf2f(H[(r0 + t) * DIN + (which ? C_KR : C_QR) + h * 128 + d]); if (which) ks[t * 128 + d] = v; else qs[t * 128 + d] = v; }
    float vt[4], gt[4];
#pragma unroll
    for (int t = 0; t < 4; ++t) { vt[t] = bf2f(H[(r0 + t) * DIN + C_VR + h * 256 + dv]); gt[t] = bf2f(H[(r0 + t) * DIN + C_GATE + h * 256 + dv]); }
    float S[64];
    const float* sp = a.state_ret + ((size_t)(b * 4 + h) * 128 + 64 * half) * 256 + dv;
#pragma unroll
    for (int d = 0; d < 64; ++d) S[d] = sp[(size_t)d * 256];
    __syncthreads();
#pragma unroll
    for (int t = 0; t < 4; ++t) { float o = 0.f;
#pragma unroll
        for (int d = 0; d < 64; ++d) { S[d] = g * S[d] + ks[t * 128 + 64 * half + d] * vt[t]; o += qs[t * 128 + 64 * half + d] * S[d]; }
        po[(half * 4 + t) * 256 + dv] = o; }
    float* so = a.out + O_RS + ((size_t)(b * 4 + h) * 128 + 64 * half) * 256 + dv;
#pragma unroll
    for (int d = 0; d < 64; ++d) so[(size_t)d * 256] = S[d];
    __syncthreads();
    float ot[4];
#pragma unroll
    for (int t = 0; t < 4; ++t) { ot[t] = po[t * 256 + dv] + po[(4 + t) * 256 + dv]; const float sq = wave_sum(half == 0 ? ot[t] * ot[t] : 0.f); if (lane == 0) red[wave * 4 + t] = sq; }
    __syncthreads();
    if (half == 0) {
#pragma unroll
        for (int t = 0; t < 4; ++t) { float ss = 0.f;
#pragma unroll
            for (int w = 0; w < 8; ++w) ss += red[w * 4 + t];
            const float rstd = rsqrtf(ss * (1.f / 256.f) + EPS); const float gv = gt[t]; const float sil = gv / (1.0f + __expf(-gv));
            H[(r0 + t) * DIN + C_VR + h * 256 + dv] = (bf16_t)(pk2(ot[t] * rstd * sil, 0.f) & 0xffffu); }
    }
    __syncthreads();
}

__device__ __forceinline__ void ret_out_unit(bf16_t* H, const bf16_t* ST, LAS unsigned char* lds, int b, int c, int h, int tid, int lane, int wave) {
    const size_t rowc = (size_t)b * TSEQ + (size_t)c * 128; const float l2g = ret_log2g(h);
    LAS unsigned char* Kimg = lds; LAS unsigned char* BIG = lds + 36864;
    const int fr = lane & 15, fq = lane >> 4, tq = fr >> 2, tpp = lane & 3;
    const int qi = 16 * wave + fr; const size_t qrow = rowc + qi;
#pragma unroll
    for (int i = 0; i < 4; ++i) { const int id = tid + NTHREADS * i, j = id >> 4, ch = id & 15;
        *(LAS u32x4*)(Kimg + j * 288 + ch * 16) = *(const u32x4*)(H + (rowc + j) * DIN + C_KR + h * 128 + ch * 8); }
    if (c > 0) {
        const bf16_t* S = ST + ((size_t)(b * 32 + c) * 4 + h) * 32768;
#pragma unroll
        for (int i = 0; i < 8; ++i) { const int id = tid + NTHREADS * i, dk = id >> 5, ch = id & 31;
            *(LAS u32x4*)(BIG + dk * 544 + ch * 16) = *(const u32x4*)(S + (size_t)dk * 256 + ch * 8); }
    }
    bf16x8 qf[4];
#pragma unroll
    for (int ks = 0; ks < 4; ++ks) { const bf16_t* qp = H + qrow * DIN + C_QR + h * 128 + 32 * ks + 4 * fq; qf[ks] = cat8(*(const u32x2*)qp, *(const u32x2*)(qp + 16)); }
    __syncthreads();
    f32x4 acc[16];
#pragma unroll
    for (int k = 0; k < 16; ++k) acc[k] = (f32x4){0.f, 0.f, 0.f, 0.f};
    if (c > 0) {
#pragma unroll
        for (int ks = 0; ks < 4; ++ks) { const int d0 = 32 * ks + 4 * fq + tq, d1 = d0 + 16;
#pragma unroll
            for (int blk = 0; blk < 16; ++blk) { const bf16x8 sf = tr_pair(BIG + d0 * 544 + (16 * blk + 4 * tpp) * 2, BIG + d1 * 544 + (16 * blk + 4 * tpp) * 2);
                acc[blk] = __builtin_amdgcn_mfma_f32_16x16x32_bf16(sf, qf[ks], acc[blk], 0, 0, 0); } }
        const float qd = exp2f(l2g * (float)(qi + 1));
#pragma unroll
        for (int blk = 0; blk < 16; ++blk) acc[blk] = acc[blk] * qd;
    }
    bf16x8 pf[4];
#pragma unroll
    for (int G = 0; G < 4; ++G) {
        f32x4 sc[2];
#pragma unroll
        for (int e = 0; e < 2; ++e) { const int jb = 2 * G + e; sc[e] = (f32x4){0.f, 0.f, 0.f, 0.f};
            if (jb <= wave) {
#pragma unroll
                for (int ks = 0; ks < 4; ++ks) { const LAS unsigned char* kp = Kimg + (16 * jb + fr) * 288 + (32 * ks + 4 * fq) * 2;
                    const bf16x8 kf = cat8(*(const LAS u32x2*)kp, *(const LAS u32x2*)(kp + 32)); sc[e] = __builtin_amdgcn_mfma_f32_16x16x32_bf16(kf, qf[ks], sc[e], 0, 0, 0); }
#pragma unroll
                for (int r = 0; r < 4; ++r) { const int j = 16 * jb + 4 * fq + r; sc[e][r] = (j <= qi) ? sc[e][r] * exp2f(l2g * (float)(qi - j)) : 0.f; }
            } }
        const u32x4 pw = {pk2(sc[0][0], sc[0][1]), pk2(sc[0][2], sc[0][3]), pk2(sc[1][0], sc[1][1]), pk2(sc[1][2], sc[1][3])};
        pf[G] = __builtin_bit_cast(bf16x8, pw);
    }
    __syncthreads();
#pragma unroll
    for (int i = 0; i < 8; ++i) { const int id = tid + NTHREADS * i, j = id >> 5, ch = id & 31;
        *(LAS u32x4*)(BIG + j * 544 + ch * 16) = *(const u32x4*)(H + (rowc + j) * DIN + C_VR + h * 256 + ch * 8); }
    __syncthreads();
#pragma unroll
    for (int G = 0; G < 4; ++G) {
        if (2 * G <= wave) { const int j0 = 32 * G + 4 * fq + tq, j1 = j0 + 16;
#pragma unroll
            for (int blk = 0; blk < 16; ++blk) { const bf16x8 vf = tr_pair(BIG + j0 * 544 + (16 * blk + 4 * tpp) * 2, BIG + j1 * 544 + (16 * blk + 4 * tpp) * 2);
                acc[blk] = __builtin_amdgcn_mfma_f32_16x16x32_bf16(vf, pf[G], acc[blk], 0, 0, 0); } }
    }
    float ss = 0.f;
#pragma unroll
    for (int blk = 0; blk < 16; ++blk) ss += (acc[blk][0] * acc[blk][0] + acc[blk][1] * acc[blk][1]) + (acc[blk][2] * acc[blk][2] + acc[blk][3] * acc[blk][3]);
    ss += __shfl_xor(ss, 16); ss += __shfl_xor(ss, 32);
    const float rstd = rsqrtf(ss * (1.f / 256.f) + EPS);
#pragma unroll
    for (int blk = 0; blk < 16; ++blk) {
        const u32x2 gw = *(const u32x2*)(H + qrow * DIN + C_GATE + h * 256 + 16 * blk + 4 * fq);
        const float g0 = bflo(gw.x), g1 = bfhi(gw.x), g2 = bflo(gw.y), g3 = bfhi(gw.y);
        u32x2 w; w.x = pk2(acc[blk][0] * rstd * g0 / (1.f + __expf(-g0)), acc[blk][1] * rstd * g1 / (1.f + __expf(-g1)));
        w.y = pk2(acc[blk][2] * rstd * g2 / (1.f + __expf(-g2)), acc[blk][3] * rstd * g3 / (1.f + __expf(-g3)));
        *(u32x2*)(H + qrow * DIN + C_VR + h * 256 + 16 * blk + 4 * fq) = w;
    }
    __syncthreads();
}

__device__ __forceinline__ f32x4 tail_gemm(const bf16_t* A, int lda, const bf16_t* Bt, int K, LAS unsigned char* lds, int tid, int lane, int wave, f32x4 acc) {
    const int fr = lane & 15, fq = lane >> 4, nc = K / 512;
    LAS unsigned char* Ai = lds; LAS unsigned char* Bi = lds + 33280;
    u32x4 ra[4], rb[8];
#pragma unroll
    for (int i = 0; i < 4; ++i) { const int id = tid + NTHREADS * i; ra[i] = *(const u32x4*)(A + (size_t)(id >> 6) * lda + (id & 63) * 8); }
#pragma unroll
    for (int i = 0; i < 8; ++i) { const int id = tid + NTHREADS * i; rb[i] = *(const u32x4*)(Bt + (size_t)(id >> 6) * K + (id & 63) * 8); }
#pragma nounroll
    for (int c = 0; c < nc; ++c) {
#pragma unroll
        for (int i = 0; i < 4; ++i) { const int id = tid + NTHREADS * i; *(LAS u32x4*)(Ai + (id >> 6) * 1040 + (id & 63) * 16) = ra[i]; }
#pragma unroll
        for (int i = 0; i < 8; ++i) { const int id = tid + NTHREADS * i; *(LAS u32x4*)(Bi + (id >> 6) * 1040 + (id & 63) * 16) = rb[i]; }
        __syncthreads();
        if (c + 1 < nc) {
#pragma unroll
            for (int i = 0; i < 4; ++i) { const int id = tid + NTHREADS * i; ra[i] = *(const u32x4*)(A + (size_t)(id >> 6) * lda + (c + 1) * 512 + (id & 63) * 8); }
#pragma unroll
            for (int i = 0; i < 8; ++i) { const int id = tid + NTHREADS * i; rb[i] = *(const u32x4*)(Bt + (size_t)(id >> 6) * K + (c + 1) * 512 + (id & 63) * 8); }
        }
        const LAS unsigned char* ap = Ai + (16 * (wave >> 2) + fr) * 1040 + fq * 16; const LAS unsigned char* bp = Bi + (16 * (wave & 3) + fr) * 1040 + fq * 16;
#pragma unroll
        for (int ks = 0; ks < 16; ++ks) { const bf16x8 av = *(const LAS bf16x8*)(ap + ks * 64), bv = *(const LAS bf16x8*)(bp + ks * 64); acc = __builtin_amdgcn_mfma_f32_16x16x32_bf16(bv, av, acc, 0, 0, 0); }
        __syncthreads();
    }
    return acc;
}

__global__ void __launch_bounds__(NTHREADS, 2) fwd_megakernel(Args a) {
    extern __shared__ __attribute__((aligned(16))) unsigned char lds_raw[];
    LAS unsigned char* lds = (LAS unsigned char*)lds_raw;
    cg::grid_group grid = cg::this_grid();
    const int tid = threadIdx.x, lane = tid & 63, wave = __builtin_amdgcn_readfirstlane(tid >> 6);
    const int nblk = gridDim.x, blk = blockIdx.x;
    unsigned char* ws = a.ws;
    bf16_t* WinT = (bf16_t*)(ws + WS_WIN); bf16_t* WupT = (bf16_t*)(ws + WS_WUP); bf16_t* WdnT = (bf16_t*)(ws + WS_WDN);
    bf16_t* WoT = (bf16_t*)(a.out + O_CS); bf16_t* WaT = WoT + 1024 * 1024; bf16_t* WrT = WaT + 1024 * 512;
    bf16_t* XN = (bf16_t*)(ws + WS_XN); bf16_t* H = (bf16_t*)(ws + WS_R1);
    bf16_t* MIXb = (bf16_t*)(ws + WS_R1);
    bf16_t* G = (bf16_t*)(ws + WS_R1 + R1_G); bf16_t* Fb = (bf16_t*)(ws + WS_R1 + R1_F); bf16_t* X1b = (bf16_t*)(ws + WS_R1 + R1_X1); bf16_t* UH = (bf16_t*)(ws + WS_R1 + R1_UH); bf16_t* US = (bf16_t*)(ws + WS_R1 + R1_US);
    bf16_t* ST = (bf16_t*)(a.out + O_Y);
    float* Y = a.out + O_Y;
    const int lo = a.ph_lo, hi = a.ph_hi;
#ifndef PROBE_REP_MASK
#define PROBE_REP_MASK 0
#endif
#define IN(k) (lo <= (k) && (k) < hi)
#define REPS(k) (((PROBE_REP_MASK >> (k)) & 1) ? 2 : 1)
#define SEAM(k) do { if (IN(k) && IN((k) + 1)) { asm volatile("s_waitcnt vmcnt(0)" ::: "memory"); __syncthreads(); grid.sync(); } } while (0)

    if (IN(0)) { p0_prologue(a, lds, tid, lane, wave); }
    SEAM(0);
    if (IN(1)) {
        pg8::Gemm g{XN, WinT, M, DIN, D, D}; pg8::StaticOrder S; S.init(M, DIN, nblk, blk);
        pg8::EpiH E{H, (const pg8::f32x2e*)(ws + WS_TABA), (const pg8::f32x2e*)(ws + WS_TABR)};
        pg8::gemm_phase<pg8::EpiH, pg8::StaticOrder, true, true>(lds, g, S, E);
    }
    SEAM(1);
    if (IN(2)) {
        for (int u = blk; u < 1024; u += nblk) { const int head = u & 7, qb = (u >> 3) & 31, b = u >> 8; attn_prompt_unit(H, a.sinks, lds, b, qb, head, tid, lane, wave); }
        for (int u = blk; u < 512; u += nblk) { const int h = u & 3, c = (u >> 2) & 31, b = u >> 7; ret_u_unit(H, ST, lds, b, c, h, tid, lane, wave); }
        for (int u = blk; u < 128; u += nblk) { attn_sample_unit(a, H, lds, u, tid, lane, wave); __syncthreads(); }
        for (int u = blk; u < 512; u += nblk) { ret_sample_unit(a, H, lds, u >> 2, u & 3, tid, lane, wave); }
        for (int e = blk * NTHREADS + tid; e < 4 * 128 * 128; e += nblk * NTHREADS) { const int gd = e & 127, r = (e >> 7) & 127, b = e >> 14; const size_t row = (size_t)b * TSEQ + TSEQ - 128 + r;
            a.out[O_KP + e] = bf2f(H[row * DIN + C_KA + gd]); a.out[O_VP + e] = bf2f(H[row * DIN + C_VA + gd]); }
    }
    SEAM(2);
    if (IN(3)) {
        for (int e4 = blk * NTHREADS + tid; e4 < 16 * 8192; e4 += nblk * NTHREADS) {
            const int bh = e4 >> 13, idx = (e4 & 8191) * 4, b = bh >> 2, h = bh & 3;
            const float gL = exp2f(128.f * ret_log2g(h));
            f32x4 S = {0.f, 0.f, 0.f, 0.f};
#pragma unroll 8
            for (int c = 0; c < 32; ++c) { bf16_t* p = ST + ((size_t)(b * 32 + c) * 4 + h) * 32768 + idx; const u32x2 uw = *(const u32x2*)p; u32x2 sw; sw.x = pk2(S.x, S.y); sw.y = pk2(S.z, S.w); *(u32x2*)p = sw;
                const f32x4 uu = {bflo(uw.x), bfhi(uw.x), bflo(uw.y), bfhi(uw.y)}; S = S * gL + uu; }
            *(f32x4*)(a.out + O_RP + (size_t)bh * 32768 + idx) = S;
        }
    }
    SEAM(3);
    if (IN(4)) {
        for (int u = blk; u < 512; u += nblk) { const int h = u & 3, c = (u >> 2) & 31, b = u >> 7; ret_out_unit(H, ST, lds, b, c, h, tid, lane, wave); }
    }
    SEAM(4);
    if (IN(5)) {
        { pg8::Gemm g{H + C_QA, WaT, MP, D, 512, DIN}; pg8::StaticOrder S; S.init(MP, D, nblk, blk);
          pg8::EpiGate<false> E{XN, H + C_GMA, DIN}; pg8::gemm_phase<pg8::EpiGate<false>, pg8::StaticOrder, true, true>(lds, g, S, E); }
        __syncthreads();
        { pg8::Gemm g{H + C_VR, WrT, MP, D, D, DIN}; pg8::StaticOrder S; S.init(MP, D, nblk, blk);
          pg8::EpiGate<true> E{XN, H + C_GMR, DIN}; pg8::gemm_phase<pg8::EpiGate<true>, pg8::StaticOrder, true, true>(lds, g, S, E); }
        for (int piece = blk; piece < 256; piece += nblk) {
            const int fr = lane & 15, fq = lane >> 4; const size_t prow = (size_t)MP + 32 * (piece >> 4); const size_t row = prow + 16 * (wave >> 2) + fr; const int pcol = 64 * (piece & 15), col0 = pcol + 16 * (wave & 3);
            const f32x4 aa = tail_gemm(H + prow * DIN + C_QA, DIN, WaT + (size_t)pcol * 512, 512, lds, tid, lane, wave, (f32x4){0.f, 0.f, 0.f, 0.f});
            const f32x4 ar = tail_gemm(H + prow * DIN + C_VR, DIN, WrT + (size_t)pcol * 1024, 1024, lds, tid, lane, wave, (f32x4){0.f, 0.f, 0.f, 0.f});
            const int cb = col0 + 4 * fq;
            const u32x2 ga = *(const u32x2*)(H + row * DIN + C_GMA + cb), gr = *(const u32x2*)(H + row * DIN + C_GMR + cb);
            u32x2 w; w.x = pk2(pg8::sigmoidf_(bflo(ga.x)) * aa[0] + pg8::sigmoidf_(bflo(gr.x)) * ar[0], pg8::sigmoidf_(bfhi(ga.x)) * aa[1] + pg8::sigmoidf_(bfhi(gr.x)) * ar[1]);
            w.y = pk2(pg8::sigmoidf_(bflo(ga.y)) * aa[2] + pg8::sigmoidf_(bflo(gr.y)) * ar[2], pg8::sigmoidf_(bfhi(ga.y)) * aa[3] + pg8::sigmoidf_(bfhi(gr.y)) * ar[3]);
            *(u32x2*)(XN + row * D + cb) = w;
        }
    }
    SEAM(5);
    if (IN(6)) {
        pg8::Gemm g{XN, WoT, MP, D, D, D}; pg8::StaticOrder S; S.init(MP, D, nblk, blk);
        pg8::EpiBf16<0> E{MIXb, D, nullptr, 0, 0, 1.f}; pg8::gemm_phase<pg8::EpiBf16<0>, pg8::StaticOrder, true, true>(lds, g, S, E);
        for (int piece = blk; piece < 256; piece += nblk) {
            const int fr = lane & 15, fq = lane >> 4; const size_t prow = (size_t)MP + 32 * (piece >> 4); const size_t row = prow + 16 * (wave >> 2) + fr; const int pcol = 64 * (piece & 15), col0 = pcol + 16 * (wave & 3);
            const f32x4 ac = tail_gemm(XN + prow * D, D, WoT + (size_t)pcol * 1024, 1024, lds, tid, lane, wave, (f32x4){0.f, 0.f, 0.f, 0.f});
            u32x2 w; w.x = pk2(ac[0], ac[1]); w.y = pk2(ac[2], ac[3]); *(u32x2*)(MIXb + row * D + col0 + 4 * fq) = w;
        }
    }
    SEAM(6);
    if (IN(7)) {
        f32x4 gpm[2][2], gpf[2][2];
#pragma unroll
        for (int j = 0; j < 2; ++j)
#pragma unroll
            for (int e = 0; e < 2; ++e) { gpm[j][e] = *((const f32x4*)a.g_post_mix + 2 * (lane + 64 * j) + e); gpf[j][e] = *((const f32x4*)a.g_pre_ffn + 2 * (lane + 64 * j) + e); }
        for (int p = blk * NWAVES + wave; p < M / 2; p += nblk * NWAVES) {
            u32x4 mb[2][2]; f32x4 xx[2][2][2];
#pragma unroll
            for (int rr = 0; rr < 2; ++rr) { const int m = 2 * p + rr; const float* xr = m < MP ? a.x_prompt + (size_t)m * D : a.x_sample + (size_t)(m - MP) * D;
#pragma unroll
                for (int j = 0; j < 2; ++j) { mb[rr][j] = *((const u32x4*)(MIXb + (size_t)m * D) + lane + 64 * j); xx[rr][j][0] = *((const f32x4*)xr + 2 * (lane + 64 * j)); xx[rr][j][1] = *((const f32x4*)xr + 2 * (lane + 64 * j) + 1); } }
            float mv[2][2][8]; float ss[2];
#pragma unroll
            for (int rr = 0; rr < 2; ++rr) { ss[rr] = 0.f;
#pragma unroll
                for (int j = 0; j < 2; ++j)
#pragma unroll
                    for (int q = 0; q < 4; ++q) { const unsigned w = mb[rr][j][q]; mv[rr][j][2 * q] = bflo(w); mv[rr][j][2 * q + 1] = bfhi(w); ss[rr] += mv[rr][j][2 * q] * mv[rr][j][2 * q] + mv[rr][j][2 * q + 1] * mv[rr][j][2 * q + 1]; } }
            ss[0] = wave_sum(ss[0]); ss[1] = wave_sum(ss[1]);
            float s2[2];
#pragma unroll
            for (int rr = 0; rr < 2; ++rr) { const float rstd = rsqrtf(ss[rr] * (1.f / D) + EPS); s2[rr] = 0.f;
#pragma unroll
                for (int j = 0; j < 2; ++j)
#pragma unroll
                    for (int q = 0; q < 8; ++q) { const float x1 = xx[rr][j][q >> 2][q & 3] + mv[rr][j][q] * rstd * gpm[j][q >> 2][q & 3]; mv[rr][j][q] = x1; s2[rr] += x1 * x1; } }
            s2[0] = wave_sum(s2[0]); s2[1] = wave_sum(s2[1]);
#pragma unroll
            for (int rr = 0; rr < 2; ++rr) { const int m = 2 * p + rr; const float rstd2 = rsqrtf(s2[rr] * (1.f / D) + EPS);
#pragma unroll
                for (int j = 0; j < 2; ++j) { u32x4 w1, w2;
#pragma unroll
                    for (int q = 0; q < 4; ++q) { const float a0 = mv[rr][j][2 * q], a1 = mv[rr][j][2 * q + 1]; w1[q] = pk2(a0, a1);
                        w2[q] = pk2(a0 * rstd2 * gpf[j][(2 * q) >> 2][(2 * q) & 3], a1 * rstd2 * gpf[j][(2 * q + 1) >> 2][(2 * q + 1) & 3]); }
                    *((u32x4*)(X1b + (size_t)m * D) + lane + 64 * j) = w1; *((u32x4*)(XN + (size_t)m * D) + lane + 64 * j) = w2; } }
        }
    }
    SEAM(7);
    if (IN(8)) {
        pg8::Gemm g{XN, WupT, M, F2, D, D}; pg8::StaticOrder S; S.init(M, F2, nblk, blk);
        pg8::EpiUp E{G, UH, US, a.out + O_CP, a.out + O_CS, a.conv_w, a.conv_b};
        pg8::gemm_phase<pg8::EpiUp, pg8::StaticOrder, true, true>(lds, g, S, E);
    }
    SEAM(8);
    if (IN(9)) {
        for (int task = blk * NWAVES + wave; task < 1024 * 6; task += nblk * NWAVES) {
            const int rt = task / 6, chunk = task % 6; const int ch = chunk * 512 + lane * 8;
            float ua[3][8], ub[3][8];
            int row;
#define LD8BF(dst, ptr) do { const u32x4 _w = *(const u32x4*)(ptr); dst[0] = bflo(_w.x); dst[1] = bfhi(_w.x); dst[2] = bflo(_w.y); dst[3] = bfhi(_w.y); dst[4] = bflo(_w.z); dst[5] = bfhi(_w.z); dst[6] = bflo(_w.w); dst[7] = bfhi(_w.w); } while (0)
#define LD8F(dst, ptr) do { const f32x4 _a = *(const f32x4*)(ptr), _b = *(const f32x4*)((ptr) + 4); dst[0] = _a.x; dst[1] = _a.y; dst[2] = _a.z; dst[3] = _a.w; dst[4] = _b.x; dst[5] = _b.y; dst[6] = _b.z; dst[7] = _b.w; } while (0)
#define ZERO8(dst) do { _Pragma("unroll") for (int _i = 0; _i < 8; ++_i) dst[_i] = 0.f; } while (0)
            if (rt < 512) {
                const int grp = rt >> 1, k = rt & 1; row = grp * 64 + k; const int t = row & 4095;
                const bf16_t* u0 = UH + (size_t)(grp * 4 + 2 + k) * F2;
                LD8BF(ua[2], u0 + ch); LD8BF(ub[2], u0 + DFF + ch);
                if (t >= 1) { const bf16_t* u1 = (k == 0) ? UH + (size_t)((grp - 1) * 4 + 1) * F2 : UH + (size_t)(grp * 4 + 2) * F2; LD8BF(ua[1], u1 + ch); LD8BF(ub[1], u1 + DFF + ch); } else { ZERO8(ua[1]); ZERO8(ub[1]); }
                if (t >= 2) { const bf16_t* u2 = UH + (size_t)((grp - 1) * 4 + k) * F2; LD8BF(ua[0], u2 + ch); LD8BF(ub[0], u2 + DFF + ch); } else { ZERO8(ua[0]); ZERO8(ub[0]); }
            } else {
                const int sr = rt - 512, b = sr >> 2, t = sr & 3; row = MP + sr;
#pragma unroll
                for (int tap = 0; tap < 3; ++tap) { const int e = t + tap;
                    if (e < 2) { const float* cp = a.state_conv + ((size_t)b * 2 + e) * F2; LD8F(ua[tap], cp + ch); LD8F(ub[tap], cp + DFF + ch); }
                    else { const bf16_t* up = US + (size_t)(b * 4 + e - 2) * F2; LD8BF(ua[tap], up + ch); LD8BF(ub[tap], up + DFF + ch); } }
            }
            float wa[3][8], wb[3][8], ba[8], bb[8];
#pragma unroll
            for (int tap = 0; tap < 3; ++tap) { LD8F(wa[tap], a.conv_w + (size_t)tap * F2 + ch); LD8F(wb[tap], a.conv_w + (size_t)tap * F2 + DFF + ch); }
            LD8F(ba, a.conv_b + ch); LD8F(bb, a.conv_b + DFF + ch);
            float gg[8];
#pragma unroll
            for (int i = 0; i < 8; ++i) { const float ca = ba[i] + wa[0][i] * ua[0][i] + wa[1][i] * ua[1][i] + wa[2][i] * ua[2][i], cb = bb[i] + wb[0][i] * ub[0][i] + wb[1][i] * ub[1][i] + wb[2][i] * ub[2][i];
                gg[i] = pg8::gelu_tanh(ca) * cb; }
            u32x4 w; w.x = pk2(gg[0], gg[1]); w.y = pk2(gg[2], gg[3]); w.z = pk2(gg[4], gg[5]); w.w = pk2(gg[6], gg[7]);
            *(u32x4*)(G + (size_t)row * DFF + ch) = w;
        }
    }
    SEAM(9);
    if (IN(10)) {
        pg8::Gemm g{G, WdnT, MP, D, DFF, DFF}; pg8::StaticOrder S; S.init(MP, D, nblk, blk);
        pg8::EpiBf16<0> E{Fb, D, nullptr, 0, 0, 1.f}; pg8::gemm_phase<pg8::EpiBf16<0>, pg8::StaticOrder, true, true>(lds, g, S, E);
        for (int piece = blk; piece < 256; piece += nblk) {
            const int fr = lane & 15, fq = lane >> 4; const size_t prow = (size_t)MP + 32 * (piece >> 4); const size_t row = prow + 16 * (wave >> 2) + fr; const int pcol = 64 * (piece & 15), col0 = pcol + 16 * (wave & 3);
            const f32x4 ac = tail_gemm(G + prow * DFF, DFF, WdnT + (size_t)pcol * DFF, DFF, lds, tid, lane, wave, (f32x4){0.f, 0.f, 0.f, 0.f});
            u32x2 w; w.x = pk2(ac[0], ac[1]); w.y = pk2(ac[2], ac[3]); *(u32x2*)(Fb + row * D + col0 + 4 * fq) = w;
        }
    }
    SEAM(10);
    if (IN(11)) {
        f32x4 gpo[2][2];
#pragma unroll
        for (int j = 0; j < 2; ++j)
#pragma unroll
            for (int e = 0; e < 2; ++e) gpo[j][e] = *((const f32x4*)a.g_post_ffn + 2 * (lane + 64 * j) + e);
        for (int p = blk * NWAVES + wave; p < M / 2; p += nblk * NWAVES) {
            u32x4 fb[2][2], xb[2][2];
#pragma unroll
            for (int rr = 0; rr < 2; ++rr) { const int m = 2 * p + rr;
#pragma unroll
                for (int j = 0; j < 2; ++j) { fb[rr][j] = *((const u32x4*)(Fb + (size_t)m * D) + lane + 64 * j); xb[rr][j] = *((const u32x4*)(X1b + (size_t)m * D) + lane + 64 * j); } }
            float ss[2];
#pragma unroll
            for (int rr = 0; rr < 2; ++rr) { ss[rr] = 0.f;
#pragma unroll
                for (int j = 0; j < 2; ++j)
#pragma unroll
                    for (int q = 0; q < 4; ++q) { const unsigned w = fb[rr][j][q]; ss[rr] += bflo(w) * bflo(w) + bfhi(w) * bfhi(w); } }
            ss[0] = wave_sum(ss[0]); ss[1] = wave_sum(ss[1]);
#pragma unroll
            for (int rr = 0; rr < 2; ++rr) { const int m = 2 * p + rr; const float rstd = rsqrtf(ss[rr] * (1.f / D) + EPS);
#pragma unroll
                for (int j = 0; j < 2; ++j)
#pragma unroll
                    for (int e = 0; e < 2; ++e) { f32x4 y;
#pragma unroll
                        for (int q = 0; q < 2; ++q) { const unsigned fw = fb[rr][j][2 * e + q], xw = xb[rr][j][2 * e + q];
                            y[2 * q] = bflo(xw) + bflo(fw) * rstd * gpo[j][e][2 * q]; y[2 * q + 1] = bfhi(xw) + bfhi(fw) * rstd * gpo[j][e][2 * q + 1]; }
                        *((f32x4*)(Y + (size_t)m * D) + 2 * (lane + 64 * j) + e) = y; } }
        }
    }
#undef IN
#undef SEAM
}

#ifndef MK_SPLIT
#define MK_SPLIT 0
#endif
extern "C" void kernel_launch(void* const* d_in, const int* in_sizes, int n_in, void* d_out, int out_size, void* d_ws, size_t ws_size, hipStream_t stream) {
    static int grid = 0;
    if (grid == 0) {
        int dev = 0, cus = 0, per_cu = 0;
        if (hipGetDevice(&dev) != hipSuccess || hipDeviceGetAttribute(&cus, hipDeviceAttributeMultiprocessorCount, dev) != hipSuccess) { fprintf(stderr, "kernel_launch: device query failed\n"); grid = -1; return; }
        if (hipFuncSetAttribute((const void*)fwd_megakernel, hipFuncAttributeMaxDynamicSharedMemorySize, LDS_BYTES) != hipSuccess) { fprintf(stderr, "kernel_launch: hipFuncSetAttribute failed\n"); grid = -1; return; }
        if (hipOccupancyMaxActiveBlocksPerMultiprocessor(&per_cu, (const void*)fwd_megakernel, NTHREADS, LDS_BYTES) != hipSuccess || per_cu < 1) { fprintf(stderr, "kernel_launch: occupancy query says %d\n", per_cu); per_cu = 1; }
        (void)hipGetLastError();
        grid = cus * 1;
        if (ws_size < 256 * MiB || out_size != (int)O_END || n_in != 19) fprintf(stderr, "kernel_launch: unexpected sizes ws %zu out %d n_in %d\n", ws_size, out_size, n_in);
    }
    if (grid < 0) return;
    Args a{};
    a.x_prompt = (const float*)d_in[0]; a.x_sample = (const float*)d_in[1]; a.cache_k = (const float*)d_in[2]; a.cache_v = (const float*)d_in[3]; a.state_ret = (const float*)d_in[4];
    a.state_conv = (const float*)d_in[5]; a.w_in = (const float*)d_in[6]; a.sinks = (const float*)d_in[7]; a.w_a = (const float*)d_in[8]; a.w_r = (const float*)d_in[9]; a.w_o = (const float*)d_in[10];
    a.g_pre_mix = (const float*)d_in[11]; a.g_post_mix = (const float*)d_in[12]; a.g_pre_ffn = (const float*)d_in[13]; a.g_post_ffn = (const float*)d_in[14];
    a.w_up = (const float*)d_in[15]; a.conv_w = (const float*)d_in[16]; a.conv_b = (const float*)d_in[17]; a.w_down = (const float*)d_in[18];
    a.out = (float*)d_out; a.ws = (unsigned char*)d_ws;
#if MK_SPLIT
    for (int ph = 0; ph < 12; ++ph) { a.ph_lo = ph; a.ph_hi = ph + 1; hipLaunchKernelGGL(fwd_megakernel, dim3(grid), dim3(NTHREADS), LDS_BYTES, stream, a); }
#else
    a.ph_lo = 0; a.ph_hi = 12;
    void* args[] = {&a};
    const hipError_t e = hipLaunchCooperativeKernel((const void*)fwd_megakernel, dim3(grid), dim3(NTHREADS), args, LDS_BYTES, stream);
    if (e != hipSuccess) fprintf(stderr, "kernel_launch: cooperative launch failed: %s (grid %d)\n", hipGetErrorString(e), grid);
#endif
}
```

```cpp
#include <hip/hip_runtime.h>
#include <hip/hip_cooperative_groups.h>
#include <cstdio>
#include <cstdint>
#include <cmath>
namespace cg = cooperative_groups;
namespace pg8 {
#define PG8_LAS __attribute__((address_space(3)))
typedef unsigned short bf16_t;
typedef short bf16x8 __attribute__((ext_vector_type(8)));
typedef float f32x4 __attribute__((ext_vector_type(4)));
typedef unsigned u32x4 __attribute__((ext_vector_type(4)));
constexpr int BM = 256, BK = 64, HALF = 128, HTB = HALF * BK * 2  , STAGE_BYTES = 8 * HTB, NXCD = 8, WGM = 8;

__host__ __device__ __forceinline__ int lds_byte(int r, int c) { const int st = (r >> 4) * 2 + (c >> 5), rr = r & 15, cc = c & 31, ob = rr * 64 + cc * 2; return st * 1024 + (ob ^ (((ob >> 9) & 1) << 5)); }
__host__ __device__ __forceinline__ void stage_rc(int b, int& R, int& C) { const int st = b / 1024, sb = b % 1024, swz = sb ^ (((sb >> 9) & 1) << 5); R = (st >> 1) * 16 + swz / 64; C = (st & 1) * 32 + (swz % 64) / 2; }
__host__ __device__ __forceinline__ int perm32(int rho) { const int n = rho >> 4, i = rho & 15; return 8 * (i >> 2) + 4 * n + (i & 3); }

struct Unit { int pm, pn; };
struct Gemm { const bf16_t* A; const bf16_t* Bt; int M, N, K, lda; };

struct StaticOrder {
    int nM, nN, nwg, G, c;
    __host__ __device__ void init(int M, int N, int G_, int c_) { nM = M / BM; nN = N / BM; nwg = nM * nN; G = G_; c = c_; }
    __host__ __device__ bool next(int i, Unit& u) const {
        const long L = (long)i * G + c; if (L >= nwg) return false;
        int wgid = (int)L; { const int q = nwg / NXCD, r = nwg % NXCD, xcd = wgid % NXCD, off = wgid / NXCD; wgid = (xcd < r ? xcd * (q + 1) : r * (q + 1) + (xcd - r) * q) + off; }
        const int nig = WGM * nN, gid = wgid / nig, fm = gid * WGM, gsz = (nM - fm) < WGM ? (nM - fm) : WGM;
        u.pm = fm + ((wgid % nig) % gsz); u.pn = (wgid % nig) / gsz; return true;
    }
    __device__ __forceinline__ void a_ready(const Unit&) const {}
    __device__ __forceinline__ void done(const Unit&) const {}
};

__device__ __forceinline__ unsigned cvt_pk_bf16(float lo, float hi) { unsigned r; asm volatile("v_cvt_pk_bf16_f32 %0, %1, %2" : "=v"(r) : "v"(lo), "v"(hi)); return r; }
typedef float f32x2 __attribute__((ext_vector_type(2)));
__device__ __forceinline__ f32x2 gelu_pk(f32x2 v) {
    const f32x2 av = __builtin_elementwise_abs(v), d = av * 0.2316418882f + 1.0f;
    f32x2 t; t.x = __builtin_amdgcn_rcpf(d.x); t.y = __builtin_amdgcn_rcpf(d.y);
    f32x2 q = t * 0.5307027145f + (-0.7265760135f); q = q * t + 0.7107068705f; q = q * t + (-0.142248368f); q = q * t + 0.127414796f; q = q * t;
    const f32x2 s = (v * v) * (-0.72134752044f);
    f32x2 e; e.x = __builtin_amdgcn_exp2f(s.x); e.y = __builtin_amdgcn_exp2f(s.y);
    const f32x2 m = v * (q * e), r = v - m;
    f32x2 o; o.x = v.x < 0.f ? m.x : r.x; o.y = v.y < 0.f ? m.y : r.y; return o;
}

template <int ACT  > struct EpiBf16 {
    static constexpr bool PERM = true, AFTER_DRAIN = false; static_assert(ACT == 0 || ACT == 1, "EpiBf16: ACT is 0 (none) or 1 (gelu_pk)");
    bf16_t* O; int ldc; const float* bias; int split_cols; size_t split_stride; float scale0;
    __device__ __forceinline__ void operator()(const f32x4 (&acc)[2][2][4][2], const Unit& u, int wr, int wc, int fr, int fq) const {
        const int row0 = u.pm * BM + wr * 64 + fr; int colt = u.pn * BM; bf16_t* base = O;
        float sc = 1.f; if (split_cols) { const int t = colt / split_cols; base += (size_t)t * split_stride; colt -= t * split_cols; if (t == 0) sc = scale0; }
        const int col0 = colt + wc * 32 + 8 * fq, bcol0 = u.pn * BM + wc * 32 + 8 * fq;
        f32x4 bv[2][2];
#pragma unroll
        for (int bj = 0; bj < 2; ++bj)
#pragma unroll
            for (int n = 0; n < 2; ++n) bv[bj][n] = bias ? *(const f32x4*)(bias + bcol0 + bj * HALF + 4 * n) : (f32x4){0.f, 0.f, 0.f, 0.f};
#pragma unroll
        for (int ai = 0; ai < 2; ++ai)
#pragma unroll
            for (int m = 0; m < 4; ++m) { bf16_t* rowp = base + (size_t)(row0 + ai * HALF + m * 16) * ldc + col0;
#pragma unroll
                for (int bj = 0; bj < 2; ++bj) { f32x4 v0 = acc[ai][bj][m][0] + bv[bj][0], v1 = acc[ai][bj][m][1] + bv[bj][1];
                    if (ACT == 1) { f32x2 a = gelu_pk((f32x2){v0[0], v0[1]}), b = gelu_pk((f32x2){v0[2], v0[3]}), c = gelu_pk((f32x2){v1[0], v1[1]}), d = gelu_pk((f32x2){v1[2], v1[3]});
                        v0 = (f32x4){a.x, a.y, b.x, b.y}; v1 = (f32x4){c.x, c.y, d.x, d.y}; }
                    v0 = v0 * sc; v1 = v1 * sc; u32x4 w; w.x = cvt_pk_bf16(v0[0], v0[1]); w.y = cvt_pk_bf16(v0[2], v0[3]); w.z = cvt_pk_bf16(v1[0], v1[1]); w.w = cvt_pk_bf16(v1[2], v1[3]);
                    *(u32x4*)(rowp + bj * HALF) = w; } }
    }
};

typedef float f32x2e __attribute__((ext_vector_type(2)));
typedef unsigned u32x2e __attribute__((ext_vector_type(2)));
__device__ __forceinline__ float bf_lo(unsigned w) { return __uint_as_float(w << 16); }
__device__ __forceinline__ float bf_hi(unsigned w) { return __uint_as_float(w & 0xffff0000u); }
__device__ __forceinline__ float sigmoidf_(float x) { return __builtin_amdgcn_rcpf(1.0f + __expf(-x)); }
constexpr int E_MP = 16384, E_DIN = 5888;

struct EpiH {
    static constexpr bool PERM = true, AFTER_DRAIN = false;
    bf16_t* H; const f32x2e* tabA; const f32x2e* tabR;
    __device__ __forceinline__ void operator()(const f32x4 (&acc)[2][2][4][2], const Unit& u, int wr, int wc, int fr, int fq) const {
        const int pn = u.pn;
        const int row0 = u.pm * BM + wr * 64 + fr;
        const int colt = pn * BM + wc * 32 + 8 * fq;
#pragma unroll
        for (int ai = 0; ai < 2; ++ai)
#pragma unroll
            for (int m = 0; m < 4; ++m) {
                const int row = row0 + ai * HALF + m * 16;
                const int tp = row < E_MP ? (row & 4095) : 4096 + (row & 3);
#pragma unroll
                for (int bj = 0; bj < 2; ++bj) {
                    float v[8];
#pragma unroll
                    for (int j = 0; j < 4; ++j) { v[j] = acc[ai][bj][m][0][j]; v[4 + j] = acc[ai][bj][m][1][j]; }
                    int mode = 0; float sc = 1.f;
                    if (pn < 2) { mode = 1; sc = 0.125f; }
                    else if (pn == 2) { mode = (bj == 0) ? 1 : 0; }
                    else if (pn < 5) { mode = 2; }
                    else if (pn < 7) { mode = 2; sc = 0.08838834764831845f; }
                    if (mode == 1) {
                        const bool rot = ((wc & 1) == 0) && (fq < 2);
                        const float sgn = (fq == 0) ? -1.f : 1.f;
#pragma unroll
                        for (int j = 0; j < 8; ++j) {
                            const float partner = __shfl_xor(v[j], 16);
                            const f32x2e cs = tabA[tp * 8 + j];
                            const float o = v[j] * cs.x + sgn * partner * cs.y;
                            v[j] = (rot ? o : v[j]) * sc;
                        }
                    } else if (mode == 2) {
                        const int pi = ((bj * HALF + wc * 32 + 8 * fq) & 127) >> 1;
#pragma unroll
                        for (int p = 0; p < 4; ++p) {
                            const f32x2e cs = tabR[tp * 64 + pi + p];
                            const float x0 = v[2 * p], x1 = v[2 * p + 1];
                            v[2 * p] = (x0 * cs.x - x1 * cs.y) * sc; v[2 * p + 1] = (x1 * cs.x + x0 * cs.y) * sc;
                        }
                    }
                    u32x4 w; w.x = cvt_pk_bf16(v[0], v[1]); w.y = cvt_pk_bf16(v[2], v[3]); w.z = cvt_pk_bf16(v[4], v[5]); w.w = cvt_pk_bf16(v[6], v[7]);
                    *(u32x4*)(H + (size_t)row * E_DIN + colt + bj * HALF) = w;
                }
            }
    }
};

template <bool ADD> struct EpiGate {
    static constexpr bool PERM = true, AFTER_DRAIN = false;
    bf16_t* T; const bf16_t* gate; int ldg;
    __device__ __forceinline__ void operator()(const f32x4 (&acc)[2][2][4][2], const Unit& u, int wr, int wc, int fr, int fq) const {
        const int row0 = u.pm * BM + wr * 64 + fr, col0 = u.pn * BM + wc * 32 + 8 * fq;
#pragma unroll
        for (int ai = 0; ai < 2; ++ai)
#pragma unroll
            for (int m = 0; m < 4; ++m) {
                const int row = row0 + ai * HALF + m * 16;
#pragma unroll
                for (int bj = 0; bj < 2; ++bj) {
                    const u32x4 gw = *(const u32x4*)(gate + (size_t)row * ldg + col0 + bj * HALF);
                    bf16_t* tp = T + (size_t)row * 1024 + col0 + bj * HALF;
                    u32x4 old = (u32x4){0u, 0u, 0u, 0u}; if (ADD) old = *(const u32x4*)tp;
                    float o[8];
#pragma unroll
                    for (int j = 0; j < 4; ++j) {
                        const unsigned g2 = gw[j], o2 = old[j];
                        const float a0 = acc[ai][bj][m][j >> 1][(j & 1) * 2], a1 = acc[ai][bj][m][j >> 1][(j & 1) * 2 + 1];
                        o[2 * j] = bf_lo(o2) + sigmoidf_(bf_lo(g2)) * a0; o[2 * j + 1] = bf_hi(o2) + sigmoidf_(bf_hi(g2)) * a1;
                    }
                    u32x4 w; w.x = cvt_pk_bf16(o[0], o[1]); w.y = cvt_pk_bf16(o[2], o[3]); w.z = cvt_pk_bf16(o[4], o[5]); w.w = cvt_pk_bf16(o[6], o[7]);
                    *(u32x4*)tp = w;
                }
            }
    }
};

struct EpiF32 {
    static constexpr bool PERM = true, AFTER_DRAIN = false;
    float* O;
    __device__ __forceinline__ void operator()(const f32x4 (&acc)[2][2][4][2], const Unit& u, int wr, int wc, int fr, int fq) const {
        const int row0 = u.pm * BM + wr * 64 + fr, col0 = u.pn * BM + wc * 32 + 8 * fq;
#pragma unroll
        for (int ai = 0; ai < 2; ++ai)
#pragma unroll
            for (int m = 0; m < 4; ++m) {
                float* rp = O + (size_t)(row0 + ai * HALF + m * 16) * 1024 + col0;
#pragma unroll
                for (int bj = 0; bj < 2; ++bj) { *(f32x4*)(rp + bj * HALF) = acc[ai][bj][m][0]; *(f32x4*)(rp + bj * HALF + 4) = acc[ai][bj][m][1]; }
            }
    }
};

__device__ __forceinline__ float dpp_ror1(float x) { return __builtin_bit_cast(float, __builtin_amdgcn_update_dpp(0, __builtin_bit_cast(int, x), 0x121, 0xf, 0xf, false)); }
__device__ __forceinline__ float dpp_ror2(float x) { return __builtin_bit_cast(float, __builtin_amdgcn_update_dpp(0, __builtin_bit_cast(int, x), 0x122, 0xf, 0xf, false)); }
__device__ __forceinline__ float gelu_tanh(float x) { const float u2 = 1.5957691216057308f * (x + 0.044715f * x * x * x); return x * __builtin_amdgcn_rcpf(1.0f + __expf(-u2)); }
struct EpiUp {
    static constexpr bool PERM = true, AFTER_DRAIN = false;
    bf16_t* G; bf16_t* UH; bf16_t* US; float* conv_prompt; float* conv_sample; const float* conv_w; const float* conv_b;
    __device__ __forceinline__ void operator()(const f32x4 (&acc)[2][2][4][2], const Unit& u, int wr, int wc, int fr, int fq) const {
        const int row0 = u.pm * BM + wr * 64 + fr;
        const bool sample = u.pm >= 64;
#pragma unroll
        for (int n = 0; n < 2; ++n) {
            const int ch = u.pn * HALF + wc * 32 + 8 * fq + 4 * n;
            const f32x4 wa0 = *(const f32x4*)(conv_w + ch), wa1 = *(const f32x4*)(conv_w + 6144 + ch), wa2 = *(const f32x4*)(conv_w + 12288 + ch), ba = *(const f32x4*)(conv_b + ch);
            const f32x4 wb0 = *(const f32x4*)(conv_w + 3072 + ch), wb1 = *(const f32x4*)(conv_w + 6144 + 3072 + ch), wb2 = *(const f32x4*)(conv_w + 12288 + 3072 + ch), bb = *(const f32x4*)(conv_b + 3072 + ch);
#pragma unroll
            for (int ai = 0; ai < 2; ++ai)
#pragma unroll
                for (int m = 0; m < 4; ++m) {
                    const int row = row0 + ai * HALF + m * 16;
                    const f32x4 ua = acc[ai][0][m][n], ub = acc[ai][1][m][n];
                    const f32x4 pa = acc[ai][0][m > 0 ? m - 1 : 0][n], pb = acc[ai][1][m > 0 ? m - 1 : 0][n];
                    float g[4];
#pragma unroll
                    for (int r = 0; r < 4; ++r) {
                        const float a1c = dpp_ror1(ua[r]), a1p = dpp_ror1(pa[r]), a2c = dpp_ror2(ua[r]), a2p = dpp_ror2(pa[r]);
                        const float b1c = dpp_ror1(ub[r]), b1p = dpp_ror1(pb[r]), b2c = dpp_ror2(ub[r]), b2p = dpp_ror2(pb[r]);
                        const float a1 = fr >= 1 ? a1c : a1p, a2 = fr >= 2 ? a2c : a2p, b1 = fr >= 1 ? b1c : b1p, b2 = fr >= 2 ? b2c : b2p;
                        const float ca = ba[r] + wa0[r] * a2 + wa1[r] * a1 + wa2[r] * ua[r];
                        const float cb = bb[r] + wb0[r] * b2 + wb1[r] * b1 + wb2[r] * ub[r];
                        g[r] = gelu_tanh(ca) * cb;
                    }
                    if (!sample) {
                        if (!(m == 0 && fr < 2)) { u32x2e w; w.x = cvt_pk_bf16(g[0], g[1]); w.y = cvt_pk_bf16(g[2], g[3]); *(u32x2e*)(G + (size_t)row * 3072 + ch) = w; }
                        if ((m == 0 && fr < 2) || (m == 3 && fr >= 14)) {
                            const int hrow = (row >> 6) * 4 + ((row + 2) & 63);
                            u32x2e w; w.x = cvt_pk_bf16(ua[0], ua[1]); w.y = cvt_pk_bf16(ua[2], ua[3]); *(u32x2e*)(UH + (size_t)hrow * 6144 + ch) = w;
                            w.x = cvt_pk_bf16(ub[0], ub[1]); w.y = cvt_pk_bf16(ub[2], ub[3]); *(u32x2e*)(UH + (size_t)hrow * 6144 + 3072 + ch) = w;
                        }
                        if ((row & 4095) >= 4094) {
                            float* cp = conv_prompt + ((size_t)(row >> 12) * 2 + ((row & 4095) - 4094)) * 6144;
                            *(f32x4*)(cp + ch) = ua; *(f32x4*)(cp + 3072 + ch) = ub;
                        }
                    } else {
                        const int sr = row - E_MP;
                        u32x2e w; w.x = cvt_pk_bf16(ua[0], ua[1]); w.y = cvt_pk_bf16(ua[2], ua[3]); *(u32x2e*)(US + (size_t)sr * 6144 + ch) = w;
                        w.x = cvt_pk_bf16(ub[0], ub[1]); w.y = cvt_pk_bf16(ub[2], ub[3]); *(u32x2e*)(US + (size_t)sr * 6144 + 3072 + ch) = w;
                        if ((sr & 3) >= 2) {
                            float* cp = conv_sample + ((size_t)(sr >> 2) * 2 + ((sr & 3) - 2)) * 6144;
                            *(f32x4*)(cp + ch) = ua; *(f32x4*)(cp + 3072 + ch) = ub;
                        }
                    }
                }
        }
    }
};

template <class Epi, class Sched, bool ALIGN_EPI = false, bool SP2 = false>
__device__ __forceinline__ void gemm_phase(PG8_LAS unsigned char* lds, const Gemm g, const Sched& S, const Epi& E) {
    const int tid = threadIdx.x, wid = __builtin_amdgcn_readfirstlane(tid >> 6), lane = tid & 63, wr = wid >> 2, wc = wid & 3, fr = lane & 15, fq = lane >> 4;
    const int K = g.K, nt = K / BK, lda = g.lda;
    unsigned voffA[2], voffB[2];
#pragma unroll
    for (int i = 0; i < 2; ++i) { int R, C; stage_rc(tid * 16 + i * 8192, R, C); const int Rb = Epi::PERM ? ((R & ~31) + perm32(R & 31)) : R;
        voffA[i] = (unsigned)(R * lda + C) * 2u; voffB[i] = (unsigned)(Rb * K + C) * 2u; }
    const size_t kstep = (size_t)(BK * 2);
    const size_t hstepA = (size_t)HALF * lda * 2, hstepB = (size_t)HALF * K * 2;
    const size_t tstepA = 2 * hstepA, tstepB = 2 * hstepB;
    const unsigned ldsw = (unsigned)wid * 1024u;
    const int aoff = lds_byte(wr * 64 + fr, fq * 8), boff = lds_byte(wc * 32 + fr, fq * 8);
#define PG8_SA(b, h) (((b) * 2 + (h)) * HTB)
#define PG8_SB(b, h) ((4 + (b) * 2 + (h)) * HTB)
#define PG8_STAGE(bufoff, gbase, voff) do { _Pragma("unroll") for (int _i = 0; _i < 2; ++_i) \
        __builtin_amdgcn_global_load_lds((const unsigned*)((const char*)(gbase) + (voff)[_i]), (PG8_LAS unsigned*)(lds + (bufoff) + ldsw + _i * 8192), 16, 0, 0); } while (0)
#define PG8_LDA(dst, b, h) do { _Pragma("unroll") for (int m = 0; m < 4; ++m) _Pragma("unroll") for (int k = 0; k < 2; ++k) dst[m][k] = *(const PG8_LAS bf16x8*)(lds + PG8_SA(b, h) + aoff + m * 2048 + k * 1024); } while (0)
#define PG8_LDB(dst, b, h) do { _Pragma("unroll") for (int n = 0; n < 2; ++n) _Pragma("unroll") for (int k = 0; k < 2; ++k) dst[n][k] = *(const PG8_LAS bf16x8*)(lds + PG8_SB(b, h) + boff + n * 2048 + k * 1024); } while (0)
#define PG8_MMA(ai, bj, At, Bt) do { __builtin_amdgcn_s_setprio(1); _Pragma("unroll") for (int m = 0; m < 4; ++m) _Pragma("unroll") for (int n = 0; n < 2; ++n) _Pragma("unroll") for (int k = 0; k < 2; ++k) \
        acc[ai][bj][m][n] = __builtin_amdgcn_mfma_f32_16x16x32_bf16(Bt[n][k], At[m][k], acc[ai][bj][m][n], 0, 0, 0); __builtin_amdgcn_s_setprio(0); } while (0)
#define PG8_WAIT_V(n) asm volatile("s_waitcnt vmcnt(" #n ")" ::: "memory")
#define PG8_WAIT_L(n) asm volatile("s_waitcnt lgkmcnt(" #n ")" ::: "memory")
#define PG8_BAR __builtin_amdgcn_s_barrier()
#define PG8_SCHED __builtin_amdgcn_sched_barrier(0)
    Unit cur, nxt; int ui = 0;
    if (!S.next(0, cur)) return;
    f32x4 acc[2][2][4][2];
#pragma unroll
    for (int a = 0; a < 2; ++a)
#pragma unroll
        for (int b = 0; b < 2; ++b)
#pragma unroll
            for (int m = 0; m < 4; ++m)
#pragma unroll
                for (int n = 0; n < 2; ++n) acc[a][b][m][n] = (f32x4){0.f, 0.f, 0.f, 0.f};
    bf16x8 At[4][2], B0[2][2], B1[2][2];
    const char* cA = (const char*)g.A + (size_t)cur.pm * tstepA; const char* cB = (const char*)g.Bt + (size_t)cur.pn * tstepB;
    S.a_ready(cur);
    if constexpr (SP2) {
        PG8_STAGE(PG8_SB(0, 0), cB, voffB); PG8_STAGE(PG8_SB(0, 1), cB + hstepB, voffB); PG8_STAGE(PG8_SA(0, 0), cA, voffA); PG8_STAGE(PG8_SA(0, 1), cA + hstepA, voffA);
        if (wr == 1) PG8_BAR;
        PG8_WAIT_V(2); PG8_BAR;
        PG8_STAGE(PG8_SB(1, 0), cB + kstep, voffB); PG8_STAGE(PG8_SA(1, 0), cA + kstep, voffA); PG8_STAGE(PG8_SB(1, 1), cB + hstepB + kstep, voffB);
        PG8_WAIT_V(6); PG8_BAR;
    } else {
        PG8_STAGE(PG8_SB(0, 0), cB, voffB); PG8_STAGE(PG8_SA(0, 0), cA, voffA); PG8_STAGE(PG8_SB(0, 1), cB + hstepB, voffB); PG8_STAGE(PG8_SA(0, 1), cA + hstepA, voffA);
        if (wr == 1) PG8_BAR;
        PG8_WAIT_V(4); PG8_BAR;
        PG8_STAGE(PG8_SB(1, 0), cB + kstep, voffB); PG8_STAGE(PG8_SA(1, 0), cA + kstep, voffA); PG8_STAGE(PG8_SB(1, 1), cB + hstepB + kstep, voffB);
        PG8_WAIT_V(6); PG8_BAR;
    }
    for (;;) {
        const bool has_next = S.next(ui + 1, nxt);
        const char* nA = has_next ? (const char*)g.A + (size_t)nxt.pm * tstepA : cA; const char* nB = has_next ? (const char*)g.Bt + (size_t)nxt.pn * tstepB : cB;
        for (int t = 0; t < nt; t += 2) {
            const bool last = (t == nt - 2);
            const char* a1 = cA + (size_t)(t + 1) * kstep;
            const char* a2 = last ? nA : cA + (size_t)(t + 2) * kstep; const char* b2 = last ? nB : cB + (size_t)(t + 2) * kstep;
            const char* a3 = a2 + kstep; const char* b3 = b2 + kstep;
            if (last && has_next) S.a_ready(nxt);
            if constexpr (SP2) {
            PG8_LDB(B0, 0, 0); PG8_LDB(B1, 0, 1); PG8_SCHED; PG8_LDA(At, 0, 0); PG8_STAGE(PG8_SA(1, 1), a1 + hstepA, voffA);
            PG8_WAIT_V(8); PG8_WAIT_L(0); PG8_BAR; PG8_MMA(0, 0, At, B0); PG8_MMA(0, 1, At, B1); PG8_BAR; PG8_SCHED;
            PG8_LDA(At, 0, 1); PG8_STAGE(PG8_SB(0, 0), b2, voffB); PG8_STAGE(PG8_SB(0, 1), b2 + hstepB, voffB); PG8_STAGE(PG8_SA(0, 0), a2, voffA);
            PG8_WAIT_V(8); PG8_WAIT_L(0); PG8_BAR; PG8_MMA(1, 0, At, B0); PG8_MMA(1, 1, At, B1); PG8_BAR; PG8_SCHED;
            PG8_LDB(B0, 1, 0); PG8_LDB(B1, 1, 1); PG8_SCHED; PG8_LDA(At, 1, 0); PG8_STAGE(PG8_SA(0, 1), a2 + hstepA, voffA);
            PG8_WAIT_V(8); PG8_WAIT_L(0); PG8_BAR; PG8_MMA(0, 0, At, B0); PG8_MMA(0, 1, At, B1); PG8_BAR; PG8_SCHED;
            PG8_LDA(At, 1, 1); PG8_STAGE(PG8_SB(1, 0), b3, voffB); PG8_STAGE(PG8_SB(1, 1), b3 + hstepB, voffB); PG8_STAGE(PG8_SA(1, 0), a3, voffA);
            PG8_WAIT_V(8); PG8_WAIT_L(0); PG8_BAR; PG8_MMA(1, 0, At, B0); PG8_MMA(1, 1, At, B1); PG8_BAR; PG8_SCHED;
            } else {
            PG8_LDB(B0, 0, 0); PG8_SCHED; PG8_LDA(At, 0, 0); PG8_STAGE(PG8_SA(1, 1), a1 + hstepA, voffA);
            PG8_WAIT_L(8); PG8_BAR; PG8_WAIT_L(0); PG8_MMA(0, 0, At, B0); PG8_BAR; PG8_SCHED;
            PG8_LDB(B1, 0, 1); PG8_STAGE(PG8_SB(0, 0), b2, voffB);
            PG8_BAR; PG8_WAIT_L(0); PG8_MMA(0, 1, At, B1); PG8_BAR;
            PG8_LDA(At, 0, 1); PG8_STAGE(PG8_SA(0, 0), a2, voffA);
            PG8_BAR; PG8_WAIT_L(0); PG8_MMA(1, 0, At, B0); PG8_BAR; PG8_SCHED;
            PG8_STAGE(PG8_SB(0, 1), b2 + hstepB, voffB);
            PG8_WAIT_V(6); PG8_BAR; PG8_MMA(1, 1, At, B1); PG8_BAR;
            PG8_LDB(B0, 1, 0); PG8_SCHED; PG8_LDA(At, 1, 0); PG8_STAGE(PG8_SA(0, 1), a2 + hstepA, voffA);
            PG8_WAIT_L(8); PG8_BAR; PG8_WAIT_L(0); PG8_MMA(0, 0, At, B0); PG8_BAR; PG8_SCHED;
            PG8_LDB(B1, 1, 1); PG8_STAGE(PG8_SB(1, 0), b3, voffB);
            PG8_BAR; PG8_WAIT_L(0); PG8_MMA(0, 1, At, B1); PG8_BAR;
            PG8_LDA(At, 1, 1); PG8_STAGE(PG8_SA(1, 0), a3, voffA);
            PG8_BAR; PG8_WAIT_L(0); PG8_MMA(1, 0, At, B0); PG8_BAR; PG8_SCHED;
            PG8_STAGE(PG8_SB(1, 1), b3 + hstepB, voffB);
            PG8_WAIT_V(6); PG8_BAR; PG8_MMA(1, 1, At, B1); PG8_BAR;
            }
        }
        if constexpr (ALIGN_EPI) { if (wr == 0) PG8_BAR; }
        if constexpr (!Epi::AFTER_DRAIN) { E(acc, cur, wr, wc, fr, fq); S.done(cur); }
        if (!has_next) break;
#pragma unroll
        for (int a = 0; a < 2; ++a)
#pragma unroll
            for (int b = 0; b < 2; ++b)
#pragma unroll
                for (int m = 0; m < 4; ++m)
#pragma unroll
                    for (int n = 0; n < 2; ++n) acc[a][b][m][n] = (f32x4){0.f, 0.f, 0.f, 0.f};
        cur = nxt; cA = nA; cB = nB; ++ui;
        if constexpr (ALIGN_EPI) { if (wr == 1) PG8_BAR; }
    }
    PG8_WAIT_V(0);
    if constexpr (!ALIGN_EPI) { if (wr == 0) PG8_BAR; }
    PG8_BAR;
    if constexpr (Epi::AFTER_DRAIN) { E.fused(acc, cur, wr, wc, fr, fq, lds, wid, lane); S.done(cur); }
#undef PG8_SA
#undef PG8_SB
#undef PG8_STAGE
#undef PG8_LDA
#undef PG8_LDB
#undef PG8_MMA
#undef PG8_WAIT_V
#undef PG8_WAIT_L
#undef PG8_BAR
#undef PG8_SCHED
}
}

#define LAS __attribute__((address_space(3)))
using pg8::bf16_t; using pg8::bf16x8; using pg8::f32x4; using pg8::u32x4;
typedef float f32x2 __attribute__((ext_vector_type(2)));
typedef unsigned u32x2 __attribute__((ext_vector_type(2)));
typedef short v4i16 __attribute__((ext_vector_type(4)));

constexpr int MP = 16384, MS = 512, M = MP + MS, D = 1024, DIN = 5888, F2 = 6144, DFF = 3072, TSEQ = 4096;
constexpr int C_QA = 0, C_KA = 512, C_VA = 640, C_QR = 768, C_KR = 1280, C_VR = 1792, C_GATE = 2816, C_GMA = 3840, C_GMR = 4864;
constexpr float EPS = 1e-6f;
constexpr int NTHREADS = 512, NWAVES = 8;
constexpr int LDS_BYTES = 147456;

constexpr size_t MiB = 1u << 20;
constexpr size_t WS_TABA = 0, WS_TABR = 512 * 1024;
constexpr size_t WS_WIN = 3 * MiB;
constexpr size_t WS_WUP = WS_WIN + (size_t)DIN * D * 2;
constexpr size_t WS_WDN = WS_WUP + (size_t)F2 * D * 2;
constexpr size_t WS_XN = WS_WDN + (size_t)D * DFF * 2;
constexpr size_t WS_R1 = WS_XN + (size_t)M * D * 2;
constexpr size_t R1_G = 0, R1_F = (size_t)M * DFF * 2, R1_UH = R1_F + (size_t)M * D * 2, R1_US = R1_UH + (size_t)264 * 4 * F2 * 2, R1_X1 = R1_US + (size_t)MS * F2 * 2, R1_END = R1_X1 + (size_t)M * D * 2;
static_assert(R1_END <= (size_t)M * DIN * 2, "R1 overlay");
static_assert(WS_R1 + (size_t)M * DIN * 2 <= 256 * MiB, "ws map");
constexpr size_t O_Y = 0, O_KP = (size_t)M * D, O_VP = O_KP + 65536, O_RP = O_VP + 65536, O_CP = O_RP + 524288, O_KS = O_CP + 49152, O_VS = O_KS + 2097152, O_RS = O_VS + 2097152, O_CS = O_RS + 16777216, O_END = O_CS + 1572864;

struct Args {
    const float *x_prompt, *x_sample, *cache_k, *cache_v, *state_ret, *state_conv, *w_in, *sinks, *w_a, *w_r, *w_o, *g_pre_mix, *g_post_mix, *g_pre_ffn, *g_post_ffn, *w_up, *conv_w, *conv_b, *w_down;
    float* out; unsigned char* ws; int ph_lo, ph_hi;
};

__device__ __forceinline__ float bf2f(bf16_t h) { return __uint_as_float((unsigned)h << 16); }
__device__ __forceinline__ float bflo(unsigned w) { return __uint_as_float(w << 16); }
__device__ __forceinline__ float bfhi(unsigned w) { return __uint_as_float(w & 0xffff0000u); }
__device__ __forceinline__ unsigned pk2(float lo, float hi) { return pg8::cvt_pk_bf16(lo, hi); }
__device__ __forceinline__ float wave_sum(float v) {
#pragma unroll
    for (int o = 1; o < 64; o <<= 1) v += __shfl_xor(v, o);
    return v;
}
__device__ __forceinline__ float wave_max(float v) {
#pragma unroll
    for (int o = 1; o < 64; o <<= 1) v = fmaxf(v, __shfl_xor(v, o));
    return v;
}
__device__ __forceinline__ float ret_log2g(int h) { return log2f(1.0f - exp2f(-5.0f - (float)h)); }
__device__ __forceinline__ bf16x8 tr_pair(const LAS unsigned char* p0, const LAS unsigned char* p1) {
    const v4i16 a = __builtin_amdgcn_ds_read_tr16_b64_v4i16((LAS v4i16*)p0), b = __builtin_amdgcn_ds_read_tr16_b64_v4i16((LAS v4i16*)p1);
    return (bf16x8){a[0], a[1], a[2], a[3], b[0], b[1], b[2], b[3]};
}
__device__ __forceinline__ bf16x8 cat8(u32x2 a, u32x2 b) { const u32x4 w = {a.x, a.y, b.x, b.y}; return __builtin_bit_cast(bf16x8, w); }

__device__ __forceinline__ void p0_transpose_item(const float* W, int K, int N, bf16_t* WT, int k0, int n0, int drow0, LAS float* scr, int lane) {
#pragma unroll 8
    for (int i = 0; i < 32; ++i) { const int kk = 2 * i + (lane >> 5); scr[kk * 33 + (lane & 31)] = W[(size_t)(k0 + kk) * N + n0 + (lane & 31)]; }
    asm volatile("s_waitcnt lgkmcnt(0)" ::: "memory");
    const int c = lane & 7;
#pragma unroll
    for (int j = 0; j < 4; ++j) { const int n = (lane >> 3) + 8 * j; const LAS float* s = scr + (8 * c) * 33 + n;
        u32x4 o; o.x = pk2(s[0 * 33], s[1 * 33]); o.y = pk2(s[2 * 33], s[3 * 33]); o.z = pk2(s[4 * 33], s[5 * 33]); o.w = pk2(s[6 * 33], s[7 * 33]);
        *(u32x4*)(WT + (size_t)(drow0 + n) * K + k0 + 8 * c) = o; }
    asm volatile("s_waitcnt lgkmcnt(0)" ::: "memory");
}
__device__ __forceinline__ void rms_row_to_bf16(const float* xrow, const float* g, bf16_t* orow, int lane) {
    f32x4 v[4]; float s = 0.f;
#pragma unroll
    for (int j = 0; j < 4; ++j) { v[j] = *((const f32x4*)xrow + lane + 64 * j); s += (v[j].x * v[j].x + v[j].y * v[j].y) + (v[j].z * v[j].z + v[j].w * v[j].w); }
    const float rstd = rsqrtf(wave_sum(s) * (1.f / D) + EPS);
#pragma unroll
    for (int j = 0; j < 4; ++j) { const f32x4 gg = *((const f32x4*)g + lane + 64 * j);
        u32x2 w; w.x = pk2(v[j].x * rstd * gg.x, v[j].y * rstd * gg.y); w.y = pk2(v[j].z * rstd * gg.z, v[j].w * rstd * gg.w);
        *((u32x2*)orow + lane + 64 * j) = w; }
}
__device__ __forceinline__ void p0_prologue(const Args& a, LAS unsigned char* lds, int tid, int lane, int wave) {
    unsigned char* ws = a.ws;
    LAS float* scr = (LAS float*)(lds + wave * 16384);
    const int gw = blockIdx.x * NWAVES + wave, NGW = gridDim.x * NWAVES;
    bf16_t* WinT = (bf16_t*)(ws + WS_WIN); bf16_t* WupT = (bf16_t*)(ws + WS_WUP); bf16_t* WdnT = (bf16_t*)(ws + WS_WDN);
    bf16_t* WoT = (bf16_t*)(a.out + O_CS); bf16_t* WaT = WoT + 1024 * 1024; bf16_t* WrT = WaT + 1024 * 512;
    constexpr int I_IN = 16 * (DIN / 32), I_A = 8 * 32, I_R = 16 * 32, I_O = 16 * 32, I_UP = 16 * (F2 / 32), I_DN = 48 * 32;
    constexpr int NITEMS = I_IN + I_A + I_R + I_O + I_UP + I_DN;
    for (int it = gw; it < NITEMS; it += NGW) {
        int r = it;
        if (r < I_IN) { const int nb = r % (DIN / 32), kb = r / (DIN / 32); p0_transpose_item(a.w_in, D, DIN, WinT, 64 * kb, 32 * nb, 32 * nb, scr, lane); continue; } r -= I_IN;
        if (r < I_A) { const int nb = r % 32, kb = r / 32; p0_transpose_item(a.w_a, 512, D, WaT, 64 * kb, 32 * nb, 32 * nb, scr, lane); continue; } r -= I_A;
        if (r < I_R) { const int nb = r % 32, kb = r / 32; p0_transpose_item(a.w_r, D, D, WrT, 64 * kb, 32 * nb, 32 * nb, scr, lane); continue; } r -= I_R;
        if (r < I_O) { const int nb = r % 32, kb = r / 32; p0_transpose_item(a.w_o, D, D, WoT, 64 * kb, 32 * nb, 32 * nb, scr, lane); continue; } r -= I_O;
        if (r < I_UP) { const int nb = r % (F2 / 32), kb = r / (F2 / 32); const int n0 = 32 * nb;
            const int drow = n0 < DFF ? (n0 / 128) * 256 + (n0 % 128) : ((n0 - DFF) / 128) * 256 + 128 + ((n0 - DFF) % 128);
            p0_transpose_item(a.w_up, D, F2, WupT, 64 * kb, n0, drow, scr, lane); continue; } r -= I_UP;
        { const int nb = r % 32, kb = r / 32; p0_transpose_item(a.w_down, DFF, D, WdnT, 64 * kb, 32 * nb, 32 * nb, scr, lane); }
    }
    bf16_t* XN = (bf16_t*)(ws + WS_XN);
    for (int m = gw; m < M; m += NGW) { const float* xr = m < MP ? a.x_prompt + (size_t)m * D : a.x_sample + (size_t)(m - MP) * D; rms_row_to_bf16(xr, a.g_pre_mix, XN + (size_t)m * D, lane); }
    f32x2* tabA = (f32x2*)(ws + WS_TABA); f32x2* tabR = (f32x2*)(ws + WS_TABR);
    __syncthreads();
    LAS float* invs = (LAS float*)lds;
    if (tid < 72) invs[tid] = tid < 8 ? (float)(1.0 / pow(500000.0, (double)((float)tid / 8.0f))) : (float)(1.0 / pow(10000.0, (double)((float)(tid - 8) / 63.0f)));
    __syncthreads();
    const int gt = blockIdx.x * NTHREADS + tid, NGT = gridDim.x * NTHREADS;
    for (int e = gt; e < 4100 * 72; e += NGT) {
        const int tp = e / 72, i = e % 72; const int pos = tp < 4096 ? tp : 16384 + (tp - 4096);
        const float ang = (float)pos * invs[i];
        const double rev = (double)ang * 0.15915494309189535; const float fr = (float)(rev - rint(rev));
        const f32x2 cs = {__builtin_amdgcn_cosf(fr), __builtin_amdgcn_sinf(fr)};
        if (i < 8) tabA[tp * 8 + i] = cs; else tabR[tp * 64 + (i - 8)] = cs;
    }
}

__device__ __forceinline__ void attn_prompt_unit(bf16_t* H, const float* sinks, LAS unsigned char* lds, int b, int qb, int head, int tid, int lane, int wave) {
    const int g = head >> 2, fr = lane & 15, fq = lane >> 4;
    const size_t rowbase = (size_t)b * TSEQ + (size_t)qb * 128;
    LAS unsigned char* Kimg = lds; LAS unsigned char* Vimg = lds + 36864;
#pragma unroll
    for (int i = 0; i < 4; ++i) {
        const int id = tid + NTHREADS * i, kidx = id >> 3, ch = id & 7;
        u32x4 kv = {0u, 0u, 0u, 0u}, vv = {0u, 0u, 0u, 0u};
        if (qb > 0 || kidx >= 128) { const bf16_t* src = H + (rowbase - 128 + kidx) * DIN; kv = *(const u32x4*)(src + C_KA + g * 64 + ch * 8); vv = *(const u32x4*)(src + C_VA + g * 64 + ch * 8); }
        *(LAS u32x4*)(Kimg + kidx * 144 + ch * 16) = kv; *(LAS u32x4*)(Vimg + kidx * 144 + ch * 16) = vv;
    }
    const size_t qrow = rowbase + 16 * wave + fr;
    bf16x8 qf[2];
#pragma unroll
    for (int ks = 0; ks < 2; ++ks) qf[ks] = *(const bf16x8*)(H + qrow * DIN + C_QA + head * 64 + 32 * ks + 8 * fq);
    __syncthreads();
    f32x4 s[10];
#pragma unroll
    for (int nn = 0; nn < 9; ++nn) {
        s[nn] = (f32x4){0.f, 0.f, 0.f, 0.f};
        const int krow = 16 * (wave + nn) + fr;
#pragma unroll
        for (int ks = 0; ks < 2; ++ks) { const bf16x8 kf = *(const LAS bf16x8*)(Kimg + krow * 144 + (32 * ks + 8 * fq) * 2); s[nn] = __builtin_amdgcn_mfma_f32_16x16x32_bf16(kf, qf[ks], s[nn], 0, 0, 0); }
    }
    s[9] = (f32x4){0.f, 0.f, 0.f, 0.f};
    const int qi = 16 * wave + fr; const float sink = sinks[head];
    float mx = sink;
#pragma unroll
    for (int nn = 0; nn < 9; ++nn)
#pragma unroll
        for (int r = 0; r < 4; ++r) { const int kidx = 16 * (wave + nn) + 4 * fq + r; const bool valid = (kidx > qi) && (kidx <= qi + 128) && (qb > 0 || kidx >= 128);
            s[nn][r] = valid ? s[nn][r] : -1e30f; mx = fmaxf(mx, s[nn][r]); }
    mx = fmaxf(mx, __shfl_xor(mx, 16)); mx = fmaxf(mx, __shfl_xor(mx, 32));
    float sum = 0.f;
#pragma unroll
    for (int nn = 0; nn < 9; ++nn)
#pragma unroll
        for (int r = 0; r < 4; ++r) { const float p = s[nn][r] > -1e29f ? __expf(s[nn][r] - mx) : 0.f; s[nn][r] = p; sum += p; }
    sum += __shfl_xor(sum, 16); sum += __shfl_xor(sum, 32);
    sum += __expf(sink - mx);
    f32x4 o[4];
#pragma unroll
    for (int db = 0; db < 4; ++db) o[db] = (f32x4){0.f, 0.f, 0.f, 0.f};
    const int tq = (lane & 15) >> 2, tpp = lane & 3;
#pragma unroll
    for (int G = 0; G < 5; ++G) {
        const u32x4 pw = {pk2(s[2 * G][0], s[2 * G][1]), pk2(s[2 * G][2], s[2 * G][3]), pk2(s[2 * G + 1][0], s[2 * G + 1][1]), pk2(s[2 * G + 1][2], s[2 * G + 1][3])};
        const bf16x8 pf = __builtin_bit_cast(bf16x8, pw);
        int k0 = 16 * (wave + 2 * G) + 4 * fq + tq, k1 = k0 + 16; k0 = k0 > 255 ? 255 : k0; k1 = k1 > 255 ? 255 : k1;
#pragma unroll
        for (int db = 0; db < 4; ++db) {
            const bf16x8 vf = tr_pair(Vimg + k0 * 144 + (16 * db + 4 * tpp) * 2, Vimg + k1 * 144 + (16 * db + 4 * tpp) * 2);
            o[db] = __builtin_amdgcn_mfma_f32_16x16x32_bf16(vf, pf, o[db], 0, 0, 0);
        }
    }
    const float inv = 1.0f / sum;
#pragma unroll
    for (int db = 0; db < 4; ++db) { u32x2 w; w.x = pk2(o[db][0] * inv, o[db][1] * inv); w.y = pk2(o[db][2] * inv, o[db][3] * inv);
        *(u32x2*)(H + qrow * DIN + C_QA + head * 64 + 16 * db + 4 * fq) = w; }
    __syncthreads();
}

__device__ __forceinline__ void attn_sample_unit(const Args& a, bf16_t* H, LAS unsigned char* lds, int b, int tid, int lane, int wave) {
    const int head = wave, g = head >> 2; const size_t r0 = (size_t)MP + 4 * b;
    LAS float* qs = (LAS float*)(lds + wave * 4096); LAS float* ps = qs + 256;
#pragma unroll
    for (int t = 0; t < 4; ++t) qs[t * 64 + lane] = bf2f(H[(r0 + t) * DIN + C_QA + head * 64 + lane]);
    asm volatile("s_waitcnt lgkmcnt(0)" ::: "memory");
    float sc[3][4];
    {
        const float* kp0 = a.cache_k + ((size_t)(b * 128 + lane) * 2 + g) * 64; const float* kp1 = kp0 + (size_t)64 * 128;
        const bf16_t* kpn = H + (r0 + (lane & 3)) * DIN + C_KA + g * 64;
#pragma unroll
        for (int t = 0; t < 4; ++t) { sc[0][t] = 0.f; sc[1][t] = 0.f; sc[2][t] = 0.f; }
#pragma nounroll
        for (int hf = 0; hf < 2; ++hf) {
            f32x4 kv0[8], kv1[8]; u32x4 kw[4];
#pragma unroll
            for (int d4 = 0; d4 < 8; ++d4) { kv0[d4] = *(const f32x4*)(kp0 + 32 * hf + 4 * d4); kv1[d4] = *(const f32x4*)(kp1 + 32 * hf + 4 * d4); }
#pragma unroll
            for (int c8 = 0; c8 < 4; ++c8) kw[c8] = *(const u32x4*)(kpn + 32 * hf + 8 * c8);
#pragma unroll
            for (int d4 = 0; d4 < 8; ++d4)
#pragma unroll
                for (int e = 0; e < 4; ++e) { const int d = 4 * d4 + e; const unsigned w = kw[d >> 3][(d & 7) >> 1]; const float kn = (d & 1) ? bfhi(w) : bflo(w);
#pragma unroll
                    for (int t = 0; t < 4; ++t) { const float q = qs[t * 64 + 32 * hf + d]; sc[0][t] += q * kv0[d4][e]; sc[1][t] += q * kv1[d4][e]; sc[2][t] += q * kn; } }
        }
    }
    const float sink = a.sinks[head];
    float inv[4];
#pragma unroll
    for (int t = 0; t < 4; ++t) {
        const bool v0 = lane > t, v1 = true, v2 = (lane < 4) && (lane <= t);
        const float s0 = v0 ? sc[0][t] : -1e30f, s1 = v1 ? sc[1][t] : -1e30f, s2 = v2 ? sc[2][t] : -1e30f;
        const float mx = fmaxf(wave_max(fmaxf(fmaxf(s0, s1), s2)), sink);
        const float p0 = v0 ? __expf(s0 - mx) : 0.f, p1 = __expf(s1 - mx), p2 = v2 ? __expf(s2 - mx) : 0.f;
        const float sum = wave_sum(p0 + p1 + p2) + __expf(sink - mx);
        inv[t] = 1.0f / sum;
        ps[t * 136 + lane] = p0; ps[t * 136 + 64 + lane] = p1; if (lane < 4) ps[t * 136 + 128 + lane] = p2;
    }
    asm volatile("s_waitcnt lgkmcnt(0)" ::: "memory");
    float o0 = 0.f, o1 = 0.f, o2 = 0.f, o3 = 0.f;
    const float* vp = a.cache_v + ((size_t)(b * 128) * 2 + g) * 64 + lane;
#pragma nounroll
    for (int rb = 0; rb < 2; ++rb) {
        float vx[64];
#pragma unroll
        for (int r = 0; r < 64; ++r) vx[r] = vp[(size_t)(64 * rb + r) * 128];
#pragma unroll
        for (int r = 0; r < 64; ++r) { const int rr = 64 * rb + r; o0 += ps[0 * 136 + rr] * vx[r]; o1 += ps[1 * 136 + rr] * vx[r]; o2 += ps[2 * 136 + rr] * vx[r]; o3 += ps[3 * 136 + rr] * vx[r]; }
    }
#pragma unroll
    for (int tn = 0; tn < 4; ++tn) { const float vx = bf2f(H[(r0 + tn) * DIN + C_VA + g * 64 + lane]); o0 += ps[0 * 136 + 128 + tn] * vx; o1 += ps[1 * 136 + 128 + tn] * vx; o2 += ps[2 * 136 + 128 + tn] * vx; o3 += ps[3 * 136 + 128 + tn] * vx; }
    H[(r0 + 0) * DIN + C_QA + head * 64 + lane] = (bf16_t)(pk2(o0 * inv[0], 0.f) & 0xffffu);
    H[(r0 + 1) * DIN + C_QA + head * 64 + lane] = (bf16_t)(pk2(o1 * inv[1], 0.f) & 0xffffu);
    H[(r0 + 2) * DIN + C_QA + head * 64 + lane] = (bf16_t)(pk2(o2 * inv[2], 0.f) & 0xffffu);
    H[(r0 + 3) * DIN + C_QA + head * 64 + lane] = (bf16_t)(pk2(o3 * inv[3], 0.f) & 0xffffu);
    float* ko = a.out + O_KS + (size_t)b * 128 * 128; float* vo = a.out + O_VS + (size_t)b * 128 * 128;
    const float* ki = a.cache_k + (size_t)b * 128 * 128 + 4 * 128; const float* vi = a.cache_v + (size_t)b * 128 * 128 + 4 * 128;
    for (int i = tid; i < 124 * 32; i += NTHREADS) { ((f32x4*)ko)[i] = ((const f32x4*)ki)[i]; ((f32x4*)vo)[i] = ((const f32x4*)vi)[i]; }
    { const int t = tid >> 7, gd = tid & 127;
      ko[(size_t)(124 + t) * 128 + gd] = bf2f(H[(r0 + t) * DIN + C_KA + gd]); vo[(size_t)(124 + t) * 128 + gd] = bf2f(H[(r0 + t) * DIN + C_VA + gd]); }
}

__device__ __forceinline__ void ret_u_unit(const bf16_t* H, bf16_t* ST, LAS unsigned char* lds, int b, int c, int h, int tid, int lane, int wave) {
    const size_t rowc = (size_t)b * TSEQ + (size_t)c * 128; const float l2g = ret_log2g(h);
    LAS unsigned char* Kimg = lds; LAS unsigned char* Vimg = lds + 36864;
#pragma unroll
    for (int i = 0; i < 4; ++i) { const int id = tid + NTHREADS * i, j = id >> 4, ch = id & 15;
        const u32x4 kv = *(const u32x4*)(H + (rowc + j) * DIN + C_KR + h * 128 + ch * 8); const float kd = exp2f(l2g * (float)(127 - j));
        u32x4 w; w.x = pk2(bflo(kv.x) * kd, bfhi(kv.x) * kd); w.y = pk2(bflo(kv.y) * kd, bfhi(kv.y) * kd); w.z = pk2(bflo(kv.z) * kd, bfhi(kv.z) * kd); w.w = pk2(bflo(kv.w) * kd, bfhi(kv.w) * kd);
        *(LAS u32x4*)(Kimg + j * 288 + ch * 16) = w; }
#pragma unroll
    for (int i = 0; i < 8; ++i) { const int id = tid + NTHREADS * i, j = id >> 5, ch = id & 31;
        *(LAS u32x4*)(Vimg + j * 544 + ch * 16) = *(const u32x4*)(H + (rowc + j) * DIN + C_VR + h * 256 + ch * 8); }
    __syncthreads();
    const int fr = lane & 15, fq = lane >> 4, tq = fr >> 2, tpp = lane & 3;
    f32x4 acc[2][8];
#pragma unroll
    for (int i = 0; i < 2; ++i)
#pragma unroll
        for (int j = 0; j < 8; ++j) acc[i][j] = (f32x4){0.f, 0.f, 0.f, 0.f};
#pragma unroll
    for (int ks = 0; ks < 4; ++ks) {
        const int j0 = 32 * ks + 4 * fq + tq, j1 = j0 + 16;
        bf16x8 vf[2];
#pragma unroll
        for (int i = 0; i < 2; ++i) { const int col = 16 * (2 * wave + i) + 4 * tpp; vf[i] = tr_pair(Vimg + j0 * 544 + col * 2, Vimg + j1 * 544 + col * 2); }
#pragma unroll
        for (int kb = 0; kb < 8; ++kb) { const int col = 16 * kb + 4 * tpp; const bf16x8 kf = tr_pair(Kimg + j0 * 288 + col * 2, Kimg + j1 * 288 + col * 2);
#pragma unroll
            for (int i = 0; i < 2; ++i) acc[i][kb] = __builtin_amdgcn_mfma_f32_16x16x32_bf16(vf[i], kf, acc[i][kb], 0, 0, 0); }
    }
    bf16_t* U = ST + ((size_t)(b * 32 + c) * 4 + h) * 32768;
#pragma unroll
    for (int i = 0; i < 2; ++i)
#pragma unroll
        for (int kb = 0; kb < 8; ++kb) { u32x2 w; w.x = pk2(acc[i][kb][0], acc[i][kb][1]); w.y = pk2(acc[i][kb][2], acc[i][kb][3]); *(u32x2*)(U + (size_t)(16 * kb + fr) * 256 + 16 * (2 * wave + i) + 4 * fq) = w; }
    __syncthreads();
}

__device__ __forceinline__ void ret_sample_unit(const Args& a, bf16_t* H, LAS unsigned char* lds, int b, int h, int tid, int lane, int wave) {
    const size_t r0 = (size_t)MP + 4 * b; const float g = 1.0f - exp2f(-5.0f - (float)h);
    LAS float* qs = (LAS float*)lds; LAS float* ks = qs + 512; LAS float* po = ks + 512; LAS float* red = po + 2048;
    const int dv = tid & 255, half = tid >> 8;
    for (int i = tid; i < 1024; i += NTHREADS) { const int which = i >> 9, t = (i >> 7) & 3, d = i & 127;
        const float v = bf2f(H[(r0 + t) * DIN + (which ? C_KR : C_QR) + h * 128 + d]); if (which) ks[t * 128 + d] = v; else qs[t * 128 + d] = v; }
    float vt[4], gt[4];
#pragma unroll
    for (int t = 0; t < 4; ++t) { vt[t] = bf2f(H[(r0 + t) * DIN + C_VR + h * 256 + dv]); gt[t] = bf2f(H[(r0 + t) * DIN + C_GATE + h * 256 + dv]); }
    float S[64];
    const float* sp = a.state_ret + ((size_t)(b * 4 + h) * 128 + 64 * half) * 256 + dv;
#pragma unroll
    for (int d = 0; d < 64; ++d) S[d] = sp[(size_t)d * 256];
    __syncthreads();
#pragma unroll
    for (int t = 0; t < 4; ++t) { float o = 0.f;
#pragma unroll
        for (int d = 0; d < 64; ++d) { S[d] = g * S[d] + ks[t * 128 + 64 * half + d] * vt[t]; o += qs[t * 128 + 64 * half + d] * S[d]; }
        po[(half * 4 + t) * 256 + dv] = o; }
    float* so = a.out + O_RS + ((size_t)(b * 4 + h) * 128 + 64 * half) * 256 + dv;
#pragma unroll
    for (int d = 0; d < 64; ++d) so[(size_t)d * 256] = S[d];
    __syncthreads();
    float ot[4];
#pragma unroll
    for (int t = 0; t < 4; ++t) { ot[t] = po[t * 256 + dv] + po[(4 + t) * 256 + dv]; const float sq = wave_sum(half == 0 ? ot[t] * ot[t] : 0.f); if (lane == 0) red[wave * 4 + t] = sq; }
    __syncthreads();
    if (half == 0) {
#pragma unroll
        for (int t = 0; t < 4; ++t) { float ss = 0.f;
#pragma unroll
            for (int w = 0; w < 8; ++w) ss += red[w * 4 + t];
            const float rstd = rsqrtf(ss * (1.f / 256.f) + EPS); const float gv = gt[t]; const float sil = gv / (1.0f + __expf(-gv));
            H[(r0 + t) * DIN + C_VR + h * 256 + dv] = (bf16_t)(pk2(ot[t] * rstd * sil, 0.f) & 0xffffu); }
    }
    __syncthreads();
}

__device__ __forceinline__ void ret_out_unit(bf16_t* H, const bf16_t* ST, LAS unsigned char* lds, int b, int c, int h, int tid, int lane, int wave) {
    const size_t rowc = (size_t)b * TSEQ + (size_t)c * 128; const float l2g = ret_log2g(h);
    LAS unsigned char* Kimg = lds; LAS unsigned char* BIG = lds + 36864;
    const int fr = lane & 15, fq = lane >> 4, tq = fr >> 2, tpp = lane & 3;
    const int qi = 16 * wave + fr; const size_t qrow = rowc + qi;
    u32x4 kreg[4], sreg[8], vreg[8]; u32x2 greg[16];
#pragma unroll
    for (int i = 0; i < 4; ++i) { const int id = tid + NTHREADS * i, j = id >> 4, ch = id & 15; kreg[i] = *(const u32x4*)(H + (rowc + j) * DIN + C_KR + h * 128 + ch * 8); }
    if (c > 0) {
        const bf16_t* S = ST + ((size_t)(b * 32 + c) * 4 + h) * 32768;
#pragma unroll
        for (int i = 0; i < 8; ++i) { const int id = tid + NTHREADS * i, dk = id >> 5, ch = id & 31; sreg[i] = *(const u32x4*)(S + (size_t)dk * 256 + ch * 8); }
    }
    bf16x8 qf[4];
#pragma unroll
    for (int ks = 0; ks < 4; ++ks) { const bf16_t* qp = H + qrow * DIN + C_QR + h * 128 + 32 * ks + 4 * fq; qf[ks] = cat8(*(const u32x2*)qp, *(const u32x2*)(qp + 16)); }
#pragma unroll
    for (int i = 0; i < 8; ++i) { const int id = tid + NTHREADS * i, j = id >> 5, ch = id & 31; vreg[i] = *(const u32x4*)(H + (rowc + j) * DIN + C_VR + h * 256 + ch * 8); }
#pragma unroll
    for (int i = 0; i < 4; ++i) { const int id = tid + NTHREADS * i, j = id >> 4, ch = id & 15; *(LAS u32x4*)(Kimg + j * 288 + ch * 16) = kreg[i]; }
    if (c > 0) {
#pragma unroll
        for (int i = 0; i < 8; ++i) { const int id = tid + NTHREADS * i, dk = id >> 5, ch = id & 31; *(LAS u32x4*)(BIG + dk * 544 + ch * 16) = sreg[i]; }
    }
    __syncthreads();
    f32x4 acc[16];
#pragma unroll
    for (int k = 0; k < 16; ++k) acc[k] = (f32x4){0.f, 0.f, 0.f, 0.f};
    if (c > 0) {
#pragma unroll
        for (int ks = 0; ks < 4; ++ks) { const int d0 = 32 * ks + 4 * fq + tq, d1 = d0 + 16;
#pragma unroll
            for (int blk = 0; blk < 16; ++blk) { const bf16x8 sf = tr_pair(BIG + d0 * 544 + (16 * blk + 4 * tpp) * 2, BIG + d1 * 544 + (16 * blk + 4 * tpp) * 2);
                acc[blk] = __builtin_amdgcn_mfma_f32_16x16x32_bf16(sf, qf[ks], acc[blk], 0, 0, 0); } }
        const float qd = exp2f(l2g * (float)(qi + 1));
#pragma unroll
        for (int blk = 0; blk < 16; ++blk) acc[blk] = acc[blk] * qd;
    }
    bf16x8 pf[4];
#pragma unroll
    for (int G = 0; G < 4; ++G) {
        f32x4 sc[2];
#pragma unroll
        for (int e = 0; e < 2; ++e) { const int jb = 2 * G + e; sc[e] = (f32x4){0.f, 0.f, 0.f, 0.f};
            if (jb <= wave) {
#pragma unroll
                for (int ks = 0; ks < 4; ++ks) { const LAS unsigned char* kp = Kimg + (16 * jb + fr) * 288 + (32 * ks + 4 * fq) * 2;
                    const bf16x8 kf = cat8(*(const LAS u32x2*)kp, *(const LAS u32x2*)(kp + 32)); sc[e] = __builtin_amdgcn_mfma_f32_16x16x32_bf16(kf, qf[ks], sc[e], 0, 0, 0); }
#pragma unroll
                for (int r = 0; r < 4; ++r) { const int j = 16 * jb + 4 * fq + r; sc[e][r] = (j <= qi) ? sc[e][r] * exp2f(l2g * (float)(qi - j)) : 0.f; }
            } }
        const u32x4 pw = {pk2(sc[0][0], sc[0][1]), pk2(sc[0][2], sc[0][3]), pk2(sc[1][0], sc[1][1]), pk2(sc[1][2], sc[1][3])};
        pf[G] = __builtin_bit_cast(bf16x8, pw);
    }
    __syncthreads();
#pragma unroll
    for (int i = 0; i < 8; ++i) { const int id = tid + NTHREADS * i, j = id >> 5, ch = id & 31; *(LAS u32x4*)(BIG + j * 544 + ch * 16) = vreg[i]; }
#pragma unroll
    for (int blk = 0; blk < 16; ++blk) greg[blk] = *(const u32x2*)(H + qrow * DIN + C_GATE + h * 256 + 16 * blk + 4 * fq);
    __syncthreads();
#pragma unroll
    for (int G = 0; G < 4; ++G) {
        if (2 * G <= wave) { const int j0 = 32 * G + 4 * fq + tq, j1 = j0 + 16;
#pragma unroll
            for (int blk = 0; blk < 16; ++blk) { const bf16x8 vf = tr_pair(BIG + j0 * 544 + (16 * blk + 4 * tpp) * 2, BIG + j1 * 544 + (16 * blk + 4 * tpp) * 2);
                acc[blk] = __builtin_amdgcn_mfma_f32_16x16x32_bf16(vf, pf[G], acc[blk], 0, 0, 0); } }
    }
    float ss = 0.f;
#pragma unroll
    for (int blk = 0; blk < 16; ++blk) ss += (acc[blk][0] * acc[blk][0] + acc[blk][1] * acc[blk][1]) + (acc[blk][2] * acc[blk][2] + acc[blk][3] * acc[blk][3]);
    ss += __shfl_xor(ss, 16); ss += __shfl_xor(ss, 32);
    const float rstd = rsqrtf(ss * (1.f / 256.f) + EPS);
#pragma unroll
    for (int blk = 0; blk < 16; ++blk) {
        const u32x2 gw = greg[blk];
        const float g0 = bflo(gw.x), g1 = bfhi(gw.x), g2 = bflo(gw.y), g3 = bfhi(gw.y);
        u32x2 w; w.x = pk2(acc[blk][0] * rstd * g0 / (1.f + __expf(-g0)), acc[blk][1] * rstd * g1 / (1.f + __expf(-g1)));
        w.y = pk2(acc[blk][2] * rstd * g2 / (1.f + __expf(-g2)), acc[blk][3] * rstd * g3 / (1.f + __expf(-g3)));
        *(u32x2*)(H + qrow * DIN + C_VR + h * 256 + 16 * blk + 4 * fq) = w;
    }
    __syncthreads();
}

__device__ __forceinline__ f32x4 tail_gemm(const bf16_t* A, int lda, const bf16_t* Bt, int K, LAS unsigned char* lds, int tid, int lane, int wave, f32x4 acc) {
    const int fr = lane & 15, fq = lane >> 4, nc = K / 512;
    LAS unsigned char* Ai = lds; LAS unsigned char* Bi = lds + 33280;
    u32x4 ra[4], rb[8];
#pragma unroll
    for (int i = 0; i < 4; ++i) { const int id = tid + NTHREADS * i; ra[i] = *(const u32x4*)(A + (size_t)(id >> 6) * lda + (id & 63) * 8); }
#pragma unroll
    for (int i = 0; i < 8; ++i) { const int id = tid + NTHREADS * i; rb[i] = *(const u32x4*)(Bt + (size_t)(id >> 6) * K + (id & 63) * 8); }
#pragma nounroll
    for (int c = 0; c < nc; ++c) {
#pragma unroll
        for (int i = 0; i < 4; ++i) { const int id = tid + NTHREADS * i; *(LAS u32x4*)(Ai + (id >> 6) * 1040 + (id & 63) * 16) = ra[i]; }
#pragma unroll
        for (int i = 0; i < 8; ++i) { const int id = tid + NTHREADS * i; *(LAS u32x4*)(Bi + (id >> 6) * 1040 + (id & 63) * 16) = rb[i]; }
        __syncthreads();
        if (c + 1 < nc) {
#pragma unroll
            for (int i = 0; i < 4; ++i) { const int id = tid + NTHREADS * i; ra[i] = *(const u32x4*)(A + (size_t)(id >> 6) * lda + (c + 1) * 512 + (id & 63) * 8); }
#pragma unroll
            for (int i = 0; i < 8; ++i) { const int id = tid + NTHREADS * i; rb[i] = *(const u32x4*)(Bt + (size_t)(id >> 6) * K + (c + 1) * 512 + (id & 63) * 8); }
        }
        const LAS unsigned char* ap = Ai + (16 * (wave >> 2) + fr) * 1040 + fq * 16; const LAS unsigned char* bp = Bi + (16 * (wave & 3) + fr) * 1040 + fq * 16;
#pragma unroll
        for (int ks = 0; ks < 16; ++ks) { const bf16x8 av = *(const LAS bf16x8*)(ap + ks * 64), bv = *(const LAS bf16x8*)(bp + ks * 64); acc = __builtin_amdgcn_mfma_f32_16x16x32_bf16(bv, av, acc, 0, 0, 0); }
        __syncthreads();
    }
    return acc;
}

__global__ void __launch_bounds__(NTHREADS, 2) fwd_megakernel(Args a) {
    extern __shared__ __attribute__((aligned(16))) unsigned char lds_raw[];
    LAS unsigned char* lds = (LAS unsigned char*)lds_raw;
    cg::grid_group grid = cg::this_grid();
    const int tid = threadIdx.x, lane = tid & 63, wave = __builtin_amdgcn_readfirstlane(tid >> 6);
    const int nblk = gridDim.x, blk = blockIdx.x;
    unsigned char* ws = a.ws;
    bf16_t* WinT = (bf16_t*)(ws + WS_WIN); bf16_t* WupT = (bf16_t*)(ws + WS_WUP); bf16_t* WdnT = (bf16_t*)(ws + WS_WDN);
    bf16_t* WoT = (bf16_t*)(a.out + O_CS); bf16_t* WaT = WoT + 1024 * 1024; bf16_t* WrT = WaT + 1024 * 512;
    bf16_t* XN = (bf16_t*)(ws + WS_XN); bf16_t* H = (bf16_t*)(ws + WS_R1);
    bf16_t* MIXb = (bf16_t*)(ws + WS_R1);
    bf16_t* G = (bf16_t*)(ws + WS_R1 + R1_G); bf16_t* Fb = (bf16_t*)(ws + WS_R1 + R1_F); bf16_t* X1b = (bf16_t*)(ws + WS_R1 + R1_X1); bf16_t* UH = (bf16_t*)(ws + WS_R1 + R1_UH); bf16_t* US = (bf16_t*)(ws + WS_R1 + R1_US);
    bf16_t* ST = (bf16_t*)(a.out + O_Y);
    float* Y = a.out + O_Y;
    const int lo = a.ph_lo, hi = a.ph_hi;
#ifndef PROBE_REP_MASK
#define PROBE_REP_MASK 0
#endif
#define IN(k) (lo <= (k) && (k) < hi)
#define REPS(k) (((PROBE_REP_MASK >> (k)) & 1) ? 2 : 1)
#define SEAM(k) do { if (IN(k) && IN((k) + 1)) { asm volatile("s_waitcnt vmcnt(0)" ::: "memory"); __syncthreads(); grid.sync(); } } while (0)

    if (IN(0)) { p0_prologue(a, lds, tid, lane, wave); }
    SEAM(0);
    if (IN(1)) {
        pg8::Gemm g{XN, WinT, M, DIN, D, D}; pg8::StaticOrder S; S.init(M, DIN, nblk, blk);
        pg8::EpiH E{H, (const pg8::f32x2e*)(ws + WS_TABA), (const pg8::f32x2e*)(ws + WS_TABR)};
        pg8::gemm_phase<pg8::EpiH, pg8::StaticOrder, true, true>(lds, g, S, E);
    }
    SEAM(1);
    if (IN(2)) {
        for (int u = blk; u < 1024; u += nblk) { const int head = u & 7, qb = (u >> 3) & 31, b = u >> 8; attn_prompt_unit(H, a.sinks, lds, b, qb, head, tid, lane, wave); }
        for (int u = blk; u < 512; u += nblk) { const int h = u & 3, c = (u >> 2) & 31, b = u >> 7; ret_u_unit(H, ST, lds, b, c, h, tid, lane, wave); }
        for (int u = blk; u < 128; u += nblk) { attn_sample_unit(a, H, lds, u, tid, lane, wave); __syncthreads(); }
        for (int u = blk; u < 512; u += nblk) { ret_sample_unit(a, H, lds, u >> 2, u & 3, tid, lane, wave); }
        for (int e = blk * NTHREADS + tid; e < 4 * 128 * 128; e += nblk * NTHREADS) { const int gd = e & 127, r = (e >> 7) & 127, b = e >> 14; const size_t row = (size_t)b * TSEQ + TSEQ - 128 + r;
            a.out[O_KP + e] = bf2f(H[row * DIN + C_KA + gd]); a.out[O_VP + e] = bf2f(H[row * DIN + C_VA + gd]); }
    }
    SEAM(2);
    if (IN(3)) {
        for (int e4 = blk * NTHREADS + tid; e4 < 16 * 8192; e4 += nblk * NTHREADS) {
            const int bh = e4 >> 13, idx = (e4 & 8191) * 4, b = bh >> 2, h = bh & 3;
            const float gL = exp2f(128.f * ret_log2g(h));
            f32x4 S = {0.f, 0.f, 0.f, 0.f};
#pragma unroll 8
            for (int c = 0; c < 32; ++c) { bf16_t* p = ST + ((size_t)(b * 32 + c) * 4 + h) * 32768 + idx; const u32x2 uw = *(const u32x2*)p; u32x2 sw; sw.x = pk2(S.x, S.y); sw.y = pk2(S.z, S.w); *(u32x2*)p = sw;
                const f32x4 uu = {bflo(uw.x), bfhi(uw.x), bflo(uw.y), bfhi(uw.y)}; S = S * gL + uu; }
            *(f32x4*)(a.out + O_RP + (size_t)bh * 32768 + idx) = S;
        }
    }
    SEAM(3);
    if (IN(4)) {
        for (int u = blk; u < 512; u += nblk) { const int h = u & 3, c = (u >> 2) & 31, b = u >> 7; ret_out_unit(H, ST, lds, b, c, h, tid, lane, wave); }
    }
    SEAM(4);
    if (IN(5)) {
        { pg8::Gemm g{H + C_QA, WaT, MP, D, 512, DIN}; pg8::StaticOrder S; S.init(MP, D, nblk, blk);
          pg8::EpiGate<false> E{XN, H + C_GMA, DIN}; pg8::gemm_phase<pg8::EpiGate<false>, pg8::StaticOrder, true, true>(lds, g, S, E); }
        __syncthreads();
        { pg8::Gemm g{H + C_VR, WrT, MP, D, D, DIN}; pg8::StaticOrder S; S.init(MP, D, nblk, blk);
          pg8::EpiGate<true> E{XN, H + C_GMR, DIN}; pg8::gemm_phase<pg8::EpiGate<true>, pg8::StaticOrder, true, true>(lds, g, S, E); }
        for (int piece = blk; piece < 256; piece += nblk) {
            const int fr = lane & 15, fq = lane >> 4; const size_t prow = (size_t)MP + 32 * (piece >> 4); const size_t row = prow + 16 * (wave >> 2) + fr; const int pcol = 64 * (piece & 15), col0 = pcol + 16 * (wave & 3);
            const f32x4 aa = tail_gemm(H + prow * DIN + C_QA, DIN, WaT + (size_t)pcol * 512, 512, lds, tid, lane, wave, (f32x4){0.f, 0.f, 0.f, 0.f});
            const f32x4 ar = tail_gemm(H + prow * DIN + C_VR, DIN, WrT + (size_t)pcol * 1024, 1024, lds, tid, lane, wave, (f32x4){0.f, 0.f, 0.f, 0.f});
            const int cb = col0 + 4 * fq;
            const u32x2 ga = *(const u32x2*)(H + row * DIN + C_GMA + cb), gr = *(const u32x2*)(H + row * DIN + C_GMR + cb);
            u32x2 w; w.x = pk2(pg8::sigmoidf_(bflo(ga.x)) * aa[0] + pg8::sigmoidf_(bflo(gr.x)) * ar[0], pg8::sigmoidf_(bfhi(ga.x)) * aa[1] + pg8::sigmoidf_(bfhi(gr.x)) * ar[1]);
            w.y = pk2(pg8::sigmoidf_(bflo(ga.y)) * aa[2] + pg8::sigmoidf_(bflo(gr.y)) * ar[2], pg8::sigmoidf_(bfhi(ga.y)) * aa[3] + pg8::sigmoidf_(bfhi(gr.y)) * ar[3]);
            *(u32x2*)(XN + row * D + cb) = w;
        }
    }
    SEAM(5);
    if (IN(6)) {
        pg8::Gemm g{XN, WoT, MP, D, D, D}; pg8::StaticOrder S; S.init(MP, D, nblk, blk);
        pg8::EpiBf16<0> E{MIXb, D, nullptr, 0, 0, 1.f}; pg8::gemm_phase<pg8::EpiBf16<0>, pg8::StaticOrder, true, true>(lds, g, S, E);
        for (int piece = blk; piece < 256; piece += nblk) {
            const int fr = lane & 15, fq = lane >> 4; const size_t prow = (size_t)MP + 32 * (piece >> 4); const size_t row = prow + 16 * (wave >> 2) + fr; const int pcol = 64 * (piece & 15), col0 = pcol + 16 * (wave & 3);
            const f32x4 ac = tail_gemm(XN + prow * D, D, WoT + (size_t)pcol * 1024, 1024, lds, tid, lane, wave, (f32x4){0.f, 0.f, 0.f, 0.f});
            u32x2 w; w.x = pk2(ac[0], ac[1]); w.y = pk2(ac[2], ac[3]); *(u32x2*)(MIXb + row * D + col0 + 4 * fq) = w;
        }
    }
    SEAM(6);
    if (IN(7)) {
        f32x4 gpm[2][2], gpf[2][2];
#pragma unroll
        for (int j = 0; j < 2; ++j)
#pragma unroll
            for (int e = 0; e < 2; ++e) { gpm[j][e] = *((const f32x4*)a.g_post_mix + 2 * (lane + 64 * j) + e); gpf[j][e] = *((const f32x4*)a.g_pre_ffn + 2 * (lane + 64 * j) + e); }
        for (int p = blk * NWAVES + wave; p < M / 2; p += nblk * NWAVES) {
            u32x4 mb[2][2]; f32x4 xx[2][2][2];
#pragma unroll
            for (int rr = 0; rr < 2; ++rr) { const int m = 2 * p + rr; const float* xr = m < MP ? a.x_prompt + (size_t)m * D : a.x_sample + (size_t)(m - MP) * D;
#pragma unroll
                for (int j = 0; j < 2; ++j) { mb[rr][j] = *((const u32x4*)(MIXb + (size_t)m * D) + lane + 64 * j); xx[rr][j][0] = *((const f32x4*)xr + 2 * (lane + 64 * j)); xx[rr][j][1] = *((const f32x4*)xr + 2 * (lane + 64 * j) + 1); } }
            float mv[2][2][8]; float ss[2];
#pragma unroll
            for (int rr = 0; rr < 2; ++rr) { ss[rr] = 0.f;
#pragma unroll
                for (int j = 0; j < 2; ++j)
#pragma unroll
                    for (int q = 0; q < 4; ++q) { const unsigned w = mb[rr][j][q]; mv[rr][j][2 * q] = bflo(w); mv[rr][j][2 * q + 1] = bfhi(w); ss[rr] += mv[rr][j][2 * q] * mv[rr][j][2 * q] + mv[rr][j][2 * q + 1] * mv[rr][j][2 * q + 1]; } }
            ss[0] = wave_sum(ss[0]); ss[1] = wave_sum(ss[1]);
            float s2[2];
#pragma unroll
            for (int rr = 0; rr < 2; ++rr) { const float rstd = rsqrtf(ss[rr] * (1.f / D) + EPS); s2[rr] = 0.f;
#pragma unroll
                for (int j = 0; j < 2; ++j)
#pragma unroll
                    for (int q = 0; q < 8; ++q) { const float x1 = xx[rr][j][q >> 2][q & 3] + mv[rr][j][q] * rstd * gpm[j][q >> 2][q & 3]; mv[rr][j][q] = x1; s2[rr] += x1 * x1; } }
            s2[0] = wave_sum(s2[0]); s2[1] = wave_sum(s2[1]);
#pragma unroll
            for (int rr = 0; rr < 2; ++rr) { const int m = 2 * p + rr; const float rstd2 = rsqrtf(s2[rr] * (1.f / D) + EPS);
#pragma unroll
                for (int j = 0; j < 2; ++j) { u32x4 w1, w2;
#pragma unroll
                    for (int q = 0; q < 4; ++q) { const float a0 = mv[rr][j][2 * q], a1 = mv[rr][j][2 * q + 1]; w1[q] = pk2(a0, a1);
                        w2[q] = pk2(a0 * rstd2 * gpf[j][(2 * q) >> 2][(2 * q) & 3], a1 * rstd2 * gpf[j][(2 * q + 1) >> 2][(2 * q + 1) & 3]); }
                    *((u32x4*)(X1b + (size_t)m * D) + lane + 64 * j) = w1; *((u32x4*)(XN + (size_t)m * D) + lane + 64 * j) = w2; } }
        }
    }
    SEAM(7);
    if (IN(8)) {
        pg8::Gemm g{XN, WupT, M, F2, D, D}; pg8::StaticOrder S; S.init(M, F2, nblk, blk);
        pg8::EpiUp E{G, UH, US, a.out + O_CP, a.out + O_CS, a.conv_w, a.conv_b};
        pg8::gemm_phase<pg8::EpiUp, pg8::StaticOrder, true, true>(lds, g, S, E);
    }
    SEAM(8);
    if (IN(9)) {
        for (int task = blk * NWAVES + wave; task < 1024 * 6; task += nblk * NWAVES) {
            const int rt = task / 6, chunk = task % 6; const int ch = chunk * 512 + lane * 8;
            float ua[3][8], ub[3][8];
            int row;
#define LD8BF(dst, ptr) do { const u32x4 _w = *(const u32x4*)(ptr); dst[0] = bflo(_w.x); dst[1] = bfhi(_w.x); dst[2] = bflo(_w.y); dst[3] = bfhi(_w.y); dst[4] = bflo(_w.z); dst[5] = bfhi(_w.z); dst[6] = bflo(_w.w); dst[7] = bfhi(_w.w); } while (0)
#define LD8F(dst, ptr) do { const f32x4 _a = *(const f32x4*)(ptr), _b = *(const f32x4*)((ptr) + 4); dst[0] = _a.x; dst[1] = _a.y; dst[2] = _a.z; dst[3] = _a.w; dst[4] = _b.x; dst[5] = _b.y; dst[6] = _b.z; dst[7] = _b.w; } while (0)
#define ZERO8(dst) do { _Pragma("unroll") for (int _i = 0; _i < 8; ++_i) dst[_i] = 0.f; } while (0)
            if (rt < 512) {
                const int grp = rt >> 1, k = rt & 1; row = grp * 64 + k; const int t = row & 4095;
                const bf16_t* u0 = UH + (size_t)(grp * 4 + 2 + k) * F2;
                LD8BF(ua[2], u0 + ch); LD8BF(ub[2], u0 + DFF + ch);
                if (t >= 1) { const bf16_t* u1 = (k == 0) ? UH + (size_t)((grp - 1) * 4 + 1) * F2 : UH + (size_t)(grp * 4 + 2) * F2; LD8BF(ua[1], u1 + ch); LD8BF(ub[1], u1 + DFF + ch); } else { ZERO8(ua[1]); ZERO8(ub[1]); }
                if (t >= 2) { const bf16_t* u2 = UH + (size_t)((grp - 1) * 4 + k) * F2; LD8BF(ua[0], u2 + ch); LD8BF(ub[0], u2 + DFF + ch); } else { ZERO8(ua[0]); ZERO8(ub[0]); }
            } else {
                const int sr = rt - 512, b = sr >> 2, t = sr & 3; row = MP + sr;
#pragma unroll
                for (int tap = 0; tap < 3; ++tap) { const int e = t + tap;
                    if (e < 2) { const float* cp = a.state_conv + ((size_t)b * 2 + e) * F2; LD8F(ua[tap], cp + ch); LD8F(ub[tap], cp + DFF + ch); }
                    else { const bf16_t* up = US + (size_t)(b * 4 + e - 2) * F2; LD8BF(ua[tap], up + ch); LD8BF(ub[tap], up + DFF + ch); } }
            }
            float wa[3][8], wb[3][8], ba[8], bb[8];
#pragma unroll
            for (int tap = 0; tap < 3; ++tap) { LD8F(wa[tap], a.conv_w + (size_t)tap * F2 + ch); LD8F(wb[tap], a.conv_w + (size_t)tap * F2 + DFF + ch); }
            LD8F(ba, a.conv_b + ch); LD8F(bb, a.conv_b + DFF + ch);
            float gg[8];
#pragma unroll
            for (int i = 0; i < 8; ++i) { const float ca = ba[i] + wa[0][i] * ua[0][i] + wa[1][i] * ua[1][i] + wa[2][i] * ua[2][i], cb = bb[i] + wb[0][i] * ub[0][i] + wb[1][i] * ub[1][i] + wb[2][i] * ub[2][i];
                gg[i] = pg8::gelu_tanh(ca) * cb; }
            u32x4 w; w.x = pk2(gg[0], gg[1]); w.y = pk2(gg[2], gg[3]); w.z = pk2(gg[4], gg[5]); w.w = pk2(gg[6], gg[7]);
            *(u32x4*)(G + (size_t)row * DFF + ch) = w;
        }
    }
    SEAM(9);
    if (IN(10)) {
        pg8::Gemm g{G, WdnT, MP, D, DFF, DFF}; pg8::StaticOrder S; S.init(MP, D, nblk, blk);
        pg8::EpiBf16<0> E{Fb, D, nullptr, 0, 0, 1.f}; pg8::gemm_phase<pg8::EpiBf16<0>, pg8::StaticOrder, true, true>(lds, g, S, E);
        for (int piece = blk; piece < 256; piece += nblk) {
            const int fr = lane & 15, fq = lane >> 4; const size_t prow = (size_t)MP + 32 * (piece >> 4); const size_t row = prow + 16 * (wave >> 2) + fr; const int pcol = 64 * (piece & 15), col0 = pcol + 16 * (wave & 3);
            const f32x4 ac = tail_gemm(G + prow * DFF, DFF, WdnT + (size_t)pcol * DFF, DFF, lds, tid, lane, wave, (f32x4){0.f, 0.f, 0.f, 0.f});
            u32x2 w; w.x = pk2(ac[0], ac[1]); w.y = pk2(ac[2], ac[3]); *(u32x2*)(Fb + row * D + col0 + 4 * fq) = w;
        }
    }
    SEAM(10);
    if (IN(11)) {
        f32x4 gpo[2][2];
#pragma unroll
        for (int j = 0; j < 2; ++j)
#pragma unroll
            for (int e = 0; e < 2; ++e) gpo[j][e] = *((const f32x4*)a.g_post_ffn + 2 * (lane + 64 * j) + e);
        for (int p = blk * NWAVES + wave; p < M / 2; p += nblk * NWAVES) {
            u32x4 fb[2][2], xb[2][2];
#pragma unroll
            for (int rr = 0; rr < 2; ++rr) { const int m = 2 * p + rr;
#pragma unroll
                for (int j = 0; j < 2; ++j) { fb[rr][j] = *((const u32x4*)(Fb + (size_t)m * D) + lane + 64 * j); xb[rr][j] = *((const u32x4*)(X1b + (size_t)m * D) + lane + 64 * j); } }
            float ss[2];
#pragma unroll
            for (int rr = 0; rr < 2; ++rr) { ss[rr] = 0.f;
#pragma unroll
                for (int j = 0; j < 2; ++j)
#pragma unroll
                    for (int q = 0; q < 4; ++q) { const unsigned w = fb[rr][j][q]; ss[rr] += bflo(w) * bflo(w) + bfhi(w) * bfhi(w); } }
            ss[0] = wave_sum(ss[0]); ss[1] = wave_sum(ss[1]);
#pragma unroll
            for (int rr = 0; rr < 2; ++rr) { const int m = 2 * p + rr; const float rstd = rsqrtf(ss[rr] * (1.f / D) + EPS);
#pragma unroll
                for (int j = 0; j < 2; ++j)
#pragma unroll
                    for (int e = 0; e < 2; ++e) { f32x4 y;
#pragma unroll
                        for (int q = 0; q < 2; ++q) { const unsigned fw = fb[rr][j][2 * e + q], xw = xb[rr][j][2 * e + q];
                            y[2 * q] = bflo(xw) + bflo(fw) * rstd * gpo[j][e][2 * q]; y[2 * q + 1] = bfhi(xw) + bfhi(fw) * rstd * gpo[j][e][2 * q + 1]; }
                        *((f32x4*)(Y + (size_t)m * D) + 2 * (lane + 64 * j) + e) = y; } }
        }
    }
#undef IN
#undef SEAM
}

#ifndef MK_SPLIT
#define MK_SPLIT 0
#endif
extern "C" void kernel_launch(void* const* d_in, const int* in_sizes, int n_in, void* d_out, int out_size, void* d_ws, size_t ws_size, hipStream_t stream) {
    static int grid = 0;
    if (grid == 0) {
        int dev = 0, cus = 0, per_cu = 0;
        if (hipGetDevice(&dev) != hipSuccess || hipDeviceGetAttribute(&cus, hipDeviceAttributeMultiprocessorCount, dev) != hipSuccess) { fprintf(stderr, "kernel_launch: device query failed\n"); grid = -1; return; }
        if (hipFuncSetAttribute((const void*)fwd_megakernel, hipFuncAttributeMaxDynamicSharedMemorySize, LDS_BYTES) != hipSuccess) { fprintf(stderr, "kernel_launch: hipFuncSetAttribute failed\n"); grid = -1; return; }
        if (hipOccupancyMaxActiveBlocksPerMultiprocessor(&per_cu, (const void*)fwd_megakernel, NTHREADS, LDS_BYTES) != hipSuccess || per_cu < 1) { fprintf(stderr, "kernel_launch: occupancy query says %d\n", per_cu); per_cu = 1; }
        (void)hipGetLastError();
        grid = cus * 1;
        if (ws_size < 256 * MiB || out_size != (int)O_END || n_in != 19) fprintf(stderr, "kernel_launch: unexpected sizes ws %zu out %d n_in %d\n", ws_size, out_size, n_in);
    }
    if (grid < 0) return;
    Args a{};
    a.x_prompt = (const float*)d_in[0]; a.x_sample = (const float*)d_in[1]; a.cache_k = (const float*)d_in[2]; a.cache_v = (const float*)d_in[3]; a.state_ret = (const float*)d_in[4];
    a.state_conv = (const float*)d_in[5]; a.w_in = (const float*)d_in[6]; a.sinks = (const float*)d_in[7]; a.w_a = (const float*)d_in[8]; a.w_r = (const float*)d_in[9]; a.w_o = (const float*)d_in[10];
    a.g_pre_mix = (const float*)d_in[11]; a.g_post_mix = (const float*)d_in[12]; a.g_pre_ffn = (const float*)d_in[13]; a.g_post_ffn = (const float*)d_in[14];
    a.w_up = (const float*)d_in[15]; a.conv_w = (const float*)d_in[16]; a.conv_b = (const float*)d_in[17]; a.w_down = (const float*)d_in[18];
    a.out = (float*)d_out; a.ws = (unsigned char*)d_ws;
#if MK_SPLIT
    for (int ph = 0; ph < 12; ++ph) { a.ph_lo = ph; a.ph_hi = ph + 1; hipLaunchKernelGGL(fwd_megakernel, dim3(grid), dim3(NTHREADS), LDS_BYTES, stream, a); }
#else
    a.ph_lo = 0; a.ph_hi = 12;
    void* args[] = {&a};
    const hipError_t e = hipLaunchCooperativeKernel((const void*)fwd_megakernel, dim3(grid), dim3(NTHREADS), args, LDS_BYTES, stream);
    if (e != hipSuccess) fprintf(stderr, "kernel_launch: cooperative launch failed: %s (grid %d)\n", hipGetErrorString(e), grid);
#endif
}
```

```cpp
#include <hip/hip_runtime.h>
#include <hip/hip_cooperative_groups.h>
#include <cstdio>
#include <cstdint>
#include <cmath>
namespace cg = cooperative_groups;
namespace pg8 {
#define PG8_LAS __attribute__((address_space(3)))
typedef unsigned short bf16_t;
typedef short bf16x8 __attribute__((ext_vector_type(8)));
typedef float f32x4 __attribute__((ext_vector_type(4)));
typedef unsigned u32x4 __attribute__((ext_vector_type(4)));
constexpr int BM = 256, BK = 64, HALF = 128, HTB = HALF * BK * 2  , STAGE_BYTES = 8 * HTB, NXCD = 8, WGM = 8;

__host__ __device__ __forceinline__ int lds_byte(int r, int c) { const int st = (r >> 4) * 2 + (c >> 5), rr = r & 15, cc = c & 31, ob = rr * 64 + cc * 2; return st * 1024 + (ob ^ (((ob >> 9) & 1) << 5)); }
__host__ __device__ __forceinline__ void stage_rc(int b, int& R, int& C) { const int st = b / 1024, sb = b % 1024, swz = sb ^ (((sb >> 9) & 1) << 5); R = (st >> 1) * 16 + swz / 64; C = (st & 1) * 32 + (swz % 64) / 2; }
__host__ __device__ __forceinline__ int perm32(int rho) { const int n = rho >> 4, i = rho & 15; return 8 * (i >> 2) + 4 * n + (i & 3); }

struct Unit { int pm, pn; };
struct Gemm { const bf16_t* A; const bf16_t* Bt; int M, N, K, lda; };

struct StaticOrder {
    int nM, nN, nwg, G, c;
    __host__ __device__ void init(int M, int N, int G_, int c_) { nM = M / BM; nN = N / BM; nwg = nM * nN; G = G_; c = c_; }
    __host__ __device__ bool next(int i, Unit& u) const {
        const long L = (long)i * G + c; if (L >= nwg) return false;
        int wgid = (int)L; { const int q = nwg / NXCD, r = nwg % NXCD, xcd = wgid % NXCD, off = wgid / NXCD; wgid = (xcd < r ? xcd * (q + 1) : r * (q + 1) + (xcd - r) * q) + off; }
        const int nig = WGM * nN, gid = wgid / nig, fm = gid * WGM, gsz = (nM - fm) < WGM ? (nM - fm) : WGM;
        u.pm = fm + ((wgid % nig) % gsz); u.pn = (wgid % nig) / gsz; return true;
    }
    __device__ __forceinline__ void a_ready(const Unit&) const {}
    __device__ __forceinline__ void done(const Unit&) const {}
};

__device__ __forceinline__ unsigned cvt_pk_bf16(float lo, float hi) { unsigned r; asm volatile("v_cvt_pk_bf16_f32 %0, %1, %2" : "=v"(r) : "v"(lo), "v"(hi)); return r; }
typedef float f32x2 __attribute__((ext_vector_type(2)));
__device__ __forceinline__ f32x2 gelu_pk(f32x2 v) {
    const f32x2 av = __builtin_elementwise_abs(v), d = av * 0.2316418882f + 1.0f;
    f32x2 t; t.x = __builtin_amdgcn_rcpf(d.x); t.y = __builtin_amdgcn_rcpf(d.y);
    f32x2 q = t * 0.5307027145f + (-0.7265760135f); q = q * t + 0.7107068705f; q = q * t + (-0.142248368f); q = q * t + 0.127414796f; q = q * t;
    const f32x2 s = (v * v) * (-0.72134752044f);
    f32x2 e; e.x = __builtin_amdgcn_exp2f(s.x); e.y = __builtin_amdgcn_exp2f(s.y);
    const f32x2 m = v * (q * e), r = v - m;
    f32x2 o; o.x = v.x < 0.f ? m.x : r.x; o.y = v.y < 0.f ? m.y : r.y; return o;
}

template <int ACT  > struct EpiBf16 {
    static constexpr bool PERM = true, AFTER_DRAIN = false; static_assert(ACT == 0 || ACT == 1, "EpiBf16: ACT is 0 (none) or 1 (gelu_pk)");
    bf16_t* O; int ldc; const float* bias; int split_cols; size_t split_stride; float scale0;
    __device__ __forceinline__ void operator()(const f32x4 (&acc)[2][2][4][2], const Unit& u, int wr, int wc, int fr, int fq) const {
        const int row0 = u.pm * BM + wr * 64 + fr; int colt = u.pn * BM; bf16_t* base = O;
        float sc = 1.f; if (split_cols) { const int t = colt / split_cols; base += (size_t)t * split_stride; colt -= t * split_cols; if (t == 0) sc = scale0; }
        const int col0 = colt + wc * 32 + 8 * fq, bcol0 = u.pn * BM + wc * 32 + 8 * fq;
        f32x4 bv[2][2];
#pragma unroll
        for (int bj = 0; bj < 2; ++bj)
#pragma unroll
            for (int n = 0; n < 2; ++n) bv[bj][n] = bias ? *(const f32x4*)(bias + bcol0 + bj * HALF + 4 * n) : (f32x4){0.f, 0.f, 0.f, 0.f};
#pragma unroll
        for (int ai = 0; ai < 2; ++ai)
#pragma unroll
            for (int m = 0; m < 4; ++m) { bf16_t* rowp = base + (size_t)(row0 + ai * HALF + m * 16) * ldc + col0;
#pragma unroll
                for (int bj = 0; bj < 2; ++bj) { f32x4 v0 = acc[ai][bj][m][0] + bv[bj][0], v1 = acc[ai][bj][m][1] + bv[bj][1];
                    if (ACT == 1) { f32x2 a = gelu_pk((f32x2){v0[0], v0[1]}), b = gelu_pk((f32x2){v0[2], v0[3]}), c = gelu_pk((f32x2){v1[0], v1[1]}), d = gelu_pk((f32x2){v1[2], v1[3]});
                        v0 = (f32x4){a.x, a.y, b.x, b.y}; v1 = (f32x4){c.x, c.y, d.x, d.y}; }
                    v0 = v0 * sc; v1 = v1 * sc; u32x4 w; w.x = cvt_pk_bf16(v0[0], v0[1]); w.y = cvt_pk_bf16(v0[2], v0[3]); w.z = cvt_pk_bf16(v1[0], v1[1]); w.w = cvt_pk_bf16(v1[2], v1[3]);
                    *(u32x4*)(rowp + bj * HALF) = w; } }
    }
};

typedef float f32x2e __attribute__((ext_vector_type(2)));
typedef unsigned u32x2e __attribute__((ext_vector_type(2)));
__device__ __forceinline__ float bf_lo(unsigned w) { return __uint_as_float(w << 16); }
__device__ __forceinline__ float bf_hi(unsigned w) { return __uint_as_float(w & 0xffff0000u); }
__device__ __forceinline__ float sigmoidf_(float x) { return __builtin_amdgcn_rcpf(1.0f + __expf(-x)); }
constexpr int E_MP = 16384, E_DIN = 5888;

struct EpiH {
    static constexpr bool PERM = true, AFTER_DRAIN = false;
    bf16_t* H; const f32x2e* tabA; const f32x2e* tabR;
    __device__ __forceinline__ void operator()(const f32x4 (&acc)[2][2][4][2], const Unit& u, int wr, int wc, int fr, int fq) const {
        const int pn = u.pn;
        const int row0 = u.pm * BM + wr * 64 + fr;
        const int colt = pn * BM + wc * 32 + 8 * fq;
#pragma unroll
        for (int ai = 0; ai < 2; ++ai)
#pragma unroll
            for (int m = 0; m < 4; ++m) {
                const int row = row0 + ai * HALF + m * 16;
                const int tp = row < E_MP ? (row & 4095) : 4096 + (row & 3);
#pragma unroll
                for (int bj = 0; bj < 2; ++bj) {
                    float v[8];
#pragma unroll
                    for (int j = 0; j < 4; ++j) { v[j] = acc[ai][bj][m][0][j]; v[4 + j] = acc[ai][bj][m][1][j]; }
                    int mode = 0; float sc = 1.f;
                    if (pn < 2) { mode = 1; sc = 0.125f; }
                    else if (pn == 2) { mode = (bj == 0) ? 1 : 0; }
                    else if (pn < 5) { mode = 2; }
                    else if (pn < 7) { mode = 2; sc = 0.08838834764831845f; }
                    if (mode == 1) {
                        const bool rot = ((wc & 1) == 0) && (fq < 2);
                        const float sgn = (fq == 0) ? -1.f : 1.f;
#pragma unroll
                        for (int j = 0; j < 8; ++j) {
                            const float partner = __shfl_xor(v[j], 16);
                            const f32x2e cs = tabA[tp * 8 + j];
                            const float o = v[j] * cs.x + sgn * partner * cs.y;
                            v[j] = (rot ? o : v[j]) * sc;
                        }
                    } else if (mode == 2) {
                        const int pi = ((bj * HALF + wc * 32 + 8 * fq) & 127) >> 1;
#pragma unroll
                        for (int p = 0; p < 4; ++p) {
                            const f32x2e cs = tabR[tp * 64 + pi + p];
                            const float x0 = v[2 * p], x1 = v[2 * p + 1];
                            v[2 * p] = (x0 * cs.x - x1 * cs.y) * sc; v[2 * p + 1] = (x1 * cs.x + x0 * cs.y) * sc;
                        }
                    }
                    u32x4 w; w.x = cvt_pk_bf16(v[0], v[1]); w.y = cvt_pk_bf16(v[2], v[3]); w.z = cvt_pk_bf16(v[4], v[5]); w.w = cvt_pk_bf16(v[6], v[7]);
                    *(u32x4*)(H + (size_t)row * E_DIN + colt + bj * HALF) = w;
                }
            }
    }
};

template <bool ADD> struct EpiGate {
    static constexpr bool PERM = true, AFTER_DRAIN = false;
    bf16_t* T; const bf16_t* gate; int ldg;
    __device__ __forceinline__ void operator()(const f32x4 (&acc)[2][2][4][2], const Unit& u, int wr, int wc, int fr, int fq) const {
        const int row0 = u.pm * BM + wr * 64 + fr, col0 = u.pn * BM + wc * 32 + 8 * fq;
#pragma unroll
        for (int ai = 0; ai < 2; ++ai)
#pragma unroll
            for (int m = 0; m < 4; ++m) {
                const int row = row0 + ai * HALF + m * 16;
#pragma unroll
                for (int bj = 0; bj < 2; ++bj) {
                    const u32x4 gw = *(const u32x4*)(gate + (size_t)row * ldg + col0 + bj * HALF);
                    bf16_t* tp = T + (size_t)row * 1024 + col0 + bj * HALF;
                    u32x4 old = (u32x4){0u, 0u, 0u, 0u}; if (ADD) old = *(const u32x4*)tp;
                    float o[8];
#pragma unroll
                    for (int j = 0; j < 4; ++j) {
                        const unsigned g2 = gw[j], o2 = old[j];
                        const float a0 = acc[ai][bj][m][j >> 1][(j & 1) * 2], a1 = acc[ai][bj][m][j >> 1][(j & 1) * 2 + 1];
                        o[2 * j] = bf_lo(o2) + sigmoidf_(bf_lo(g2)) * a0; o[2 * j + 1] = bf_hi(o2) + sigmoidf_(bf_hi(g2)) * a1;
                    }
                    u32x4 w; w.x = cvt_pk_bf16(o[0], o[1]); w.y = cvt_pk_bf16(o[2], o[3]); w.z = cvt_pk_bf16(o[4], o[5]); w.w = cvt_pk_bf16(o[6], o[7]);
                    *(u32x4*)tp = w;
                }
            }
    }
};

struct EpiF32 {
    static constexpr bool PERM = true, AFTER_DRAIN = false;
    float* O;
    __device__ __forceinline__ void operator()(const f32x4 (&acc)[2][2][4][2], const Unit& u, int wr, int wc, int fr, int fq) const {
        const int row0 = u.pm * BM + wr * 64 + fr, col0 = u.pn * BM + wc * 32 + 8 * fq;
#pragma unroll
        for (int ai = 0; ai < 2; ++ai)
#pragma unroll
            for (int m = 0; m < 4; ++m) {
                float* rp = O + (size_t)(row0 + ai * HALF + m * 16) * 1024 + col0;
#pragma unroll
                for (int bj = 0; bj < 2; ++bj) { *(f32x4*)(rp + bj * HALF) = acc[ai][bj][m][0]; *(f32x4*)(rp + bj * HALF + 4) = acc[ai][bj][m][1]; }
            }
    }
};

__device__ __forceinline__ float dpp_ror1(float x) { return __builtin_bit_cast(float, __builtin_amdgcn_update_dpp(0, __builtin_bit_cast(int, x), 0x121, 0xf, 0xf, false)); }
__device__ __forceinline__ float dpp_ror2(float x) { return __builtin_bit_cast(float, __builtin_amdgcn_update_dpp(0, __builtin_bit_cast(int, x), 0x122, 0xf, 0xf, false)); }
__device__ __forceinline__ float gelu_tanh(float x) { const float u2 = 1.5957691216057308f * (x + 0.044715f * x * x * x); return x * __builtin_amdgcn_rcpf(1.0f + __expf(-u2)); }
struct EpiUp {
    static constexpr bool PERM = true, AFTER_DRAIN = false;
    bf16_t* G; bf16_t* UH; bf16_t* US; float* conv_prompt; float* conv_sample; const float* conv_w; const float* conv_b;
    __device__ __forceinline__ void operator()(const f32x4 (&acc)[2][2][4][2], const Unit& u, int wr, int wc, int fr, int fq) const {
        const int row0 = u.pm * BM + wr * 64 + fr;
        const bool sample = u.pm >= 64;
#pragma unroll
        for (int n = 0; n < 2; ++n) {
            const int ch = u.pn * HALF + wc * 32 + 8 * fq + 4 * n;
            const f32x4 wa0 = *(const f32x4*)(conv_w + ch), wa1 = *(const f32x4*)(conv_w + 6144 + ch), wa2 = *(const f32x4*)(conv_w + 12288 + ch), ba = *(const f32x4*)(conv_b + ch);
            const f32x4 wb0 = *(const f32x4*)(conv_w + 3072 + ch), wb1 = *(const f32x4*)(conv_w + 6144 + 3072 + ch), wb2 = *(const f32x4*)(conv_w + 12288 + 3072 + ch), bb = *(const f32x4*)(conv_b + 3072 + ch);
#pragma unroll
            for (int ai = 0; ai < 2; ++ai)
#pragma unroll
                for (int m = 0; m < 4; ++m) {
                    const int row = row0 + ai * HALF + m * 16;
                    const f32x4 ua = acc[ai][0][m][n], ub = acc[ai][1][m][n];
                    const f32x4 pa = acc[ai][0][m > 0 ? m - 1 : 0][n], pb = acc[ai][1][m > 0 ? m - 1 : 0][n];
                    float g[4];
#pragma unroll
                    for (int r = 0; r < 4; ++r) {
                        const float a1c = dpp_ror1(ua[r]), a1p = dpp_ror1(pa[r]), a2c = dpp_ror2(ua[r]), a2p = dpp_ror2(pa[r]);
                        const float b1c = dpp_ror1(ub[r]), b1p = dpp_ror1(pb[r]), b2c = dpp_ror2(ub[r]), b2p = dpp_ror2(pb[r]);
                        const float a1 = fr >= 1 ? a1c : a1p, a2 = fr >= 2 ? a2c : a2p, b1 = fr >= 1 ? b1c : b1p, b2 = fr >= 2 ? b2c : b2p;
                        const float ca = ba[r] + wa0[r] * a2 + wa1[r] * a1 + wa2[r] * ua[r];
                        const float cb = bb[r] + wb0[r] * b2 + wb1[r] * b1 + wb2[r] * ub[r];
                        g[r] = gelu_tanh(ca) * cb;
                    }
                    if (!sample) {
                        if (!(m == 0 && fr < 2)) { u32x2e w; w.x = cvt_pk_bf16(g[0], g[1]); w.y = cvt_pk_bf16(g[2], g[3]); *(u32x2e*)(G + (size_t)row * 3072 + ch) = w; }
                        if ((m == 0 && fr < 2) || (m == 3 && fr >= 14)) {
                            const int hrow = (row >> 6) * 4 + ((row + 2) & 63);
                            u32x2e w; w.x = cvt_pk_bf16(ua[0], ua[1]); w.y = cvt_pk_bf16(ua[2], ua[3]); *(u32x2e*)(UH + (size_t)hrow * 6144 + ch) = w;
                            w.x = cvt_pk_bf16(ub[0], ub[1]); w.y = cvt_pk_bf16(ub[2], ub[3]); *(u32x2e*)(UH + (size_t)hrow * 6144 + 3072 + ch) = w;
                        }
                        if ((row & 4095) >= 4094) {
                            float* cp = conv_prompt + ((size_t)(row >> 12) * 2 + ((row & 4095) - 4094)) * 6144;
                            *(f32x4*)(cp + ch) = ua; *(f32x4*)(cp + 3072 + ch) = ub;
                        }
                    } else {
                        const int sr = row - E_MP;
                        u32x2e w; w.x = cvt_pk_bf16(ua[0], ua[1]); w.y = cvt_pk_bf16(ua[2], ua[3]); *(u32x2e*)(US + (size_t)sr * 6144 + ch) = w;
                        w.x = cvt_pk_bf16(ub[0], ub[1]); w.y = cvt_pk_bf16(ub[2], ub[3]); *(u32x2e*)(US + (size_t)sr * 6144 + 3072 + ch) = w;
                        if ((sr & 3) >= 2) {
                            float* cp = conv_sample + ((size_t)(sr >> 2) * 2 + ((sr & 3) - 2)) * 6144;
                            *(f32x4*)(cp + ch) = ua; *(f32x4*)(cp + 3072 + ch) = ub;
                        }
                    }
                }
        }
    }
};

template <class Epi, class Sched, bool ALIGN_EPI = false, bool SP2 = false>
__device__ __forceinline__ void gemm_phase(PG8_LAS unsigned char* lds, const Gemm g, const Sched& S, const Epi& E) {
    const int tid = threadIdx.x, wid = __builtin_amdgcn_readfirstlane(tid >> 6), lane = tid & 63, wr = wid >> 2, wc = wid & 3, fr = lane & 15, fq = lane >> 4;
    const int K = g.K, nt = K / BK, lda = g.lda;
    unsigned voffA[2], voffB[2];
#pragma unroll
    for (int i = 0; i < 2; ++i) { int R, C; stage_rc(tid * 16 + i * 8192, R, C); const int Rb = Epi::PERM ? ((R & ~31) + perm32(R & 31)) : R;
        voffA[i] = (unsigned)(R * lda + C) * 2u; voffB[i] = (unsigned)(Rb * K + C) * 2u; }
    const size_t kstep = (size_t)(BK * 2);
    const size_t hstepA = (size_t)HALF * lda * 2, hstepB = (size_t)HALF * K * 2;
    const size_t tstepA = 2 * hstepA, tstepB = 2 * hstepB;
    const unsigned ldsw = (unsigned)wid * 1024u;
    const int aoff = lds_byte(wr * 64 + fr, fq * 8), boff = lds_byte(wc * 32 + fr, fq * 8);
#define PG8_SA(b, h) (((b) * 2 + (h)) * HTB)
#define PG8_SB(b, h) ((4 + (b) * 2 + (h)) * HTB)
#define PG8_STAGE(bufoff, gbase, voff) do { _Pragma("unroll") for (int _i = 0; _i < 2; ++_i) \
        __builtin_amdgcn_global_load_lds((const unsigned*)((const char*)(gbase) + (voff)[_i]), (PG8_LAS unsigned*)(lds + (bufoff) + ldsw + _i * 8192), 16, 0, 0); } while (0)
#define PG8_LDA(dst, b, h) do { _Pragma("unroll") for (int m = 0; m < 4; ++m) _Pragma("unroll") for (int k = 0; k < 2; ++k) dst[m][k] = *(const PG8_LAS bf16x8*)(lds + PG8_SA(b, h) + aoff + m * 2048 + k * 1024); } while (0)
#define PG8_LDB(dst, b, h) do { _Pragma("unroll") for (int n = 0; n < 2; ++n) _Pragma("unroll") for (int k = 0; k < 2; ++k) dst[n][k] = *(const PG8_LAS bf16x8*)(lds + PG8_SB(b, h) + boff + n * 2048 + k * 1024); } while (0)
#define PG8_MMA(ai, bj, At, Bt) do { __builtin_amdgcn_s_setprio(1); _Pragma("unroll") for (int m = 0; m < 4; ++m) _Pragma("unroll") for (int n = 0; n < 2; ++n) _Pragma("unroll") for (int k = 0; k < 2; ++k) \
        acc[ai][bj][m][n] = __builtin_amdgcn_mfma_f32_16x16x32_bf16(Bt[n][k], At[m][k], acc[ai][bj][m][n], 0, 0, 0); __builtin_amdgcn_s_setprio(0); } while (0)
#define PG8_WAIT_V(n) asm volatile("s_waitcnt vmcnt(" #n ")" ::: "memory")
#define PG8_WAIT_L(n) asm volatile("s_waitcnt lgkmcnt(" #n ")" ::: "memory")
#define PG8_BAR __builtin_amdgcn_s_barrier()
#define PG8_SCHED __builtin_amdgcn_sched_barrier(0)
    Unit cur, nxt; int ui = 0;
    if (!S.next(0, cur)) return;
    f32x4 acc[2][2][4][2];
#pragma unroll
    for (int a = 0; a < 2; ++a)
#pragma unroll
        for (int b = 0; b < 2; ++b)
#pragma unroll
            for (int m = 0; m < 4; ++m)
#pragma unroll
                for (int n = 0; n < 2; ++n) acc[a][b][m][n] = (f32x4){0.f, 0.f, 0.f, 0.f};
    bf16x8 At[4][2], B0[2][2], B1[2][2];
    const char* cA = (const char*)g.A + (size_t)cur.pm * tstepA; const char* cB = (const char*)g.Bt + (size_t)cur.pn * tstepB;
    S.a_ready(cur);
    if constexpr (SP2) {
        PG8_STAGE(PG8_SB(0, 0), cB, voffB); PG8_STAGE(PG8_SB(0, 1), cB + hstepB, voffB); PG8_STAGE(PG8_SA(0, 0), cA, voffA); PG8_STAGE(PG8_SA(0, 1), cA + hstepA, voffA);
        if (wr == 1) PG8_BAR;
        PG8_WAIT_V(2); PG8_BAR;
        PG8_STAGE(PG8_SB(1, 0), cB + kstep, voffB); PG8_STAGE(PG8_SA(1, 0), cA + kstep, voffA); PG8_STAGE(PG8_SB(1, 1), cB + hstepB + kstep, voffB);
        PG8_WAIT_V(6); PG8_BAR;
    } else {
        PG8_STAGE(PG8_SB(0, 0), cB, voffB); PG8_STAGE(PG8_SA(0, 0), cA, voffA); PG8_STAGE(PG8_SB(0, 1), cB + hstepB, voffB); PG8_STAGE(PG8_SA(0, 1), cA + hstepA, voffA);
        if (wr == 1) PG8_BAR;
        PG8_WAIT_V(4); PG8_BAR;
        PG8_STAGE(PG8_SB(1, 0), cB + kstep, voffB); PG8_STAGE(PG8_SA(1, 0), cA + kstep, voffA); PG8_STAGE(PG8_SB(1, 1), cB + hstepB + kstep, voffB);
        PG8_WAIT_V(6); PG8_BAR;
    }
    for (;;) {
        const bool has_next = S.next(ui + 1, nxt);
        const char* nA = has_next ? (const char*)g.A + (size_t)nxt.pm * tstepA : cA; const char* nB = has_next ? (const char*)g.Bt + (size_t)nxt.pn * tstepB : cB;
        for (int t = 0; t < nt; t += 2) {
            const bool last = (t == nt - 2);
            const char* a1 = cA + (size_t)(t + 1) * kstep;
            const char* a2 = last ? nA : cA + (size_t)(t + 2) * kstep; const char* b2 = last ? nB : cB + (size_t)(t + 2) * kstep;
            const char* a3 = a2 + kstep; const char* b3 = b2 + kstep;
            if (last && has_next) S.a_ready(nxt);
            if constexpr (SP2) {
            PG8_LDB(B0, 0, 0); PG8_LDB(B1, 0, 1); PG8_SCHED; PG8_LDA(At, 0, 0); PG8_STAGE(PG8_SA(1, 1), a1 + hstepA, voffA);
            PG8_WAIT_V(8); PG8_WAIT_L(0); PG8_BAR; PG8_MMA(0, 0, At, B0); PG8_MMA(0, 1, At, B1); PG8_BAR; PG8_SCHED;
            PG8_LDA(At, 0, 1); PG8_STAGE(PG8_SB(0, 0), b2, voffB); PG8_STAGE(PG8_SB(0, 1), b2 + hstepB, voffB); PG8_STAGE(PG8_SA(0, 0), a2, voffA);
            PG8_WAIT_V(8); PG8_WAIT_L(0); PG8_BAR; PG8_MMA(1, 0, At, B0); PG8_MMA(1, 1, At, B1); PG8_BAR; PG8_SCHED;
            PG8_LDB(B0, 1, 0); PG8_LDB(B1, 1, 1); PG8_SCHED; PG8_LDA(At, 1, 0); PG8_STAGE(PG8_SA(0, 1), a2 + hstepA, voffA);
            PG8_WAIT_V(8); PG8_WAIT_L(0); PG8_BAR; PG8_MMA(0, 0, At, B0); PG8_MMA(0, 1, At, B1); PG8_BAR; PG8_SCHED;
            PG8_LDA(At, 1, 1); PG8_STAGE(PG8_SB(1, 0), b3, voffB); PG8_STAGE(PG8_SB(1, 1), b3 + hstepB, voffB); PG8_STAGE(PG8_SA(1, 0), a3, voffA);
            PG8_WAIT_V(8); PG8_WAIT_L(0); PG8_BAR; PG8_MMA(1, 0, At, B0); PG8_MMA(1, 1, At, B1); PG8_BAR; PG8_SCHED;
            } else {
            PG8_LDB(B0, 0, 0); PG8_SCHED; PG8_LDA(At, 0, 0); PG8_STAGE(PG8_SA(1, 1), a1 + hstepA, voffA);
            PG8_WAIT_L(8); PG8_BAR; PG8_WAIT_L(0); PG8_MMA(0, 0, At, B0); PG8_BAR; PG8_SCHED;
            PG8_LDB(B1, 0, 1); PG8_STAGE(PG8_SB(0, 0), b2, voffB);
            PG8_BAR; PG8_WAIT_L(0); PG8_MMA(0, 1, At, B1); PG8_BAR;
            PG8_LDA(At, 0, 1); PG8_STAGE(PG8_SA(0, 0), a2, voffA);
            PG8_BAR; PG8_WAIT_L(0); PG8_MMA(1, 0, At, B0); PG8_BAR; PG8_SCHED;
            PG8_STAGE(PG8_SB(0, 1), b2 + hstepB, voffB);
            PG8_WAIT_V(6); PG8_BAR; PG8_MMA(1, 1, At, B1); PG8_BAR;
            PG8_LDB(B0, 1, 0); PG8_SCHED; PG8_LDA(At, 1, 0); PG8_STAGE(PG8_SA(0, 1), a2 + hstepA, voffA);
            PG8_WAIT_L(8); PG8_BAR; PG8_WAIT_L(0); PG8_MMA(0, 0, At, B0); PG8_BAR; PG8_SCHED;
            PG8_LDB(B1, 1, 1); PG8_STAGE(PG8_SB(1, 0), b3, voffB);
            PG8_BAR; PG8_WAIT_L(0); PG8_MMA(0, 1, At, B1); PG8_BAR;
            PG8_LDA(At, 1, 1); PG8_STAGE(PG8_SA(1, 0), a3, voffA);
            PG8_BAR; PG8_WAIT_L(0); PG8_MMA(1, 0, At, B0); PG8_BAR; PG8_SCHED;
            PG8_STAGE(PG8_SB(1, 1), b3 + hstepB, voffB);
            PG8_WAIT_V(6); PG8_BAR; PG8_MMA(1, 1, At, B1); PG8_BAR;
            }
        }
        if constexpr (ALIGN_EPI) { if (wr == 0) PG8_BAR; }
        if constexpr (!Epi::AFTER_DRAIN) { E(acc, cur, wr, wc, fr, fq); S.done(cur); }
        if (!has_next) break;
#pragma unroll
        for (int a = 0; a < 2; ++a)
#pragma unroll
            for (int b = 0; b < 2; ++b)
#pragma unroll
                for (int m = 0; m < 4; ++m)
#pragma unroll
                    for (int n = 0; n < 2; ++n) acc[a][b][m][n] = (f32x4){0.f, 0.f, 0.f, 0.f};
        cur = nxt; cA = nA; cB = nB; ++ui;
        if constexpr (ALIGN_EPI) { if (wr == 1) PG8_BAR; }
    }
    PG8_WAIT_V(0);
    if constexpr (!ALIGN_EPI) { if (wr == 0) PG8_BAR; }
    PG8_BAR;
    if constexpr (Epi::AFTER_DRAIN) { E.fused(acc, cur, wr, wc, fr, fq, lds, wid, lane); S.done(cur); }
#undef PG8_SA
#undef PG8_SB
#undef PG8_STAGE
#undef PG8_LDA
#undef PG8_LDB
#undef PG8_MMA
#undef PG8_WAIT_V
#undef PG8_WAIT_L
#undef PG8_BAR
#undef PG8_SCHED
}
}

#define LAS __attribute__((address_space(3)))
using pg8::bf16_t; using pg8::bf16x8; using pg8::f32x4; using pg8::u32x4;
typedef float f32x2 __attribute__((ext_vector_type(2)));
typedef unsigned u32x2 __attribute__((ext_vector_type(2)));
typedef short v4i16 __attribute__((ext_vector_type(4)));

constexpr int MP = 16384, MS = 512, M = MP + MS, D = 1024, DIN = 5888, F2 = 6144, DFF = 3072, TSEQ = 4096;
constexpr int C_QA = 0, C_KA = 512, C_VA = 640, C_QR = 768, C_KR = 1280, C_VR = 1792, C_GATE = 2816, C_GMA = 3840, C_GMR = 4864;
constexpr float EPS = 1e-6f;
constexpr int NTHREADS = 512, NWAVES = 8;
constexpr int LDS_BYTES = 147456;

constexpr size_t MiB = 1u << 20;
constexpr size_t WS_TABA = 0, WS_TABR = 512 * 1024;
constexpr size_t WS_WIN = 3 * MiB;
constexpr size_t WS_WUP = WS_WIN + (size_t)DIN * D * 2;
constexpr size_t WS_WDN = WS_WUP + (size_t)F2 * D * 2;
constexpr size_t WS_XN = WS_WDN + (size_t)D * DFF * 2;
constexpr size_t WS_R1 = WS_XN + (size_t)M * D * 2;
constexpr size_t R1_G = 0, R1_F = (size_t)M * DFF * 2, R1_UH = R1_F + (size_t)M * D * 2, R1_US = R1_UH + (size_t)264 * 4 * F2 * 2, R1_X1 = R1_US + (size_t)MS * F2 * 2, R1_END = R1_X1 + (size_t)M * D * 2;
static_assert(R1_END <= (size_t)M * DIN * 2, "R1 overlay");
static_assert(WS_R1 + (size_t)M * DIN * 2 <= 256 * MiB, "ws map");
constexpr size_t O_Y = 0, O_KP = (size_t)M * D, O_VP = O_KP + 65536, O_RP = O_VP + 65536, O_CP = O_RP + 524288, O_KS = O_CP + 49152, O_VS = O_KS + 2097152, O_RS = O_VS + 2097152, O_CS = O_RS + 16777216, O_END = O_CS + 1572864;

struct Args {
    const float *x_prompt, *x_sample, *cache_k, *cache_v, *state_ret, *state_conv, *w_in, *sinks, *w_a, *w_r, *w_o, *g_pre_mix, *g_post_mix, *g_pre_ffn, *g_post_ffn, *w_up, *conv_w, *conv_b, *w_down;
    float* out; unsigned char* ws; int ph_lo, ph_hi;
};

__device__ __forceinline__ float bf2f(bf16_t h) { return __uint_as_float((unsigned)h << 16); }
__device__ __forceinline__ float bflo(unsigned w) { return __uint_as_float(w << 16); }
__device__ __forceinline__ float bfhi(unsigned w) { return __uint_as_float(w & 0xffff0000u); }
__device__ __forceinline__ unsigned pk2(float lo, float hi) { return pg8::cvt_pk_bf16(lo, hi); }
__device__ __forceinline__ float wave_sum(float v) {
#pragma unroll
    for (int o = 1; o < 64; o <<= 1) v += __shfl_xor(v, o);
    return v;
}
__device__ __forceinline__ float wave_max(float v) {
#pragma unroll
    for (int o = 1; o < 64; o <<= 1) v = fmaxf(v, __shfl_xor(v, o));
    return v;
}
__device__ __forceinline__ float ret_log2g(int h) { return log2f(1.0f - exp2f(-5.0f - (float)h)); }
__device__ __forceinline__ bf16x8 tr_pair(const LAS unsigned char* p0, const LAS unsigned char* p1) {
    const v4i16 a = __builtin_amdgcn_ds_read_tr16_b64_v4i16((LAS v4i16*)p0), b = __builtin_amdgcn_ds_read_tr16_b64_v4i16((LAS v4i16*)p1);
    return (bf16x8){a[0], a[1], a[2], a[3], b[0], b[1], b[2], b[3]};
}
__device__ __forceinline__ bf16x8 cat8(u32x2 a, u32x2 b) { const u32x4 w = {a.x, a.y, b.x, b.y}; return __builtin_bit_cast(bf16x8, w); }

__device__ __forceinline__ void p0_transpose_item(const float* W, int K, int N, bf16_t* WT, int k0, int n0, int drow0, LAS float* scr, int lane) {
    f32x4 wv[8];
#pragma unroll
    for (int i = 0; i < 8; ++i) wv[i] = *(const f32x4*)(W + (size_t)(k0 + 8 * i + (lane >> 3)) * N + n0 + 4 * (lane & 7));
#pragma unroll
    for (int i = 0; i < 8; ++i) { LAS float* d = scr + (8 * i + (lane >> 3)) * 33 + 4 * (lane & 7); d[0] = wv[i].x; d[1] = wv[i].y; d[2] = wv[i].z; d[3] = wv[i].w; }
    asm volatile("s_waitcnt lgkmcnt(0)" ::: "memory");
    const int c = lane & 7;
#pragma unroll
    for (int j = 0; j < 4; ++j) { const int n = (lane >> 3) + 8 * j; const LAS float* s = scr + (8 * c) * 33 + n;
        u32x4 o; o.x = pk2(s[0 * 33], s[1 * 33]); o.y = pk2(s[2 * 33], s[3 * 33]); o.z = pk2(s[4 * 33], s[5 * 33]); o.w = pk2(s[6 * 33], s[7 * 33]);
        *(u32x4*)(WT + (size_t)(drow0 + n) * K + k0 + 8 * c) = o; }
    asm volatile("s_waitcnt lgkmcnt(0)" ::: "memory");
}
__device__ __forceinline__ void rms_row_to_bf16(const float* xrow, const float* g, bf16_t* orow, int lane) {
    f32x4 v[4]; float s = 0.f;
#pragma unroll
    for (int j = 0; j < 4; ++j) { v[j] = *((const f32x4*)xrow + lane + 64 * j); s += (v[j].x * v[j].x + v[j].y * v[j].y) + (v[j].z * v[j].z + v[j].w * v[j].w); }
    const float rstd = rsqrtf(wave_sum(s) * (1.f / D) + EPS);
#pragma unroll
    for (int j = 0; j < 4; ++j) { const f32x4 gg = *((const f32x4*)g + lane + 64 * j);
        u32x2 w; w.x = pk2(v[j].x * rstd * gg.x, v[j].y * rstd * gg.y); w.y = pk2(v[j].z * rstd * gg.z, v[j].w * rstd * gg.w);
        *((u32x2*)orow + lane + 64 * j) = w; }
}
__device__ __forceinline__ void p0_prologue(const Args& a, LAS unsigned char* lds, int tid, int lane, int wave) {
    unsigned char* ws = a.ws;
    LAS float* scr = (LAS float*)(lds + wave * 16384);
    const int gw = blockIdx.x * NWAVES + wave, NGW = gridDim.x * NWAVES;
    bf16_t* WinT = (bf16_t*)(ws + WS_WIN); bf16_t* WupT = (bf16_t*)(ws + WS_WUP); bf16_t* WdnT = (bf16_t*)(ws + WS_WDN);
    bf16_t* WoT = (bf16_t*)(a.out + O_CS); bf16_t* WaT = WoT + 1024 * 1024; bf16_t* WrT = WaT + 1024 * 512;
    constexpr int I_IN = 16 * (DIN / 32), I_A = 8 * 32, I_R = 16 * 32, I_O = 16 * 32, I_UP = 16 * (F2 / 32), I_DN = 48 * 32;
    constexpr int NITEMS = I_IN + I_A + I_R + I_O + I_UP + I_DN;
    for (int it = gw; it < NITEMS; it += NGW) {
        int r = it;
        if (r < I_IN) { const int nb = r % (DIN / 32), kb = r / (DIN / 32); p0_transpose_item(a.w_in, D, DIN, WinT, 64 * kb, 32 * nb, 32 * nb, scr, lane); continue; } r -= I_IN;
        if (r < I_A) { const int nb = r % 32, kb = r / 32; p0_transpose_item(a.w_a, 512, D, WaT, 64 * kb, 32 * nb, 32 * nb, scr, lane); continue; } r -= I_A;
        if (r < I_R) { const int nb = r % 32, kb = r / 32; p0_transpose_item(a.w_r, D, D, WrT, 64 * kb, 32 * nb, 32 * nb, scr, lane); continue; } r -= I_R;
        if (r < I_O) { const int nb = r % 32, kb = r / 32; p0_transpose_item(a.w_o, D, D, WoT, 64 * kb, 32 * nb, 32 * nb, scr, lane); continue; } r -= I_O;
        if (r < I_UP) { const int nb = r % (F2 / 32), kb = r / (F2 / 32); const int n0 = 32 * nb;
            const int drow = n0 < DFF ? (n0 / 128) * 256 + (n0 % 128) : ((n0 - DFF) / 128) * 256 + 128 + ((n0 - DFF) % 128);
            p0_transpose_item(a.w_up, D, F2, WupT, 64 * kb, n0, drow, scr, lane); continue; } r -= I_UP;
        { const int nb = r % 32, kb = r / 32; p0_transpose_item(a.w_down, DFF, D, WdnT, 64 * kb, 32 * nb, 32 * nb, scr, lane); }
    }
    bf16_t* XN = (bf16_t*)(ws + WS_XN);
    for (int m = gw; m < M; m += NGW) { const float* xr = m < MP ? a.x_prompt + (size_t)m * D : a.x_sample + (size_t)(m - MP) * D; rms_row_to_bf16(xr, a.g_pre_mix, XN + (size_t)m * D, lane); }
    f32x2* tabA = (f32x2*)(ws + WS_TABA); f32x2* tabR = (f32x2*)(ws + WS_TABR);
    __syncthreads();
    LAS float* invs = (LAS float*)lds;
    if (tid < 72) invs[tid] = tid < 8 ? (float)(1.0 / pow(500000.0, (double)((float)tid / 8.0f))) : (float)(1.0 / pow(10000.0, (double)((float)(tid - 8) / 63.0f)));
    __syncthreads();
    const int gt = blockIdx.x * NTHREADS + tid, NGT = gridDim.x * NTHREADS;
    for (int e = gt; e < 4100 * 72; e += NGT) {
        const int tp = e / 72, i = e % 72; const int pos = tp < 4096 ? tp : 16384 + (tp - 4096);
        const float ang = (float)pos * invs[i];
        const double rev = (double)ang * 0.15915494309189535; const float fr = (float)(rev - rint(rev));
        const f32x2 cs = {__builtin_amdgcn_cosf(fr), __builtin_amdgcn_sinf(fr)};
        if (i < 8) tabA[tp * 8 + i] = cs; else tabR[tp * 64 + (i - 8)] = cs;
    }
}

__device__ __forceinline__ void attn_prompt_unit(bf16_t* H, const float* sinks, LAS unsigned char* lds, int b, int qb, int head, int tid, int lane, int wave) {
    const int g = head >> 2, fr = lane & 15, fq = lane >> 4;
    const size_t rowbase = (size_t)b * TSEQ + (size_t)qb * 128;
    LAS unsigned char* Kimg = lds; LAS unsigned char* Vimg = lds + 36864;
#pragma unroll
    for (int i = 0; i < 4; ++i) {
        const int id = tid + NTHREADS * i, kidx = id >> 3, ch = id & 7;
        u32x4 kv = {0u, 0u, 0u, 0u}, vv = {0u, 0u, 0u, 0u};
        if (qb > 0 || kidx >= 128) { const bf16_t* src = H + (rowbase - 128 + kidx) * DIN; kv = *(const u32x4*)(src + C_KA + g * 64 + ch * 8); vv = *(const u32x4*)(src + C_VA + g * 64 + ch * 8); }
        *(LAS u32x4*)(Kimg + kidx * 144 + ch * 16) = kv; *(LAS u32x4*)(Vimg + kidx * 144 + ch * 16) = vv;
    }
    const size_t qrow = rowbase + 16 * wave + fr;
    bf16x8 qf[2];
#pragma unroll
    for (int ks = 0; ks < 2; ++ks) qf[ks] = *(const bf16x8*)(H + qrow * DIN + C_QA + head * 64 + 32 * ks + 8 * fq);
    __syncthreads();
    f32x4 s[10];
#pragma unroll
    for (int nn = 0; nn < 9; ++nn) {
        s[nn] = (f32x4){0.f, 0.f, 0.f, 0.f};
        const int krow = 16 * (wave + nn) + fr;
#pragma unroll
        for (int ks = 0; ks < 2; ++ks) { const bf16x8 kf = *(const LAS bf16x8*)(Kimg + krow * 144 + (32 * ks + 8 * fq) * 2); s[nn] = __builtin_amdgcn_mfma_f32_16x16x32_bf16(kf, qf[ks], s[nn], 0, 0, 0); }
    }
    s[9] = (f32x4){0.f, 0.f, 0.f, 0.f};
    const int qi = 16 * wave + fr; const float sink = sinks[head];
    float mx = sink;
#pragma unroll
    for (int nn = 0; nn < 9; ++nn)
#pragma unroll
        for (int r = 0; r < 4; ++r) { const int kidx = 16 * (wave + nn) + 4 * fq + r; const bool valid = (kidx > qi) && (kidx <= qi + 128) && (qb > 0 || kidx >= 128);
            s[nn][r] = valid ? s[nn][r] : -1e30f; mx = fmaxf(mx, s[nn][r]); }
    mx = fmaxf(mx, __shfl_xor(mx, 16)); mx = fmaxf(mx, __shfl_xor(mx, 32));
    float sum = 0.f;
#pragma unroll
    for (int nn = 0; nn < 9; ++nn)
#pragma unroll
        for (int r = 0; r < 4; ++r) { const float p = s[nn][r] > -1e29f ? __expf(s[nn][r] - mx) : 0.f; s[nn][r] = p; sum += p; }
    sum += __shfl_xor(sum, 16); sum += __shfl_xor(sum, 32);
    sum += __expf(sink - mx);
    f32x4 o[4];
#pragma unroll
    for (int db = 0; db < 4; ++db) o[db] = (f32x4){0.f, 0.f, 0.f, 0.f};
    const int tq = (lane & 15) >> 2, tpp = lane & 3;
#pragma unroll
    for (int G = 0; G < 5; ++G) {
        const u32x4 pw = {pk2(s[2 * G][0], s[2 * G][1]), pk2(s[2 * G][2], s[2 * G][3]), pk2(s[2 * G + 1][0], s[2 * G + 1][1]), pk2(s[2 * G + 1][2], s[2 * G + 1][3])};
        const bf16x8 pf = __builtin_bit_cast(bf16x8, pw);
        int k0 = 16 * (wave + 2 * G) + 4 * fq + tq, k1 = k0 + 16; k0 = k0 > 255 ? 255 : k0; k1 = k1 > 255 ? 255 : k1;
#pragma unroll
        for (int db = 0; db < 4; ++db) {
            const bf16x8 vf = tr_pair(Vimg + k0 * 144 + (16 * db + 4 * tpp) * 2, Vimg + k1 * 144 + (16 * db + 4 * tpp) * 2);
            o[db] = __builtin_amdgcn_mfma_f32_16x16x32_bf16(vf, pf, o[db], 0, 0, 0);
        }
    }
    const float inv = 1.0f / sum;
#pragma unroll
    for (int db = 0; db < 4; ++db) { u32x2 w; w.x = pk2(o[db][0] * inv, o[db][1] * inv); w.y = pk2(o[db][2] * inv, o[db][3] * inv);
        *(u32x2*)(H + qrow * DIN + C_QA + head * 64 + 16 * db + 4 * fq) = w; }
    __syncthreads();
}

__device__ __forceinline__ void attn_sample_unit(const Args& a, bf16_t* H, LAS unsigned char* lds, int b, int tid, int lane, int wave) {
    const int head = wave, g = head >> 2; const size_t r0 = (size_t)MP + 4 * b;
    LAS float* qs = (LAS float*)(lds + wave * 4096); LAS float* ps = qs + 256;
#pragma unroll
    for (int t = 0; t < 4; ++t) qs[t * 64 + lane] = bf2f(H[(r0 + t) * DIN + C_QA + head * 64 + lane]);
    asm volatile("s_waitcnt lgkmcnt(0)" ::: "memory");
    float sc[3][4];
    {
        const float* kp0 = a.cache_k + ((size_t)(b * 128 + lane) * 2 + g) * 64; const float* kp1 = kp0 + (size_t)64 * 128;
        const bf16_t* kpn = H + (r0 + (lane & 3)) * DIN + C_KA + g * 64;
#pragma unroll
        for (int t = 0; t < 4; ++t) { sc[0][t] = 0.f; sc[1][t] = 0.f; sc[2][t] = 0.f; }
#pragma nounroll
        for (int hf = 0; hf < 2; ++hf) {
            f32x4 kv0[8], kv1[8]; u32x4 kw[4];
#pragma unroll
            for (int d4 = 0; d4 < 8; ++d4) { kv0[d4] = *(const f32x4*)(kp0 + 32 * hf + 4 * d4); kv1[d4] = *(const f32x4*)(kp1 + 32 * hf + 4 * d4); }
#pragma unroll
            for (int c8 = 0; c8 < 4; ++c8) kw[c8] = *(const u32x4*)(kpn + 32 * hf + 8 * c8);
#pragma unroll
            for (int d4 = 0; d4 < 8; ++d4)
#pragma unroll
                for (int e = 0; e < 4; ++e) { const int d = 4 * d4 + e; const unsigned w = kw[d >> 3][(d & 7) >> 1]; const float kn = (d & 1) ? bfhi(w) : bflo(w);
#pragma unroll
                    for (int t = 0; t < 4; ++t) { const float q = qs[t * 64 + 32 * hf + d]; sc[0][t] += q * kv0[d4][e]; sc[1][t] += q * kv1[d4][e]; sc[2][t] += q * kn; } }
        }
    }
    const float sink = a.sinks[head];
    float inv[4];
#pragma unroll
    for (int t = 0; t < 4; ++t) {
        const bool v0 = lane > t, v1 = true, v2 = (lane < 4) && (lane <= t);
        const float s0 = v0 ? sc[0][t] : -1e30f, s1 = v1 ? sc[1][t] : -1e30f, s2 = v2 ? sc[2][t] : -1e30f;
        const float mx = fmaxf(wave_max(fmaxf(fmaxf(s0, s1), s2)), sink);
        const float p0 = v0 ? __expf(s0 - mx) : 0.f, p1 = __expf(s1 - mx), p2 = v2 ? __expf(s2 - mx) : 0.f;
        const float sum = wave_sum(p0 + p1 + p2) + __expf(sink - mx);
        inv[t] = 1.0f / sum;
        ps[t * 136 + lane] = p0; ps[t * 136 + 64 + lane] = p1; if (lane < 4) ps[t * 136 + 128 + lane] = p2;
    }
    asm volatile("s_waitcnt lgkmcnt(0)" ::: "memory");
    float o0 = 0.f, o1 = 0.f, o2 = 0.f, o3 = 0.f;
    const float* vp = a.cache_v + ((size_t)(b * 128) * 2 + g) * 64 + lane;
#pragma nounroll
    for (int rb = 0; rb < 2; ++rb) {
        float vx[64];
#pragma unroll
        for (int r = 0; r < 64; ++r) vx[r] = vp[(size_t)(64 * rb + r) * 128];
#pragma unroll
        for (int r = 0; r < 64; ++r) { const int rr = 64 * rb + r; o0 += ps[0 * 136 + rr] * vx[r]; o1 += ps[1 * 136 + rr] * vx[r]; o2 += ps[2 * 136 + rr] * vx[r]; o3 += ps[3 * 136 + rr] * vx[r]; }
    }
#pragma unroll
    for (int tn = 0; tn < 4; ++tn) { const float vx = bf2f(H[(r0 + tn) * DIN + C_VA + g * 64 + lane]); o0 += ps[0 * 136 + 128 + tn] * vx; o1 += ps[1 * 136 + 128 + tn] * vx; o2 += ps[2 * 136 + 128 + tn] * vx; o3 += ps[3 * 136 + 128 + tn] * vx; }
    H[(r0 + 0) * DIN + C_QA + head * 64 + lane] = (bf16_t)(pk2(o0 * inv[0], 0.f) & 0xffffu);
    H[(r0 + 1) * DIN + C_QA + head * 64 + lane] = (bf16_t)(pk2(o1 * inv[1], 0.f) & 0xffffu);
    H[(r0 + 2) * DIN + C_QA + head * 64 + lane] = (bf16_t)(pk2(o2 * inv[2], 0.f) & 0xffffu);
    H[(r0 + 3) * DIN + C_QA + head * 64 + lane] = (bf16_t)(pk2(o3 * inv[3], 0.f) & 0xffffu);
    float* ko = a.out + O_KS + (size_t)b * 128 * 128; float* vo = a.out + O_VS + (size_t)b * 128 * 128;
    const float* ki = a.cache_k + (size_t)b * 128 * 128 + 4 * 128; const float* vi = a.cache_v + (size_t)b * 128 * 128 + 4 * 128;
    for (int i = tid; i < 124 * 32; i += NTHREADS) { ((f32x4*)ko)[i] = ((const f32x4*)ki)[i]; ((f32x4*)vo)[i] = ((const f32x4*)vi)[i]; }
    { const int t = tid >> 7, gd = tid & 127;
      ko[(size_t)(124 + t) * 128 + gd] = bf2f(H[(r0 + t) * DIN + C_KA + gd]); vo[(size_t)(124 + t) * 128 + gd] = bf2f(H[(r0 + t) * DIN + C_VA + gd]); }
}

__device__ __forceinline__ void ret_u_unit(const bf16_t* H, bf16_t* ST, LAS unsigned char* lds, int b, int c, int h, int tid, int lane, int wave) {
    const size_t rowc = (size_t)b * TSEQ + (size_t)c * 128; const float l2g = ret_log2g(h);
    LAS unsigned char* Kimg = lds; LAS unsigned char* Vimg = lds + 36864;
#pragma unroll
    for (int i = 0; i < 4; ++i) { const int id = tid + NTHREADS * i, j = id >> 4, ch = id & 15;
        const u32x4 kv = *(const u32x4*)(H + (rowc + j) * DIN + C_KR + h * 128 + ch * 8); const float kd = exp2f(l2g * (float)(127 - j));
        u32x4 w; w.x = pk2(bflo(kv.x) * kd, bfhi(kv.x) * kd); w.y = pk2(bflo(kv.y) * kd, bfhi(kv.y) * kd); w.z = pk2(bflo(kv.z) * kd, bfhi(kv.z) * kd); w.w = pk2(bflo(kv.w) * kd, bfhi(kv.w) * kd);
        *(LAS u32x4*)(Kimg + j * 288 + ch * 16) = w; }
#pragma unroll
    for (int i = 0; i < 8; ++i) { const int id = tid + NTHREADS * i, j = id >> 5, ch = id & 31;
        *(LAS u32x4*)(Vimg + j * 544 + ch * 16) = *(const u32x4*)(H + (rowc + j) * DIN + C_VR + h * 256 + ch * 8); }
    __syncthreads();
    const int fr = lane & 15, fq = lane >> 4, tq = fr >> 2, tpp = lane & 3;
    f32x4 acc[2][8];
#pragma unroll
    for (int i = 0; i < 2; ++i)
#pragma unroll
        for (int j = 0; j < 8; ++j) acc[i][j] = (f32x4){0.f, 0.f, 0.f, 0.f};
#pragma unroll
    for (int ks = 0; ks < 4; ++ks) {
        const int j0 = 32 * ks + 4 * fq + tq, j1 = j0 + 16;
        bf16x8 vf[2];
#pragma unroll
        for (int i = 0; i < 2; ++i) { const int col = 16 * (2 * wave + i) + 4 * tpp; vf[i] = tr_pair(Vimg + j0 * 544 + col * 2, Vimg + j1 * 544 + col * 2); }
#pragma unroll
        for (int kb = 0; kb < 8; ++kb) { const int col = 16 * kb + 4 * tpp; const bf16x8 kf = tr_pair(Kimg + j0 * 288 + col * 2, Kimg + j1 * 288 + col * 2);
#pragma unroll
            for (int i = 0; i < 2; ++i) acc[i][kb] = __builtin_amdgcn_mfma_f32_16x16x32_bf16(vf[i], kf, acc[i][kb], 0, 0, 0); }
    }
    bf16_t* U = ST + ((size_t)(b * 32 + c) * 4 + h) * 32768;
#pragma unroll
    for (int i = 0; i < 2; ++i)
#pragma unroll
        for (int kb = 0; kb < 8; ++kb) { u32x2 w; w.x = pk2(acc[i][kb][0], acc[i][kb][1]); w.y = pk2(acc[i][kb][2], acc[i][kb][3]); *(u32x2*)(U + (size_t)(16 * kb + fr) * 256 + 16 * (2 * wave + i) + 4 * fq) = w; }
    __syncthreads();
}

__device__ __forceinline__ void ret_sample_unit(const Args& a, bf16_t* H, LAS unsigned char* lds, int b, int h, int tid, int lane, int wave) {
    const size_t r0 = (size_t)MP + 4 * b; const float g = 1.0f - exp2f(-5.0f - (float)h);
    LAS float* qs = (LAS float*)lds; LAS float* ks = qs + 512; LAS float* po = ks + 512; LAS float* red = po + 2048;
    const int dv = tid & 255, half = tid >> 8;
    for (int i = tid; i < 1024; i += NTHREADS) { const int which = i >> 9, t = (i >> 7) & 3, d = i & 127;
        const float v = bf2f(H[(r0 + t) * DIN + (which ? C_KR : C_QR) + h * 128 + d]); if (which) ks[t * 128 + d] = v; else qs[t * 128 + d] = v; }
    float vt[4], gt[4];
#pragma unroll
    for (int t = 0; t < 4; ++t) { vt[t] = bf2f(H[(r0 + t) * DIN + C_VR + h * 256 + dv]); gt[t] = bf2f(H[(r0 + t) * DIN + C_GATE + h * 256 + dv]); }
    float S[64];
    const float* sp = a.state_ret + ((size_t)(b * 4 + h) * 128 + 64 * half) * 256 + dv;
#pragma unroll
    for (int d = 0; d < 64; ++d) S[d] = sp[(size_t)d * 256];
    __syncthreads();
#pragma unroll
    for (int t = 0; t < 4; ++t) { float o = 0.f;
#pragma unroll
        for (int d = 0; d < 64; ++d) { S[d] = g * S[d] + ks[t * 128 + 64 * half + d] * vt[t]; o += qs[t * 128 + 64 * half + d] * S[d]; }
        po[(half * 4 + t) * 256 + dv] = o; }
    float* so = a.out + O_RS + ((size_t)(b * 4 + h) * 128 + 64 * half) * 256 + dv;
#pragma unroll
    for (int d = 0; d < 64; ++d) so[(size_t)d * 256] = S[d];
    __syncthreads();
    float ot[4];
#pragma unroll
    for (int t = 0; t < 4; ++t) { ot[t] = po[t * 256 + dv] + po[(4 + t) * 256 + dv]; const float sq = wave_sum(half == 0 ? ot[t] * ot[t] : 0.f); if (lane == 0) red[wave * 4 + t] = sq; }
    __syncthreads();
    if (half == 0) {
#pragma unroll
        for (int t = 0; t < 4; ++t) { float ss = 0.f;
#pragma unroll
            for (int w = 0; w < 8; ++w) ss += red[w * 4 + t];
            const float rstd = rsqrtf(ss * (1.f / 256.f) + EPS); const float gv = gt[t]; const float sil = gv / (1.0f + __expf(-gv));
            H[(r0 + t) * DIN + C_VR + h * 256 + dv] = (bf16_t)(pk2(ot[t] * rstd * sil, 0.f) & 0xffffu); }
    }
    __syncthreads();
}

__device__ __forceinline__ void ret_out_unit(bf16_t* H, const bf16_t* ST, LAS unsigned char* lds, int b, int c, int h, int tid, int lane, int wave) {
    const size_t rowc = (size_t)b * TSEQ + (size_t)c * 128; const float l2g = ret_log2g(h);
    LAS unsigned char* Kimg = lds; LAS unsigned char* BIG = lds + 36864;
    const int fr = lane & 15, fq = lane >> 4, tq = fr >> 2, tpp = lane & 3;
    const int qi = 16 * wave + fr; const size_t qrow = rowc + qi;
    u32x4 kreg[4], sreg[8], vreg[8]; u32x2 greg[16];
#pragma unroll
    for (int i = 0; i < 4; ++i) { const int id = tid + NTHREADS * i, j = id >> 4, ch = id & 15; kreg[i] = *(const u32x4*)(H + (rowc + j) * DIN + C_KR + h * 128 + ch * 8); }
    if (c > 0) {
        const bf16_t* S = ST + ((size_t)(b * 32 + c) * 4 + h) * 32768;
#pragma unroll
        for (int i = 0; i < 8; ++i) { const int id = tid + NTHREADS * i, dk = id >> 5, ch = id & 31; sreg[i] = *(const u32x4*)(S + (size_t)dk * 256 + ch * 8); }
    }
    bf16x8 qf[4];
#pragma unroll
    for (int ks = 0; ks < 4; ++ks) { const bf16_t* qp = H + qrow * DIN + C_QR + h * 128 + 32 * ks + 4 * fq; qf[ks] = cat8(*(const u32x2*)qp, *(const u32x2*)(qp + 16)); }
#pragma unroll
    for (int i = 0; i < 8; ++i) { const int id = tid + NTHREADS * i, j = id >> 5, ch = id & 31; vreg[i] = *(const u32x4*)(H + (rowc + j) * DIN + C_VR + h * 256 + ch * 8); }
#pragma unroll
    for (int i = 0; i < 4; ++i) { const int id = tid + NTHREADS * i, j = id >> 4, ch = id & 15; *(LAS u32x4*)(Kimg + j * 288 + ch * 16) = kreg[i]; }
    if (c > 0) {
#pragma unroll
        for (int i = 0; i < 8; ++i) { const int id = tid + NTHREADS * i, dk = id >> 5, ch = id & 31; *(LAS u32x4*)(BIG + dk * 544 + ch * 16) = sreg[i]; }
    }
    __syncthreads();
    f32x4 acc[16];
#pragma unroll
    for (int k = 0; k < 16; ++k) acc[k] = (f32x4){0.f, 0.f, 0.f, 0.f};
    if (c > 0) {
#pragma unroll
        for (int ks = 0; ks < 4; ++ks) { const int d0 = 32 * ks + 4 * fq + tq, d1 = d0 + 16;
#pragma unroll
            for (int blk = 0; blk < 16; ++blk) { const bf16x8 sf = tr_pair(BIG + d0 * 544 + (16 * blk + 4 * tpp) * 2, BIG + d1 * 544 + (16 * blk + 4 * tpp) * 2);
                acc[blk] = __builtin_amdgcn_mfma_f32_16x16x32_bf16(sf, qf[ks], acc[blk], 0, 0, 0); } }
        const float qd = exp2f(l2g * (float)(qi + 1));
#pragma unroll
        for (int blk = 0; blk < 16; ++blk) acc[blk] = acc[blk] * qd;
    }
    bf16x8 pf[4];
#pragma unroll
    for (int G = 0; G < 4; ++G) {
        f32x4 sc[2];
#pragma unroll
        for (int e = 0; e < 2; ++e) { const int jb = 2 * G + e; sc[e] = (f32x4){0.f, 0.f, 0.f, 0.f};
            if (jb <= wave) {
#pragma unroll
                for (int ks = 0; ks < 4; ++ks) { const LAS unsigned char* kp = Kimg + (16 * jb + fr) * 288 + (32 * ks + 4 * fq) * 2;
                    const bf16x8 kf = cat8(*(const LAS u32x2*)kp, *(const LAS u32x2*)(kp + 32)); sc[e] = __builtin_amdgcn_mfma_f32_16x16x32_bf16(kf, qf[ks], sc[e], 0, 0, 0); }
#pragma unroll
                for (int r = 0; r < 4; ++r) { const int j = 16 * jb + 4 * fq + r; sc[e][r] = (j <= qi) ? sc[e][r] * exp2f(l2g * (float)(qi - j)) : 0.f; }
            } }
        const u32x4 pw = {pk2(sc[0][0], sc[0][1]), pk2(sc[0][2], sc[0][3]), pk2(sc[1][0], sc[1][1]), pk2(sc[1][2], sc[1][3])};
        pf[G] = __builtin_bit_cast(bf16x8, pw);
    }
    __syncthreads();
#pragma unroll
    for (int i = 0; i < 8; ++i) { const int id = tid + NTHREADS * i, j = id >> 5, ch = id & 31; *(LAS u32x4*)(BIG + j * 544 + ch * 16) = vreg[i]; }
#pragma unroll
    for (int blk = 0; blk < 16; ++blk) greg[blk] = *(const u32x2*)(H + qrow * DIN + C_GATE + h * 256 + 16 * blk + 4 * fq);
    __syncthreads();
#pragma unroll
    for (int G = 0; G < 4; ++G) {
        if (2 * G <= wave) { const int j0 = 32 * G + 4 * fq + tq, j1 = j0 + 16;
#pragma unroll
            for (int blk = 0; blk < 16; ++blk) { const bf16x8 vf = tr_pair(BIG + j0 * 544 + (16 * blk + 4 * tpp) * 2, BIG + j1 * 544 + (16 * blk + 4 * tpp) * 2);
                acc[blk] = __builtin_amdgcn_mfma_f32_16x16x32_bf16(vf, pf[G], acc[blk], 0, 0, 0); } }
    }
    float ss = 0.f;
#pragma unroll
    for (int blk = 0; blk < 16; ++blk) ss += (acc[blk][0] * acc[blk][0] + acc[blk][1] * acc[blk][1]) + (acc[blk][2] * acc[blk][2] + acc[blk][3] * acc[blk][3]);
    ss += __shfl_xor(ss, 16); ss += __shfl_xor(ss, 32);
    const float rstd = rsqrtf(ss * (1.f / 256.f) + EPS);
#pragma unroll
    for (int blk = 0; blk < 16; ++blk) {
        const u32x2 gw = greg[blk];
        const float g0 = bflo(gw.x), g1 = bfhi(gw.x), g2 = bflo(gw.y), g3 = bfhi(gw.y);
        u32x2 w; w.x = pk2(acc[blk][0] * rstd * g0 / (1.f + __expf(-g0)), acc[blk][1] * rstd * g1 / (1.f + __expf(-g1)));
        w.y = pk2(acc[blk][2] * rstd * g2 / (1.f + __expf(-g2)), acc[blk][3] * rstd * g3 / (1.f + __expf(-g3)));
        *(u32x2*)(H + qrow * DIN + C_VR + h * 256 + 16 * blk + 4 * fq) = w;
    }
    __syncthreads();
}

__device__ __forceinline__ f32x4 tail_gemm(const bf16_t* A, int lda, const bf16_t* Bt, int K, LAS unsigned char* lds, int tid, int lane, int wave, f32x4 acc) {
    const int fr = lane & 15, fq = lane >> 4, nc = K / 512;
    LAS unsigned char* Ai = lds; LAS unsigned char* Bi = lds + 33280;
    u32x4 ra[4], rb[8];
#pragma unroll
    for (int i = 0; i < 4; ++i) { const int id = tid + NTHREADS * i; ra[i] = *(const u32x4*)(A + (size_t)(id >> 6) * lda + (id & 63) * 8); }
#pragma unroll
    for (int i = 0; i < 8; ++i) { const int id = tid + NTHREADS * i; rb[i] = *(const u32x4*)(Bt + (size_t)(id >> 6) * K + (id & 63) * 8); }
#pragma nounroll
    for (int c = 0; c < nc; ++c) {
#pragma unroll
        for (int i = 0; i < 4; ++i) { const int id = tid + NTHREADS * i; *(LAS u32x4*)(Ai + (id >> 6) * 1040 + (id & 63) * 16) = ra[i]; }
#pragma unroll
        for (int i = 0; i < 8; ++i) { const int id = tid + NTHREADS * i; *(LAS u32x4*)(Bi + (id >> 6) * 1040 + (id & 63) * 16) = rb[i]; }
        __syncthreads();
        if (c + 1 < nc) {
#pragma unroll
            for (int i = 0; i < 4; ++i) { const int id = tid + NTHREADS * i; ra[i] = *(const u32x4*)(A + (size_t)(id >> 6) * lda + (c + 1) * 512 + (id & 63) * 8); }
#pragma unroll
            for (int i = 0; i < 8; ++i) { const int id = tid + NTHREADS * i; rb[i] = *(const u32x4*)(Bt + (size_t)(id >> 6) * K + (c + 1) * 512 + (id & 63) * 8); }
        }
        const LAS unsigned char* ap = Ai + (16 * (wave >> 2) + fr) * 1040 + fq * 16; const LAS unsigned char* bp = Bi + (16 * (wave & 3) + fr) * 1040 + fq * 16;
#pragma unroll
        for (int ks = 0; ks < 16; ++ks) { const bf16x8 av = *(const LAS bf16x8*)(ap + ks * 64), bv = *(const LAS bf16x8*)(bp + ks * 64); acc = __builtin_amdgcn_mfma_f32_16x16x32_bf16(bv, av, acc, 0, 0, 0); }
        __syncthreads();
    }
    return acc;
}

__global__ void __launch_bounds__(NTHREADS, 2) fwd_megakernel(Args a) {
    extern __shared__ __attribute__((aligned(16))) unsigned char lds_raw[];
    LAS unsigned char* lds = (LAS unsigned char*)lds_raw;
    cg::grid_group grid = cg::this_grid();
    const int tid = threadIdx.x, lane = tid & 63, wave = __builtin_amdgcn_readfirstlane(tid >> 6);
    const int nblk = gridDim.x, blk = blockIdx.x;
    unsigned char* ws = a.ws;
    bf16_t* WinT = (bf16_t*)(ws + WS_WIN); bf16_t* WupT = (bf16_t*)(ws + WS_WUP); bf16_t* WdnT = (bf16_t*)(ws + WS_WDN);
    bf16_t* WoT = (bf16_t*)(a.out + O_CS); bf16_t* WaT = WoT + 1024 * 1024; bf16_t* WrT = WaT + 1024 * 512;
    bf16_t* XN = (bf16_t*)(ws + WS_XN); bf16_t* H = (bf16_t*)(ws + WS_R1);
    bf16_t* MIXb = (bf16_t*)(ws + WS_R1);
    bf16_t* G = (bf16_t*)(ws + WS_R1 + R1_G); bf16_t* Fb = (bf16_t*)(ws + WS_R1 + R1_F); bf16_t* X1b = (bf16_t*)(ws + WS_R1 + R1_X1); bf16_t* UH = (bf16_t*)(ws + WS_R1 + R1_UH); bf16_t* US = (bf16_t*)(ws + WS_R1 + R1_US);
    bf16_t* ST = (bf16_t*)(a.out + O_Y);
    float* Y = a.out + O_Y;
    const int lo = a.ph_lo, hi = a.ph_hi;
#ifndef PROBE_REP_MASK
#define PROBE_REP_MASK 0
#endif
#define IN(k) (lo <= (k) && (k) < hi)
#define REPS(k) (((PROBE_REP_MASK >> (k)) & 1) ? 2 : 1)
#define SEAM(k) do { if (IN(k) && IN((k) + 1)) { asm volatile("s_waitcnt vmcnt(0)" ::: "memory"); __syncthreads(); grid.sync(); } } while (0)

    if (IN(0)) { p0_prologue(a, lds, tid, lane, wave); }
    SEAM(0);
    if (IN(1)) {
        pg8::Gemm g{XN, WinT, M, DIN, D, D}; pg8::StaticOrder S; S.init(M, DIN, nblk, blk);
        pg8::EpiH E{H, (const pg8::f32x2e*)(ws + WS_TABA), (const pg8::f32x2e*)(ws + WS_TABR)};
        pg8::gemm_phase<pg8::EpiH, pg8::StaticOrder, true, true>(lds, g, S, E);
    }
    SEAM(1);
    if (IN(2)) {
        for (int u = blk; u < 1024; u += nblk) { const int head = u & 7, qb = (u >> 3) & 31, b = u >> 8; attn_prompt_unit(H, a.sinks, lds, b, qb, head, tid, lane, wave); }
        for (int u = blk; u < 512; u += nblk) { const int h = u & 3, c = (u >> 2) & 31, b = u >> 7; ret_u_unit(H, ST, lds, b, c, h, tid, lane, wave); }
        for (int u = blk; u < 128; u += nblk) { attn_sample_unit(a, H, lds, u, tid, lane, wave); __syncthreads(); }
        for (int u = blk; u < 512; u += nblk) { ret_sample_unit(a, H, lds, u >> 2, u & 3, tid, lane, wave); }
        for (int e = blk * NTHREADS + tid; e < 4 * 128 * 128; e += nblk * NTHREADS) { const int gd = e & 127, r = (e >> 7) & 127, b = e >> 14; const size_t row = (size_t)b * TSEQ + TSEQ - 128 + r;
            a.out[O_KP + e] = bf2f(H[row * DIN + C_KA + gd]); a.out[O_VP + e] = bf2f(H[row * DIN + C_VA + gd]); }
    }
    SEAM(2);
    if (IN(3)) {
        for (int e4 = blk * NTHREADS + tid; e4 < 16 * 8192; e4 += nblk * NTHREADS) {
            const int bh = e4 >> 13, idx = (e4 & 8191) * 4, b = bh >> 2, h = bh & 3;
            const float gL = exp2f(128.f * ret_log2g(h));
            f32x4 S = {0.f, 0.f, 0.f, 0.f};
#pragma unroll 8
            for (int c = 0; c < 32; ++c) { bf16_t* p = ST + ((size_t)(b * 32 + c) * 4 + h) * 32768 + idx; const u32x2 uw = *(const u32x2*)p; u32x2 sw; sw.x = pk2(S.x, S.y); sw.y = pk2(S.z, S.w); *(u32x2*)p = sw;
                const f32x4 uu = {bflo(uw.x), bfhi(uw.x), bflo(uw.y), bfhi(uw.y)}; S = S * gL + uu; }
            *(f32x4*)(a.out + O_RP + (size_t)bh * 32768 + idx) = S;
        }
    }
    SEAM(3);
    if (IN(4)) {
        for (int u = blk; u < 512; u += nblk) { const int h = u & 3, c = (u >> 2) & 31, b = u >> 7; ret_out_unit(H, ST, lds, b, c, h, tid, lane, wave); }
    }
    SEAM(4);
    if (IN(5)) {
        { pg8::Gemm g{H + C_QA, WaT, MP, D, 512, DIN}; pg8::StaticOrder S; S.init(MP, D, nblk, blk);
          pg8::EpiGate<false> E{XN, H + C_GMA, DIN}; pg8::gemm_phase<pg8::EpiGate<false>, pg8::StaticOrder, true, true>(lds, g, S, E); }
        __syncthreads();
        { pg8::Gemm g{H + C_VR, WrT, MP, D, D, DIN}; pg8::StaticOrder S; S.init(MP, D, nblk, blk);
          pg8::EpiGate<true> E{XN, H + C_GMR, DIN}; pg8::gemm_phase<pg8::EpiGate<true>, pg8::StaticOrder, true, true>(lds, g, S, E); }
        for (int piece = blk; piece < 256; piece += nblk) {
            const int fr = lane & 15, fq = lane >> 4; const size_t prow = (size_t)MP + 32 * (piece >> 4); const size_t row = prow + 16 * (wave >> 2) + fr; const int pcol = 64 * (piece & 15), col0 = pcol + 16 * (wave & 3);
            const f32x4 aa = tail_gemm(H + prow * DIN + C_QA, DIN, WaT + (size_t)pcol * 512, 512, lds, tid, lane, wave, (f32x4){0.f, 0.f, 0.f, 0.f});
            const f32x4 ar = tail_gemm(H + prow * DIN + C_VR, DIN, WrT + (size_t)pcol * 1024, 1024, lds, tid, lane, wave, (f32x4){0.f, 0.f, 0.f, 0.f});
            const int cb = col0 + 4 * fq;
            const u32x2 ga = *(const u32x2*)(H + row * DIN + C_GMA + cb), gr = *(const u32x2*)(H + row * DIN + C_GMR + cb);
            u32x2 w; w.x = pk2(pg8::sigmoidf_(bflo(ga.x)) * aa[0] + pg8::sigmoidf_(bflo(gr.x)) * ar[0], pg8::sigmoidf_(bfhi(ga.x)) * aa[1] + pg8::sigmoidf_(bfhi(gr.x)) * ar[1]);
            w.y = pk2(pg8::sigmoidf_(bflo(ga.y)) * aa[2] + pg8::sigmoidf_(bflo(gr.y)) * ar[2], pg8::sigmoidf_(bfhi(ga.y)) * aa[3] + pg8::sigmoidf_(bfhi(gr.y)) * ar[3]);
            *(u32x2*)(XN + row * D + cb) = w;
        }
    }
    SEAM(5);
    if (IN(6)) {
        pg8::Gemm g{XN, WoT, MP, D, D, D}; pg8::StaticOrder S; S.init(MP, D, nblk, blk);
        pg8::EpiBf16<0> E{MIXb, D, nullptr, 0, 0, 1.f}; pg8::gemm_phase<pg8::EpiBf16<0>, pg8::StaticOrder, true, true>(lds, g, S, E);
        for (int piece = blk; piece < 256; piece += nblk) {
            const int fr = lane & 15, fq = lane >> 4; const size_t prow = (size_t)MP + 32 * (piece >> 4); const size_t row = prow + 16 * (wave >> 2) + fr; const int pcol = 64 * (piece & 15), col0 = pcol + 16 * (wave & 3);
            const f32x4 ac = tail_gemm(XN + prow * D, D, WoT + (size_t)pcol * 1024, 1024, lds, tid, lane, wave, (f32x4){0.f, 0.f, 0.f, 0.f});
            u32x2 w; w.x = pk2(ac[0], ac[1]); w.y = pk2(ac[2], ac[3]); *(u32x2*)(MIXb + row * D + col0 + 4 * fq) = w;
        }
    }
    SEAM(6);
    if (IN(7)) {
        f32x4 gpm[2][2], gpf[2][2];
#pragma unroll
        for (int j = 0; j < 2; ++j)
#pragma unroll
            for (int e = 0; e < 2; ++e) { gpm[j][e] = *((const f32x4*)a.g_post_mix + 2 * (lane + 64 * j) + e); gpf[j][e] = *((const f32x4*)a.g_pre_ffn + 2 * (lane + 64 * j) + e); }
        for (int p = blk * NWAVES + wave; p < M / 2; p += nblk * NWAVES) {
            u32x4 mb[2][2]; f32x4 xx[2][2][2];
#pragma unroll
            for (int rr = 0; rr < 2; ++rr) { const int m = 2 * p + rr; const float* xr = m < MP ? a.x_prompt + (size_t)m * D : a.x_sample + (size_t)(m - MP) * D;
#pragma unroll
                for (int j = 0; j < 2; ++j) { mb[rr][j] = *((const u32x4*)(MIXb + (size_t)m * D) + lane + 64 * j); xx[rr][j][0] = *((const f32x4*)xr + 2 * (lane + 64 * j)); xx[rr][j][1] = *((const f32x4*)xr + 2 * (lane + 64 * j) + 1); } }
            float mv[2][2][8]; float ss[2];
#pragma unroll
            for (int rr = 0; rr < 2; ++rr) { ss[rr] = 0.f;
#pragma unroll
                for (int j = 0; j < 2; ++j)
#pragma unroll
                    for (int q = 0; q < 4; ++q) { const unsigned w = mb[rr][j][q]; mv[rr][j][2 * q] = bflo(w); mv[rr][j][2 * q + 1] = bfhi(w); ss[rr] += mv[rr][j][2 * q] * mv[rr][j][2 * q] + mv[rr][j][2 * q + 1] * mv[rr][j][2 * q + 1]; } }
            ss[0] = wave_sum(ss[0]); ss[1] = wave_sum(ss[1]);
            float s2[2];
#pragma unroll
            for (int rr = 0; rr < 2; ++rr) { const float rstd = rsqrtf(ss[rr] * (1.f / D) + EPS); s2[rr] = 0.f;
#pragma unroll
                for (int j = 0; j < 2; ++j)
#pragma unroll
                    for (int q = 0; q < 8; ++q) { const float x1 = xx[rr][j][q >> 2][q & 3] + mv[rr][j][q] * rstd * gpm[j][q >> 2][q & 3]; mv[rr][j][q] = x1; s2[rr] += x1 * x1; } }
            s2[0] = wave_sum(s2[0]); s2[1] = wave_sum(s2[1]);
#pragma unroll
            for (int rr = 0; rr < 2; ++rr) { const int m = 2 * p + rr; const float rstd2 = rsqrtf(s2[rr] * (1.f / D) + EPS);
#pragma unroll
                for (int j = 0; j < 2; ++j) { u32x4 w1, w2;
#pragma unroll
                    for (int q = 0; q < 4; ++q) { const float a0 = mv[rr][j][2 * q], a1 = mv[rr][j][2 * q + 1]; w1[q] = pk2(a0, a1);
                        w2[q] = pk2(a0 * rstd2 * gpf[j][(2 * q) >> 2][(2 * q) & 3], a1 * rstd2 * gpf[j][(2 * q + 1) >> 2][(2 * q + 1) & 3]); }
                    *((u32x4*)(X1b + (size_t)m * D) + lane + 64 * j) = w1; *((u32x4*)(XN + (size_t)m * D) + lane + 64 * j) = w2; } }
        }
    }
    SEAM(7);
    if (IN(8)) {
        pg8::Gemm g{XN, WupT, M, F2, D, D}; pg8::StaticOrder S; S.init(M, F2, nblk, blk);
        pg8::EpiUp E{G, UH, US, a.out + O_CP, a.out + O_CS, a.conv_w, a.conv_b};
        pg8::gemm_phase<pg8::EpiUp, pg8::StaticOrder, true, true>(lds, g, S, E);
    }
    SEAM(8);
    if (IN(9)) {
        for (int task = blk * NWAVES + wave; task < 1024 * 6; task += nblk * NWAVES) {
            const int rt = task / 6, chunk = task % 6; const int ch = chunk * 512 + lane * 8;
            float ua[3][8], ub[3][8];
            int row;
#define LD8BF(dst, ptr) do { const u32x4 _w = *(const u32x4*)(ptr); dst[0] = bflo(_w.x); dst[1] = bfhi(_w.x); dst[2] = bflo(_w.y); dst[3] = bfhi(_w.y); dst[4] = bflo(_w.z); dst[5] = bfhi(_w.z); dst[6] = bflo(_w.w); dst[7] = bfhi(_w.w); } while (0)
#define LD8F(dst, ptr) do { const f32x4 _a = *(const f32x4*)(ptr), _b = *(const f32x4*)((ptr) + 4); dst[0] = _a.x; dst[1] = _a.y; dst[2] = _a.z; dst[3] = _a.w; dst[4] = _b.x; dst[5] = _b.y; dst[6] = _b.z; dst[7] = _b.w; } while (0)
#define ZERO8(dst) do { _Pragma("unroll") for (int _i = 0; _i < 8; ++_i) dst[_i] = 0.f; } while (0)
            if (rt < 512) {
                const int grp = rt >> 1, k = rt & 1; row = grp * 64 + k; const int t = row & 4095;
                const bf16_t* u0 = UH + (size_t)(grp * 4 + 2 + k) * F2;
                LD8BF(ua[2], u0 + ch); LD8BF(ub[2], u0 + DFF + ch);
                if (t >= 1) { const bf16_t* u1 = (k == 0) ? UH + (size_t)((grp - 1) * 4 + 1) * F2 : UH + (size_t)(grp * 4 + 2) * F2; LD8BF(ua[1], u1 + ch); LD8BF(ub[1], u1 + DFF + ch); } else { ZERO8(ua[1]); ZERO8(ub[1]); }
                if (t >= 2) { const bf16_t* u2 = UH + (size_t)((grp - 1) * 4 + k) * F2; LD8BF(ua[0], u2 + ch); LD8BF(ub[0], u2 + DFF + ch); } else { ZERO8(ua[0]); ZERO8(ub[0]); }
            } else {
                const int sr = rt - 512, b = sr >> 2, t = sr & 3; row = MP + sr;
#pragma unroll
                for (int tap = 0; tap < 3; ++tap) { const int e = t + tap;
                    if (e < 2) { const float* cp = a.state_conv + ((size_t)b * 2 + e) * F2; LD8F(ua[tap], cp + ch); LD8F(ub[tap], cp + DFF + ch); }
                    else { const bf16_t* up = US + (size_t)(b * 4 + e - 2) * F2; LD8BF(ua[tap], up + ch); LD8BF(ub[tap], up + DFF + ch); } }
            }
            float wa[3][8], wb[3][8], ba[8], bb[8];
#pragma unroll
            for (int tap = 0; tap < 3; ++tap) { LD8F(wa[tap], a.conv_w + (size_t)tap * F2 + ch); LD8F(wb[tap], a.conv_w + (size_t)tap * F2 + DFF + ch); }
            LD8F(ba, a.conv_b + ch); LD8F(bb, a.conv_b + DFF + ch);
            float gg[8];
#pragma unroll
            for (int i = 0; i < 8; ++i) { const float ca = ba[i] + wa[0][i] * ua[0][i] + wa[1][i] * ua[1][i] + wa[2][i] * ua[2][i], cb = bb[i] + wb[0][i] * ub[0][i] + wb[1][i] * ub[1][i] + wb[2][i] * ub[2][i];
                gg[i] = pg8::gelu_tanh(ca) * cb; }
            u32x4 w; w.x = pk2(gg[0], gg[1]); w.y = pk2(gg[2], gg[3]); w.z = pk2(gg[4], gg[5]); w.w = pk2(gg[6], gg[7]);
            *(u32x4*)(G + (size_t)row * DFF + ch) = w;
        }
    }
    SEAM(9);
    if (IN(10)) {
        pg8::Gemm g{G, WdnT, MP, D, DFF, DFF}; pg8::StaticOrder S; S.init(MP, D, nblk, blk);
        pg8::EpiBf16<0> E{Fb, D, nullptr, 0, 0, 1.f}; pg8::gemm_phase<pg8::EpiBf16<0>, pg8::StaticOrder, true, true>(lds, g, S, E);
        for (int piece = blk; piece < 256; piece += nblk) {
            const int fr = lane & 15, fq = lane >> 4; const size_t prow = (size_t)MP + 32 * (piece >> 4); const size_t row = prow + 16 * (wave >> 2) + fr; const int pcol = 64 * (piece & 15), col0 = pcol + 16 * (wave & 3);
            const f32x4 ac = tail_gemm(G + prow * DFF, DFF, WdnT + (size_t)pcol * DFF, DFF, lds, tid, lane, wave, (f32x4){0.f, 0.f, 0.f, 0.f});
            u32x2 w; w.x = pk2(ac[0], ac[1]); w.y = pk2(ac[2], ac[3]); *(u32x2*)(Fb + row * D + col0 + 4 * fq) = w;
        }
    }
    SEAM(10);
    if (IN(11)) {
        f32x4 gpo[2][2];
#pragma unroll
        for (int j = 0; j < 2; ++j)
#pragma unroll
            for (int e = 0; e < 2; ++e) gpo[j][e] = *((const f32x4*)a.g_post_ffn + 2 * (lane + 64 * j) + e);
        for (int p = blk * NWAVES + wave; p < M / 2; p += nblk * NWAVES) {
            u32x4 fb[2][2], xb[2][2];
#pragma unroll
            for (int rr = 0; rr < 2; ++rr) { const int m = 2 * p + rr;
#pragma unroll
                for (int j = 0; j < 2; ++j) { fb[rr][j] = *((const u32x4*)(Fb + (size_t)m * D) + lane + 64 * j); xb[rr][j] = *((const u32x4*)(X1b + (size_t)m * D) + lane + 64 * j); } }
            float ss[2];
#pragma unroll
            for (int rr = 0; rr < 2; ++rr) { ss[rr] = 0.f;
#pragma unroll
                for (int j = 0; j < 2; ++j)
#pragma unroll
                    for (int q = 0; q < 4; ++q) { const unsigned w = fb[rr][j][q]; ss[rr] += bflo(w) * bflo(w) + bfhi(w) * bfhi(w); } }
            ss[0] = wave_sum(ss[0]); ss[1] = wave_sum(ss[1]);
#pragma unroll
            for (int rr = 0; rr < 2; ++rr) { const int m = 2 * p + rr; const float rstd = rsqrtf(ss[rr] * (1.f / D) + EPS);
#pragma unroll
                for (int j = 0; j < 2; ++j)
#pragma unroll
                    for (int e = 0; e < 2; ++e) { f32x4 y;
#pragma unroll
                        for (int q = 0; q < 2; ++q) { const unsigned fw = fb[rr][j][2 * e + q], xw = xb[rr][j][2 * e + q];
                            y[2 * q] = bflo(xw) + bflo(fw) * rstd * gpo[j][e][2 * q]; y[2 * q + 1] = bfhi(xw) + bfhi(fw) * rstd * gpo[j][e][2 * q + 1]; }
                        *((f32x4*)(Y + (size_t)m * D) + 2 * (lane + 64 * j) + e) = y; } }
        }
    }
#undef IN
#undef SEAM
}

#ifndef MK_SPLIT
#define MK_SPLIT 0
#endif
extern "C" void kernel_launch(void* const* d_in, const int* in_sizes, int n_in, void* d_out, int out_size, void* d_ws, size_t ws_size, hipStream_t stream) {
    static int grid = 0;
    if (grid == 0) {
        int dev = 0, cus = 0, per_cu = 0;
        if (hipGetDevice(&dev) != hipSuccess || hipDeviceGetAttribute(&cus, hipDeviceAttributeMultiprocessorCount, dev) != hipSuccess) { fprintf(stderr, "kernel_launch: device query failed\n"); grid = -1; return; }
        if (hipFuncSetAttribute((const void*)fwd_megakernel, hipFuncAttributeMaxDynamicSharedMemorySize, LDS_BYTES) != hipSuccess) { fprintf(stderr, "kernel_launch: hipFuncSetAttribute failed\n"); grid = -1; return; }
        if (hipOccupancyMaxActiveBlocksPerMultiprocessor(&per_cu, (const void*)fwd_megakernel, NTHREADS, LDS_BYTES) != hipSuccess || per_cu < 1) { fprintf(stderr, "kernel_launch: occupancy query says %d\n", per_cu); per_cu = 1; }
        (void)hipGetLastError();
        grid = cus * 1;
        if (ws_size < 256 * MiB || out_size != (int)O_END || n_in != 19) fprintf(stderr, "kernel_launch: unexpected sizes ws %zu out %d n_in %d\n", ws_size, out_size, n_in);
    }
    if (grid < 0) return;
    Args a{};
    a.x_prompt = (const float*)d_in[0]; a.x_sample = (const float*)d_in[1]; a.cache_k = (const float*)d_in[2]; a.cache_v = (const float*)d_in[3]; a.state_ret = (const float*)d_in[4];
    a.state_conv = (const float*)d_in[5]; a.w_in = (const float*)d_in[6]; a.sinks = (const float*)d_in[7]; a.w_a = (const float*)d_in[8]; a.w_r = (const float*)d_in[9]; a.w_o = (const float*)d_in[10];
    a.g_pre_mix = (const float*)d_in[11]; a.g_post_mix = (const float*)d_in[12]; a.g_pre_ffn = (const float*)d_in[13]; a.g_post_ffn = (const float*)d_in[14];
    a.w_up = (const float*)d_in[15]; a.conv_w = (const float*)d_in[16]; a.conv_b = (const float*)d_in[17]; a.w_down = (const float*)d_in[18];
    a.out = (float*)d_out; a.ws = (unsigned char*)d_ws;
#if MK_SPLIT
    for (int ph = 0; ph < 12; ++ph) { a.ph_lo = ph; a.ph_hi = ph + 1; hipLaunchKernelGGL(fwd_megakernel, dim3(grid), dim3(NTHREADS), LDS_BYTES, stream, a); }
#else
    a.ph_lo = 0; a.ph_hi = 12;
    void* args[] = {&a};
    const hipError_t e = hipLaunchCooperativeKernel((const void*)fwd_megakernel, dim3(grid), dim3(NTHREADS), args, LDS_BYTES, stream);
    if (e != hipSuccess) fprintf(stderr, "kernel_launch: cooperative launch failed: %s (grid %d)\n", hipGetErrorString(e), grid);
#endif
}
```

```cpp
#include <hip/hip_runtime.h>
#include <hip/hip_cooperative_groups.h>
#include <cstdio>
#include <cstdint>
#include <cmath>
namespace cg = cooperative_groups;
namespace pg8 {
#define PG8_LAS __attribute__((address_space(3)))
typedef unsigned short bf16_t;
typedef short bf16x8 __attribute__((ext_vector_type(8)));
typedef float f32x4 __attribute__((ext_vector_type(4)));
typedef unsigned u32x4 __attribute__((ext_vector_type(4)));
constexpr int BM = 256, BK = 64, HALF = 128, HTB = HALF * BK * 2  , STAGE_BYTES = 8 * HTB, NXCD = 8, WGM = 8;

__host__ __device__ __forceinline__ int lds_byte(int r, int c) { const int st = (r >> 4) * 2 + (c >> 5), rr = r & 15, cc = c & 31, ob = rr * 64 + cc * 2; return st * 1024 + (ob ^ (((ob >> 9) & 1) << 5)); }
__host__ __device__ __forceinline__ void stage_rc(int b, int& R, int& C) { const int st = b / 1024, sb = b % 1024, swz = sb ^ (((sb >> 9) & 1) << 5); R = (st >> 1) * 16 + swz / 64; C = (st & 1) * 32 + (swz % 64) / 2; }
__host__ __device__ __forceinline__ int perm32(int rho) { const int n = rho >> 4, i = rho & 15; return 8 * (i >> 2) + 4 * n + (i & 3); }

struct Unit { int pm, pn; };
struct Gemm { const bf16_t* A; const bf16_t* Bt; int M, N, K, lda; };

struct StaticOrder {
    int nM, nN, nwg, G, c;
    __host__ __device__ void init(int M, int N, int G_, int c_) { nM = M / BM; nN = N / BM; nwg = nM * nN; G = G_; c = c_; }
    __host__ __device__ bool next(int i, Unit& u) const {
        const long L = (long)i * G + c; if (L >= nwg) return false;
        int wgid = (int)L; { const int q = nwg / NXCD, r = nwg % NXCD, xcd = wgid % NXCD, off = wgid / NXCD; wgid = (xcd < r ? xcd * (q + 1) : r * (q + 1) + (xcd - r) * q) + off; }
        const int nig = WGM * nN, gid = wgid / nig, fm = gid * WGM, gsz = (nM - fm) < WGM ? (nM - fm) : WGM;
        u.pm = fm + ((wgid % nig) % gsz); u.pn = (wgid % nig) / gsz; return true;
    }
    __device__ __forceinline__ void a_ready(const Unit&) const {}
    __device__ __forceinline__ void done(const Unit&) const {}
};

__device__ __forceinline__ unsigned cvt_pk_bf16(float lo, float hi) { unsigned r; asm volatile("v_cvt_pk_bf16_f32 %0, %1, %2" : "=v"(r) : "v"(lo), "v"(hi)); return r; }
typedef float f32x2 __attribute__((ext_vector_type(2)));
__device__ __forceinline__ f32x2 gelu_pk(f32x2 v) {
    const f32x2 av = __builtin_elementwise_abs(v), d = av * 0.2316418882f + 1.0f;
    f32x2 t; t.x = __builtin_amdgcn_rcpf(d.x); t.y = __builtin_amdgcn_rcpf(d.y);
    f32x2 q = t * 0.5307027145f + (-0.7265760135f); q = q * t + 0.7107068705f; q = q * t + (-0.142248368f); q = q * t + 0.127414796f; q = q * t;
    const f32x2 s = (v * v) * (-0.72134752044f);
    f32x2 e; e.x = __builtin_amdgcn_exp2f(s.x); e.y = __builtin_amdgcn_exp2f(s.y);
    const f32x2 m = v * (q * e), r = v - m;
    f32x2 o; o.x = v.x < 0.f ? m.x : r.x; o.y = v.y < 0.f ? m.y : r.y; return o;
}

template <int ACT  > struct EpiBf16 {
    static constexpr bool PERM = true, AFTER_DRAIN = false; static_assert(ACT == 0 || ACT == 1, "EpiBf16: ACT is 0 (none) or 1 (gelu_pk)");
    bf16_t* O; int ldc; const float* bias; int split_cols; size_t split_stride; float scale0;
    __device__ __forceinline__ void operator()(const f32x4 (&acc)[2][2][4][2], const Unit& u, int wr, int wc, int fr, int fq) const {
        const int row0 = u.pm * BM + wr * 64 + fr; int colt = u.pn * BM; bf16_t* base = O;
        float sc = 1.f; if (split_cols) { const int t = colt / split_cols; base += (size_t)t * split_stride; colt -= t * split_cols; if (t == 0) sc = scale0; }
        const int col0 = colt + wc * 32 + 8 * fq, bcol0 = u.pn * BM + wc * 32 + 8 * fq;
        f32x4 bv[2][2];
#pragma unroll
        for (int bj = 0; bj < 2; ++bj)
#pragma unroll
            for (int n = 0; n < 2; ++n) bv[bj][n] = bias ? *(const f32x4*)(bias + bcol0 + bj * HALF + 4 * n) : (f32x4){0.f, 0.f, 0.f, 0.f};
#pragma unroll
        for (int ai = 0; ai < 2; ++ai)
#pragma unroll
            for (int m = 0; m < 4; ++m) { bf16_t* rowp = base + (size_t)(row0 + ai * HALF + m * 16) * ldc + col0;
#pragma unroll
                for (int bj = 0; bj < 2; ++bj) { f32x4 v0 = acc[ai][bj][m][0] + bv[bj][0], v1 = acc[ai][bj][m][1] + bv[bj][1];
                    if (ACT == 1) { f32x2 a = gelu_pk((f32x2){v0[0], v0[1]}), b = gelu_pk((f32x2){v0[2], v0[3]}), c = gelu_pk((f32x2){v1[0], v1[1]}), d = gelu_pk((f32x2){v1[2], v1[3]});
                        v0 = (f32x4){a.x, a.y, b.x, b.y}; v1 = (f32x4){c.x, c.y, d.x, d.y}; }
                    v0 = v0 * sc; v1 = v1 * sc; u32x4 w; w.x = cvt_pk_bf16(v0[0], v0[1]); w.y = cvt_pk_bf16(v0[2], v0[3]); w.z = cvt_pk_bf16(v1[0], v1[1]); w.w = cvt_pk_bf16(v1[2], v1[3]);
                    *(u32x4*)(rowp + bj * HALF) = w; } }
    }
};

typedef float f32x2e __attribute__((ext_vector_type(2)));
typedef unsigned u32x2e __attribute__((ext_vector_type(2)));
__device__ __forceinline__ float bf_lo(unsigned w) { return __uint_as_float(w << 16); }
__device__ __forceinline__ float bf_hi(unsigned w) { return __uint_as_float(w & 0xffff0000u); }
__device__ __forceinline__ float sigmoidf_(float x) { return __builtin_amdgcn_rcpf(1.0f + __expf(-x)); }
constexpr int E_MP = 16384, E_DIN = 5888;

struct EpiH {
    static constexpr bool PERM = true, AFTER_DRAIN = false;
    bf16_t* H; const f32x2e* tabA; const f32x2e* tabR;
    __device__ __forceinline__ void operator()(const f32x4 (&acc)[2][2][4][2], const Unit& u, int wr, int wc, int fr, int fq) const {
        const int pn = u.pn;
        const int row0 = u.pm * BM + wr * 64 + fr;
        const int colt = pn * BM + wc * 32 + 8 * fq;
#pragma unroll
        for (int ai = 0; ai < 2; ++ai)
#pragma unroll
            for (int m = 0; m < 4; ++m) {
                const int row = row0 + ai * HALF + m * 16;
                const int tp = row < E_MP ? (row & 4095) : 4096 + (row & 3);
#pragma unroll
                for (int bj = 0; bj < 2; ++bj) {
                    float v[8];
#pragma unroll
                    for (int j = 0; j < 4; ++j) { v[j] = acc[ai][bj][m][0][j]; v[4 + j] = acc[ai][bj][m][1][j]; }
                    int mode = 0; float sc = 1.f;
                    if (pn < 2) { mode = 1; sc = 0.125f; }
                    else if (pn == 2) { mode = (bj == 0) ? 1 : 0; }
                    else if (pn < 5) { mode = 2; }
                    else if (pn < 7) { mode = 2; sc = 0.08838834764831845f; }
                    if (mode == 1) {
                        const bool rot = ((wc & 1) == 0) && (fq < 2);
                        const float sgn = (fq == 0) ? -1.f : 1.f;
#pragma unroll
                        for (int j = 0; j < 8; ++j) {
                            const float partner = __shfl_xor(v[j], 16);
                            const f32x2e cs = tabA[tp * 8 + j];
                            const float o = v[j] * cs.x + sgn * partner * cs.y;
                            v[j] = (rot ? o : v[j]) * sc;
                        }
                    } else if (mode == 2) {
                        const int pi = ((bj * HALF + wc * 32 + 8 * fq) & 127) >> 1;
#pragma unroll
                        for (int p = 0; p < 4; ++p) {
                            const f32x2e cs = tabR[tp * 64 + pi + p];
                            const float x0 = v[2 * p], x1 = v[2 * p + 1];
                            v[2 * p] = (x0 * cs.x - x1 * cs.y) * sc; v[2 * p + 1] = (x1 * cs.x + x0 * cs.y) * sc;
                        }
                    }
                    u32x4 w; w.x = cvt_pk_bf16(v[0], v[1]); w.y = cvt_pk_bf16(v[2], v[3]); w.z = cvt_pk_bf16(v[4], v[5]); w.w = cvt_pk_bf16(v[6], v[7]);
                    *(u32x4*)(H + (size_t)row * E_DIN + colt + bj * HALF) = w;
                }
            }
    }
};

template <bool ADD> struct EpiGate {
    static constexpr bool PERM = true, AFTER_DRAIN = false;
    bf16_t* T; const bf16_t* gate; int ldg;
    __device__ __forceinline__ void operator()(const f32x4 (&acc)[2][2][4][2], const Unit& u, int wr, int wc, int fr, int fq) const {
        const int row0 = u.pm * BM + wr * 64 + fr, col0 = u.pn * BM + wc * 32 + 8 * fq;
#pragma unroll
        for (int ai = 0; ai < 2; ++ai)
#pragma unroll
            for (int m = 0; m < 4; ++m) {
                const int row = row0 + ai * HALF + m * 16;
#pragma unroll
                for (int bj = 0; bj < 2; ++bj) {
                    const u32x4 gw = *(const u32x4*)(gate + (size_t)row * ldg + col0 + bj * HALF);
                    bf16_t* tp = T + (size_t)row * 1024 + col0 + bj * HALF;
                    u32x4 old = (u32x4){0u, 0u, 0u, 0u}; if (ADD) old = *(const u32x4*)tp;
                    float o[8];
#pragma unroll
                    for (int j = 0; j < 4; ++j) {
                        const unsigned g2 = gw[j], o2 = old[j];
                        const float a0 = acc[ai][bj][m][j >> 1][(j & 1) * 2], a1 = acc[ai][bj][m][j >> 1][(j & 1) * 2 + 1];
                        o[2 * j] = bf_lo(o2) + sigmoidf_(bf_lo(g2)) * a0; o[2 * j + 1] = bf_hi(o2) + sigmoidf_(bf_hi(g2)) * a1;
                    }
                    u32x4 w; w.x = cvt_pk_bf16(o[0], o[1]); w.y = cvt_pk_bf16(o[2], o[3]); w.z = cvt_pk_bf16(o[4], o[5]); w.w = cvt_pk_bf16(o[6], o[7]);
                    *(u32x4*)tp = w;
                }
            }
    }
};

struct EpiF32 {
    static constexpr bool PERM = true, AFTER_DRAIN = false;
    float* O;
    __device__ __forceinline__ void operator()(const f32x4 (&acc)[2][2][4][2], const Unit& u, int wr, int wc, int fr, int fq) const {
        const int row0 = u.pm * BM + wr * 64 + fr, col0 = u.pn * BM + wc * 32 + 8 * fq;
#pragma unroll
        for (int ai = 0; ai < 2; ++ai)
#pragma unroll
            for (int m = 0; m < 4; ++m) {
                float* rp = O + (size_t)(row0 + ai * HALF + m * 16) * 1024 + col0;
#pragma unroll
                for (int bj = 0; bj < 2; ++bj) { *(f32x4*)(rp + bj * HALF) = acc[ai][bj][m][0]; *(f32x4*)(rp + bj * HALF + 4) = acc[ai][bj][m][1]; }
            }
    }
};

__device__ __forceinline__ float dpp_ror1(float x) { return __builtin_bit_cast(float, __builtin_amdgcn_update_dpp(0, __builtin_bit_cast(int, x), 0x121, 0xf, 0xf, false)); }
__device__ __forceinline__ float dpp_ror2(float x) { return __builtin_bit_cast(float, __builtin_amdgcn_update_dpp(0, __builtin_bit_cast(int, x), 0x122, 0xf, 0xf, false)); }
__device__ __forceinline__ float gelu_tanh(float x) { const float u2 = 1.5957691216057308f * (x + 0.044715f * x * x * x); return x * __builtin_amdgcn_rcpf(1.0f + __expf(-u2)); }
struct EpiUp {
    static constexpr bool PERM = true, AFTER_DRAIN = false;
    bf16_t* G; bf16_t* UH; bf16_t* US; float* conv_prompt; float* conv_sample; const float* conv_w; const float* conv_b;
    __device__ __forceinline__ void operator()(const f32x4 (&acc)[2][2][4][2], const Unit& u, int wr, int wc, int fr, int fq) const {
        const int row0 = u.pm * BM + wr * 64 + fr;
        const bool sample = u.pm >= 64;
        u32x2e keep[2][4];
#pragma unroll
        for (int n = 0; n < 2; ++n) {
            const int ch = u.pn * HALF + wc * 32 + 8 * fq + 4 * n;
            const f32x4 wa0 = *(const f32x4*)(conv_w + ch), wa1 = *(const f32x4*)(conv_w + 6144 + ch), wa2 = *(const f32x4*)(conv_w + 12288 + ch), ba = *(const f32x4*)(conv_b + ch);
            const f32x4 wb0 = *(const f32x4*)(conv_w + 3072 + ch), wb1 = *(const f32x4*)(conv_w + 6144 + 3072 + ch), wb2 = *(const f32x4*)(conv_w + 12288 + 3072 + ch), bb = *(const f32x4*)(conv_b + 3072 + ch);
#pragma unroll
            for (int ai = 0; ai < 2; ++ai)
#pragma unroll
                for (int m = 0; m < 4; ++m) {
                    const int row = row0 + ai * HALF + m * 16;
                    const f32x4 ua = acc[ai][0][m][n], ub = acc[ai][1][m][n];
                    const f32x4 pa = acc[ai][0][m > 0 ? m - 1 : 0][n], pb = acc[ai][1][m > 0 ? m - 1 : 0][n];
                    float g[4];
#pragma unroll
                    for (int rp = 0; rp < 2; ++rp) {
                        f32x2e a0v, a1v, a2v, b0v, b1v, b2v;
#pragma unroll
                        for (int e = 0; e < 2; ++e) { const int r = 2 * rp + e;
                            a0v[e] = ua[r]; b0v[e] = ub[r];
                            a1v[e] = dpp_ror1(fr == 15 ? pa[r] : ua[r]); a2v[e] = dpp_ror2(fr >= 14 ? pa[r] : ua[r]);
                            b1v[e] = dpp_ror1(fr == 15 ? pb[r] : ub[r]); b2v[e] = dpp_ror2(fr >= 14 ? pb[r] : ub[r]); }
                        const f32x2e wa0v = {wa0[2 * rp], wa0[2 * rp + 1]}, wa1v = {wa1[2 * rp], wa1[2 * rp + 1]}, wa2v = {wa2[2 * rp], wa2[2 * rp + 1]}, bav = {ba[2 * rp], ba[2 * rp + 1]};
                        const f32x2e wb0v = {wb0[2 * rp], wb0[2 * rp + 1]}, wb1v = {wb1[2 * rp], wb1[2 * rp + 1]}, wb2v = {wb2[2 * rp], wb2[2 * rp + 1]}, bbv = {bb[2 * rp], bb[2 * rp + 1]};
                        const f32x2e ca = bav + wa0v * a2v + wa1v * a1v + wa2v * a0v;
                        const f32x2e cb = bbv + wb0v * b2v + wb1v * b1v + wb2v * b0v;
                        const f32x2e u2 = ca * (ca * ca * (-0.044715f * 1.5957691216057308f * 1.4426950408889634f) + (-1.5957691216057308f * 1.4426950408889634f));
                        f32x2e den; den.x = __builtin_amdgcn_rcpf(1.0f + __builtin_amdgcn_exp2f(u2.x)); den.y = __builtin_amdgcn_rcpf(1.0f + __builtin_amdgcn_exp2f(u2.y));
                        const f32x2e gv = ca * den * cb;
                        g[2 * rp] = gv.x; g[2 * rp + 1] = gv.y;
                    }
                    if (!sample) {
                        { u32x2e w; w.x = cvt_pk_bf16(g[0], g[1]); w.y = cvt_pk_bf16(g[2], g[3]);
                          if (n == 0) keep[ai][m] = w;
                          else if (!(m == 0 && fr < 2)) { u32x4 w4; w4.x = keep[ai][m].x; w4.y = keep[ai][m].y; w4.z = w.x; w4.w = w.y; *(u32x4*)(G + (size_t)row * 3072 + ch - 4) = w4; } }
                        if ((m == 0 && fr < 2) || (m == 3 && fr >= 14)) {
                            const int hrow = (row >> 6) * 4 + ((row + 2) & 63);
                            u32x2e w; w.x = cvt_pk_bf16(ua[0], ua[1]); w.y = cvt_pk_bf16(ua[2], ua[3]); *(u32x2e*)(UH + (size_t)hrow * 6144 + ch) = w;
                            w.x = cvt_pk_bf16(ub[0], ub[1]); w.y = cvt_pk_bf16(ub[2], ub[3]); *(u32x2e*)(UH + (size_t)hrow * 6144 + 3072 + ch) = w;
                        }
                        if ((row & 4095) >= 4094) {
                            float* cp = conv_prompt + ((size_t)(row >> 12) * 2 + ((row & 4095) - 4094)) * 6144;
                            *(f32x4*)(cp + ch) = ua; *(f32x4*)(cp + 3072 + ch) = ub;
                        }
                    } else {
                        const int sr = row - E_MP;
                        u32x2e w; w.x = cvt_pk_bf16(ua[0], ua[1]); w.y = cvt_pk_bf16(ua[2], ua[3]); *(u32x2e*)(US + (size_t)sr * 6144 + ch) = w;
                        w.x = cvt_pk_bf16(ub[0], ub[1]); w.y = cvt_pk_bf16(ub[2], ub[3]); *(u32x2e*)(US + (size_t)sr * 6144 + 3072 + ch) = w;
                        if ((sr & 3) >= 2) {
                            float* cp = conv_sample + ((size_t)(sr >> 2) * 2 + ((sr & 3) - 2)) * 6144;
                            *(f32x4*)(cp + ch) = ua; *(f32x4*)(cp + 3072 + ch) = ub;
                        }
                    }
                }
        }
    }
};

template <class Epi, class Sched, bool ALIGN_EPI = false, bool SP2 = false>
__device__ __forceinline__ void gemm_phase(PG8_LAS unsigned char* lds, const Gemm g, const Sched& S, const Epi& E) {
    const int tid = threadIdx.x, wid = __builtin_amdgcn_readfirstlane(tid >> 6), lane = tid & 63, wr = wid >> 2, wc = wid & 3, fr = lane & 15, fq = lane >> 4;
    const int K = g.K, nt = K / BK, lda = g.lda;
    unsigned voffA[2], voffB[2];
#pragma unroll
    for (int i = 0; i < 2; ++i) { int R, C; stage_rc(tid * 16 + i * 8192, R, C); const int Rb = Epi::PERM ? ((R & ~31) + perm32(R & 31)) : R;
        voffA[i] = (unsigned)(R * lda + C) * 2u; voffB[i] = (unsigned)(Rb * K + C) * 2u; }
    const size_t kstep = (size_t)(BK * 2);
    const size_t hstepA = (size_t)HALF * lda * 2, hstepB = (size_t)HALF * K * 2;
    const size_t tstepA = 2 * hstepA, tstepB = 2 * hstepB;
    const unsigned ldsw = (unsigned)wid * 1024u;
    const int aoff = lds_byte(wr * 64 + fr, fq * 8), boff = lds_byte(wc * 32 + fr, fq * 8);
#define PG8_SA(b, h) (((b) * 2 + (h)) * HTB)
#define PG8_SB(b, h) ((4 + (b) * 2 + (h)) * HTB)
#define PG8_STAGE(bufoff, gbase, voff) do { _Pragma("unroll") for (int _i = 0; _i < 2; ++_i) \
        __builtin_amdgcn_global_load_lds((const unsigned*)((const char*)(gbase) + (voff)[_i]), (PG8_LAS unsigned*)(lds + (bufoff) + ldsw + _i * 8192), 16, 0, 0); } while (0)
#define PG8_LDA(dst, b, h) do { _Pragma("unroll") for (int m = 0; m < 4; ++m) _Pragma("unroll") for (int k = 0; k < 2; ++k) dst[m][k] = *(const PG8_LAS bf16x8*)(lds + PG8_SA(b, h) + aoff + m * 2048 + k * 1024); } while (0)
#define PG8_LDB(dst, b, h) do { _Pragma("unroll") for (int n = 0; n < 2; ++n) _Pragma("unroll") for (int k = 0; k < 2; ++k) dst[n][k] = *(const PG8_LAS bf16x8*)(lds + PG8_SB(b, h) + boff + n * 2048 + k * 1024); } while (0)
#define PG8_MMA(ai, bj, At, Bt) do { __builtin_amdgcn_s_setprio(1); _Pragma("unroll") for (int m = 0; m < 4; ++m) _Pragma("unroll") for (int n = 0; n < 2; ++n) _Pragma("unroll") for (int k = 0; k < 2; ++k) \
        acc[ai][bj][m][n] = __builtin_amdgcn_mfma_f32_16x16x32_bf16(Bt[n][k], At[m][k], acc[ai][bj][m][n], 0, 0, 0); __builtin_amdgcn_s_setprio(0); } while (0)
#define PG8_WAIT_V(n) asm volatile("s_waitcnt vmcnt(" #n ")" ::: "memory")
#define PG8_WAIT_L(n) asm volatile("s_waitcnt lgkmcnt(" #n ")" ::: "memory")
#define PG8_BAR __builtin_amdgcn_s_barrier()
#define PG8_SCHED __builtin_amdgcn_sched_barrier(0)
    Unit cur, nxt; int ui = 0;
    if (!S.next(0, cur)) return;
    f32x4 acc[2][2][4][2];
#pragma unroll
    for (int a = 0; a < 2; ++a)
#pragma unroll
        for (int b = 0; b < 2; ++b)
#pragma unroll
            for (int m = 0; m < 4; ++m)
#pragma unroll
                for (int n = 0; n < 2; ++n) acc[a][b][m][n] = (f32x4){0.f, 0.f, 0.f, 0.f};
    bf16x8 At[4][2], B0[2][2], B1[2][2];
    const char* cA = (const char*)g.A + (size_t)cur.pm * tstepA; const char* cB = (const char*)g.Bt + (size_t)cur.pn * tstepB;
    S.a_ready(cur);
    if constexpr (SP2) {
        PG8_STAGE(PG8_SB(0, 0), cB, voffB); PG8_STAGE(PG8_SB(0, 1), cB + hstepB, voffB); PG8_STAGE(PG8_SA(0, 0), cA, voffA); PG8_STAGE(PG8_SA(0, 1), cA + hstepA, voffA);
        if (wr == 1) PG8_BAR;
        PG8_WAIT_V(2); PG8_BAR;
        PG8_STAGE(PG8_SB(1, 0), cB + kstep, voffB); PG8_STAGE(PG8_SA(1, 0), cA + kstep, voffA); PG8_STAGE(PG8_SB(1, 1), cB + hstepB + kstep, voffB);
        PG8_WAIT_V(6); PG8_BAR;
    } else {
        PG8_STAGE(PG8_SB(0, 0), cB, voffB); PG8_STAGE(PG8_SA(0, 0), cA, voffA); PG8_STAGE(PG8_SB(0, 1), cB + hstepB, voffB); PG8_STAGE(PG8_SA(0, 1), cA + hstepA, voffA);
        if (wr == 1) PG8_BAR;
        PG8_WAIT_V(4); PG8_BAR;
        PG8_STAGE(PG8_SB(1, 0), cB + kstep, voffB); PG8_STAGE(PG8_SA(1, 0), cA + kstep, voffA); PG8_STAGE(PG8_SB(1, 1), cB + hstepB + kstep, voffB);
        PG8_WAIT_V(6); PG8_BAR;
    }
    for (;;) {
        const bool has_next = S.next(ui + 1, nxt);
        const char* nA = has_next ? (const char*)g.A + (size_t)nxt.pm * tstepA : cA; const char* nB = has_next ? (const char*)g.Bt + (size_t)nxt.pn * tstepB : cB;
        for (int t = 0; t < nt; t += 2) {
            const bool last = (t == nt - 2);
            const char* a1 = cA + (size_t)(t + 1) * kstep;
            const char* a2 = last ? nA : cA + (size_t)(t + 2) * kstep; const char* b2 = last ? nB : cB + (size_t)(t + 2) * kstep;
            const char* a3 = a2 + kstep; const char* b3 = b2 + kstep;
            if (last && has_next) S.a_ready(nxt);
            if constexpr (SP2) {
            PG8_LDB(B0, 0, 0); PG8_LDB(B1, 0, 1); PG8_SCHED; PG8_LDA(At, 0, 0); PG8_STAGE(PG8_SA(1, 1), a1 + hstepA, voffA);
            PG8_WAIT_V(8); PG8_WAIT_L(0); PG8_BAR; PG8_MMA(0, 0, At, B0); PG8_MMA(0, 1, At, B1); PG8_BAR; PG8_SCHED;
            PG8_LDA(At, 0, 1); PG8_STAGE(PG8_SB(0, 0), b2, voffB); PG8_STAGE(PG8_SB(0, 1), b2 + hstepB, voffB); PG8_STAGE(PG8_SA(0, 0), a2, voffA);
            PG8_WAIT_V(8); PG8_WAIT_L(0); PG8_BAR; PG8_MMA(1, 0, At, B0); PG8_MMA(1, 1, At, B1); PG8_BAR; PG8_SCHED;
            PG8_LDB(B0, 1, 0); PG8_LDB(B1, 1, 1); PG8_SCHED; PG8_LDA(At, 1, 0); PG8_STAGE(PG8_SA(0, 1), a2 + hstepA, voffA);
            PG8_WAIT_V(8); PG8_WAIT_L(0); PG8_BAR; PG8_MMA(0, 0, At, B0); PG8_MMA(0, 1, At, B1); PG8_BAR; PG8_SCHED;
            PG8_LDA(At, 1, 1); PG8_STAGE(PG8_SB(1, 0), b3, voffB); PG8_STAGE(PG8_SB(1, 1), b3 + hstepB, voffB); PG8_STAGE(PG8_SA(1, 0), a3, voffA);
            PG8_WAIT_V(8); PG8_WAIT_L(0); PG8_BAR; PG8_MMA(1, 0, At, B0); PG8_MMA(1, 1, At, B1); PG8_BAR; PG8_SCHED;
            } else {
            PG8_LDB(B0, 0, 0); PG8_SCHED; PG8_LDA(At, 0, 0); PG8_STAGE(PG8_SA(1, 1), a1 + hstepA, voffA);
            PG8_WAIT_L(8); PG8_BAR; PG8_WAIT_L(0); PG8_MMA(0, 0, At, B0); PG8_BAR; PG8_SCHED;
            PG8_LDB(B1, 0, 1); PG8_STAGE(PG8_SB(0, 0), b2, voffB);
            PG8_BAR; PG8_WAIT_L(0); PG8_MMA(0, 1, At, B1); PG8_BAR;
            PG8_LDA(At, 0, 1); PG8_STAGE(PG8_SA(0, 0), a2, voffA);
            PG8_BAR; PG8_WAIT_L(0); PG8_MMA(1, 0, At, B0); PG8_BAR; PG8_SCHED;
            PG8_STAGE(PG8_SB(0, 1), b2 + hstepB, voffB);
            PG8_WAIT_V(6); PG8_BAR; PG8_MMA(1, 1, At, B1); PG8_BAR;
            PG8_LDB(B0, 1, 0); PG8_SCHED; PG8_LDA(At, 1, 0); PG8_STAGE(PG8_SA(0, 1), a2 + hstepA, voffA);
            PG8_WAIT_L(8); PG8_BAR; PG8_WAIT_L(0); PG8_MMA(0, 0, At, B0); PG8_BAR; PG8_SCHED;
            PG8_LDB(B1, 1, 1); PG8_STAGE(PG8_SB(1, 0), b3, voffB);
            PG8_BAR; PG8_WAIT_L(0); PG8_MMA(0, 1, At, B1); PG8_BAR;
            PG8_LDA(At, 1, 1); PG8_STAGE(PG8_SA(1, 0), a3, voffA);
            PG8_BAR; PG8_WAIT_L(0); PG8_MMA(1, 0, At, B0); PG8_BAR; PG8_SCHED;
            PG8_STAGE(PG8_SB(1, 1), b3 + hstepB, voffB);
            PG8_WAIT_V(6); PG8_BAR; PG8_MMA(1, 1, At, B1); PG8_BAR;
            }
        }
        if constexpr (ALIGN_EPI) { if (wr == 0) PG8_BAR; }
        if constexpr (!Epi::AFTER_DRAIN) { E(acc, cur, wr, wc, fr, fq); S.done(cur); }
        if (!has_next) break;
#pragma unroll
        for (int a = 0; a < 2; ++a)
#pragma unroll
            for (int b = 0; b < 2; ++b)
#pragma unroll
                for (int m = 0; m < 4; ++m)
#pragma unroll
                    for (int n = 0; n < 2; ++n) acc[a][b][m][n] = (f32x4){0.f, 0.f, 0.f, 0.f};
        cur = nxt; cA = nA; cB = nB; ++ui;
        if constexpr (ALIGN_EPI) { if (wr == 1) PG8_BAR; }
    }
    PG8_WAIT_V(0);
    if constexpr (!ALIGN_EPI) { if (wr == 0) PG8_BAR; }
    PG8_BAR;
    if constexpr (Epi::AFTER_DRAIN) { E.fused(acc, cur, wr, wc, fr, fq, lds, wid, lane); S.done(cur); }
#undef PG8_SA
#undef PG8_SB
#undef PG8_STAGE
#undef PG8_LDA
#undef PG8_LDB
#undef PG8_MMA
#undef PG8_WAIT_V
#undef PG8_WAIT_L
#undef PG8_BAR
#undef PG8_SCHED
}
}

#define LAS __attribute__((address_space(3)))
using pg8::bf16_t; using pg8::bf16x8; using pg8::f32x4; using pg8::u32x4;
typedef float f32x2 __attribute__((ext_vector_type(2)));
typedef unsigned u32x2 __attribute__((ext_vector_type(2)));
typedef short v4i16 __attribute__((ext_vector_type(4)));

constexpr int MP = 16384, MS = 512, M = MP + MS, D = 1024, DIN = 5888, F2 = 6144, DFF = 3072, TSEQ = 4096;
constexpr int C_QA = 0, C_KA = 512, C_VA = 640, C_QR = 768, C_KR = 1280, C_VR = 1792, C_GATE = 2816, C_GMA = 3840, C_GMR = 4864;
constexpr float EPS = 1e-6f;
constexpr int NTHREADS = 512, NWAVES = 8;
constexpr int LDS_BYTES = 147456;

constexpr size_t MiB = 1u << 20;
constexpr size_t WS_TABA = 0, WS_TABR = 512 * 1024;
constexpr size_t WS_WIN = 3 * MiB;
constexpr size_t WS_WUP = WS_WIN + (size_t)DIN * D * 2;
constexpr size_t WS_WDN = WS_WUP + (size_t)F2 * D * 2;
constexpr size_t WS_XN = WS_WDN + (size_t)D * DFF * 2;
constexpr size_t WS_R1 = WS_XN + (size_t)M * D * 2;
constexpr size_t R1_G = 0, R1_F = (size_t)M * DFF * 2, R1_UH = R1_F + (size_t)M * D * 2, R1_US = R1_UH + (size_t)264 * 4 * F2 * 2, R1_X1 = R1_US + (size_t)MS * F2 * 2, R1_END = R1_X1 + (size_t)M * D * 2;
static_assert(R1_END <= (size_t)M * DIN * 2, "R1 overlay");
static_assert(WS_R1 + (size_t)M * DIN * 2 <= 256 * MiB, "ws map");
constexpr size_t O_Y = 0, O_KP = (size_t)M * D, O_VP = O_KP + 65536, O_RP = O_VP + 65536, O_CP = O_RP + 524288, O_KS = O_CP + 49152, O_VS = O_KS + 2097152, O_RS = O_VS + 2097152, O_CS = O_RS + 16777216, O_END = O_CS + 1572864;

struct Args {
    const float *x_prompt, *x_sample, *cache_k, *cache_v, *state_ret, *state_conv, *w_in, *sinks, *w_a, *w_r, *w_o, *g_pre_mix, *g_post_mix, *g_pre_ffn, *g_post_ffn, *w_up, *conv_w, *conv_b, *w_down;
    float* out; unsigned char* ws; int ph_lo, ph_hi;
};

__device__ __forceinline__ float bf2f(bf16_t h) { return __uint_as_float((unsigned)h << 16); }
__device__ __forceinline__ float bflo(unsigned w) { return __uint_as_float(w << 16); }
__device__ __forceinline__ float bfhi(unsigned w) { return __uint_as_float(w & 0xffff0000u); }
__device__ __forceinline__ unsigned pk2(float lo, float hi) { return pg8::cvt_pk_bf16(lo, hi); }
__device__ __forceinline__ float wave_sum(float v) {
#pragma unroll
    for (int o = 1; o < 64; o <<= 1) v += __shfl_xor(v, o);
    return v;
}
__device__ __forceinline__ float wave_max(float v) {
#pragma unroll
    for (int o = 1; o < 64; o <<= 1) v = fmaxf(v, __shfl_xor(v, o));
    return v;
}
__device__ __forceinline__ float ret_log2g(int h) { return log2f(1.0f - exp2f(-5.0f - (float)h)); }
__device__ __forceinline__ bf16x8 tr_pair(const LAS unsigned char* p0, const LAS unsigned char* p1) {
    const v4i16 a = __builtin_amdgcn_ds_read_tr16_b64_v4i16((LAS v4i16*)p0), b = __builtin_amdgcn_ds_read_tr16_b64_v4i16((LAS v4i16*)p1);
    return (bf16x8){a[0], a[1], a[2], a[3], b[0], b[1], b[2], b[3]};
}
__device__ __forceinline__ bf16x8 cat8(u32x2 a, u32x2 b) { const u32x4 w = {a.x, a.y, b.x, b.y}; return __builtin_bit_cast(bf16x8, w); }

__device__ __forceinline__ void p0_transpose_item(const float* W, int K, int N, bf16_t* WT, int k0, int n0, int drow0, LAS float* scr, int lane) {
    f32x4 wv[8];
#pragma unroll
    for (int i = 0; i < 8; ++i) wv[i] = *(const f32x4*)(W + (size_t)(k0 + 8 * i + (lane >> 3)) * N + n0 + 4 * (lane & 7));
#pragma unroll
    for (int i = 0; i < 8; ++i) { LAS float* d = scr + (8 * i + (lane >> 3)) * 33 + 4 * (lane & 7); d[0] = wv[i].x; d[1] = wv[i].y; d[2] = wv[i].z; d[3] = wv[i].w; }
    asm volatile("s_waitcnt lgkmcnt(0)" ::: "memory");
    const int c = lane & 7;
#pragma unroll
    for (int j = 0; j < 4; ++j) { const int n = (lane >> 3) + 8 * j; const LAS float* s = scr + (8 * c) * 33 + n;
        u32x4 o; o.x = pk2(s[0 * 33], s[1 * 33]); o.y = pk2(s[2 * 33], s[3 * 33]); o.z = pk2(s[4 * 33], s[5 * 33]); o.w = pk2(s[6 * 33], s[7 * 33]);
        *(u32x4*)(WT + (size_t)(drow0 + n) * K + k0 + 8 * c) = o; }
    asm volatile("s_waitcnt lgkmcnt(0)" ::: "memory");
}
__device__ __forceinline__ void rms_row_to_bf16(const float* xrow, const float* g, bf16_t* orow, int lane) {
    f32x4 v[4]; float s = 0.f;
#pragma unroll
    for (int j = 0; j < 4; ++j) { v[j] = *((const f32x4*)xrow + lane + 64 * j); s += (v[j].x * v[j].x + v[j].y * v[j].y) + (v[j].z * v[j].z + v[j].w * v[j].w); }
    const float rstd = rsqrtf(wave_sum(s) * (1.f / D) + EPS);
#pragma unroll
    for (int j = 0; j < 4; ++j) { const f32x4 gg = *((const f32x4*)g + lane + 64 * j);
        u32x2 w; w.x = pk2(v[j].x * rstd * gg.x, v[j].y * rstd * gg.y); w.y = pk2(v[j].z * rstd * gg.z, v[j].w * rstd * gg.w);
        *((u32x2*)orow + lane + 64 * j) = w; }
}
__device__ __forceinline__ void p0_prologue(const Args& a, LAS unsigned char* lds, int tid, int lane, int wave) {
    unsigned char* ws = a.ws;
    LAS float* scr = (LAS float*)(lds + wave * 16384);
    const int gw = blockIdx.x * NWAVES + wave, NGW = gridDim.x * NWAVES;
    bf16_t* WinT = (bf16_t*)(ws + WS_WIN); bf16_t* WupT = (bf16_t*)(ws + WS_WUP); bf16_t* WdnT = (bf16_t*)(ws + WS_WDN);
    bf16_t* WoT = (bf16_t*)(a.out + O_CS); bf16_t* WaT = WoT + 1024 * 1024; bf16_t* WrT = WaT + 1024 * 512;
    constexpr int I_IN = 16 * (DIN / 32), I_A = 8 * 32, I_R = 16 * 32, I_O = 16 * 32, I_UP = 16 * (F2 / 32), I_DN = 48 * 32;
    constexpr int NITEMS = I_IN + I_A + I_R + I_O + I_UP + I_DN;
    for (int it = gw; it < NITEMS; it += NGW) {
        int r = it;
        if (r < I_IN) { const int nb = r % (DIN / 32), kb = r / (DIN / 32); p0_transpose_item(a.w_in, D, DIN, WinT, 64 * kb, 32 * nb, 32 * nb, scr, lane); continue; } r -= I_IN;
        if (r < I_A) { const int nb = r % 32, kb = r / 32; p0_transpose_item(a.w_a, 512, D, WaT, 64 * kb, 32 * nb, 32 * nb, scr, lane); continue; } r -= I_A;
        if (r < I_R) { const int nb = r % 32, kb = r / 32; p0_transpose_item(a.w_r, D, D, WrT, 64 * kb, 32 * nb, 32 * nb, scr, lane); continue; } r -= I_R;
        if (r < I_O) { const int nb = r % 32, kb = r / 32; p0_transpose_item(a.w_o, D, D, WoT, 64 * kb, 32 * nb, 32 * nb, scr, lane); continue; } r -= I_O;
        if (r < I_UP) { const int nb = r % (F2 / 32), kb = r / (F2 / 32); const int n0 = 32 * nb;
            const int drow = n0 < DFF ? (n0 / 128) * 256 + (n0 % 128) : ((n0 - DFF) / 128) * 256 + 128 + ((n0 - DFF) % 128);
            p0_transpose_item(a.w_up, D, F2, WupT, 64 * kb, n0, drow, scr, lane); continue; } r -= I_UP;
        { const int nb = r % 32, kb = r / 32; p0_transpose_item(a.w_down, DFF, D, WdnT, 64 * kb, 32 * nb, 32 * nb, scr, lane); }
    }
    bf16_t* XN = (bf16_t*)(ws + WS_XN);
    for (int m = gw; m < M; m += NGW) { const float* xr = m < MP ? a.x_prompt + (size_t)m * D : a.x_sample + (size_t)(m - MP) * D; rms_row_to_bf16(xr, a.g_pre_mix, XN + (size_t)m * D, lane); }
    f32x2* tabA = (f32x2*)(ws + WS_TABA); f32x2* tabR = (f32x2*)(ws + WS_TABR);
    __syncthreads();
    LAS float* invs = (LAS float*)lds;
    if (tid < 72) invs[tid] = tid < 8 ? (float)(1.0 / pow(500000.0, (double)((float)tid / 8.0f))) : (float)(1.0 / pow(10000.0, (double)((float)(tid - 8) / 63.0f)));
    __syncthreads();
    const int gt = blockIdx.x * NTHREADS + tid, NGT = gridDim.x * NTHREADS;
    for (int e = gt; e < 4100 * 72; e += NGT) {
        const int tp = e / 72, i = e % 72; const int pos = tp < 4096 ? tp : 16384 + (tp - 4096);
        const float ang = (float)pos * invs[i];
        const double rev = (double)ang * 0.15915494309189535; const float fr = (float)(rev - rint(rev));
        const f32x2 cs = {__builtin_amdgcn_cosf(fr), __builtin_amdgcn_sinf(fr)};
        if (i < 8) tabA[tp * 8 + i] = cs; else tabR[tp * 64 + (i - 8)] = cs;
    }
}

__device__ __forceinline__ void attn_prompt_unit(bf16_t* H, const float* sinks, LAS unsigned char* lds, int b, int qb, int head, int tid, int lane, int wave) {
    const int g = head >> 2, fr = lane & 15, fq = lane >> 4;
    const size_t rowbase = (size_t)b * TSEQ + (size_t)qb * 128;
    LAS unsigned char* Kimg = lds; LAS unsigned char* Vimg = lds + 36864;
#pragma unroll
    for (int i = 0; i < 4; ++i) {
        const int id = tid + NTHREADS * i, kidx = id >> 3, ch = id & 7;
        u32x4 kv = {0u, 0u, 0u, 0u}, vv = {0u, 0u, 0u, 0u};
        if (qb > 0 || kidx >= 128) { const bf16_t* src = H + (rowbase - 128 + kidx) * DIN; kv = *(const u32x4*)(src + C_KA + g * 64 + ch * 8); vv = *(const u32x4*)(src + C_VA + g * 64 + ch * 8); }
        *(LAS u32x4*)(Kimg + kidx * 144 + ch * 16) = kv; *(LAS u32x4*)(Vimg + kidx * 144 + ch * 16) = vv;
    }
    const size_t qrow = rowbase + 16 * wave + fr;
    bf16x8 qf[2];
#pragma unroll
    for (int ks = 0; ks < 2; ++ks) qf[ks] = *(const bf16x8*)(H + qrow * DIN + C_QA + head * 64 + 32 * ks + 8 * fq);
    __syncthreads();
    f32x4 s[10];
#pragma unroll
    for (int nn = 0; nn < 9; ++nn) {
        s[nn] = (f32x4){0.f, 0.f, 0.f, 0.f};
        const int krow = 16 * (wave + nn) + fr;
#pragma unroll
        for (int ks = 0; ks < 2; ++ks) { const bf16x8 kf = *(const LAS bf16x8*)(Kimg + krow * 144 + (32 * ks + 8 * fq) * 2); s[nn] = __builtin_amdgcn_mfma_f32_16x16x32_bf16(kf, qf[ks], s[nn], 0, 0, 0); }
    }
    s[9] = (f32x4){0.f, 0.f, 0.f, 0.f};
    const int qi = 16 * wave + fr; const float sink = sinks[head];
    float mx = sink;
#pragma unroll
    for (int nn = 0; nn < 9; ++nn)
#pragma unroll
        for (int r = 0; r < 4; ++r) { const int kidx = 16 * (wave + nn) + 4 * fq + r; const bool valid = (kidx > qi) && (kidx <= qi + 128) && (qb > 0 || kidx >= 128);
            s[nn][r] = valid ? s[nn][r] : -1e30f; mx = fmaxf(mx, s[nn][r]); }
    mx = fmaxf(mx, __shfl_xor(mx, 16)); mx = fmaxf(mx, __shfl_xor(mx, 32));
    float sum = 0.f;
#pragma unroll
    for (int nn = 0; nn < 9; ++nn)
#pragma unroll
        for (int r = 0; r < 4; ++r) { const float p = s[nn][r] > -1e29f ? __expf(s[nn][r] - mx) : 0.f; s[nn][r] = p; sum += p; }
    sum += __shfl_xor(sum, 16); sum += __shfl_xor(sum, 32);
    sum += __expf(sink - mx);
    f32x4 o[4];
#pragma unroll
    for (int db = 0; db < 4; ++db) o[db] = (f32x4){0.f, 0.f, 0.f, 0.f};
    const int tq = (lane & 15) >> 2, tpp = lane & 3;
#pragma unroll
    for (int G = 0; G < 5; ++G) {
        const u32x4 pw = {pk2(s[2 * G][0], s[2 * G][1]), pk2(s[2 * G][2], s[2 * G][3]), pk2(s[2 * G + 1][0], s[2 * G + 1][1]), pk2(s[2 * G + 1][2], s[2 * G + 1][3])};
        const bf16x8 pf = __builtin_bit_cast(bf16x8, pw);
        int k0 = 16 * (wave + 2 * G) + 4 * fq + tq, k1 = k0 + 16; k0 = k0 > 255 ? 255 : k0; k1 = k1 > 255 ? 255 : k1;
#pragma unroll
        for (int db = 0; db < 4; ++db) {
            const bf16x8 vf = tr_pair(Vimg + k0 * 144 + (16 * db + 4 * tpp) * 2, Vimg + k1 * 144 + (16 * db + 4 * tpp) * 2);
            o[db] = __builtin_amdgcn_mfma_f32_16x16x32_bf16(vf, pf, o[db], 0, 0, 0);
        }
    }
    const float inv = 1.0f / sum;
#pragma unroll
    for (int db = 0; db < 4; ++db) { u32x2 w; w.x = pk2(o[db][0] * inv, o[db][1] * inv); w.y = pk2(o[db][2] * inv, o[db][3] * inv);
        *(u32x2*)(H + qrow * DIN + C_QA + head * 64 + 16 * db + 4 * fq) = w; }
    __syncthreads();
}

__device__ __forceinline__ void attn_sample_unit(const Args& a, bf16_t* H, LAS unsigned char* lds, int b, int tid, int lane, int wave) {
    const int head = wave, g = head >> 2; const size_t r0 = (size_t)MP + 4 * b;
    LAS float* qs = (LAS float*)(lds + wave * 4096); LAS float* ps = qs + 256;
#pragma unroll
    for (int t = 0; t < 4; ++t) qs[t * 64 + lane] = bf2f(H[(r0 + t) * DIN + C_QA + head * 64 + lane]);
    asm volatile("s_waitcnt lgkmcnt(0)" ::: "memory");
    float sc[3][4];
    {
        const float* kp0 = a.cache_k + ((size_t)(b * 128 + lane) * 2 + g) * 64; const float* kp1 = kp0 + (size_t)64 * 128;
        const bf16_t* kpn = H + (r0 + (lane & 3)) * DIN + C_KA + g * 64;
#pragma unroll
        for (int t = 0; t < 4; ++t) { sc[0][t] = 0.f; sc[1][t] = 0.f; sc[2][t] = 0.f; }
#pragma nounroll
        for (int hf = 0; hf < 2; ++hf) {
            f32x4 kv0[8], kv1[8]; u32x4 kw[4];
#pragma unroll
            for (int d4 = 0; d4 < 8; ++d4) { kv0[d4] = *(const f32x4*)(kp0 + 32 * hf + 4 * d4); kv1[d4] = *(const f32x4*)(kp1 + 32 * hf + 4 * d4); }
#pragma unroll
            for (int c8 = 0; c8 < 4; ++c8) kw[c8] = *(const u32x4*)(kpn + 32 * hf + 8 * c8);
#pragma unroll
            for (int d4 = 0; d4 < 8; ++d4)
#pragma unroll
                for (int e = 0; e < 4; ++e) { const int d = 4 * d4 + e; const unsigned w = kw[d >> 3][(d & 7) >> 1]; const float kn = (d & 1) ? bfhi(w) : bflo(w);
#pragma unroll
                    for (int t = 0; t < 4; ++t) { const float q = qs[t * 64 + 32 * hf + d]; sc[0][t] += q * kv0[d4][e]; sc[1][t] += q * kv1[d4][e]; sc[2][t] += q * kn; } }
        }
    }
    const float sink = a.sinks[head];
    float inv[4];
#pragma unroll
    for (int t = 0; t < 4; ++t) {
        const bool v0 = lane > t, v1 = true, v2 = (lane < 4) && (lane <= t);
        const float s0 = v0 ? sc[0][t] : -1e30f, s1 = v1 ? sc[1][t] : -1e30f, s2 = v2 ? sc[2][t] : -1e30f;
        const float mx = fmaxf(wave_max(fmaxf(fmaxf(s0, s1), s2)), sink);
        const float p0 = v0 ? __expf(s0 - mx) : 0.f, p1 = __expf(s1 - mx), p2 = v2 ? __expf(s2 - mx) : 0.f;
        const float sum = wave_sum(p0 + p1 + p2) + __expf(sink - mx);
        inv[t] = 1.0f / sum;
        ps[t * 136 + lane] = p0; ps[t * 136 + 64 + lane] = p1; if (lane < 4) ps[t * 136 + 128 + lane] = p2;
    }
    asm volatile("s_waitcnt lgkmcnt(0)" ::: "memory");
    float o0 = 0.f, o1 = 0.f, o2 = 0.f, o3 = 0.f;
    const float* vp = a.cache_v + ((size_t)(b * 128) * 2 + g) * 64 + lane;
#pragma nounroll
    for (int rb = 0; rb < 2; ++rb) {
        float vx[64];
#pragma unroll
        for (int r = 0; r < 64; ++r) vx[r] = vp[(size_t)(64 * rb + r) * 128];
#pragma unroll
        for (int r = 0; r < 64; ++r) { const int rr = 64 * rb + r; o0 += ps[0 * 136 + rr] * vx[r]; o1 += ps[1 * 136 + rr] * vx[r]; o2 += ps[2 * 136 + rr] * vx[r]; o3 += ps[3 * 136 + rr] * vx[r]; }
    }
#pragma unroll
    for (int tn = 0; tn < 4; ++tn) { const float vx = bf2f(H[(r0 + tn) * DIN + C_VA + g * 64 + lane]); o0 += ps[0 * 136 + 128 + tn] * vx; o1 += ps[1 * 136 + 128 + tn] * vx; o2 += ps[2 * 136 + 128 + tn] * vx; o3 += ps[3 * 136 + 128 + tn] * vx; }
    H[(r0 + 0) * DIN + C_QA + head * 64 + lane] = (bf16_t)(pk2(o0 * inv[0], 0.f) & 0xffffu);
    H[(r0 + 1) * DIN + C_QA + head * 64 + lane] = (bf16_t)(pk2(o1 * inv[1], 0.f) & 0xffffu);
    H[(r0 + 2) * DIN + C_QA + head * 64 + lane] = (bf16_t)(pk2(o2 * inv[2], 0.f) & 0xffffu);
    H[(r0 + 3) * DIN + C_QA + head * 64 + lane] = (bf16_t)(pk2(o3 * inv[3], 0.f) & 0xffffu);
    float* ko = a.out + O_KS + (size_t)b * 128 * 128; float* vo = a.out + O_VS + (size_t)b * 128 * 128;
    const float* ki = a.cache_k + (size_t)b * 128 * 128 + 4 * 128; const float* vi = a.cache_v + (size_t)b * 128 * 128 + 4 * 128;
    for (int i = tid; i < 124 * 32; i += NTHREADS) { ((f32x4*)ko)[i] = ((const f32x4*)ki)[i]; ((f32x4*)vo)[i] = ((const f32x4*)vi)[i]; }
    { const int t = tid >> 7, gd = tid & 127;
      ko[(size_t)(124 + t) * 128 + gd] = bf2f(H[(r0 + t) * DIN + C_KA + gd]); vo[(size_t)(124 + t) * 128 + gd] = bf2f(H[(r0 + t) * DIN + C_VA + gd]); }
}

__device__ __forceinline__ void ret_u_unit(const bf16_t* H, bf16_t* ST, LAS unsigned char* lds, int b, int c, int h, int tid, int lane, int wave) {
    const size_t rowc = (size_t)b * TSEQ + (size_t)c * 128; const float l2g = ret_log2g(h);
    LAS unsigned char* Kimg = lds; LAS unsigned char* Vimg = lds + 36864;
#pragma unroll
    for (int i = 0; i < 4; ++i) { const int id = tid + NTHREADS * i, j = id >> 4, ch = id & 15;
        const u32x4 kv = *(const u32x4*)(H + (rowc + j) * DIN + C_KR + h * 128 + ch * 8); const float kd = exp2f(l2g * (float)(127 - j));
        u32x4 w; w.x = pk2(bflo(kv.x) * kd, bfhi(kv.x) * kd); w.y = pk2(bflo(kv.y) * kd, bfhi(kv.y) * kd); w.z = pk2(bflo(kv.z) * kd, bfhi(kv.z) * kd); w.w = pk2(bflo(kv.w) * kd, bfhi(kv.w) * kd);
        *(LAS u32x4*)(Kimg + j * 288 + ch * 16) = w; }
#pragma unroll
    for (int i = 0; i < 8; ++i) { const int id = tid + NTHREADS * i, j = id >> 5, ch = id & 31;
        *(LAS u32x4*)(Vimg + j * 544 + ch * 16) = *(const u32x4*)(H + (rowc + j) * DIN + C_VR + h * 256 + ch * 8); }
    __syncthreads();
    const int fr = lane & 15, fq = lane >> 4, tq = fr >> 2, tpp = lane & 3;
    f32x4 acc[2][8];
#pragma unroll
    for (int i = 0; i < 2; ++i)
#pragma unroll
        for (int j = 0; j < 8; ++j) acc[i][j] = (f32x4){0.f, 0.f, 0.f, 0.f};
#pragma unroll
    for (int ks = 0; ks < 4; ++ks) {
        const int j0 = 32 * ks + 4 * fq + tq, j1 = j0 + 16;
        bf16x8 vf[2];
#pragma unroll
        for (int i = 0; i < 2; ++i) { const int col = 16 * (2 * wave + i) + 4 * tpp; vf[i] = tr_pair(Vimg + j0 * 544 + col * 2, Vimg + j1 * 544 + col * 2); }
#pragma unroll
        for (int kb = 0; kb < 8; ++kb) { const int col = 16 * kb + 4 * tpp; const bf16x8 kf = tr_pair(Kimg + j0 * 288 + col * 2, Kimg + j1 * 288 + col * 2);
#pragma unroll
            for (int i = 0; i < 2; ++i) acc[i][kb] = __builtin_amdgcn_mfma_f32_16x16x32_bf16(vf[i], kf, acc[i][kb], 0, 0, 0); }
    }
    bf16_t* U = ST + ((size_t)(b * 32 + c) * 4 + h) * 32768;
#pragma unroll
    for (int i = 0; i < 2; ++i)
#pragma unroll
        for (int kb = 0; kb < 8; ++kb) { u32x2 w; w.x = pk2(acc[i][kb][0], acc[i][kb][1]); w.y = pk2(acc[i][kb][2], acc[i][kb][3]); *(u32x2*)(U + (size_t)(16 * kb + fr) * 256 + 16 * (2 * wave + i) + 4 * fq) = w; }
    __syncthreads();
}

__device__ __forceinline__ void ret_sample_unit(const Args& a, bf16_t* H, LAS unsigned char* lds, int b, int h, int tid, int lane, int wave) {
    const size_t r0 = (size_t)MP + 4 * b; const float g = 1.0f - exp2f(-5.0f - (float)h);
    LAS float* qs = (LAS float*)lds; LAS float* ks = qs + 512; LAS float* po = ks + 512; LAS float* red = po + 2048;
    const int dv = tid & 255, half = tid >> 8;
    for (int i = tid; i < 1024; i += NTHREADS) { const int which = i >> 9, t = (i >> 7) & 3, d = i & 127;
        const float v = bf2f(H[(r0 + t) * DIN + (which ? C_KR : C_QR) + h * 128 + d]); if (which) ks[t * 128 + d] = v; else qs[t * 128 + d] = v; }
    float vt[4], gt[4];
#pragma unroll
    for (int t = 0; t < 4; ++t) { vt[t] = bf2f(H[(r0 + t) * DIN + C_VR + h * 256 + dv]); gt[t] = bf2f(H[(r0 + t) * DIN + C_GATE + h * 256 + dv]); }
    float S[64];
    const float* sp = a.state_ret + ((size_t)(b * 4 + h) * 128 + 64 * half) * 256 + dv;
#pragma unroll
    for (int d = 0; d < 64; ++d) S[d] = sp[(size_t)d * 256];
    __syncthreads();
#pragma unroll
    for (int t = 0; t < 4; ++t) { float o = 0.f;
#pragma unroll
        for (int d = 0; d < 64; ++d) { S[d] = g * S[d] + ks[t * 128 + 64 * half + d] * vt[t]; o += qs[t * 128 + 64 * half + d] * S[d]; }
        po[(half * 4 + t) * 256 + dv] = o; }
    float* so = a.out + O_RS + ((size_t)(b * 4 + h) * 128 + 64 * half) * 256 + dv;
#pragma unroll
    for (int d = 0; d < 64; ++d) so[(size_t)d * 256] = S[d];
    __syncthreads();
    float ot[4];
#pragma unroll
    for (int t = 0; t < 4; ++t) { ot[t] = po[t * 256 + dv] + po[(4 + t) * 256 + dv]; const float sq = wave_sum(half == 0 ? ot[t] * ot[t] : 0.f); if (lane == 0) red[wave * 4 + t] = sq; }
    __syncthreads();
    if (half == 0) {
#pragma unroll
        for (int t = 0; t < 4; ++t) { float ss = 0.f;
#pragma unroll
            for (int w = 0; w < 8; ++w) ss += red[w * 4 + t];
            const float rstd = rsqrtf(ss * (1.f / 256.f) + EPS); const float gv = gt[t]; const float sil = gv / (1.0f + __expf(-gv));
            H[(r0 + t) * DIN + C_VR + h * 256 + dv] = (bf16_t)(pk2(ot[t] * rstd * sil, 0.f) & 0xffffu); }
    }
    __syncthreads();
}

__device__ __forceinline__ void ret_out_unit(bf16_t* H, const bf16_t* ST, LAS unsigned char* lds, int b, int c, int h, int tid, int lane, int wave) {
    const size_t rowc = (size_t)b * TSEQ + (size_t)c * 128; const float l2g = ret_log2g(h);
    LAS unsigned char* Kimg = lds; LAS unsigned char* BIG = lds + 36864;
    const int fr = lane & 15, fq = lane >> 4, tq = fr >> 2, tpp = lane & 3;
    const int qi = 16 * wave + fr; const size_t qrow = rowc + qi;
    u32x4 kreg[4], sreg[8], vreg[8]; u32x2 greg[16];
#pragma unroll
    for (int i = 0; i < 4; ++i) { const int id = tid + NTHREADS * i, j = id >> 4, ch = id & 15; kreg[i] = *(const u32x4*)(H + (rowc + j) * DIN + C_KR + h * 128 + ch * 8); }
    if (c > 0) {
        const bf16_t* S = ST + ((size_t)(b * 32 + c) * 4 + h) * 32768;
#pragma unroll
        for (int i = 0; i < 8; ++i) { const int id = tid + NTHREADS * i, dk = id >> 5, ch = id & 31; sreg[i] = *(const u32x4*)(S + (size_t)dk * 256 + ch * 8); }
    }
    bf16x8 qf[4];
#pragma unroll
    for (int ks = 0; ks < 4; ++ks) { const bf16_t* qp = H + qrow * DIN + C_QR + h * 128 + 32 * ks + 4 * fq; qf[ks] = cat8(*(const u32x2*)qp, *(const u32x2*)(qp + 16)); }
#pragma unroll
    for (int i = 0; i < 8; ++i) { const int id = tid + NTHREADS * i, j = id >> 5, ch = id & 31; vreg[i] = *(const u32x4*)(H + (rowc + j) * DIN + C_VR + h * 256 + ch * 8); }
#pragma unroll
    for (int i = 0; i < 4; ++i) { const int id = tid + NTHREADS * i, j = id >> 4, ch = id & 15; *(LAS u32x4*)(Kimg + j * 288 + ch * 16) = kreg[i]; }
    if (c > 0) {
#pragma unroll
        for (int i = 0; i < 8; ++i) { const int id = tid + NTHREADS * i, dk = id >> 5, ch = id & 31; *(LAS u32x4*)(BIG + dk * 544 + ch * 16) = sreg[i]; }
    }
    __syncthreads();
    f32x4 acc[16];
#pragma unroll
    for (int k = 0; k < 16; ++k) acc[k] = (f32x4){0.f, 0.f, 0.f, 0.f};
    if (c > 0) {
#pragma unroll
        for (int ks = 0; ks < 4; ++ks) { const int d0 = 32 * ks + 4 * fq + tq, d1 = d0 + 16;
#pragma unroll
            for (int blk = 0; blk < 16; ++blk) { const bf16x8 sf = tr_pair(BIG + d0 * 544 + (16 * blk + 4 * tpp) * 2, BIG + d1 * 544 + (16 * blk + 4 * tpp) * 2);
                acc[blk] = __builtin_amdgcn_mfma_f32_16x16x32_bf16(sf, qf[ks], acc[blk], 0, 0, 0); } }
        const float qd = exp2f(l2g * (float)(qi + 1));
#pragma unroll
        for (int blk = 0; blk < 16; ++blk) acc[blk] = acc[blk] * qd;
    }
    bf16x8 pf[4];
#pragma unroll
    for (int G = 0; G < 4; ++G) {
        f32x4 sc[2];
#pragma unroll
        for (int e = 0; e < 2; ++e) { const int jb = 2 * G + e; sc[e] = (f32x4){0.f, 0.f, 0.f, 0.f};
            if (jb <= wave) {
#pragma unroll
                for (int ks = 0; ks < 4; ++ks) { const LAS unsigned char* kp = Kimg + (16 * jb + fr) * 288 + (32 * ks + 4 * fq) * 2;
                    const bf16x8 kf = cat8(*(const LAS u32x2*)kp, *(const LAS u32x2*)(kp + 32)); sc[e] = __builtin_amdgcn_mfma_f32_16x16x32_bf16(kf, qf[ks], sc[e], 0, 0, 0); }
#pragma unroll
                for (int r = 0; r < 4; ++r) { const int j = 16 * jb + 4 * fq + r; sc[e][r] = (j <= qi) ? sc[e][r] * exp2f(l2g * (float)(qi - j)) : 0.f; }
            } }
        const u32x4 pw = {pk2(sc[0][0], sc[0][1]), pk2(sc[0][2], sc[0][3]), pk2(sc[1][0], sc[1][1]), pk2(sc[1][2], sc[1][3])};
        pf[G] = __builtin_bit_cast(bf16x8, pw);
    }
    __syncthreads();
#pragma unroll
    for (int i = 0; i < 8; ++i) { const int id = tid + NTHREADS * i, j = id >> 5, ch = id & 31; *(LAS u32x4*)(BIG + j * 544 + ch * 16) = vreg[i]; }
#pragma unroll
    for (int blk = 0; blk < 16; ++blk) greg[blk] = *(const u32x2*)(H + qrow * DIN + C_GATE + h * 256 + 16 * blk + 4 * fq);
    __syncthreads();
#pragma unroll
    for (int G = 0; G < 4; ++G) {
        if (2 * G <= wave) { const int j0 = 32 * G + 4 * fq + tq, j1 = j0 + 16;
#pragma unroll
            for (int blk = 0; blk < 16; ++blk) { const bf16x8 vf = tr_pair(BIG + j0 * 544 + (16 * blk + 4 * tpp) * 2, BIG + j1 * 544 + (16 * blk + 4 * tpp) * 2);
                acc[blk] = __builtin_amdgcn_mfma_f32_16x16x32_bf16(vf, pf[G], acc[blk], 0, 0, 0); } }
    }
    float ss = 0.f;
#pragma unroll
    for (int blk = 0; blk < 16; ++blk) ss += (acc[blk][0] * acc[blk][0] + acc[blk][1] * acc[blk][1]) + (acc[blk][2] * acc[blk][2] + acc[blk][3] * acc[blk][3]);
    ss += __shfl_xor(ss, 16); ss += __shfl_xor(ss, 32);
    const float rstd = rsqrtf(ss * (1.f / 256.f) + EPS);
#pragma unroll
    for (int blk = 0; blk < 16; ++blk) {
        const u32x2 gw = greg[blk];
        const float g0 = bflo(gw.x), g1 = bfhi(gw.x), g2 = bflo(gw.y), g3 = bfhi(gw.y);
        u32x2 w; w.x = pk2(acc[blk][0] * rstd * g0 / (1.f + __expf(-g0)), acc[blk][1] * rstd * g1 / (1.f + __expf(-g1)));
        w.y = pk2(acc[blk][2] * rstd * g2 / (1.f + __expf(-g2)), acc[blk][3] * rstd * g3 / (1.f + __expf(-g3)));
        *(u32x2*)(H + qrow * DIN + C_VR + h * 256 + 16 * blk + 4 * fq) = w;
    }
    __syncthreads();
}

__device__ __forceinline__ f32x4 tail_gemm(const bf16_t* A, int lda, const bf16_t* Bt, int K, LAS unsigned char* lds, int tid, int lane, int wave, f32x4 acc) {
    const int fr = lane & 15, fq = lane >> 4, nc = K / 512;
    LAS unsigned char* Ai = lds; LAS unsigned char* Bi = lds + 33280;
    u32x4 ra[4], rb[8];
#pragma unroll
    for (int i = 0; i < 4; ++i) { const int id = tid + NTHREADS * i; ra[i] = *(const u32x4*)(A + (size_t)(id >> 6) * lda + (id & 63) * 8); }
#pragma unroll
    for (int i = 0; i < 8; ++i) { const int id = tid + NTHREADS * i; rb[i] = *(const u32x4*)(Bt + (size_t)(id >> 6) * K + (id & 63) * 8); }
#pragma nounroll
    for (int c = 0; c < nc; ++c) {
#pragma unroll
        for (int i = 0; i < 4; ++i) { const int id = tid + NTHREADS * i; *(LAS u32x4*)(Ai + (id >> 6) * 1040 + (id & 63) * 16) = ra[i]; }
#pragma unroll
        for (int i = 0; i < 8; ++i) { const int id = tid + NTHREADS * i; *(LAS u32x4*)(Bi + (id >> 6) * 1040 + (id & 63) * 16) = rb[i]; }
        __syncthreads();
        if (c + 1 < nc) {
#pragma unroll
            for (int i = 0; i < 4; ++i) { const int id = tid + NTHREADS * i; ra[i] = *(const u32x4*)(A + (size_t)(id >> 6) * lda + (c + 1) * 512 + (id & 63) * 8); }
#pragma unroll
            for (int i = 0; i < 8; ++i) { const int id = tid + NTHREADS * i; rb[i] = *(const u32x4*)(Bt + (size_t)(id >> 6) * K + (c + 1) * 512 + (id & 63) * 8); }
        }
        const LAS unsigned char* ap = Ai + (16 * (wave >> 2) + fr) * 1040 + fq * 16; const LAS unsigned char* bp = Bi + (16 * (wave & 3) + fr) * 1040 + fq * 16;
#pragma unroll
        for (int ks = 0; ks < 16; ++ks) { const bf16x8 av = *(const LAS bf16x8*)(ap + ks * 64), bv = *(const LAS bf16x8*)(bp + ks * 64); acc = __builtin_amdgcn_mfma_f32_16x16x32_bf16(bv, av, acc, 0, 0, 0); }
        __syncthreads();
    }
    return acc;
}

__global__ void __launch_bounds__(NTHREADS, 2) fwd_megakernel(Args a) {
    extern __shared__ __attribute__((aligned(16))) unsigned char lds_raw[];
    LAS unsigned char* lds = (LAS unsigned char*)lds_raw;
    cg::grid_group grid = cg::this_grid();
    const int tid = threadIdx.x, lane = tid & 63, wave = __builtin_amdgcn_readfirstlane(tid >> 6);
    const int nblk = gridDim.x, blk = blockIdx.x;
    unsigned char* ws = a.ws;
    bf16_t* WinT = (bf16_t*)(ws + WS_WIN); bf16_t* WupT = (bf16_t*)(ws + WS_WUP); bf16_t* WdnT = (bf16_t*)(ws + WS_WDN);
    bf16_t* WoT = (bf16_t*)(a.out + O_CS); bf16_t* WaT = WoT + 1024 * 1024; bf16_t* WrT = WaT + 1024 * 512;
    bf16_t* XN = (bf16_t*)(ws + WS_XN); bf16_t* H = (bf16_t*)(ws + WS_R1);
    bf16_t* MIXb = (bf16_t*)(ws + WS_R1);
    bf16_t* G = (bf16_t*)(ws + WS_R1 + R1_G); bf16_t* Fb = (bf16_t*)(ws + WS_R1 + R1_F); bf16_t* X1b = (bf16_t*)(ws + WS_R1 + R1_X1); bf16_t* UH = (bf16_t*)(ws + WS_R1 + R1_UH); bf16_t* US = (bf16_t*)(ws + WS_R1 + R1_US);
    bf16_t* ST = (bf16_t*)(a.out + O_Y);
    float* Y = a.out + O_Y;
    const int lo = a.ph_lo, hi = a.ph_hi;
#ifndef PROBE_REP_MASK
#define PROBE_REP_MASK 0
#endif
#define IN(k) (lo <= (k) && (k) < hi)
#define REPS(k) (((PROBE_REP_MASK >> (k)) & 1) ? 2 : 1)
#define SEAM(k) do { if (IN(k) && IN((k) + 1)) { asm volatile("s_waitcnt vmcnt(0)" ::: "memory"); __syncthreads(); grid.sync(); } } while (0)

    if (IN(0)) { p0_prologue(a, lds, tid, lane, wave); }
    SEAM(0);
    if (IN(1)) {
        pg8::Gemm g{XN, WinT, M, DIN, D, D}; pg8::StaticOrder S; S.init(M, DIN, nblk, blk);
        pg8::EpiH E{H, (const pg8::f32x2e*)(ws + WS_TABA), (const pg8::f32x2e*)(ws + WS_TABR)};
        pg8::gemm_phase<pg8::EpiH, pg8::StaticOrder, true, true>(lds, g, S, E);
    }
    SEAM(1);
    if (IN(2)) {
        for (int u = blk; u < 1024; u += nblk) { const int head = u & 7, qb = (u >> 3) & 31, b = u >> 8; attn_prompt_unit(H, a.sinks, lds, b, qb, head, tid, lane, wave); }
        for (int u = blk; u < 512; u += nblk) { const int h = u & 3, c = (u >> 2) & 31, b = u >> 7; ret_u_unit(H, ST, lds, b, c, h, tid, lane, wave); }
        for (int u = blk; u < 128; u += nblk) { attn_sample_unit(a, H, lds, u, tid, lane, wave); __syncthreads(); }
        for (int u = blk; u < 512; u += nblk) { ret_sample_unit(a, H, lds, u >> 2, u & 3, tid, lane, wave); }
        for (int e = blk * NTHREADS + tid; e < 4 * 128 * 128; e += nblk * NTHREADS) { const int gd = e & 127, r = (e >> 7) & 127, b = e >> 14; const size_t row = (size_t)b * TSEQ + TSEQ - 128 + r;
            a.out[O_KP + e] = bf2f(H[row * DIN + C_KA + gd]); a.out[O_VP + e] = bf2f(H[row * DIN + C_VA + gd]); }
    }
    SEAM(2);
    if (IN(3)) {
        for (int e4 = blk * NTHREADS + tid; e4 < 16 * 8192; e4 += nblk * NTHREADS) {
            const int bh = e4 >> 13, idx = (e4 & 8191) * 4, b = bh >> 2, h = bh & 3;
            const float gL = exp2f(128.f * ret_log2g(h));
            f32x4 S = {0.f, 0.f, 0.f, 0.f};
#pragma unroll 8
            for (int c = 0; c < 32; ++c) { bf16_t* p = ST + ((size_t)(b * 32 + c) * 4 + h) * 32768 + idx; const u32x2 uw = *(const u32x2*)p; u32x2 sw; sw.x = pk2(S.x, S.y); sw.y = pk2(S.z, S.w); *(u32x2*)p = sw;
                const f32x4 uu = {bflo(uw.x), bfhi(uw.x), bflo(uw.y), bfhi(uw.y)}; S = S * gL + uu; }
            *(f32x4*)(a.out + O_RP + (size_t)bh * 32768 + idx) = S;
        }
    }
    SEAM(3);
    if (IN(4)) {
        for (int u = blk; u < 512; u += nblk) { const int h = u & 3, c = (u >> 2) & 31, b = u >> 7; ret_out_unit(H, ST, lds, b, c, h, tid, lane, wave); }
    }
    SEAM(4);
    if (IN(5)) {
        { pg8::Gemm g{H + C_QA, WaT, MP, D, 512, DIN}; pg8::StaticOrder S; S.init(MP, D, nblk, blk);
          pg8::EpiGate<false> E{XN, H + C_GMA, DIN}; pg8::gemm_phase<pg8::EpiGate<false>, pg8::StaticOrder, true, true>(lds, g, S, E); }
        __syncthreads();
        { pg8::Gemm g{H + C_VR, WrT, MP, D, D, DIN}; pg8::StaticOrder S; S.init(MP, D, nblk, blk);
          pg8::EpiGate<true> E{XN, H + C_GMR, DIN}; pg8::gemm_phase<pg8::EpiGate<true>, pg8::StaticOrder, true, true>(lds, g, S, E); }
        for (int piece = blk; piece < 256; piece += nblk) {
            const int fr = lane & 15, fq = lane >> 4; const size_t prow = (size_t)MP + 32 * (piece >> 4); const size_t row = prow + 16 * (wave >> 2) + fr; const int pcol = 64 * (piece & 15), col0 = pcol + 16 * (wave & 3);
            const f32x4 aa = tail_gemm(H + prow * DIN + C_QA, DIN, WaT + (size_t)pcol * 512, 512, lds, tid, lane, wave, (f32x4){0.f, 0.f, 0.f, 0.f});
            const f32x4 ar = tail_gemm(H + prow * DIN + C_VR, DIN, WrT + (size_t)pcol * 1024, 1024, lds, tid, lane, wave, (f32x4){0.f, 0.f, 0.f, 0.f});
            const int cb = col0 + 4 * fq;
            const u32x2 ga = *(const u32x2*)(H + row * DIN + C_GMA + cb), gr = *(const u32x2*)(H + row * DIN + C_GMR + cb);
            u32x2 w; w.x = pk2(pg8::sigmoidf_(bflo(ga.x)) * aa[0] + pg8::sigmoidf_(bflo(gr.x)) * ar[0], pg8::sigmoidf_(bfhi(ga.x)) * aa[1] + pg8::sigmoidf_(bfhi(gr.x)) * ar[1]);
            w.y = pk2(pg8::sigmoidf_(bflo(ga.y)) * aa[2] + pg8::sigmoidf_(bflo(gr.y)) * ar[2], pg8::sigmoidf_(bfhi(ga.y)) * aa[3] + pg8::sigmoidf_(bfhi(gr.y)) * ar[3]);
            *(u32x2*)(XN + row * D + cb) = w;
        }
    }
    SEAM(5);
    if (IN(6)) {
        pg8::Gemm g{XN, WoT, MP, D, D, D}; pg8::StaticOrder S; S.init(MP, D, nblk, blk);
        pg8::EpiBf16<0> E{MIXb, D, nullptr, 0, 0, 1.f}; pg8::gemm_phase<pg8::EpiBf16<0>, pg8::StaticOrder, true, true>(lds, g, S, E);
        for (int piece = blk; piece < 256; piece += nblk) {
            const int fr = lane & 15, fq = lane >> 4; const size_t prow = (size_t)MP + 32 * (piece >> 4); const size_t row = prow + 16 * (wave >> 2) + fr; const int pcol = 64 * (piece & 15), col0 = pcol + 16 * (wave & 3);
            const f32x4 ac = tail_gemm(XN + prow * D, D, WoT + (size_t)pcol * 1024, 1024, lds, tid, lane, wave, (f32x4){0.f, 0.f, 0.f, 0.f});
            u32x2 w; w.x = pk2(ac[0], ac[1]); w.y = pk2(ac[2], ac[3]); *(u32x2*)(MIXb + row * D + col0 + 4 * fq) = w;
        }
    }
    SEAM(6);
    if (IN(7)) {
        f32x4 gpm[2][2], gpf[2][2];
#pragma unroll
        for (int j = 0; j < 2; ++j)
#pragma unroll
            for (int e = 0; e < 2; ++e) { gpm[j][e] = *((const f32x4*)a.g_post_mix + 2 * (lane + 64 * j) + e); gpf[j][e] = *((const f32x4*)a.g_pre_ffn + 2 * (lane + 64 * j) + e); }
        for (int p = blk * NWAVES + wave; p < M / 2; p += nblk * NWAVES) {
            u32x4 mb[2][2]; f32x4 xx[2][2][2];
#pragma unroll
            for (int rr = 0; rr < 2; ++rr) { const int m = 2 * p + rr; const float* xr = m < MP ? a.x_prompt + (size_t)m * D : a.x_sample + (size_t)(m - MP) * D;
#pragma unroll
                for (int j = 0; j < 2; ++j) { mb[rr][j] = *((const u32x4*)(MIXb + (size_t)m * D) + lane + 64 * j); xx[rr][j][0] = *((const f32x4*)xr + 2 * (lane + 64 * j)); xx[rr][j][1] = *((const f32x4*)xr + 2 * (lane + 64 * j) + 1); } }
            float mv[2][2][8]; float ss[2];
#pragma unroll
            for (int rr = 0; rr < 2; ++rr) { ss[rr] = 0.f;
#pragma unroll
                for (int j = 0; j < 2; ++j)
#pragma unroll
                    for (int q = 0; q < 4; ++q) { const unsigned w = mb[rr][j][q]; mv[rr][j][2 * q] = bflo(w); mv[rr][j][2 * q + 1] = bfhi(w); ss[rr] += mv[rr][j][2 * q] * mv[rr][j][2 * q] + mv[rr][j][2 * q + 1] * mv[rr][j][2 * q + 1]; } }
            ss[0] = wave_sum(ss[0]); ss[1] = wave_sum(ss[1]);
            float s2[2];
#pragma unroll
            for (int rr = 0; rr < 2; ++rr) { const float rstd = rsqrtf(ss[rr] * (1.f / D) + EPS); s2[rr] = 0.f;
#pragma unroll
                for (int j = 0; j < 2; ++j)
#pragma unroll
                    for (int q = 0; q < 8; ++q) { const float x1 = xx[rr][j][q >> 2][q & 3] + mv[rr][j][q] * rstd * gpm[j][q >> 2][q & 3]; mv[rr][j][q] = x1; s2[rr] += x1 * x1; } }
            s2[0] = wave_sum(s2[0]); s2[1] = wave_sum(s2[1]);
#pragma unroll
            for (int rr = 0; rr < 2; ++rr) { const int m = 2 * p + rr; const float rstd2 = rsqrtf(s2[rr] * (1.f / D) + EPS);
#pragma unroll
                for (int j = 0; j < 2; ++j) { u32x4 w1, w2;
#pragma unroll
                    for (int q = 0; q < 4; ++q) { const float a0 = mv[rr][j][2 * q], a1 = mv[rr][j][2 * q + 1]; w1[q] = pk2(a0, a1);
                        w2[q] = pk2(a0 * rstd2 * gpf[j][(2 * q) >> 2][(2 * q) & 3], a1 * rstd2 * gpf[j][(2 * q + 1) >> 2][(2 * q + 1) & 3]); }
                    *((u32x4*)(X1b + (size_t)m * D) + lane + 64 * j) = w1; *((u32x4*)(XN + (size_t)m * D) + lane + 64 * j) = w2; } }
        }
    }
    SEAM(7);
    if (IN(8)) {
        pg8::Gemm g{XN, WupT, M, F2, D, D}; pg8::StaticOrder S; S.init(M, F2, nblk, blk);
        pg8::EpiUp E{G, UH, US, a.out + O_CP, a.out + O_CS, a.conv_w, a.conv_b};
        pg8::gemm_phase<pg8::EpiUp, pg8::StaticOrder, true, true>(lds, g, S, E);
    }
    SEAM(8);
    if (IN(9)) {
        for (int task = blk * NWAVES + wave; task < 1024 * 6; task += nblk * NWAVES) {
            const int rt = task / 6, chunk = task % 6; const int ch = chunk * 512 + lane * 8;
            float ua[3][8], ub[3][8];
            int row;
#define LD8BF(dst, ptr) do { const u32x4 _w = *(const u32x4*)(ptr); dst[0] = bflo(_w.x); dst[1] = bfhi(_w.x); dst[2] = bflo(_w.y); dst[3] = bfhi(_w.y); dst[4] = bflo(_w.z); dst[5] = bfhi(_w.z); dst[6] = bflo(_w.w); dst[7] = bfhi(_w.w); } while (0)
#define LD8F(dst, ptr) do { const f32x4 _a = *(const f32x4*)(ptr), _b = *(const f32x4*)((ptr) + 4); dst[0] = _a.x; dst[1] = _a.y; dst[2] = _a.z; dst[3] = _a.w; dst[4] = _b.x; dst[5] = _b.y; dst[6] = _b.z; dst[7] = _b.w; } while (0)
#define ZERO8(dst) do { _Pragma("unroll") for (int _i = 0; _i < 8; ++_i) dst[_i] = 0.f; } while (0)
            if (rt < 512) {
                const int grp = rt >> 1, k = rt & 1; row = grp * 64 + k; const int t = row & 4095;
                const bf16_t* u0 = UH + (size_t)(grp * 4 + 2 + k) * F2;
                LD8BF(ua[2], u0 + ch); LD8BF(ub[2], u0 + DFF + ch);
                if (t >= 1) { const bf16_t* u1 = (k == 0) ? UH + (size_t)((grp - 1) * 4 + 1) * F2 : UH + (size_t)(grp * 4 + 2) * F2; LD8BF(ua[1], u1 + ch); LD8BF(ub[1], u1 + DFF + ch); } else { ZERO8(ua[1]); ZERO8(ub[1]); }
                if (t >= 2) { const bf16_t* u2 = UH + (size_t)((grp - 1) * 4 + k) * F2; LD8BF(ua[0], u2 + ch); LD8BF(ub[0], u2 + DFF + ch); } else { ZERO8(ua[0]); ZERO8(ub[0]); }
            } else {
                const int sr = rt - 512, b = sr >> 2, t = sr & 3; row = MP + sr;
#pragma unroll
                for (int tap = 0; tap < 3; ++tap) { const int e = t + tap;
                    if (e < 2) { const float* cp = a.state_conv + ((size_t)b * 2 + e) * F2; LD8F(ua[tap], cp + ch); LD8F(ub[tap], cp + DFF + ch); }
                    else { const bf16_t* up = US + (size_t)(b * 4 + e - 2) * F2; LD8BF(ua[tap], up + ch); LD8BF(ub[tap], up + DFF + ch); } }
            }
            float wa[3][8], wb[3][8], ba[8], bb[8];
#pragma unroll
            for (int tap = 0; tap < 3; ++tap) { LD8F(wa[tap], a.conv_w + (size_t)tap * F2 + ch); LD8F(wb[tap], a.conv_w + (size_t)tap * F2 + DFF + ch); }
            LD8F(ba, a.conv_b + ch); LD8F(bb, a.conv_b + DFF + ch);
            float gg[8];
#pragma unroll
            for (int i = 0; i < 8; ++i) { const float ca = ba[i] + wa[0][i] * ua[0][i] + wa[1][i] * ua[1][i] + wa[2][i] * ua[2][i], cb = bb[i] + wb[0][i] * ub[0][i] + wb[1][i] * ub[1][i] + wb[2][i] * ub[2][i];
                gg[i] = pg8::gelu_tanh(ca) * cb; }
            u32x4 w; w.x = pk2(gg[0], gg[1]); w.y = pk2(gg[2], gg[3]); w.z = pk2(gg[4], gg[5]); w.w = pk2(gg[6], gg[7]);
            *(u32x4*)(G + (size_t)row * DFF + ch) = w;
        }
    }
    SEAM(9);
    if (IN(10)) {
        pg8::Gemm g{G, WdnT, MP, D, DFF, DFF}; pg8::StaticOrder S; S.init(MP, D, nblk, blk);
        pg8::EpiBf16<0> E{Fb, D, nullptr, 0, 0, 1.f}; pg8::gemm_phase<pg8::EpiBf16<0>, pg8::StaticOrder, true, true>(lds, g, S, E);
        for (int piece = blk; piece < 256; piece += nblk) {
            const int fr = lane & 15, fq = lane >> 4; const size_t prow = (size_t)MP + 32 * (piece >> 4); const size_t row = prow + 16 * (wave >> 2) + fr; const int pcol = 64 * (piece & 15), col0 = pcol + 16 * (wave & 3);
            const f32x4 ac = tail_gemm(G + prow * DFF, DFF, WdnT + (size_t)pcol * DFF, DFF, lds, tid, lane, wave, (f32x4){0.f, 0.f, 0.f, 0.f});
            u32x2 w; w.x = pk2(ac[0], ac[1]); w.y = pk2(ac[2], ac[3]); *(u32x2*)(Fb + row * D + col0 + 4 * fq) = w;
        }
    }
    SEAM(10);
    if (IN(11)) {
        f32x4 gpo[2][2];
#pragma unroll
        for (int j = 0; j < 2; ++j)
#pragma unroll
            for (int e = 0; e < 2; ++e) gpo[j][e] = *((const f32x4*)a.g_post_ffn + 2 * (lane + 64 * j) + e);
        for (int p = blk * NWAVES + wave; p < M / 2; p += nblk * NWAVES) {
            u32x4 fb[2][2], xb[2][2];
#pragma unroll
            for (int rr = 0; rr < 2; ++rr) { const int m = 2 * p + rr;
#pragma unroll
                for (int j = 0; j < 2; ++j) { fb[rr][j] = *((const u32x4*)(Fb + (size_t)m * D) + lane + 64 * j); xb[rr][j] = *((const u32x4*)(X1b + (size_t)m * D) + lane + 64 * j); } }
            float ss[2];
#pragma unroll
            for (int rr = 0; rr < 2; ++rr) { ss[rr] = 0.f;
#pragma unroll
                for (int j = 0; j < 2; ++j)
#pragma unroll
                    for (int q = 0; q < 4; ++q) { const unsigned w = fb[rr][j][q]; ss[rr] += bflo(w) * bflo(w) + bfhi(w) * bfhi(w); } }
            ss[0] = wave_sum(ss[0]); ss[1] = wave_sum(ss[1]);
#pragma unroll
            for (int rr = 0; rr < 2; ++rr) { const int m = 2 * p + rr; const float rstd = rsqrtf(ss[rr] * (1.f / D) + EPS);
#pragma unroll
                for (int j = 0; j < 2; ++j)
#pragma unroll
                    for (int e = 0; e < 2; ++e) { f32x4 y;
#pragma unroll
                        for (int q = 0; q < 2; ++q) { const unsigned fw = fb[rr][j][2 * e + q], xw = xb[rr][j][2 * e + q];
                            y[2 * q] = bflo(xw) + bflo(fw) * rstd * gpo[j][e][2 * q]; y[2 * q + 1] = bfhi(xw) + bfhi(fw) * rstd * gpo[j][e][2 * q + 1]; }
                        *((f32x4*)(Y + (size_t)m * D) + 2 * (lane + 64 * j) + e) = y; } }
        }
    }
#undef IN
#undef SEAM
}

#ifndef MK_SPLIT
#define MK_SPLIT 0
#endif
extern "C" void kernel_launch(void* const* d_in, const int* in_sizes, int n_in, void* d_out, int out_size, void* d_ws, size_t ws_size, hipStream_t stream) {
    static int grid = 0;
    if (grid == 0) {
        int dev = 0, cus = 0, per_cu = 0;
        if (hipGetDevice(&dev) != hipSuccess || hipDeviceGetAttribute(&cus, hipDeviceAttributeMultiprocessorCount, dev) != hipSuccess) { fprintf(stderr, "kernel_launch: device query failed\n"); grid = -1; return; }
        if (hipFuncSetAttribute((const void*)fwd_megakernel, hipFuncAttributeMaxDynamicSharedMemorySize, LDS_BYTES) != hipSuccess) { fprintf(stderr, "kernel_launch: hipFuncSetAttribute failed\n"); grid = -1; return; }
        if (hipOccupancyMaxActiveBlocksPerMultiprocessor(&per_cu, (const void*)fwd_megakernel, NTHREADS, LDS_BYTES) != hipSuccess || per_cu < 1) { fprintf(stderr, "kernel_launch: occupancy query says %d\n", per_cu); per_cu = 1; }
        (void)hipGetLastError();
        grid = cus * 1;
        if (ws_size < 256 * MiB || out_size != (int)O_END || n_in != 19) fprintf(stderr, "kernel_launch: unexpected sizes ws %zu out %d n_in %d\n", ws_size, out_size, n_in);
    }
    if (grid < 0) return;
    Args a{};
    a.x_prompt = (const float*)d_in[0]; a.x_sample = (const float*)d_in[1]; a.cache_k = (const float*)d_in[2]; a.cache_v = (const float*)d_in[3]; a.state_ret = (const float*)d_in[4];
    a.state_conv = (const float*)d_in[5]; a.w_in = (const float*)d_in[6]; a.sinks = (const float*)d_in[7]; a.w_a = (const float*)d_in[8]; a.w_r = (const float*)d_in[9]; a.w_o = (const float*)d_in[10];
    a.g_pre_mix = (const float*)d_in[11]; a.g_post_mix = (const float*)d_in[12]; a.g_pre_ffn = (const float*)d_in[13]; a.g_post_ffn = (const float*)d_in[14];
    a.w_up = (const float*)d_in[15]; a.conv_w = (const float*)d_in[16]; a.conv_b = (const float*)d_in[17]; a.w_down = (const float*)d_in[18];
    a.out = (float*)d_out; a.ws = (unsigned char*)d_ws;
#if MK_SPLIT
    for (int ph = 0; ph < 12; ++ph) { a.ph_lo = ph; a.ph_hi = ph + 1; hipLaunchKernelGGL(fwd_megakernel, dim3(grid), dim3(NTHREADS), LDS_BYTES, stream, a); }
#else
    a.ph_lo = 0; a.ph_hi = 12;
    void* args[] = {&a};
    const hipError_t e = hipLaunchCooperativeKernel((const void*)fwd_megakernel, dim3(grid), dim3(NTHREADS), args, LDS_BYTES, stream);
    if (e != hipSuccess) fprintf(stderr, "kernel_launch: cooperative launch failed: %s (grid %d)\n", hipGetErrorString(e), grid);
#endif
}
```

```cpp
#include <hip/hip_runtime.h>
#include <hip/hip_cooperative_groups.h>
#include <cstdio>
#include <cstdint>
#include <cmath>
namespace cg = cooperative_groups;
namespace pg8 {
#define PG8_LAS __attribute__((address_space(3)))
typedef unsigned short bf16_t;
typedef short bf16x8 __attribute__((ext_vector_type(8)));
typedef float f32x4 __attribute__((ext_vector_type(4)));
typedef unsigned u32x4 __attribute__((ext_vector_type(4)));
constexpr int BM = 256, BK = 64, HALF = 128, HTB = HALF * BK * 2  , STAGE_BYTES = 8 * HTB, NXCD = 8, WGM = 8;

__host__ __device__ __forceinline__ int lds_byte(int r, int c) { const int st = (r >> 4) * 2 + (c >> 5), rr = r & 15, cc = c & 31, ob = rr * 64 + cc * 2; return st * 1024 + (ob ^ (((ob >> 9) & 1) << 5)); }
__host__ __device__ __forceinline__ void stage_rc(int b, int& R, int& C) { const int st = b / 1024, sb = b % 1024, swz = sb ^ (((sb >> 9) & 1) << 5); R = (st >> 1) * 16 + swz / 64; C = (st & 1) * 32 + (swz % 64) / 2; }
__host__ __device__ __forceinline__ int perm32(int rho) { const int n = rho >> 4, i = rho & 15; return 8 * (i >> 2) + 4 * n + (i & 3); }

struct Unit { int pm, pn; };
struct Gemm { const bf16_t* A; const bf16_t* Bt; int M, N, K, lda; };

struct StaticOrder {
    int nM, nN, nwg, G, c;
    __host__ __device__ void init(int M, int N, int G_, int c_) { nM = M / BM; nN = N / BM; nwg = nM * nN; G = G_; c = c_; }
    __host__ __device__ bool next(int i, Unit& u) const {
        const long L = (long)i * G + c; if (L >= nwg) return false;
        int wgid = (int)L; { const int q = nwg / NXCD, r = nwg % NXCD, xcd = wgid % NXCD, off = wgid / NXCD; wgid = (xcd < r ? xcd * (q + 1) : r * (q + 1) + (xcd - r) * q) + off; }
        const int nig = WGM * nN, gid = wgid / nig, fm = gid * WGM, gsz = (nM - fm) < WGM ? (nM - fm) : WGM;
        u.pm = fm + ((wgid % nig) % gsz); u.pn = (wgid % nig) / gsz; return true;
    }
    __device__ __forceinline__ void a_ready(const Unit&) const {}
    __device__ __forceinline__ void done(const Unit&) const {}
};

__device__ __forceinline__ unsigned cvt_pk_bf16(float lo, float hi) { unsigned r; asm volatile("v_cvt_pk_bf16_f32 %0, %1, %2" : "=v"(r) : "v"(lo), "v"(hi)); return r; }
typedef float f32x2 __attribute__((ext_vector_type(2)));
__device__ __forceinline__ f32x2 gelu_pk(f32x2 v) {
    const f32x2 av = __builtin_elementwise_abs(v), d = av * 0.2316418882f + 1.0f;
    f32x2 t; t.x = __builtin_amdgcn_rcpf(d.x); t.y = __builtin_amdgcn_rcpf(d.y);
    f32x2 q = t * 0.5307027145f + (-0.7265760135f); q = q * t + 0.7107068705f; q = q * t + (-0.142248368f); q = q * t + 0.127414796f; q = q * t;
    const f32x2 s = (v * v) * (-0.72134752044f);
    f32x2 e; e.x = __builtin_amdgcn_exp2f(s.x); e.y = __builtin_amdgcn_exp2f(s.y);
    const f32x2 m = v * (q * e), r = v - m;
    f32x2 o; o.x = v.x < 0.f ? m.x : r.x; o.y = v.y < 0.f ? m.y : r.y; return o;
}

template <int ACT  > struct EpiBf16 {
    static constexpr bool PERM = true, AFTER_DRAIN = false; static_assert(ACT == 0 || ACT == 1, "EpiBf16: ACT is 0 (none) or 1 (gelu_pk)");
    bf16_t* O; int ldc; const float* bias; int split_cols; size_t split_stride; float scale0;
    __device__ __forceinline__ void operator()(const f32x4 (&acc)[2][2][4][2], const Unit& u, int wr, int wc, int fr, int fq) const {
        const int row0 = u.pm * BM + wr * 64 + fr; int colt = u.pn * BM; bf16_t* base = O;
        float sc = 1.f; if (split_cols) { const int t = colt / split_cols; base += (size_t)t * split_stride; colt -= t * split_cols; if (t == 0) sc = scale0; }
        const int col0 = colt + wc * 32 + 8 * fq, bcol0 = u.pn * BM + wc * 32 + 8 * fq;
        f32x4 bv[2][2];
#pragma unroll
        for (int bj = 0; bj < 2; ++bj)
#pragma unroll
            for (int n = 0; n < 2; ++n) bv[bj][n] = bias ? *(const f32x4*)(bias + bcol0 + bj * HALF + 4 * n) : (f32x4){0.f, 0.f, 0.f, 0.f};
#pragma unroll
        for (int ai = 0; ai < 2; ++ai)
#pragma unroll
            for (int m = 0; m < 4; ++m) { bf16_t* rowp = base + (size_t)(row0 + ai * HALF + m * 16) * ldc + col0;
#pragma unroll
                for (int bj = 0; bj < 2; ++bj) { f32x4 v0 = acc[ai][bj][m][0] + bv[bj][0], v1 = acc[ai][bj][m][1] + bv[bj][1];
                    if (ACT == 1) { f32x2 a = gelu_pk((f32x2){v0[0], v0[1]}), b = gelu_pk((f32x2){v0[2], v0[3]}), c = gelu_pk((f32x2){v1[0], v1[1]}), d = gelu_pk((f32x2){v1[2], v1[3]});
                        v0 = (f32x4){a.x, a.y, b.x, b.y}; v1 = (f32x4){c.x, c.y, d.x, d.y}; }
                    v0 = v0 * sc; v1 = v1 * sc; u32x4 w; w.x = cvt_pk_bf16(v0[0], v0[1]); w.y = cvt_pk_bf16(v0[2], v0[3]); w.z = cvt_pk_bf16(v1[0], v1[1]); w.w = cvt_pk_bf16(v1[2], v1[3]);
                    *(u32x4*)(rowp + bj * HALF) = w; } }
    }
};

typedef float f32x2e __attribute__((ext_vector_type(2)));
typedef unsigned u32x2e __attribute__((ext_vector_type(2)));
__device__ __forceinline__ float bf_lo(unsigned w) { return __uint_as_float(w << 16); }
__device__ __forceinline__ float bf_hi(unsigned w) { return __uint_as_float(w & 0xffff0000u); }
__device__ __forceinline__ float sigmoidf_(float x) { return __builtin_amdgcn_rcpf(1.0f + __expf(-x)); }
constexpr int E_MP = 16384, E_DIN = 5888;

struct EpiH {
    static constexpr bool PERM = true, AFTER_DRAIN = false;
    bf16_t* H; const f32x2e* tabA; const f32x2e* tabR;
    __device__ __forceinline__ void operator()(const f32x4 (&acc)[2][2][4][2], const Unit& u, int wr, int wc, int fr, int fq) const {
        const int pn = u.pn;
        const int row0 = u.pm * BM + wr * 64 + fr;
        const int colt = pn * BM + wc * 32 + 8 * fq;
#pragma unroll
        for (int ai = 0; ai < 2; ++ai)
#pragma unroll
            for (int m = 0; m < 4; ++m) {
                const int row = row0 + ai * HALF + m * 16;
                const int tp = row < E_MP ? (row & 4095) : 4096 + (row & 3);
#pragma unroll
                for (int bj = 0; bj < 2; ++bj) {
                    float v[8];
#pragma unroll
                    for (int j = 0; j < 4; ++j) { v[j] = acc[ai][bj][m][0][j]; v[4 + j] = acc[ai][bj][m][1][j]; }
                    int mode = 0; float sc = 1.f;
                    if (pn < 2) { mode = 1; sc = 0.125f; }
                    else if (pn == 2) { mode = (bj == 0) ? 1 : 0; }
                    else if (pn < 5) { mode = 2; }
                    else if (pn < 7) { mode = 2; sc = 0.08838834764831845f; }
                    if (mode == 1) {
                        const bool rot = ((wc & 1) == 0) && (fq < 2);
                        const float sgn = (fq == 0) ? -1.f : 1.f;
#pragma unroll
                        for (int j = 0; j < 8; ++j) {
                            const float partner = __shfl_xor(v[j], 16);
                            const f32x2e cs = tabA[tp * 8 + j];
                            const float o = v[j] * cs.x + sgn * partner * cs.y;
                            v[j] = (rot ? o : v[j]) * sc;
                        }
                    } else if (mode == 2) {
                        const int pi = ((bj * HALF + wc * 32 + 8 * fq) & 127) >> 1;
#pragma unroll
                        for (int p = 0; p < 4; ++p) {
                            const f32x2e cs = tabR[tp * 64 + pi + p];
                            const float x0 = v[2 * p], x1 = v[2 * p + 1];
                            v[2 * p] = (x0 * cs.x - x1 * cs.y) * sc; v[2 * p + 1] = (x1 * cs.x + x0 * cs.y) * sc;
                        }
                    }
                    u32x4 w; w.x = cvt_pk_bf16(v[0], v[1]); w.y = cvt_pk_bf16(v[2], v[3]); w.z = cvt_pk_bf16(v[4], v[5]); w.w = cvt_pk_bf16(v[6], v[7]);
                    *(u32x4*)(H + (size_t)row * E_DIN + colt + bj * HALF) = w;
                }
            }
    }
};

template <bool ADD> struct EpiGate {
    static constexpr bool PERM = true, AFTER_DRAIN = false;
    bf16_t* T; const bf16_t* gate; int ldg;
    __device__ __forceinline__ void operator()(const f32x4 (&acc)[2][2][4][2], const Unit& u, int wr, int wc, int fr, int fq) const {
        const int row0 = u.pm * BM + wr * 64 + fr, col0 = u.pn * BM + wc * 32 + 8 * fq;
#pragma unroll
        for (int ai = 0; ai < 2; ++ai)
#pragma unroll
            for (int m = 0; m < 4; ++m) {
                const int row = row0 + ai * HALF + m * 16;
#pragma unroll
                for (int bj = 0; bj < 2; ++bj) {
                    const u32x4 gw = *(const u32x4*)(gate + (size_t)row * ldg + col0 + bj * HALF);
                    bf16_t* tp = T + (size_t)row * 1024 + col0 + bj * HALF;
                    u32x4 old = (u32x4){0u, 0u, 0u, 0u}; if (ADD) old = *(const u32x4*)tp;
                    float o[8];
#pragma unroll
                    for (int j = 0; j < 4; ++j) {
                        const unsigned g2 = gw[j], o2 = old[j];
                        const float a0 = acc[ai][bj][m][j >> 1][(j & 1) * 2], a1 = acc[ai][bj][m][j >> 1][(j & 1) * 2 + 1];
                        o[2 * j] = bf_lo(o2) + sigmoidf_(bf_lo(g2)) * a0; o[2 * j + 1] = bf_hi(o2) + sigmoidf_(bf_hi(g2)) * a1;
                    }
                    u32x4 w; w.x = cvt_pk_bf16(o[0], o[1]); w.y = cvt_pk_bf16(o[2], o[3]); w.z = cvt_pk_bf16(o[4], o[5]); w.w = cvt_pk_bf16(o[6], o[7]);
                    *(u32x4*)tp = w;
                }
            }
    }
};

struct EpiF32 {
    static constexpr bool PERM = true, AFTER_DRAIN = false;
    float* O;
    __device__ __forceinline__ void operator()(const f32x4 (&acc)[2][2][4][2], const Unit& u, int wr, int wc, int fr, int fq) const {
        const int row0 = u.pm * BM + wr * 64 + fr, col0 = u.pn * BM + wc * 32 + 8 * fq;
#pragma unroll
        for (int ai = 0; ai < 2; ++ai)
#pragma unroll
            for (int m = 0; m < 4; ++m) {
                float* rp = O + (size_t)(row0 + ai * HALF + m * 16) * 1024 + col0;
#pragma unroll
                for (int bj = 0; bj < 2; ++bj) { *(f32x4*)(rp + bj * HALF) = acc[ai][bj][m][0]; *(f32x4*)(rp + bj * HALF + 4) = acc[ai][bj][m][1]; }
            }
    }
};

__device__ __forceinline__ float dpp_ror1(float x) { return __builtin_bit_cast(float, __builtin_amdgcn_update_dpp(0, __builtin_bit_cast(int, x), 0x121, 0xf, 0xf, false)); }
__device__ __forceinline__ float dpp_ror2(float x) { return __builtin_bit_cast(float, __builtin_amdgcn_update_dpp(0, __builtin_bit_cast(int, x), 0x122, 0xf, 0xf, false)); }
__device__ __forceinline__ float gelu_tanh(float x) { const float u2 = 1.5957691216057308f * (x + 0.044715f * x * x * x); return x * __builtin_amdgcn_rcpf(1.0f + __expf(-u2)); }
struct EpiUp {
    static constexpr bool PERM = true, AFTER_DRAIN = false;
    bf16_t* G; bf16_t* UH; bf16_t* US; float* conv_prompt; float* conv_sample; const float* conv_w; const float* conv_b;
    __device__ __forceinline__ void operator()(const f32x4 (&acc)[2][2][4][2], const Unit& u, int wr, int wc, int fr, int fq) const {
        const int row0 = u.pm * BM + wr * 64 + fr;
        const bool sample = u.pm >= 64;
        u32x2e keep[2][4];
#pragma unroll
        for (int n = 0; n < 2; ++n) {
            const int ch = u.pn * HALF + wc * 32 + 8 * fq + 4 * n;
            const f32x4 wa0 = *(const f32x4*)(conv_w + ch), wa1 = *(const f32x4*)(conv_w + 6144 + ch), wa2 = *(const f32x4*)(conv_w + 12288 + ch), ba = *(const f32x4*)(conv_b + ch);
            const f32x4 wb0 = *(const f32x4*)(conv_w + 3072 + ch), wb1 = *(const f32x4*)(conv_w + 6144 + 3072 + ch), wb2 = *(const f32x4*)(conv_w + 12288 + 3072 + ch), bb = *(const f32x4*)(conv_b + 3072 + ch);
#pragma unroll
            for (int ai = 0; ai < 2; ++ai)
#pragma unroll
                for (int m = 0; m < 4; ++m) {
                    const int row = row0 + ai * HALF + m * 16;
                    const f32x4 ua = acc[ai][0][m][n], ub = acc[ai][1][m][n];
                    const f32x4 pa = acc[ai][0][m > 0 ? m - 1 : 0][n], pb = acc[ai][1][m > 0 ? m - 1 : 0][n];
                    float g[4];
#pragma unroll
                    for (int rp = 0; rp < 2; ++rp) {
                        f32x2e a0v, a1v, a2v, b0v, b1v, b2v;
#pragma unroll
                        for (int e = 0; e < 2; ++e) { const int r = 2 * rp + e;
                            a0v[e] = ua[r]; b0v[e] = ub[r];
                            a1v[e] = dpp_ror1(fr == 15 ? pa[r] : ua[r]); a2v[e] = dpp_ror2(fr >= 14 ? pa[r] : ua[r]);
                            b1v[e] = dpp_ror1(fr == 15 ? pb[r] : ub[r]); b2v[e] = dpp_ror2(fr >= 14 ? pb[r] : ub[r]); }
                        const f32x2e wa0v = {wa0[2 * rp], wa0[2 * rp + 1]}, wa1v = {wa1[2 * rp], wa1[2 * rp + 1]}, wa2v = {wa2[2 * rp], wa2[2 * rp + 1]}, bav = {ba[2 * rp], ba[2 * rp + 1]};
                        const f32x2e wb0v = {wb0[2 * rp], wb0[2 * rp + 1]}, wb1v = {wb1[2 * rp], wb1[2 * rp + 1]}, wb2v = {wb2[2 * rp], wb2[2 * rp + 1]}, bbv = {bb[2 * rp], bb[2 * rp + 1]};
                        const f32x2e ca = bav + wa0v * a2v + wa1v * a1v + wa2v * a0v;
                        const f32x2e cb = bbv + wb0v * b2v + wb1v * b1v + wb2v * b0v;
                        const f32x2e u2 = ca * (ca * ca * (-0.044715f * 1.5957691216057308f * 1.4426950408889634f) + (-1.5957691216057308f * 1.4426950408889634f));
                        f32x2e den; den.x = __builtin_amdgcn_rcpf(1.0f + __builtin_amdgcn_exp2f(u2.x)); den.y = __builtin_amdgcn_rcpf(1.0f + __builtin_amdgcn_exp2f(u2.y));
                        const f32x2e gv = ca * den * cb;
                        g[2 * rp] = gv.x; g[2 * rp + 1] = gv.y;
                    }
                    if (!sample) {
                        { u32x2e w; w.x = cvt_pk_bf16(g[0], g[1]); w.y = cvt_pk_bf16(g[2], g[3]);
                          if (n == 0) keep[ai][m] = w;
                          else if (!(m == 0 && fr < 2)) { u32x4 w4; w4.x = keep[ai][m].x; w4.y = keep[ai][m].y; w4.z = w.x; w4.w = w.y; *(u32x4*)(G + (size_t)row * 3072 + ch - 4) = w4; } }
                        if ((m == 0 && fr < 2) || (m == 3 && fr >= 14)) {
                            const int hrow = (row >> 6) * 4 + ((row + 2) & 63);
                            u32x2e w; w.x = cvt_pk_bf16(ua[0], ua[1]); w.y = cvt_pk_bf16(ua[2], ua[3]); *(u32x2e*)(UH + (size_t)hrow * 6144 + ch) = w;
                            w.x = cvt_pk_bf16(ub[0], ub[1]); w.y = cvt_pk_bf16(ub[2], ub[3]); *(u32x2e*)(UH + (size_t)hrow * 6144 + 3072 + ch) = w;
                        }
                        if ((row & 4095) >= 4094) {
                            float* cp = conv_prompt + ((size_t)(row >> 12) * 2 + ((row & 4095) - 4094)) * 6144;
                            *(f32x4*)(cp + ch) = ua; *(f32x4*)(cp + 3072 + ch) = ub;
                        }
                    } else {
                        const int sr = row - E_MP;
                        u32x2e w; w.x = cvt_pk_bf16(ua[0], ua[1]); w.y = cvt_pk_bf16(ua[2], ua[3]); *(u32x2e*)(US + (size_t)sr * 6144 + ch) = w;
                        w.x = cvt_pk_bf16(ub[0], ub[1]); w.y = cvt_pk_bf16(ub[2], ub[3]); *(u32x2e*)(US + (size_t)sr * 6144 + 3072 + ch) = w;
                        if ((sr & 3) >= 2) {
                            float* cp = conv_sample + ((size_t)(sr >> 2) * 2 + ((sr & 3) - 2)) * 6144;
                            *(f32x4*)(cp + ch) = ua; *(f32x4*)(cp + 3072 + ch) = ub;
                        }
                    }
                }
        }
    }
};

template <class Epi, class Sched, bool ALIGN_EPI = false, bool SP2 = false>
__device__ __forceinline__ void gemm_phase(PG8_LAS unsigned char* lds, const Gemm g, const Sched& S, const Epi& E) {
    const int tid = threadIdx.x, wid = __builtin_amdgcn_readfirstlane(tid >> 6), lane = tid & 63, wr = wid >> 2, wc = wid & 3, fr = lane & 15, fq = lane >> 4;
    const int K = g.K, nt = K / BK, lda = g.lda;
    unsigned voffA[2], voffB[2];
#pragma unroll
    for (int i = 0; i < 2; ++i) { int R, C; stage_rc(tid * 16 + i * 8192, R, C); const int Rb = Epi::PERM ? ((R & ~31) + perm32(R & 31)) : R;
        voffA[i] = (unsigned)(R * lda + C) * 2u; voffB[i] = (unsigned)(Rb * K + C) * 2u; }
    const size_t kstep = (size_t)(BK * 2);
    const size_t hstepA = (size_t)HALF * lda * 2, hstepB = (size_t)HALF * K * 2;
    const size_t tstepA = 2 * hstepA, tstepB = 2 * hstepB;
    const unsigned ldsw = (unsigned)wid * 1024u;
    const int aoff = lds_byte(wr * 64 + fr, fq * 8), boff = lds_byte(wc * 32 + fr, fq * 8);
#define PG8_SA(b, h) (((b) * 2 + (h)) * HTB)
#define PG8_SB(b, h) ((4 + (b) * 2 + (h)) * HTB)
#define PG8_STAGE(bufoff, gbase, voff) do { _Pragma("unroll") for (int _i = 0; _i < 2; ++_i) \
        __builtin_amdgcn_global_load_lds((const unsigned*)((const char*)(gbase) + (voff)[_i]), (PG8_LAS unsigned*)(lds + (bufoff) + ldsw + _i * 8192), 16, 0, 0); } while (0)
#define PG8_LDA(dst, b, h) do { _Pragma("unroll") for (int m = 0; m < 4; ++m) _Pragma("unroll") for (int k = 0; k < 2; ++k) dst[m][k] = *(const PG8_LAS bf16x8*)(lds + PG8_SA(b, h) + aoff + m * 2048 + k * 1024); } while (0)
#define PG8_LDB(dst, b, h) do { _Pragma("unroll") for (int n = 0; n < 2; ++n) _Pragma("unroll") for (int k = 0; k < 2; ++k) dst[n][k] = *(const PG8_LAS bf16x8*)(lds + PG8_SB(b, h) + boff + n * 2048 + k * 1024); } while (0)
#define PG8_MMA(ai, bj, At, Bt) do { __builtin_amdgcn_s_setprio(1); _Pragma("unroll") for (int m = 0; m < 4; ++m) _Pragma("unroll") for (int n = 0; n < 2; ++n) _Pragma("unroll") for (int k = 0; k < 2; ++k) \
        acc[ai][bj][m][n] = __builtin_amdgcn_mfma_f32_16x16x32_bf16(Bt[n][k], At[m][k], acc[ai][bj][m][n], 0, 0, 0); __builtin_amdgcn_s_setprio(0); } while (0)
#define PG8_WAIT_V(n) asm volatile("s_waitcnt vmcnt(" #n ")" ::: "memory")
#define PG8_WAIT_L(n) asm volatile("s_waitcnt lgkmcnt(" #n ")" ::: "memory")
#define PG8_BAR __builtin_amdgcn_s_barrier()
#define PG8_SCHED __builtin_amdgcn_sched_barrier(0)
    Unit cur, nxt; int ui = 0;
    if (!S.next(0, cur)) return;
    f32x4 acc[2][2][4][2];
#pragma unroll
    for (int a = 0; a < 2; ++a)
#pragma unroll
        for (int b = 0; b < 2; ++b)
#pragma unroll
            for (int m = 0; m < 4; ++m)
#pragma unroll
                for (int n = 0; n < 2; ++n) acc[a][b][m][n] = (f32x4){0.f, 0.f, 0.f, 0.f};
    bf16x8 At[4][2], B0[2][2], B1[2][2];
    const char* cA = (const char*)g.A + (size_t)cur.pm * tstepA; const char* cB = (const char*)g.Bt + (size_t)cur.pn * tstepB;
    S.a_ready(cur);
    if constexpr (SP2) {
        PG8_STAGE(PG8_SB(0, 0), cB, voffB); PG8_STAGE(PG8_SB(0, 1), cB + hstepB, voffB); PG8_STAGE(PG8_SA(0, 0), cA, voffA); PG8_STAGE(PG8_SA(0, 1), cA + hstepA, voffA);
        if (wr == 1) PG8_BAR;
        PG8_WAIT_V(2); PG8_BAR;
        PG8_STAGE(PG8_SB(1, 0), cB + kstep, voffB); PG8_STAGE(PG8_SA(1, 0), cA + kstep, voffA); PG8_STAGE(PG8_SB(1, 1), cB + hstepB + kstep, voffB);
        PG8_WAIT_V(6); PG8_BAR;
    } else {
        PG8_STAGE(PG8_SB(0, 0), cB, voffB); PG8_STAGE(PG8_SA(0, 0), cA, voffA); PG8_STAGE(PG8_SB(0, 1), cB + hstepB, voffB); PG8_STAGE(PG8_SA(0, 1), cA + hstepA, voffA);
        if (wr == 1) PG8_BAR;
        PG8_WAIT_V(4); PG8_BAR;
        PG8_STAGE(PG8_SB(1, 0), cB + kstep, voffB); PG8_STAGE(PG8_SA(1, 0), cA + kstep, voffA); PG8_STAGE(PG8_SB(1, 1), cB + hstepB + kstep, voffB);
        PG8_WAIT_V(6); PG8_BAR;
    }
    for (;;) {
        const bool has_next = S.next(ui + 1, nxt);
        const char* nA = has_next ? (const char*)g.A + (size_t)nxt.pm * tstepA : cA; const char* nB = has_next ? (const char*)g.Bt + (size_t)nxt.pn * tstepB : cB;
        for (int t = 0; t < nt; t += 2) {
            const bool last = (t == nt - 2);
            const char* a1 = cA + (size_t)(t + 1) * kstep;
            const char* a2 = last ? nA : cA + (size_t)(t + 2) * kstep; const char* b2 = last ? nB : cB + (size_t)(t + 2) * kstep;
            const char* a3 = a2 + kstep; const char* b3 = b2 + kstep;
            if (last && has_next) S.a_ready(nxt);
            if constexpr (SP2) {
            PG8_LDB(B0, 0, 0); PG8_LDB(B1, 0, 1); PG8_SCHED; PG8_LDA(At, 0, 0); PG8_STAGE(PG8_SA(1, 1), a1 + hstepA, voffA);
            PG8_WAIT_V(8); PG8_WAIT_L(0); PG8_BAR; PG8_MMA(0, 0, At, B0); PG8_MMA(0, 1, At, B1); PG8_BAR; PG8_SCHED;
            PG8_LDA(At, 0, 1); PG8_STAGE(PG8_SB(0, 0), b2, voffB); PG8_STAGE(PG8_SB(0, 1), b2 + hstepB, voffB); PG8_STAGE(PG8_SA(0, 0), a2, voffA);
            PG8_WAIT_V(8); PG8_WAIT_L(0); PG8_BAR; PG8_MMA(1, 0, At, B0); PG8_MMA(1, 1, At, B1); PG8_BAR; PG8_SCHED;
            PG8_LDB(B0, 1, 0); PG8_LDB(B1, 1, 1); PG8_SCHED; PG8_LDA(At, 1, 0); PG8_STAGE(PG8_SA(0, 1), a2 + hstepA, voffA);
            PG8_WAIT_V(8); PG8_WAIT_L(0); PG8_BAR; PG8_MMA(0, 0, At, B0); PG8_MMA(0, 1, At, B1); PG8_BAR; PG8_SCHED;
            PG8_LDA(At, 1, 1); PG8_STAGE(PG8_SB(1, 0), b3, voffB); PG8_STAGE(PG8_SB(1, 1), b3 + hstepB, voffB); PG8_STAGE(PG8_SA(1, 0), a3, voffA);
            PG8_WAIT_V(8); PG8_WAIT_L(0); PG8_BAR; PG8_MMA(1, 0, At, B0); PG8_MMA(1, 1, At, B1); PG8_BAR; PG8_SCHED;
            } else {
            PG8_LDB(B0, 0, 0); PG8_SCHED; PG8_LDA(At, 0, 0); PG8_STAGE(PG8_SA(1, 1), a1 + hstepA, voffA);
            PG8_WAIT_L(8); PG8_BAR; PG8_WAIT_L(0); PG8_MMA(0, 0, At, B0); PG8_BAR; PG8_SCHED;
            PG8_LDB(B1, 0, 1); PG8_STAGE(PG8_SB(0, 0), b2, voffB);
            PG8_BAR; PG8_WAIT_L(0); PG8_MMA(0, 1, At, B1); PG8_BAR;
            PG8_LDA(At, 0, 1); PG8_STAGE(PG8_SA(0, 0), a2, voffA);
            PG8_BAR; PG8_WAIT_L(0); PG8_MMA(1, 0, At, B0); PG8_BAR; PG8_SCHED;
            PG8_STAGE(PG8_SB(0, 1), b2 + hstepB, voffB);
            PG8_WAIT_V(6); PG8_BAR; PG8_MMA(1, 1, At, B1); PG8_BAR;
            PG8_LDB(B0, 1, 0); PG8_SCHED; PG8_LDA(At, 1, 0); PG8_STAGE(PG8_SA(0, 1), a2 + hstepA, voffA);
            PG8_WAIT_L(8); PG8_BAR; PG8_WAIT_L(0); PG8_MMA(0, 0, At, B0); PG8_BAR; PG8_SCHED;
            PG8_LDB(B1, 1, 1); PG8_STAGE(PG8_SB(1, 0), b3, voffB);
            PG8_BAR; PG8_WAIT_L(0); PG8_MMA(0, 1, At, B1); PG8_BAR;
            PG8_LDA(At, 1, 1); PG8_STAGE(PG8_SA(1, 0), a3, voffA);
            PG8_BAR; PG8_WAIT_L(0); PG8_MMA(1, 0, At, B0); PG8_BAR; PG8_SCHED;
            PG8_STAGE(PG8_SB(1, 1), b3 + hstepB, voffB);
            PG8_WAIT_V(6); PG8_BAR; PG8_MMA(1, 1, At, B1); PG8_BAR;
            }
        }
        if constexpr (ALIGN_EPI) { if (wr == 0) PG8_BAR; }
        if constexpr (!Epi::AFTER_DRAIN) { E(acc, cur, wr, wc, fr, fq); S.done(cur); }
        if (!has_next) break;
#pragma unroll
        for (int a = 0; a < 2; ++a)
#pragma unroll
            for (int b = 0; b < 2; ++b)
#pragma unroll
                for (int m = 0; m < 4; ++m)
#pragma unroll
                    for (int n = 0; n < 2; ++n) acc[a][b][m][n] = (f32x4){0.f, 0.f, 0.f, 0.f};
        cur = nxt; cA = nA; cB = nB; ++ui;
        if constexpr (ALIGN_EPI) { if (wr == 1) PG8_BAR; }
    }
    PG8_WAIT_V(0);
    if constexpr (!ALIGN_EPI) { if (wr == 0) PG8_BAR; }
    PG8_BAR;
    if constexpr (Epi::AFTER_DRAIN) { E.fused(acc, cur, wr, wc, fr, fq, lds, wid, lane); S.done(cur); }
#undef PG8_SA
#undef PG8_SB
#undef PG8_STAGE
#undef PG8_LDA
#undef PG8_LDB
#undef PG8_MMA
#undef PG8_WAIT_V
#undef PG8_WAIT_L
#undef PG8_BAR
#undef PG8_SCHED
}
}

#define LAS __attribute__((address_space(3)))
using pg8::bf16_t; using pg8::bf16x8; using pg8::f32x4; using pg8::u32x4;
typedef float f32x2 __attribute__((ext_vector_type(2)));
typedef unsigned u32x2 __attribute__((ext_vector_type(2)));
typedef short v4i16 __attribute__((ext_vector_type(4)));

constexpr int MP = 16384, MS = 512, M = MP + MS, D = 1024, DIN = 5888, F2 = 6144, DFF = 3072, TSEQ = 4096;
constexpr int C_QA = 0, C_KA = 512, C_VA = 640, C_QR = 768, C_KR = 1280, C_VR = 1792, C_GATE = 2816, C_GMA = 3840, C_GMR = 4864;
constexpr float EPS = 1e-6f;
constexpr int NTHREADS = 512, NWAVES = 8;
constexpr int LDS_BYTES = 147456;

constexpr size_t MiB = 1u << 20;
constexpr size_t WS_TABA = 0, WS_TABR = 512 * 1024;
constexpr size_t WS_WIN = 3 * MiB;
constexpr size_t WS_WUP = WS_WIN + (size_t)DIN * D * 2;
constexpr size_t WS_WDN = WS_WUP + (size_t)F2 * D * 2;
constexpr size_t WS_XN = WS_WDN + (size_t)D * DFF * 2;
constexpr size_t WS_R1 = WS_XN + (size_t)M * D * 2;
constexpr size_t R1_G = 0, R1_F = (size_t)M * DFF * 2, R1_UH = R1_F + (size_t)M * D * 2, R1_US = R1_UH + (size_t)264 * 4 * F2 * 2, R1_X1 = R1_US + (size_t)MS * F2 * 2, R1_END = R1_X1 + (size_t)M * D * 2;
static_assert(R1_END <= (size_t)M * DIN * 2, "R1 overlay");
static_assert(WS_R1 + (size_t)M * DIN * 2 <= 256 * MiB, "ws map");
constexpr size_t O_Y = 0, O_KP = (size_t)M * D, O_VP = O_KP + 65536, O_RP = O_VP + 65536, O_CP = O_RP + 524288, O_KS = O_CP + 49152, O_VS = O_KS + 2097152, O_RS = O_VS + 2097152, O_CS = O_RS + 16777216, O_END = O_CS + 1572864;

struct Args {
    const float *x_prompt, *x_sample, *cache_k, *cache_v, *state_ret, *state_conv, *w_in, *sinks, *w_a, *w_r, *w_o, *g_pre_mix, *g_post_mix, *g_pre_ffn, *g_post_ffn, *w_up, *conv_w, *conv_b, *w_down;
    float* out; unsigned char* ws; int ph_lo, ph_hi;
};

__device__ __forceinline__ float bf2f(bf16_t h) { return __uint_as_float((unsigned)h << 16); }
__device__ __forceinline__ float bflo(unsigned w) { return __uint_as_float(w << 16); }
__device__ __forceinline__ float bfhi(unsigned w) { return __uint_as_float(w & 0xffff0000u); }
__device__ __forceinline__ unsigned pk2(float lo, float hi) { return pg8::cvt_pk_bf16(lo, hi); }
__device__ __forceinline__ float wave_sum(float v) {
#pragma unroll
    for (int o = 1; o < 64; o <<= 1) v += __shfl_xor(v, o);
    return v;
}
__device__ __forceinline__ float wave_max(float v) {
#pragma unroll
    for (int o = 1; o < 64; o <<= 1) v = fmaxf(v, __shfl_xor(v, o));
    return v;
}
__device__ __forceinline__ float ret_log2g(int h) { return log2f(1.0f - exp2f(-5.0f - (float)h)); }
__device__ __forceinline__ bf16x8 tr_pair(const LAS unsigned char* p0, const LAS unsigned char* p1) {
    const v4i16 a = __builtin_amdgcn_ds_read_tr16_b64_v4i16((LAS v4i16*)p0), b = __builtin_amdgcn_ds_read_tr16_b64_v4i16((LAS v4i16*)p1);
    return (bf16x8){a[0], a[1], a[2], a[3], b[0], b[1], b[2], b[3]};
}
__device__ __forceinline__ bf16x8 cat8(u32x2 a, u32x2 b) { const u32x4 w = {a.x, a.y, b.x, b.y}; return __builtin_bit_cast(bf16x8, w); }

__device__ __forceinline__ void p0_transpose_item(const float* W, int K, int N, bf16_t* WT, int k0, int n0, int drow0, LAS float* scr, int lane) {
    f32x4 wv[8];
#pragma unroll
    for (int i = 0; i < 8; ++i) wv[i] = *(const f32x4*)(W + (size_t)(k0 + 8 * i + (lane >> 3)) * N + n0 + 4 * (lane & 7));
#pragma unroll
    for (int i = 0; i < 8; ++i) { LAS float* d = scr + (8 * i + (lane >> 3)) * 33 + 4 * (lane & 7); d[0] = wv[i].x; d[1] = wv[i].y; d[2] = wv[i].z; d[3] = wv[i].w; }
    asm volatile("s_waitcnt lgkmcnt(0)" ::: "memory");
    const int c = lane & 7;
#pragma unroll
    for (int j = 0; j < 4; ++j) { const int n = (lane >> 3) + 8 * j; const LAS float* s = scr + (8 * c) * 33 + n;
        u32x4 o; o.x = pk2(s[0 * 33], s[1 * 33]); o.y = pk2(s[2 * 33], s[3 * 33]); o.z = pk2(s[4 * 33], s[5 * 33]); o.w = pk2(s[6 * 33], s[7 * 33]);
        *(u32x4*)(WT + (size_t)(drow0 + n) * K + k0 + 8 * c) = o; }
    asm volatile("s_waitcnt lgkmcnt(0)" ::: "memory");
}
__device__ __forceinline__ void rms_row_to_bf16(const float* xrow, const float* g, bf16_t* orow, int lane) {
    f32x4 v[4]; float s = 0.f;
#pragma unroll
    for (int j = 0; j < 4; ++j) { v[j] = *((const f32x4*)xrow + lane + 64 * j); s += (v[j].x * v[j].x + v[j].y * v[j].y) + (v[j].z * v[j].z + v[j].w * v[j].w); }
    const float rstd = rsqrtf(wave_sum(s) * (1.f / D) + EPS);
#pragma unroll
    for (int j = 0; j < 4; ++j) { const f32x4 gg = *((const f32x4*)g + lane + 64 * j);
        u32x2 w; w.x = pk2(v[j].x * rstd * gg.x, v[j].y * rstd * gg.y); w.y = pk2(v[j].z * rstd * gg.z, v[j].w * rstd * gg.w);
        *((u32x2*)orow + lane + 64 * j) = w; }
}
__device__ __forceinline__ void p0_prologue(const Args& a, LAS unsigned char* lds, int tid, int lane, int wave) {
    unsigned char* ws = a.ws;
    LAS float* scr = (LAS float*)(lds + wave * 16384);
    const int gw = blockIdx.x * NWAVES + wave, NGW = gridDim.x * NWAVES;
    bf16_t* WinT = (bf16_t*)(ws + WS_WIN); bf16_t* WupT = (bf16_t*)(ws + WS_WUP); bf16_t* WdnT = (bf16_t*)(ws + WS_WDN);
    bf16_t* WoT = (bf16_t*)(a.out + O_CS); bf16_t* WaT = WoT + 1024 * 1024; bf16_t* WrT = WaT + 1024 * 512;
    constexpr int I_IN = 16 * (DIN / 32), I_A = 8 * 32, I_R = 16 * 32, I_O = 16 * 32, I_UP = 16 * (F2 / 32), I_DN = 48 * 32;
    constexpr int NITEMS = I_IN + I_A + I_R + I_O + I_UP + I_DN;
    for (int it = gw; it < NITEMS; it += NGW) {
        int r = it;
        if (r < I_IN) { const int nb = r % (DIN / 32), kb = r / (DIN / 32); p0_transpose_item(a.w_in, D, DIN, WinT, 64 * kb, 32 * nb, 32 * nb, scr, lane); continue; } r -= I_IN;
        if (r < I_A) { const int nb = r % 32, kb = r / 32; p0_transpose_item(a.w_a, 512, D, WaT, 64 * kb, 32 * nb, 32 * nb, scr, lane); continue; } r -= I_A;
        if (r < I_R) { const int nb = r % 32, kb = r / 32; p0_transpose_item(a.w_r, D, D, WrT, 64 * kb, 32 * nb, 32 * nb, scr, lane); continue; } r -= I_R;
        if (r < I_O) { const int nb = r % 32, kb = r / 32; p0_transpose_item(a.w_o, D, D, WoT, 64 * kb, 32 * nb, 32 * nb, scr, lane); continue; } r -= I_O;
        if (r < I_UP) { const int nb = r % (F2 / 32), kb = r / (F2 / 32); const int n0 = 32 * nb;
            const int drow = n0 < DFF ? (n0 / 128) * 256 + (n0 % 128) : ((n0 - DFF) / 128) * 256 + 128 + ((n0 - DFF) % 128);
            p0_transpose_item(a.w_up, D, F2, WupT, 64 * kb, n0, drow, scr, lane); continue; } r -= I_UP;
        { const int nb = r % 32, kb = r / 32; p0_transpose_item(a.w_down, DFF, D, WdnT, 64 * kb, 32 * nb, 32 * nb, scr, lane); }
    }
    bf16_t* XN = (bf16_t*)(ws + WS_XN);
    for (int m = gw; m < M; m += NGW) { const float* xr = m < MP ? a.x_prompt + (size_t)m * D : a.x_sample + (size_t)(m - MP) * D; rms_row_to_bf16(xr, a.g_pre_mix, XN + (size_t)m * D, lane); }
    f32x2* tabA = (f32x2*)(ws + WS_TABA); f32x2* tabR = (f32x2*)(ws + WS_TABR);
    __syncthreads();
    LAS float* invs = (LAS float*)lds;
    if (tid < 72) invs[tid] = tid < 8 ? (float)(1.0 / pow(500000.0, (double)((float)tid / 8.0f))) : (float)(1.0 / pow(10000.0, (double)((float)(tid - 8) / 63.0f)));
    __syncthreads();
    const int gt = blockIdx.x * NTHREADS + tid, NGT = gridDim.x * NTHREADS;
    for (int e = gt; e < 4100 * 72; e += NGT) {
        const int tp = e / 72, i = e % 72; const int pos = tp < 4096 ? tp : 16384 + (tp - 4096);
        const float ang = (float)pos * invs[i];
        const double rev = (double)ang * 0.15915494309189535; const float fr = (float)(rev - rint(rev));
        const f32x2 cs = {__builtin_amdgcn_cosf(fr), __builtin_amdgcn_sinf(fr)};
        if (i < 8) tabA[tp * 8 + i] = cs; else tabR[tp * 64 + (i - 8)] = cs;
    }
}

__device__ __forceinline__ void attn_prompt_unit(bf16_t* H, const float* sinks, LAS unsigned char* lds, int b, int qb, int head, int tid, int lane, int wave) {
    const int g = head >> 2, fr = lane & 15, fq = lane >> 4;
    const size_t rowbase = (size_t)b * TSEQ + (size_t)qb * 128;
    LAS unsigned char* Kimg = lds; LAS unsigned char* Vimg = lds + 36864;
#pragma unroll
    for (int i = 0; i < 4; ++i) {
        const int id = tid + NTHREADS * i, kidx = id >> 3, ch = id & 7;
        u32x4 kv = {0u, 0u, 0u, 0u}, vv = {0u, 0u, 0u, 0u};
        if (qb > 0 || kidx >= 128) { const bf16_t* src = H + (rowbase - 128 + kidx) * DIN; kv = *(const u32x4*)(src + C_KA + g * 64 + ch * 8); vv = *(const u32x4*)(src + C_VA + g * 64 + ch * 8); }
        *(LAS u32x4*)(Kimg + kidx * 144 + ch * 16) = kv; *(LAS u32x4*)(Vimg + kidx * 144 + ch * 16) = vv;
    }
    const size_t qrow = rowbase + 16 * wave + fr;
    bf16x8 qf[2];
#pragma unroll
    for (int ks = 0; ks < 2; ++ks) qf[ks] = *(const bf16x8*)(H + qrow * DIN + C_QA + head * 64 + 32 * ks + 8 * fq);
    __syncthreads();
    f32x4 s[10];
#pragma unroll
    for (int nn = 0; nn < 9; ++nn) {
        s[nn] = (f32x4){0.f, 0.f, 0.f, 0.f};
        const int krow = 16 * (wave + nn) + fr;
#pragma unroll
        for (int ks = 0; ks < 2; ++ks) { const bf16x8 kf = *(const LAS bf16x8*)(Kimg + krow * 144 + (32 * ks + 8 * fq) * 2); s[nn] = __builtin_amdgcn_mfma_f32_16x16x32_bf16(kf, qf[ks], s[nn], 0, 0, 0); }
    }
    s[9] = (f32x4){0.f, 0.f, 0.f, 0.f};
    const int qi = 16 * wave + fr; const float sink = sinks[head];
    float mx = sink;
#pragma unroll
    for (int nn = 0; nn < 9; ++nn)
#pragma unroll
        for (int r = 0; r < 4; ++r) { const int kidx = 16 * (wave + nn) + 4 * fq + r; const bool valid = (kidx > qi) && (kidx <= qi + 128) && (qb > 0 || kidx >= 128);
            s[nn][r] = valid ? s[nn][r] : -1e30f; mx = fmaxf(mx, s[nn][r]); }
    mx = fmaxf(mx, __shfl_xor(mx, 16)); mx = fmaxf(mx, __shfl_xor(mx, 32));
    float sum = 0.f;
#pragma unroll
    for (int nn = 0; nn < 9; ++nn)
#pragma unroll
        for (int r = 0; r < 4; ++r) { const float p = s[nn][r] > -1e29f ? __expf(s[nn][r] - mx) : 0.f; s[nn][r] = p; sum += p; }
    sum += __shfl_xor(sum, 16); sum += __shfl_xor(sum, 32);
    sum += __expf(sink - mx);
    f32x4 o[4];
#pragma unroll
    for (int db = 0; db < 4; ++db) o[db] = (f32x4){0.f, 0.f, 0.f, 0.f};
    const int tq = (lane & 15) >> 2, tpp = lane & 3;
#pragma unroll
    for (int G = 0; G < 5; ++G) {
        const u32x4 pw = {pk2(s[2 * G][0], s[2 * G][1]), pk2(s[2 * G][2], s[2 * G][3]), pk2(s[2 * G + 1][0], s[2 * G + 1][1]), pk2(s[2 * G + 1][2], s[2 * G + 1][3])};
        const bf16x8 pf = __builtin_bit_cast(bf16x8, pw);
        int k0 = 16 * (wave + 2 * G) + 4 * fq + tq, k1 = k0 + 16; k0 = k0 > 255 ? 255 : k0; k1 = k1 > 255 ? 255 : k1;
#pragma unroll
        for (int db = 0; db < 4; ++db) {
            const int colb = (32 * (db >> 1) + 8 * tpp + 4 * (db & 1)) * 2; const bf16x8 vf = tr_pair(Vimg + k0 * 144 + colb, Vimg + k1 * 144 + colb);
            o[db] = __builtin_amdgcn_mfma_f32_16x16x32_bf16(vf, pf, o[db], 0, 0, 0);
        }
    }
    const float inv = 1.0f / sum;
#pragma unroll
    for (int dp = 0; dp < 2; ++dp) { u32x4 w; w.x = pk2(o[2 * dp][0] * inv, o[2 * dp][1] * inv); w.y = pk2(o[2 * dp][2] * inv, o[2 * dp][3] * inv); w.z = pk2(o[2 * dp + 1][0] * inv, o[2 * dp + 1][1] * inv); w.w = pk2(o[2 * dp + 1][2] * inv, o[2 * dp + 1][3] * inv);
        *(u32x4*)(H + qrow * DIN + C_QA + head * 64 + 32 * dp + 8 * fq) = w; }
    __syncthreads();
}

__device__ __forceinline__ void attn_sample_unit(const Args& a, bf16_t* H, LAS unsigned char* lds, int b, int tid, int lane, int wave) {
    const int head = wave, g = head >> 2; const size_t r0 = (size_t)MP + 4 * b;
    LAS float* qs = (LAS float*)(lds + wave * 4096); LAS float* ps = qs + 256;
#pragma unroll
    for (int t = 0; t < 4; ++t) qs[t * 64 + lane] = bf2f(H[(r0 + t) * DIN + C_QA + head * 64 + lane]);
    asm volatile("s_waitcnt lgkmcnt(0)" ::: "memory");
    float sc[3][4];
    {
        const float* kp0 = a.cache_k + ((size_t)(b * 128 + lane) * 2 + g) * 64; const float* kp1 = kp0 + (size_t)64 * 128;
        const bf16_t* kpn = H + (r0 + (lane & 3)) * DIN + C_KA + g * 64;
#pragma unroll
        for (int t = 0; t < 4; ++t) { sc[0][t] = 0.f; sc[1][t] = 0.f; sc[2][t] = 0.f; }
#pragma nounroll
        for (int hf = 0; hf < 2; ++hf) {
            f32x4 kv0[8], kv1[8]; u32x4 kw[4];
#pragma unroll
            for (int d4 = 0; d4 < 8; ++d4) { kv0[d4] = *(const f32x4*)(kp0 + 32 * hf + 4 * d4); kv1[d4] = *(const f32x4*)(kp1 + 32 * hf + 4 * d4); }
#pragma unroll
            for (int c8 = 0; c8 < 4; ++c8) kw[c8] = *(const u32x4*)(kpn + 32 * hf + 8 * c8);
#pragma unroll
            for (int d4 = 0; d4 < 8; ++d4)
#pragma unroll
                for (int e = 0; e < 4; ++e) { const int d = 4 * d4 + e; const unsigned w = kw[d >> 3][(d & 7) >> 1]; const float kn = (d & 1) ? bfhi(w) : bflo(w);
#pragma unroll
                    for (int t = 0; t < 4; ++t) { const float q = qs[t * 64 + 32 * hf + d]; sc[0][t] += q * kv0[d4][e]; sc[1][t] += q * kv1[d4][e]; sc[2][t] += q * kn; } }
        }
    }
    const float sink = a.sinks[head];
    float inv[4];
#pragma unroll
    for (int t = 0; t < 4; ++t) {
        const bool v0 = lane > t, v1 = true, v2 = (lane < 4) && (lane <= t);
        const float s0 = v0 ? sc[0][t] : -1e30f, s1 = v1 ? sc[1][t] : -1e30f, s2 = v2 ? sc[2][t] : -1e30f;
        const float mx = fmaxf(wave_max(fmaxf(fmaxf(s0, s1), s2)), sink);
        const float p0 = v0 ? __expf(s0 - mx) : 0.f, p1 = __expf(s1 - mx), p2 = v2 ? __expf(s2 - mx) : 0.f;
        const float sum = wave_sum(p0 + p1 + p2) + __expf(sink - mx);
        inv[t] = 1.0f / sum;
        ps[t * 136 + lane] = p0; ps[t * 136 + 64 + lane] = p1; if (lane < 4) ps[t * 136 + 128 + lane] = p2;
    }
    asm volatile("s_waitcnt lgkmcnt(0)" ::: "memory");
    float o0 = 0.f, o1 = 0.f, o2 = 0.f, o3 = 0.f;
    const float* vp = a.cache_v + ((size_t)(b * 128) * 2 + g) * 64 + lane;
#pragma nounroll
    for (int rb = 0; rb < 2; ++rb) {
        float vx[64];
#pragma unroll
        for (int r = 0; r < 64; ++r) vx[r] = vp[(size_t)(64 * rb + r) * 128];
#pragma unroll
        for (int r = 0; r < 64; ++r) { const int rr = 64 * rb + r; o0 += ps[0 * 136 + rr] * vx[r]; o1 += ps[1 * 136 + rr] * vx[r]; o2 += ps[2 * 136 + rr] * vx[r]; o3 += ps[3 * 136 + rr] * vx[r]; }
    }
#pragma unroll
    for (int tn = 0; tn < 4; ++tn) { const float vx = bf2f(H[(r0 + tn) * DIN + C_VA + g * 64 + lane]); o0 += ps[0 * 136 + 128 + tn] * vx; o1 += ps[1 * 136 + 128 + tn] * vx; o2 += ps[2 * 136 + 128 + tn] * vx; o3 += ps[3 * 136 + 128 + tn] * vx; }
    H[(r0 + 0) * DIN + C_QA + head * 64 + lane] = (bf16_t)(pk2(o0 * inv[0], 0.f) & 0xffffu);
    H[(r0 + 1) * DIN + C_QA + head * 64 + lane] = (bf16_t)(pk2(o1 * inv[1], 0.f) & 0xffffu);
    H[(r0 + 2) * DIN + C_QA + head * 64 + lane] = (bf16_t)(pk2(o2 * inv[2], 0.f) & 0xffffu);
    H[(r0 + 3) * DIN + C_QA + head * 64 + lane] = (bf16_t)(pk2(o3 * inv[3], 0.f) & 0xffffu);
    float* ko = a.out + O_KS + (size_t)b * 128 * 128; float* vo = a.out + O_VS + (size_t)b * 128 * 128;
    const float* ki = a.cache_k + (size_t)b * 128 * 128 + 4 * 128; const float* vi = a.cache_v + (size_t)b * 128 * 128 + 4 * 128;
    for (int i = tid; i < 124 * 32; i += NTHREADS) { ((f32x4*)ko)[i] = ((const f32x4*)ki)[i]; ((f32x4*)vo)[i] = ((const f32x4*)vi)[i]; }
    { const int t = tid >> 7, gd = tid & 127;
      ko[(size_t)(124 + t) * 128 + gd] = bf2f(H[(r0 + t) * DIN + C_KA + gd]); vo[(size_t)(124 + t) * 128 + gd] = bf2f(H[(r0 + t) * DIN + C_VA + gd]); }
}

__device__ __forceinline__ void ret_u_unit(const bf16_t* H, bf16_t* ST, LAS unsigned char* lds, int b, int c, int h, int tid, int lane, int wave) {
    const size_t rowc = (size_t)b * TSEQ + (size_t)c * 128; const float l2g = ret_log2g(h);
    LAS unsigned char* Kimg = lds; LAS unsigned char* Vimg = lds + 36864;
#pragma unroll
    for (int i = 0; i < 4; ++i) { const int id = tid + NTHREADS * i, j = id >> 4, ch = id & 15;
        const u32x4 kv = *(const u32x4*)(H + (rowc + j) * DIN + C_KR + h * 128 + ch * 8); const float kd = exp2f(l2g * (float)(127 - j));
        u32x4 w; w.x = pk2(bflo(kv.x) * kd, bfhi(kv.x) * kd); w.y = pk2(bflo(kv.y) * kd, bfhi(kv.y) * kd); w.z = pk2(bflo(kv.z) * kd, bfhi(kv.z) * kd); w.w = pk2(bflo(kv.w) * kd, bfhi(kv.w) * kd);
        *(LAS u32x4*)(Kimg + j * 288 + ch * 16) = w; }
#pragma unroll
    for (int i = 0; i < 8; ++i) { const int id = tid + NTHREADS * i, j = id >> 5, ch = id & 31;
        *(LAS u32x4*)(Vimg + j * 544 + ch * 16) = *(const u32x4*)(H + (rowc + j) * DIN + C_VR + h * 256 + ch * 8); }
    __syncthreads();
    const int fr = lane & 15, fq = lane >> 4, tq = fr >> 2, tpp = lane & 3;
    f32x4 acc[2][8];
#pragma unroll
    for (int i = 0; i < 2; ++i)
#pragma unroll
        for (int j = 0; j < 8; ++j) acc[i][j] = (f32x4){0.f, 0.f, 0.f, 0.f};
#pragma unroll
    for (int ks = 0; ks < 4; ++ks) {
        const int j0 = 32 * ks + 4 * fq + tq, j1 = j0 + 16;
        bf16x8 vf[2];
#pragma unroll
        for (int i = 0; i < 2; ++i) { const int col = 32 * wave + 8 * tpp + 4 * i; vf[i] = tr_pair(Vimg + j0 * 544 + col * 2, Vimg + j1 * 544 + col * 2); }
#pragma unroll
        for (int kb = 0; kb < 8; ++kb) { const int col = 16 * kb + 4 * tpp; const bf16x8 kf = tr_pair(Kimg + j0 * 288 + col * 2, Kimg + j1 * 288 + col * 2);
#pragma unroll
            for (int i = 0; i < 2; ++i) acc[i][kb] = __builtin_amdgcn_mfma_f32_16x16x32_bf16(vf[i], kf, acc[i][kb], 0, 0, 0); }
    }
    bf16_t* U = ST + ((size_t)(b * 32 + c) * 4 + h) * 32768;
#pragma unroll
    for (int kb = 0; kb < 8; ++kb) { u32x4 w; w.x = pk2(acc[0][kb][0], acc[0][kb][1]); w.y = pk2(acc[0][kb][2], acc[0][kb][3]); w.z = pk2(acc[1][kb][0], acc[1][kb][1]); w.w = pk2(acc[1][kb][2], acc[1][kb][3]);
        *(u32x4*)(U + (size_t)(16 * kb + fr) * 256 + 32 * wave + 8 * fq) = w; }
    __syncthreads();
}

__device__ __forceinline__ void ret_sample_unit(const Args& a, bf16_t* H, LAS unsigned char* lds, int b, int h, int tid, int lane, int wave) {
    const size_t r0 = (size_t)MP + 4 * b; const float g = 1.0f - exp2f(-5.0f - (float)h);
    LAS float* qs = (LAS float*)lds; LAS float* ks = qs + 512; LAS float* po = ks + 512; LAS float* red = po + 2048;
    const int dv = tid & 255, half = tid >> 8;
    for (int i = tid; i < 1024; i += NTHREADS) { const int which = i >> 9, t = (i >> 7) & 3, d = i & 127;
        const float v = bf2f(H[(r0 + t) * DIN + (which ? C_KR : C_QR) + h * 128 + d]); if (which) ks[t * 128 + d] = v; else qs[t * 128 + d] = v; }
    float vt[4], gt[4];
#pragma unroll
    for (int t = 0; t < 4; ++t) { vt[t] = bf2f(H[(r0 + t) * DIN + C_VR + h * 256 + dv]); gt[t] = bf2f(H[(r0 + t) * DIN + C_GATE + h * 256 + dv]); }
    float S[64];
    const float* sp = a.state_ret + ((size_t)(b * 4 + h) * 128 + 64 * half) * 256 + dv;
#pragma unroll
    for (int d = 0; d < 64; ++d) S[d] = sp[(size_t)d * 256];
    __syncthreads();
#pragma unroll
    for (int t = 0; t < 4; ++t) { float o = 0.f;
#pragma unroll
        for (int d = 0; d < 64; ++d) { S[d] = g * S[d] + ks[t * 128 + 64 * half + d] * vt[t]; o += qs[t * 128 + 64 * half + d] * S[d]; }
        po[(half * 4 + t) * 256 + dv] = o; }
    float* so = a.out + O_RS + ((size_t)(b * 4 + h) * 128 + 64 * half) * 256 + dv;
#pragma unroll
    for (int d = 0; d < 64; ++d) so[(size_t)d * 256] = S[d];
    __syncthreads();
    float ot[4];
#pragma unroll
    for (int t = 0; t < 4; ++t) { ot[t] = po[t * 256 + dv] + po[(4 + t) * 256 + dv]; const float sq = wave_sum(half == 0 ? ot[t] * ot[t] : 0.f); if (lane == 0) red[wave * 4 + t] = sq; }
    __syncthreads();
    if (half == 0) {
#pragma unroll
        for (int t = 0; t < 4; ++t) { float ss = 0.f;
#pragma unroll
            for (int w = 0; w < 8; ++w) ss += red[w * 4 + t];
            const float rstd = rsqrtf(ss * (1.f / 256.f) + EPS); const float gv = gt[t]; const float sil = gv / (1.0f + __expf(-gv));
            H[(r0 + t) * DIN + C_VR + h * 256 + dv] = (bf16_t)(pk2(ot[t] * rstd * sil, 0.f) & 0xffffu); }
    }
    __syncthreads();
}

__device__ __forceinline__ void ret_out_unit(bf16_t* H, const bf16_t* ST, LAS unsigned char* lds, int b, int c, int h, int tid, int lane, int wave) {
    const size_t rowc = (size_t)b * TSEQ + (size_t)c * 128; const float l2g = ret_log2g(h);
    LAS unsigned char* Kimg = lds; LAS unsigned char* BIG = lds + 36864;
    const int fr = lane & 15, fq = lane >> 4, tq = fr >> 2, tpp = lane & 3;
    const int qi = 16 * wave + fr; const size_t qrow = rowc + qi;
    u32x4 kreg[4], sreg[8], vreg[8]; u32x4 greg[8];
#pragma unroll
    for (int i = 0; i < 4; ++i) { const int id = tid + NTHREADS * i, j = id >> 4, ch = id & 15; kreg[i] = *(const u32x4*)(H + (rowc + j) * DIN + C_KR + h * 128 + ch * 8); }
    if (c > 0) {
        const bf16_t* S = ST + ((size_t)(b * 32 + c) * 4 + h) * 32768;
#pragma unroll
        for (int i = 0; i < 8; ++i) { const int id = tid + NTHREADS * i, dk = id >> 5, ch = id & 31; sreg[i] = *(const u32x4*)(S + (size_t)dk * 256 + ch * 8); }
    }
    bf16x8 qf[4];
#pragma unroll
    for (int ks = 0; ks < 4; ++ks) { const bf16_t* qp = H + qrow * DIN + C_QR + h * 128 + 32 * ks + 4 * fq; qf[ks] = cat8(*(const u32x2*)qp, *(const u32x2*)(qp + 16)); }
#pragma unroll
    for (int i = 0; i < 8; ++i) { const int id = tid + NTHREADS * i, j = id >> 5, ch = id & 31; vreg[i] = *(const u32x4*)(H + (rowc + j) * DIN + C_VR + h * 256 + ch * 8); }
#pragma unroll
    for (int i = 0; i < 4; ++i) { const int id = tid + NTHREADS * i, j = id >> 4, ch = id & 15; *(LAS u32x4*)(Kimg + j * 288 + ch * 16) = kreg[i]; }
    if (c > 0) {
#pragma unroll
        for (int i = 0; i < 8; ++i) { const int id = tid + NTHREADS * i, dk = id >> 5, ch = id & 31; *(LAS u32x4*)(BIG + dk * 544 + ch * 16) = sreg[i]; }
    }
    __syncthreads();
    f32x4 acc[16];
#pragma unroll
    for (int k = 0; k < 16; ++k) acc[k] = (f32x4){0.f, 0.f, 0.f, 0.f};
    if (c > 0) {
#pragma unroll
        for (int ks = 0; ks < 4; ++ks) { const int d0 = 32 * ks + 4 * fq + tq, d1 = d0 + 16;
#pragma unroll
            for (int blk = 0; blk < 16; ++blk) { const int colb = (32 * (blk >> 1) + 8 * tpp + 4 * (blk & 1)) * 2; const bf16x8 sf = tr_pair(BIG + d0 * 544 + colb, BIG + d1 * 544 + colb);
                acc[blk] = __builtin_amdgcn_mfma_f32_16x16x32_bf16(sf, qf[ks], acc[blk], 0, 0, 0); } }
        const float qd = exp2f(l2g * (float)(qi + 1));
#pragma unroll
        for (int blk = 0; blk < 16; ++blk) acc[blk] = acc[blk] * qd;
    }
    bf16x8 pf[4];
#pragma unroll
    for (int G = 0; G < 4; ++G) {
        f32x4 sc[2];
#pragma unroll
        for (int e = 0; e < 2; ++e) { const int jb = 2 * G + e; sc[e] = (f32x4){0.f, 0.f, 0.f, 0.f};
            if (jb <= wave) {
#pragma unroll
                for (int ks = 0; ks < 4; ++ks) { const LAS unsigned char* kp = Kimg + (16 * jb + fr) * 288 + (32 * ks + 4 * fq) * 2;
                    const bf16x8 kf = cat8(*(const LAS u32x2*)kp, *(const LAS u32x2*)(kp + 32)); sc[e] = __builtin_amdgcn_mfma_f32_16x16x32_bf16(kf, qf[ks], sc[e], 0, 0, 0); }
#pragma unroll
                for (int r = 0; r < 4; ++r) { const int j = 16 * jb + 4 * fq + r; sc[e][r] = (j <= qi) ? sc[e][r] * exp2f(l2g * (float)(qi - j)) : 0.f; }
            } }
        const u32x4 pw = {pk2(sc[0][0], sc[0][1]), pk2(sc[0][2], sc[0][3]), pk2(sc[1][0], sc[1][1]), pk2(sc[1][2], sc[1][3])};
        pf[G] = __builtin_bit_cast(bf16x8, pw);
    }
    __syncthreads();
#pragma unroll
    for (int i = 0; i < 8; ++i) { const int id = tid + NTHREADS * i, j = id >> 5, ch = id & 31; *(LAS u32x4*)(BIG + j * 544 + ch * 16) = vreg[i]; }
#pragma unroll
    for (int k = 0; k < 8; ++k) greg[k] = *(const u32x4*)(H + qrow * DIN + C_GATE + h * 256 + 32 * k + 8 * fq);
    __syncthreads();
#pragma unroll
    for (int G = 0; G < 4; ++G) {
        if (2 * G <= wave) { const int j0 = 32 * G + 4 * fq + tq, j1 = j0 + 16;
#pragma unroll
            for (int blk = 0; blk < 16; ++blk) { const int colb = (32 * (blk >> 1) + 8 * tpp + 4 * (blk & 1)) * 2; const bf16x8 vf = tr_pair(BIG + j0 * 544 + colb, BIG + j1 * 544 + colb);
                acc[blk] = __builtin_amdgcn_mfma_f32_16x16x32_bf16(vf, pf[G], acc[blk], 0, 0, 0); } }
    }
    float ss = 0.f;
#pragma unroll
    for (int blk = 0; blk < 16; ++blk) ss += (acc[blk][0] * acc[blk][0] + acc[blk][1] * acc[blk][1]) + (acc[blk][2] * acc[blk][2] + acc[blk][3] * acc[blk][3]);
    ss += __shfl_xor(ss, 16); ss += __shfl_xor(ss, 32);
    const float rstd = rsqrtf(ss * (1.f / 256.f) + EPS);
#pragma unroll
    for (int k = 0; k < 8; ++k) {
        const u32x4 gw = greg[k]; u32x4 w;
#pragma unroll
        for (int q = 0; q < 4; ++q) { const float g0 = bflo(gw[q]), g1 = bfhi(gw[q]); const f32x4 av = acc[2 * k + (q >> 1)];
            const float a0 = av[(2 * q) & 3], a1 = av[(2 * q + 1) & 3];
            w[q] = pk2(a0 * rstd * g0 / (1.f + __expf(-g0)), a1 * rstd * g1 / (1.f + __expf(-g1))); }
        *(u32x4*)(H + qrow * DIN + C_VR + h * 256 + 32 * k + 8 * fq) = w;
    }
    __syncthreads();
}

__device__ __forceinline__ f32x4 tail_gemm(const bf16_t* A, int lda, const bf16_t* Bt, int K, LAS unsigned char* lds, int tid, int lane, int wave, f32x4 acc) {
    const int fr = lane & 15, fq = lane >> 4, nc = K / 512;
    LAS unsigned char* Ai = lds; LAS unsigned char* Bi = lds + 33280;
    u32x4 ra[4], rb[8];
#pragma unroll
    for (int i = 0; i < 4; ++i) { const int id = tid + NTHREADS * i; ra[i] = *(const u32x4*)(A + (size_t)(id >> 6) * lda + (id & 63) * 8); }
#pragma unroll
    for (int i = 0; i < 8; ++i) { const int id = tid + NTHREADS * i; rb[i] = *(const u32x4*)(Bt + (size_t)(id >> 6) * K + (id & 63) * 8); }
#pragma nounroll
    for (int c = 0; c < nc; ++c) {
#pragma unroll
        for (int i = 0; i < 4; ++i) { const int id = tid + NTHREADS * i; *(LAS u32x4*)(Ai + (id >> 6) * 1040 + (id & 63) * 16) = ra[i]; }
#pragma unroll
        for (int i = 0; i < 8; ++i) { const int id = tid + NTHREADS * i; *(LAS u32x4*)(Bi + (id >> 6) * 1040 + (id & 63) * 16) = rb[i]; }
        __syncthreads();
        if (c + 1 < nc) {
#pragma unroll
            for (int i = 0; i < 4; ++i) { const int id = tid + NTHREADS * i; ra[i] = *(const u32x4*)(A + (size_t)(id >> 6) * lda + (c + 1) * 512 + (id & 63) * 8); }
#pragma unroll
            for (int i = 0; i < 8; ++i) { const int id = tid + NTHREADS * i; rb[i] = *(const u32x4*)(Bt + (size_t)(id >> 6) * K + (c + 1) * 512 + (id & 63) * 8); }
        }
        const LAS unsigned char* ap = Ai + (16 * (wave >> 2) + fr) * 1040 + fq * 16; const LAS unsigned char* bp = Bi + (16 * (wave & 3) + fr) * 1040 + fq * 16;
#pragma unroll
        for (int ks = 0; ks < 16; ++ks) { const bf16x8 av = *(const LAS bf16x8*)(ap + ks * 64), bv = *(const LAS bf16x8*)(bp + ks * 64); acc = __builtin_amdgcn_mfma_f32_16x16x32_bf16(bv, av, acc, 0, 0, 0); }
        __syncthreads();
    }
    return acc;
}

__global__ void __launch_bounds__(NTHREADS, 2) fwd_megakernel(Args a) {
    extern __shared__ __attribute__((aligned(16))) unsigned char lds_raw[];
    LAS unsigned char* lds = (LAS unsigned char*)lds_raw;
    cg::grid_group grid = cg::this_grid();
    const int tid = threadIdx.x, lane = tid & 63, wave = __builtin_amdgcn_readfirstlane(tid >> 6);
    const int nblk = gridDim.x, blk = blockIdx.x;
    unsigned char* ws = a.ws;
    bf16_t* WinT = (bf16_t*)(ws + WS_WIN); bf16_t* WupT = (bf16_t*)(ws + WS_WUP); bf16_t* WdnT = (bf16_t*)(ws + WS_WDN);
    bf16_t* WoT = (bf16_t*)(a.out + O_CS); bf16_t* WaT = WoT + 1024 * 1024; bf16_t* WrT = WaT + 1024 * 512;
    bf16_t* XN = (bf16_t*)(ws + WS_XN); bf16_t* H = (bf16_t*)(ws + WS_R1);
    bf16_t* MIXb = (bf16_t*)(ws + WS_R1);
    bf16_t* G = (bf16_t*)(ws + WS_R1 + R1_G); bf16_t* Fb = (bf16_t*)(ws + WS_R1 + R1_F); bf16_t* X1b = (bf16_t*)(ws + WS_R1 + R1_X1); bf16_t* UH = (bf16_t*)(ws + WS_R1 + R1_UH); bf16_t* US = (bf16_t*)(ws + WS_R1 + R1_US);
    bf16_t* ST = (bf16_t*)(a.out + O_Y);
    float* Y = a.out + O_Y;
    const int lo = a.ph_lo, hi = a.ph_hi;
#ifndef PROBE_REP_MASK
#define PROBE_REP_MASK 0
#endif
#define IN(k) (lo <= (k) && (k) < hi)
#define REPS(k) (((PROBE_REP_MASK >> (k)) & 1) ? 2 : 1)
#define SEAM(k) do { if (IN(k) && IN((k) + 1)) { asm volatile("s_waitcnt vmcnt(0)" ::: "memory"); __syncthreads(); grid.sync(); } } while (0)

    if (IN(0)) { p0_prologue(a, lds, tid, lane, wave); }
    SEAM(0);
    if (IN(1)) {
        pg8::Gemm g{XN, WinT, M, DIN, D, D}; pg8::StaticOrder S; S.init(M, DIN, nblk, blk);
        pg8::EpiH E{H, (const pg8::f32x2e*)(ws + WS_TABA), (const pg8::f32x2e*)(ws + WS_TABR)};
        pg8::gemm_phase<pg8::EpiH, pg8::StaticOrder, true, true>(lds, g, S, E);
    }
    SEAM(1);
    if (IN(2)) {
        for (int u = blk; u < 1024; u += nblk) { const int head = u & 7, qb = (u >> 3) & 31, b = u >> 8; attn_prompt_unit(H, a.sinks, lds, b, qb, head, tid, lane, wave); }
        for (int u = blk; u < 512; u += nblk) { const int h = u & 3, c = (u >> 2) & 31, b = u >> 7; ret_u_unit(H, ST, lds, b, c, h, tid, lane, wave); }
        for (int u = blk; u < 128; u += nblk) { attn_sample_unit(a, H, lds, u, tid, lane, wave); __syncthreads(); }
        for (int u = blk; u < 512; u += nblk) { ret_sample_unit(a, H, lds, u >> 2, u & 3, tid, lane, wave); }
        for (int e = blk * NTHREADS + tid; e < 4 * 128 * 128; e += nblk * NTHREADS) { const int gd = e & 127, r = (e >> 7) & 127, b = e >> 14; const size_t row = (size_t)b * TSEQ + TSEQ - 128 + r;
            a.out[O_KP + e] = bf2f(H[row * DIN + C_KA + gd]); a.out[O_VP + e] = bf2f(H[row * DIN + C_VA + gd]); }
    }
    SEAM(2);
    if (IN(3)) {
        for (int e4 = blk * NTHREADS + tid; e4 < 16 * 8192; e4 += nblk * NTHREADS) {
            const int bh = e4 >> 13, idx = (e4 & 8191) * 4, b = bh >> 2, h = bh & 3;
            const float gL = exp2f(128.f * ret_log2g(h));
            f32x4 S = {0.f, 0.f, 0.f, 0.f};
#pragma unroll 8
            for (int c = 0; c < 32; ++c) { bf16_t* p = ST + ((size_t)(b * 32 + c) * 4 + h) * 32768 + idx; const u32x2 uw = *(const u32x2*)p; u32x2 sw; sw.x = pk2(S.x, S.y); sw.y = pk2(S.z, S.w); *(u32x2*)p = sw;
                const f32x4 uu = {bflo(uw.x), bfhi(uw.x), bflo(uw.y), bfhi(uw.y)}; S = S * gL + uu; }
            *(f32x4*)(a.out + O_RP + (size_t)bh * 32768 + idx) = S;
        }
    }
    SEAM(3);
    if (IN(4)) {
        for (int u = blk; u < 512; u += nblk) { const int h = u & 3, c = (u >> 2) & 31, b = u >> 7; ret_out_unit(H, ST, lds, b, c, h, tid, lane, wave); }
    }
    SEAM(4);
    if (IN(5)) {
        { pg8::Gemm g{H + C_QA, WaT, MP, D, 512, DIN}; pg8::StaticOrder S; S.init(MP, D, nblk, blk);
          pg8::EpiGate<false> E{XN, H + C_GMA, DIN}; pg8::gemm_phase<pg8::EpiGate<false>, pg8::StaticOrder, true, true>(lds, g, S, E); }
        __syncthreads();
        { pg8::Gemm g{H + C_VR, WrT, MP, D, D, DIN}; pg8::StaticOrder S; S.init(MP, D, nblk, blk);
          pg8::EpiGate<true> E{XN, H + C_GMR, DIN}; pg8::gemm_phase<pg8::EpiGate<true>, pg8::StaticOrder, true, true>(lds, g, S, E); }
        for (int piece = blk; piece < 256; piece += nblk) {
            const int fr = lane & 15, fq = lane >> 4; const size_t prow = (size_t)MP + 32 * (piece >> 4); const size_t row = prow + 16 * (wave >> 2) + fr; const int pcol = 64 * (piece & 15), col0 = pcol + 16 * (wave & 3);
            const f32x4 aa = tail_gemm(H + prow * DIN + C_QA, DIN, WaT + (size_t)pcol * 512, 512, lds, tid, lane, wave, (f32x4){0.f, 0.f, 0.f, 0.f});
            const f32x4 ar = tail_gemm(H + prow * DIN + C_VR, DIN, WrT + (size_t)pcol * 1024, 1024, lds, tid, lane, wave, (f32x4){0.f, 0.f, 0.f, 0.f});
            const int cb = col0 + 4 * fq;
            const u32x2 ga = *(const u32x2*)(H + row * DIN + C_GMA + cb), gr = *(const u32x2*)(H + row * DIN + C_GMR + cb);
            u32x2 w; w.x = pk2(pg8::sigmoidf_(bflo(ga.x)) * aa[0] + pg8::sigmoidf_(bflo(gr.x)) * ar[0], pg8::sigmoidf_(bfhi(ga.x)) * aa[1] + pg8::sigmoidf_(bfhi(gr.x)) * ar[1]);
            w.y = pk2(pg8::sigmoidf_(bflo(ga.y)) * aa[2] + pg8::sigmoidf_(bflo(gr.y)) * ar[2], pg8::sigmoidf_(bfhi(ga.y)) * aa[3] + pg8::sigmoidf_(bfhi(gr.y)) * ar[3]);
            *(u32x2*)(XN + row * D + cb) = w;
        }
    }
    SEAM(5);
    if (IN(6)) {
        pg8::Gemm g{XN, WoT, MP, D, D, D}; pg8::StaticOrder S; S.init(MP, D, nblk, blk);
        pg8::EpiBf16<0> E{MIXb, D, nullptr, 0, 0, 1.f}; pg8::gemm_phase<pg8::EpiBf16<0>, pg8::StaticOrder, true, true>(lds, g, S, E);
        for (int piece = blk; piece < 256; piece += nblk) {
            const int fr = lane & 15, fq = lane >> 4; const size_t prow = (size_t)MP + 32 * (piece >> 4); const size_t row = prow + 16 * (wave >> 2) + fr; const int pcol = 64 * (piece & 15), col0 = pcol + 16 * (wave & 3);
            const f32x4 ac = tail_gemm(XN + prow * D, D, WoT + (size_t)pcol * 1024, 1024, lds, tid, lane, wave, (f32x4){0.f, 0.f, 0.f, 0.f});
            u32x2 w; w.x = pk2(ac[0], ac[1]); w.y = pk2(ac[2], ac[3]); *(u32x2*)(MIXb + row * D + col0 + 4 * fq) = w;
        }
    }
    SEAM(6);
    if (IN(7)) {
        f32x4 gpm[2][2], gpf[2][2];
#pragma unroll
        for (int j = 0; j < 2; ++j)
#pragma unroll
            for (int e = 0; e < 2; ++e) { gpm[j][e] = *((const f32x4*)a.g_post_mix + 2 * (lane + 64 * j) + e); gpf[j][e] = *((const f32x4*)a.g_pre_ffn + 2 * (lane + 64 * j) + e); }
        for (int p = blk * NWAVES + wave; p < M / 2; p += nblk * NWAVES) {
            u32x4 mb[2][2]; f32x4 xx[2][2][2];
#pragma unroll
            for (int rr = 0; rr < 2; ++rr) { const int m = 2 * p + rr; const float* xr = m < MP ? a.x_prompt + (size_t)m * D : a.x_sample + (size_t)(m - MP) * D;
#pragma unroll
                for (int j = 0; j < 2; ++j) { mb[rr][j] = *((const u32x4*)(MIXb + (size_t)m * D) + lane + 64 * j); xx[rr][j][0] = *((const f32x4*)xr + 2 * (lane + 64 * j)); xx[rr][j][1] = *((const f32x4*)xr + 2 * (lane + 64 * j) + 1); } }
            float mv[2][2][8]; float ss[2];
#pragma unroll
            for (int rr = 0; rr < 2; ++rr) { ss[rr] = 0.f;
#pragma unroll
                for (int j = 0; j < 2; ++j)
#pragma unroll
                    for (int q = 0; q < 4; ++q) { const unsigned w = mb[rr][j][q]; mv[rr][j][2 * q] = bflo(w); mv[rr][j][2 * q + 1] = bfhi(w); ss[rr] += mv[rr][j][2 * q] * mv[rr][j][2 * q] + mv[rr][j][2 * q + 1] * mv[rr][j][2 * q + 1]; } }
            ss[0] = wave_sum(ss[0]); ss[1] = wave_sum(ss[1]);
            float s2[2];
#pragma unroll
            for (int rr = 0; rr < 2; ++rr) { const float rstd = rsqrtf(ss[rr] * (1.f / D) + EPS); s2[rr] = 0.f;
#pragma unroll
                for (int j = 0; j < 2; ++j)
#pragma unroll
                    for (int q = 0; q < 8; ++q) { const float x1 = xx[rr][j][q >> 2][q & 3] + mv[rr][j][q] * rstd * gpm[j][q >> 2][q & 3]; mv[rr][j][q] = x1; s2[rr] += x1 * x1; } }
            s2[0] = wave_sum(s2[0]); s2[1] = wave_sum(s2[1]);
#pragma unroll
            for (int rr = 0; rr < 2; ++rr) { const int m = 2 * p + rr; const float rstd2 = rsqrtf(s2[rr] * (1.f / D) + EPS);
#pragma unroll
                for (int j = 0; j < 2; ++j) { u32x4 w1, w2;
#pragma unroll
                    for (int q = 0; q < 4; ++q) { const float a0 = mv[rr][j][2 * q], a1 = mv[rr][j][2 * q + 1]; w1[q] = pk2(a0, a1);
                        w2[q] = pk2(a0 * rstd2 * gpf[j][(2 * q) >> 2][(2 * q) & 3], a1 * rstd2 * gpf[j][(2 * q + 1) >> 2][(2 * q + 1) & 3]); }
                    *((u32x4*)(X1b + (size_t)m * D) + lane + 64 * j) = w1; *((u32x4*)(XN + (size_t)m * D) + lane + 64 * j) = w2; } }
        }
    }
    SEAM(7);
    if (IN(8)) {
        pg8::Gemm g{XN, WupT, M, F2, D, D}; pg8::StaticOrder S; S.init(M, F2, nblk, blk);
        pg8::EpiUp E{G, UH, US, a.out + O_CP, a.out + O_CS, a.conv_w, a.conv_b};
        pg8::gemm_phase<pg8::EpiUp, pg8::StaticOrder, true, true>(lds, g, S, E);
    }
    SEAM(8);
    if (IN(9)) {
        for (int task = blk * NWAVES + wave; task < 1024 * 6; task += nblk * NWAVES) {
            const int rt = task / 6, chunk = task % 6; const int ch = chunk * 512 + lane * 8;
            float ua[3][8], ub[3][8];
            int row;
#define LD8BF(dst, ptr) do { const u32x4 _w = *(const u32x4*)(ptr); dst[0] = bflo(_w.x); dst[1] = bfhi(_w.x); dst[2] = bflo(_w.y); dst[3] = bfhi(_w.y); dst[4] = bflo(_w.z); dst[5] = bfhi(_w.z); dst[6] = bflo(_w.w); dst[7] = bfhi(_w.w); } while (0)
#define LD8F(dst, ptr) do { const f32x4 _a = *(const f32x4*)(ptr), _b = *(const f32x4*)((ptr) + 4); dst[0] = _a.x; dst[1] = _a.y; dst[2] = _a.z; dst[3] = _a.w; dst[4] = _b.x; dst[5] = _b.y; dst[6] = _b.z; dst[7] = _b.w; } while (0)
#define ZERO8(dst) do { _Pragma("unroll") for (int _i = 0; _i < 8; ++_i) dst[_i] = 0.f; } while (0)
            if (rt < 512) {
                const int grp = rt >> 1, k = rt & 1; row = grp * 64 + k; const int t = row & 4095;
                const bf16_t* u0 = UH + (size_t)(grp * 4 + 2 + k) * F2;
                LD8BF(ua[2], u0 + ch); LD8BF(ub[2], u0 + DFF + ch);
                if (t >= 1) { const bf16_t* u1 = (k == 0) ? UH + (size_t)((grp - 1) * 4 + 1) * F2 : UH + (size_t)(grp * 4 + 2) * F2; LD8BF(ua[1], u1 + ch); LD8BF(ub[1], u1 + DFF + ch); } else { ZERO8(ua[1]); ZERO8(ub[1]); }
                if (t >= 2) { const bf16_t* u2 = UH + (size_t)((grp - 1) * 4 + k) * F2; LD8BF(ua[0], u2 + ch); LD8BF(ub[0], u2 + DFF + ch); } else { ZERO8(ua[0]); ZERO8(ub[0]); }
            } else {
                const int sr = rt - 512, b = sr >> 2, t = sr & 3; row = MP + sr;
#pragma unroll
                for (int tap = 0; tap < 3; ++tap) { const int e = t + tap;
                    if (e < 2) { const float* cp = a.state_conv + ((size_t)b * 2 + e) * F2; LD8F(ua[tap], cp + ch); LD8F(ub[tap], cp + DFF + ch); }
                    else { const bf16_t* up = US + (size_t)(b * 4 + e - 2) * F2; LD8BF(ua[tap], up + ch); LD8BF(ub[tap], up + DFF + ch); } }
            }
            float wa[3][8], wb[3][8], ba[8], bb[8];
#pragma unroll
            for (int tap = 0; tap < 3; ++tap) { LD8F(wa[tap], a.conv_w + (size_t)tap * F2 + ch); LD8F(wb[tap], a.conv_w + (size_t)tap * F2 + DFF + ch); }
            LD8F(ba, a.conv_b + ch); LD8F(bb, a.conv_b + DFF + ch);
            float gg[8];
#pragma unroll
            for (int i = 0; i < 8; ++i) { const float ca = ba[i] + wa[0][i] * ua[0][i] + wa[1][i] * ua[1][i] + wa[2][i] * ua[2][i], cb = bb[i] + wb[0][i] * ub[0][i] + wb[1][i] * ub[1][i] + wb[2][i] * ub[2][i];
                gg[i] = pg8::gelu_tanh(ca) * cb; }
            u32x4 w; w.x = pk2(gg[0], gg[1]); w.y = pk2(gg[2], gg[3]); w.z = pk2(gg[4], gg[5]); w.w = pk2(gg[6], gg[7]);
            *(u32x4*)(G + (size_t)row * DFF + ch) = w;
        }
    }
    SEAM(9);
    if (IN(10)) {
        pg8::Gemm g{G, WdnT, MP, D, DFF, DFF}; pg8::StaticOrder S; S.init(MP, D, nblk, blk);
        pg8::EpiBf16<0> E{Fb, D, nullptr, 0, 0, 1.f}; pg8::gemm_phase<pg8::EpiBf16<0>, pg8::StaticOrder, true, true>(lds, g, S, E);
        for (int piece = blk; piece < 256; piece += nblk) {
            const int fr = lane & 15, fq = lane >> 4; const size_t prow = (size_t)MP + 32 * (piece >> 4); const size_t row = prow + 16 * (wave >> 2) + fr; const int pcol = 64 * (piece & 15), col0 = pcol + 16 * (wave & 3);
            const f32x4 ac = tail_gemm(G + prow * DFF, DFF, WdnT + (size_t)pcol * DFF, DFF, lds, tid, lane, wave, (f32x4){0.f, 0.f, 0.f, 0.f});
            u32x2 w; w.x = pk2(ac[0], ac[1]); w.y = pk2(ac[2], ac[3]); *(u32x2*)(Fb + row * D + col0 + 4 * fq) = w;
        }
    }
    SEAM(10);
    if (IN(11)) {
        f32x4 gpo[2][2];
#pragma unroll
        for (int j = 0; j < 2; ++j)
#pragma unroll
            for (int e = 0; e < 2; ++e) gpo[j][e] = *((const f32x4*)a.g_post_ffn + 2 * (lane + 64 * j) + e);
        for (int p = blk * NWAVES + wave; p < M / 2; p += nblk * NWAVES) {
            u32x4 fb[2][2], xb[2][2];
#pragma unroll
            for (int rr = 0; rr < 2; ++rr) { const int m = 2 * p + rr;
#pragma unroll
                for (int j = 0; j < 2; ++j) { fb[rr][j] = *((const u32x4*)(Fb + (size_t)m * D) + lane + 64 * j); xb[rr][j] = *((const u32x4*)(X1b + (size_t)m * D) + lane + 64 * j); } }
            float ss[2];
#pragma unroll
            for (int rr = 0; rr < 2; ++rr) { ss[rr] = 0.f;
#pragma unroll
                for (int j = 0; j < 2; ++j)
#pragma unroll
                    for (int q = 0; q < 4; ++q) { const unsigned w = fb[rr][j][q]; ss[rr] += bflo(w) * bflo(w) + bfhi(w) * bfhi(w); } }
            ss[0] = wave_sum(ss[0]); ss[1] = wave_sum(ss[1]);
#pragma unroll
            for (int rr = 0; rr < 2; ++rr) { const int m = 2 * p + rr; const float rstd = rsqrtf(ss[rr] * (1.f / D) + EPS);
#pragma unroll
                for (int j = 0; j < 2; ++j)
#pragma unroll
                    for (int e = 0; e < 2; ++e) { f32x4 y;
#pragma unroll
                        for (int q = 0; q < 2; ++q) { const unsigned fw = fb[rr][j][2 * e + q], xw = xb[rr][j][2 * e + q];
                            y[2 * q] = bflo(xw) + bflo(fw) * rstd * gpo[j][e][2 * q]; y[2 * q + 1] = bfhi(xw) + bfhi(fw) * rstd * gpo[j][e][2 * q + 1]; }
                        *((f32x4*)(Y + (size_t)m * D) + 2 * (lane + 64 * j) + e) = y; } }
        }
    }
#undef IN
#undef SEAM
}

#ifndef MK_SPLIT
#define MK_SPLIT 0
#endif
extern "C" void kernel_launch(void* const* d_in, const int* in_sizes, int n_in, void* d_out, int out_size, void* d_ws, size_t ws_size, hipStream_t stream) {
    static int grid = 0;
    if (grid == 0) {
        int dev = 0, cus = 0, per_cu = 0;
        if (hipGetDevice(&dev) != hipSuccess || hipDeviceGetAttribute(&cus, hipDeviceAttributeMultiprocessorCount, dev) != hipSuccess) { fprintf(stderr, "kernel_launch: device query failed\n"); grid = -1; return; }
        if (hipFuncSetAttribute((const void*)fwd_megakernel, hipFuncAttributeMaxDynamicSharedMemorySize, LDS_BYTES) != hipSuccess) { fprintf(stderr, "kernel_launch: hipFuncSetAttribute failed\n"); grid = -1; return; }
        if (hipOccupancyMaxActiveBlocksPerMultiprocessor(&per_cu, (const void*)fwd_megakernel, NTHREADS, LDS_BYTES) != hipSuccess || per_cu < 1) { fprintf(stderr, "kernel_launch: occupancy query says %d\n", per_cu); per_cu = 1; }
        (void)hipGetLastError();
        grid = cus * 1;
        if (ws_size < 256 * MiB || out_size != (int)O_END || n_in != 19) fprintf(stderr, "kernel_launch: unexpected sizes ws %zu out %d n_in %d\n", ws_size, out_size, n_in);
    }
    if (grid < 0) return;
    Args a{};
    a.x_prompt = (const float*)d_in[0]; a.x_sample = (const float*)d_in[1]; a.cache_k = (const float*)d_in[2]; a.cache_v = (const float*)d_in[3]; a.state_ret = (const float*)d_in[4];
    a.state_conv = (const float*)d_in[5]; a.w_in = (const float*)d_in[6]; a.sinks = (const float*)d_in[7]; a.w_a = (const float*)d_in[8]; a.w_r = (const float*)d_in[9]; a.w_o = (const float*)d_in[10];
    a.g_pre_mix = (const float*)d_in[11]; a.g_post_mix = (const float*)d_in[12]; a.g_pre_ffn = (const float*)d_in[13]; a.g_post_ffn = (const float*)d_in[14];
    a.w_up = (const float*)d_in[15]; a.conv_w = (const float*)d_in[16]; a.conv_b = (const float*)d_in[17]; a.w_down = (const float*)d_in[18];
    a.out = (float*)d_out; a.ws = (unsigned char*)d_ws;
#if MK_SPLIT
    for (int ph = 0; ph < 12; ++ph) { a.ph_lo = ph; a.ph_hi = ph + 1; hipLaunchKernelGGL(fwd_megakernel, dim3(grid), dim3(NTHREADS), LDS_BYTES, stream, a); }
#else
    a.ph_lo = 0; a.ph_hi = 12;
    void* args[] = {&a};
    const hipError_t e = hipLaunchCooperativeKernel((const void*)fwd_megakernel, dim3(grid), dim3(NTHREADS), args, LDS_BYTES, stream);
    if (e != hipSuccess) fprintf(stderr, "kernel_launch: cooperative launch failed: %s (grid %d)\n", hipGetErrorString(e), grid);
#endif
}
```

```cpp
#include <hip/hip_runtime.h>
#include <hip/hip_cooperative_groups.h>
#include <cstdio>
#include <cstdint>
#include <cmath>
namespace cg = cooperative_groups;
namespace pg8 {
#define PG8_LAS __attribute__((address_space(3)))
typedef unsigned short bf16_t;
typedef short bf16x8 __attribute__((ext_vector_type(8)));
typedef float f32x4 __attribute__((ext_vector_type(4)));
typedef unsigned u32x4 __attribute__((ext_vector_type(4)));
constexpr int BM = 256, BK = 64, HALF = 128, HTB = HALF * BK * 2  , STAGE_BYTES = 8 * HTB, NXCD = 8, WGM = 8;

__host__ __device__ __forceinline__ int lds_byte(int r, int c) { const int st = (r >> 4) * 2 + (c >> 5), rr = r & 15, cc = c & 31, ob = rr * 64 + cc * 2; return st * 1024 + (ob ^ (((ob >> 9) & 1) << 5)); }
__host__ __device__ __forceinline__ void stage_rc(int b, int& R, int& C) { const int st = b / 1024, sb = b % 1024, swz = sb ^ (((sb >> 9) & 1) << 5); R = (st >> 1) * 16 + swz / 64; C = (st & 1) * 32 + (swz % 64) / 2; }
__host__ __device__ __forceinline__ int perm32(int rho) { const int n = rho >> 4, i = rho & 15; return 8 * (i >> 2) + 4 * n + (i & 3); }

struct Unit { int pm, pn; };
struct Gemm { const bf16_t* A; const bf16_t* Bt; int M, N, K, lda; };

struct StaticOrder {
    int nM, nN, nwg, G, c;
    __host__ __device__ void init(int M, int N, int G_, int c_) { nM = M / BM; nN = N / BM; nwg = nM * nN; G = G_; c = c_; }
    __host__ __device__ bool next(int i, Unit& u) const {
        const long L = (long)i * G + c; if (L >= nwg) return false;
        int wgid = (int)L; { const int q = nwg / NXCD, r = nwg % NXCD, xcd = wgid % NXCD, off = wgid / NXCD; wgid = (xcd < r ? xcd * (q + 1) : r * (q + 1) + (xcd - r) * q) + off; }
        const int nig = WGM * nN, gid = wgid / nig, fm = gid * WGM, gsz = (nM - fm) < WGM ? (nM - fm) : WGM;
        u.pm = fm + ((wgid % nig) % gsz); u.pn = (wgid % nig) / gsz; return true;
    }
    __device__ __forceinline__ void a_ready(const Unit&) const {}
    __device__ __forceinline__ void done(const Unit&) const {}
};

__device__ __forceinline__ unsigned cvt_pk_bf16(float lo, float hi) { unsigned r; asm volatile("v_cvt_pk_bf16_f32 %0, %1, %2" : "=v"(r) : "v"(lo), "v"(hi)); return r; }
typedef float f32x2 __attribute__((ext_vector_type(2)));
__device__ __forceinline__ f32x2 gelu_pk(f32x2 v) {
    const f32x2 av = __builtin_elementwise_abs(v), d = av * 0.2316418882f + 1.0f;
    f32x2 t; t.x = __builtin_amdgcn_rcpf(d.x); t.y = __builtin_amdgcn_rcpf(d.y);
    f32x2 q = t * 0.5307027145f + (-0.7265760135f); q = q * t + 0.7107068705f; q = q * t + (-0.142248368f); q = q * t + 0.127414796f; q = q * t;
    const f32x2 s = (v * v) * (-0.72134752044f);
    f32x2 e; e.x = __builtin_amdgcn_exp2f(s.x); e.y = __builtin_amdgcn_exp2f(s.y);
    const f32x2 m = v * (q * e), r = v - m;
    f32x2 o; o.x = v.x < 0.f ? m.x : r.x; o.y = v.y < 0.f ? m.y : r.y; return o;
}

template <int ACT  > struct EpiBf16 {
    static constexpr bool PERM = true, AFTER_DRAIN = false; static_assert(ACT == 0 || ACT == 1, "EpiBf16: ACT is 0 (none) or 1 (gelu_pk)");
    bf16_t* O; int ldc; const float* bias; int split_cols; size_t split_stride; float scale0;
    __device__ __forceinline__ void operator()(const f32x4 (&acc)[2][2][4][2], const Unit& u, int wr, int wc, int fr, int fq) const {
        const int row0 = u.pm * BM + wr * 64 + fr; int colt = u.pn * BM; bf16_t* base = O;
        float sc = 1.f; if (split_cols) { const int t = colt / split_cols; base += (size_t)t * split_stride; colt -= t * split_cols; if (t == 0) sc = scale0; }
        const int col0 = colt + wc * 32 + 8 * fq, bcol0 = u.pn * BM + wc * 32 + 8 * fq;
        f32x4 bv[2][2];
#pragma unroll
        for (int bj = 0; bj < 2; ++bj)
#pragma unroll
            for (int n = 0; n < 2; ++n) bv[bj][n] = bias ? *(const f32x4*)(bias + bcol0 + bj * HALF + 4 * n) : (f32x4){0.f, 0.f, 0.f, 0.f};
#pragma unroll
        for (int ai = 0; ai < 2; ++ai)
#pragma unroll
            for (int m = 0; m < 4; ++m) { bf16_t* rowp = base + (size_t)(row0 + ai * HALF + m * 16) * ldc + col0;
#pragma unroll
                for (int bj = 0; bj < 2; ++bj) { f32x4 v0 = acc[ai][bj][m][0] + bv[bj][0], v1 = acc[ai][bj][m][1] + bv[bj][1];
                    if (ACT == 1) { f32x2 a = gelu_pk((f32x2){v0[0], v0[1]}), b = gelu_pk((f32x2){v0[2], v0[3]}), c = gelu_pk((f32x2){v1[0], v1[1]}), d = gelu_pk((f32x2){v1[2], v1[3]});
                        v0 = (f32x4){a.x, a.y, b.x, b.y}; v1 = (f32x4){c.x, c.y, d.x, d.y}; }
                    v0 = v0 * sc; v1 = v1 * sc; u32x4 w; w.x = cvt_pk_bf16(v0[0], v0[1]); w.y = cvt_pk_bf16(v0[2], v0[3]); w.z = cvt_pk_bf16(v1[0], v1[1]); w.w = cvt_pk_bf16(v1[2], v1[3]);
                    *(u32x4*)(rowp + bj * HALF) = w; } }
    }
};

typedef float f32x2e __attribute__((ext_vector_type(2)));
typedef unsigned u32x2e __attribute__((ext_vector_type(2)));
__device__ __forceinline__ float bf_lo(unsigned w) { return __uint_as_float(w << 16); }
__device__ __forceinline__ float bf_hi(unsigned w) { return __uint_as_float(w & 0xffff0000u); }
__device__ __forceinline__ float sigmoidf_(float x) { return __builtin_amdgcn_rcpf(1.0f + __expf(-x)); }
constexpr int E_MP = 16384, E_DIN = 5888;

struct EpiH {
    static constexpr bool PERM = true, AFTER_DRAIN = false;
    bf16_t* H; const f32x2e* tabA; const f32x2e* tabR;
    __device__ __forceinline__ void operator()(const f32x4 (&acc)[2][2][4][2], const Unit& u, int wr, int wc, int fr, int fq) const {
        const int pn = u.pn;
        const int row0 = u.pm * BM + wr * 64 + fr;
        const int colt = pn * BM + wc * 32 + 8 * fq;
#pragma unroll
        for (int ai = 0; ai < 2; ++ai)
#pragma unroll
            for (int m = 0; m < 4; ++m) {
                const int row = row0 + ai * HALF + m * 16;
                const int tp = row < E_MP ? (row & 4095) : 4096 + (row & 3);
#pragma unroll
                for (int bj = 0; bj < 2; ++bj) {
                    float v[8];
#pragma unroll
                    for (int j = 0; j < 4; ++j) { v[j] = acc[ai][bj][m][0][j]; v[4 + j] = acc[ai][bj][m][1][j]; }
                    int mode = 0; float sc = 1.f;
                    if (pn < 2) { mode = 1; sc = 0.125f; }
                    else if (pn == 2) { mode = (bj == 0) ? 1 : 0; }
                    else if (pn < 5) { mode = 2; }
                    else if (pn < 7) { mode = 2; sc = 0.08838834764831845f; }
                    if (mode == 1) {
                        const bool rot = ((wc & 1) == 0) && (fq < 2);
                        const float sgn = (fq == 0) ? -1.f : 1.f;
#pragma unroll
                        for (int j = 0; j < 8; ++j) {
                            const float partner = __shfl_xor(v[j], 16);
                            const f32x2e cs = tabA[tp * 8 + j];
                            const float o = v[j] * cs.x + sgn * partner * cs.y;
                            v[j] = (rot ? o : v[j]) * sc;
                        }
                    } else if (mode == 2) {
                        const int pi = ((bj * HALF + wc * 32 + 8 * fq) & 127) >> 1;
#pragma unroll
                        for (int p = 0; p < 4; ++p) {
                            const f32x2e cs = tabR[tp * 64 + pi + p];
                            const float x0 = v[2 * p], x1 = v[2 * p + 1];
                            v[2 * p] = (x0 * cs.x - x1 * cs.y) * sc; v[2 * p + 1] = (x1 * cs.x + x0 * cs.y) * sc;
                        }
                    }
                    u32x4 w; w.x = cvt_pk_bf16(v[0], v[1]); w.y = cvt_pk_bf16(v[2], v[3]); w.z = cvt_pk_bf16(v[4], v[5]); w.w = cvt_pk_bf16(v[6], v[7]);
                    *(u32x4*)(H + (size_t)row * E_DIN + colt + bj * HALF) = w;
                }
            }
    }
};

template <bool ADD> struct EpiGate {
    static constexpr bool PERM = true, AFTER_DRAIN = false;
    bf16_t* T; const bf16_t* gate; int ldg;
    __device__ __forceinline__ void operator()(const f32x4 (&acc)[2][2][4][2], const Unit& u, int wr, int wc, int fr, int fq) const {
        const int row0 = u.pm * BM + wr * 64 + fr, col0 = u.pn * BM + wc * 32 + 8 * fq;
#pragma unroll
        for (int ai = 0; ai < 2; ++ai)
#pragma unroll
            for (int m = 0; m < 4; ++m) {
                const int row = row0 + ai * HALF + m * 16;
#pragma unroll
                for (int bj = 0; bj < 2; ++bj) {
                    const u32x4 gw = *(const u32x4*)(gate + (size_t)row * ldg + col0 + bj * HALF);
                    bf16_t* tp = T + (size_t)row * 1024 + col0 + bj * HALF;
                    u32x4 old = (u32x4){0u, 0u, 0u, 0u}; if (ADD) old = *(const u32x4*)tp;
                    float o[8];
#pragma unroll
                    for (int j = 0; j < 4; ++j) {
                        const unsigned g2 = gw[j], o2 = old[j];
                        const float a0 = acc[ai][bj][m][j >> 1][(j & 1) * 2], a1 = acc[ai][bj][m][j >> 1][(j & 1) * 2 + 1];
                        o[2 * j] = bf_lo(o2) + sigmoidf_(bf_lo(g2)) * a0; o[2 * j + 1] = bf_hi(o2) + sigmoidf_(bf_hi(g2)) * a1;
                    }
                    u32x4 w; w.x = cvt_pk_bf16(o[0], o[1]); w.y = cvt_pk_bf16(o[2], o[3]); w.z = cvt_pk_bf16(o[4], o[5]); w.w = cvt_pk_bf16(o[6], o[7]);
                    *(u32x4*)tp = w;
                }
            }
    }
};

struct EpiF32 {
    static constexpr bool PERM = true, AFTER_DRAIN = false;
    float* O;
    __device__ __forceinline__ void operator()(const f32x4 (&acc)[2][2][4][2], const Unit& u, int wr, int wc, int fr, int fq) const {
        const int row0 = u.pm * BM + wr * 64 + fr, col0 = u.pn * BM + wc * 32 + 8 * fq;
#pragma unroll
        for (int ai = 0; ai < 2; ++ai)
#pragma unroll
            for (int m = 0; m < 4; ++m) {
                float* rp = O + (size_t)(row0 + ai * HALF + m * 16) * 1024 + col0;
#pragma unroll
                for (int bj = 0; bj < 2; ++bj) { *(f32x4*)(rp + bj * HALF) = acc[ai][bj][m][0]; *(f32x4*)(rp + bj * HALF + 4) = acc[ai][bj][m][1]; }
            }
    }
};

__device__ __forceinline__ float dpp_ror1(float x) { return __builtin_bit_cast(float, __builtin_amdgcn_update_dpp(0, __builtin_bit_cast(int, x), 0x121, 0xf, 0xf, false)); }
__device__ __forceinline__ float dpp_ror2(float x) { return __builtin_bit_cast(float, __builtin_amdgcn_update_dpp(0, __builtin_bit_cast(int, x), 0x122, 0xf, 0xf, false)); }
__device__ __forceinline__ float gelu_tanh(float x) { const float u2 = 1.5957691216057308f * (x + 0.044715f * x * x * x); return x * __builtin_amdgcn_rcpf(1.0f + __expf(-u2)); }
struct EpiUp {
    static constexpr bool PERM = true, AFTER_DRAIN = false;
    bf16_t* G; bf16_t* UH; bf16_t* US; float* conv_prompt; float* conv_sample; const float* conv_w; const float* conv_b;
    __device__ __forceinline__ void operator()(const f32x4 (&acc)[2][2][4][2], const Unit& u, int wr, int wc, int fr, int fq) const {
        const int row0 = u.pm * BM + wr * 64 + fr;
        const bool sample = u.pm >= 64;
        u32x2e keep[2][4];
#pragma unroll
        for (int n = 0; n < 2; ++n) {
            const int ch = u.pn * HALF + wc * 32 + 8 * fq + 4 * n;
            const f32x4 wa0 = *(const f32x4*)(conv_w + ch), wa1 = *(const f32x4*)(conv_w + 6144 + ch), wa2 = *(const f32x4*)(conv_w + 12288 + ch), ba = *(const f32x4*)(conv_b + ch);
            const f32x4 wb0 = *(const f32x4*)(conv_w + 3072 + ch), wb1 = *(const f32x4*)(conv_w + 6144 + 3072 + ch), wb2 = *(const f32x4*)(conv_w + 12288 + 3072 + ch), bb = *(const f32x4*)(conv_b + 3072 + ch);
#pragma unroll
            for (int ai = 0; ai < 2; ++ai)
#pragma unroll
                for (int m = 0; m < 4; ++m) {
                    const int row = row0 + ai * HALF + m * 16;
                    const f32x4 ua = acc[ai][0][m][n], ub = acc[ai][1][m][n];
                    const f32x4 pa = acc[ai][0][m > 0 ? m - 1 : 0][n], pb = acc[ai][1][m > 0 ? m - 1 : 0][n];
                    float g[4];
#pragma unroll
                    for (int rp = 0; rp < 2; ++rp) {
                        f32x2e a0v, a1v, a2v, b0v, b1v, b2v;
#pragma unroll
                        for (int e = 0; e < 2; ++e) { const int r = 2 * rp + e;
                            a0v[e] = ua[r]; b0v[e] = ub[r];
                            a1v[e] = dpp_ror1(fr == 15 ? pa[r] : ua[r]); a2v[e] = dpp_ror2(fr >= 14 ? pa[r] : ua[r]);
                            b1v[e] = dpp_ror1(fr == 15 ? pb[r] : ub[r]); b2v[e] = dpp_ror2(fr >= 14 ? pb[r] : ub[r]); }
                        const f32x2e wa0v = {wa0[2 * rp], wa0[2 * rp + 1]}, wa1v = {wa1[2 * rp], wa1[2 * rp + 1]}, wa2v = {wa2[2 * rp], wa2[2 * rp + 1]}, bav = {ba[2 * rp], ba[2 * rp + 1]};
                        const f32x2e wb0v = {wb0[2 * rp], wb0[2 * rp + 1]}, wb1v = {wb1[2 * rp], wb1[2 * rp + 1]}, wb2v = {wb2[2 * rp], wb2[2 * rp + 1]}, bbv = {bb[2 * rp], bb[2 * rp + 1]};
                        const f32x2e ca = bav + wa0v * a2v + wa1v * a1v + wa2v * a0v;
                        const f32x2e cb = bbv + wb0v * b2v + wb1v * b1v + wb2v * b0v;
                        const f32x2e u2 = ca * (ca * ca * (-0.044715f * 1.5957691216057308f * 1.4426950408889634f) + (-1.5957691216057308f * 1.4426950408889634f));
                        f32x2e den; den.x = __builtin_amdgcn_rcpf(1.0f + __builtin_amdgcn_exp2f(u2.x)); den.y = __builtin_amdgcn_rcpf(1.0f + __builtin_amdgcn_exp2f(u2.y));
                        const f32x2e gv = ca * den * cb;
                        g[2 * rp] = gv.x; g[2 * rp + 1] = gv.y;
                    }
                    if (!sample) {
                        { u32x2e w; w.x = cvt_pk_bf16(g[0], g[1]); w.y = cvt_pk_bf16(g[2], g[3]);
                          if (n == 0) keep[ai][m] = w;
                          else if (!(m == 0 && fr < 2)) { u32x4 w4; w4.x = keep[ai][m].x; w4.y = keep[ai][m].y; w4.z = w.x; w4.w = w.y; *(u32x4*)(G + (size_t)row * 3072 + ch - 4) = w4; } }
                        if ((m == 0 && fr < 2) || (m == 3 && fr >= 14)) {
                            const int hrow = (row >> 6) * 4 + ((row + 2) & 63);
                            u32x2e w; w.x = cvt_pk_bf16(ua[0], ua[1]); w.y = cvt_pk_bf16(ua[2], ua[3]); *(u32x2e*)(UH + (size_t)hrow * 6144 + ch) = w;
                            w.x = cvt_pk_bf16(ub[0], ub[1]); w.y = cvt_pk_bf16(ub[2], ub[3]); *(u32x2e*)(UH + (size_t)hrow * 6144 + 3072 + ch) = w;
                        }
                        if ((row & 4095) >= 4094) {
                            float* cp = conv_prompt + ((size_t)(row >> 12) * 2 + ((row & 4095) - 4094)) * 6144;
                            *(f32x4*)(cp + ch) = ua; *(f32x4*)(cp + 3072 + ch) = ub;
                        }
                    } else {
                        const int sr = row - E_MP;
                        u32x2e w; w.x = cvt_pk_bf16(ua[0], ua[1]); w.y = cvt_pk_bf16(ua[2], ua[3]); *(u32x2e*)(US + (size_t)sr * 6144 + ch) = w;
                        w.x = cvt_pk_bf16(ub[0], ub[1]); w.y = cvt_pk_bf16(ub[2], ub[3]); *(u32x2e*)(US + (size_t)sr * 6144 + 3072 + ch) = w;
                        if ((sr & 3) >= 2) {
                            float* cp = conv_sample + ((size_t)(sr >> 2) * 2 + ((sr & 3) - 2)) * 6144;
                            *(f32x4*)(cp + ch) = ua; *(f32x4*)(cp + 3072 + ch) = ub;
                        }
                    }
                }
        }
    }
};

template <class Epi, class Sched, bool ALIGN_EPI = false, bool SP2 = false>
__device__ __forceinline__ void gemm_phase(PG8_LAS unsigned char* lds, const Gemm g, const Sched& S, const Epi& E) {
    const int tid = threadIdx.x, wid = __builtin_amdgcn_readfirstlane(tid >> 6), lane = tid & 63, wr = wid >> 2, wc = wid & 3, fr = lane & 15, fq = lane >> 4;
    const int K = g.K, nt = K / BK, lda = g.lda;
    unsigned voffA[2], voffB[2];
#pragma unroll
    for (int i = 0; i < 2; ++i) { int R, C; stage_rc(tid * 16 + i * 8192, R, C); const int Rb = Epi::PERM ? ((R & ~31) + perm32(R & 31)) : R;
        voffA[i] = (unsigned)(R * lda + C) * 2u; voffB[i] = (unsigned)(Rb * K + C) * 2u; }
    const size_t kstep = (size_t)(BK * 2);
    const size_t hstepA = (size_t)HALF * lda * 2, hstepB = (size_t)HALF * K * 2;
    const size_t tstepA = 2 * hstepA, tstepB = 2 * hstepB;
    const unsigned ldsw = (unsigned)wid * 1024u;
    const int aoff = lds_byte(wr * 64 + fr, fq * 8), boff = lds_byte(wc * 32 + fr, fq * 8);
#define PG8_SA(b, h) (((b) * 2 + (h)) * HTB)
#define PG8_SB(b, h) ((4 + (b) * 2 + (h)) * HTB)
#define PG8_STAGE(bufoff, gbase, voff) do { _Pragma("unroll") for (int _i = 0; _i < 2; ++_i) \
        __builtin_amdgcn_global_load_lds((const unsigned*)((const char*)(gbase) + (voff)[_i]), (PG8_LAS unsigned*)(lds + (bufoff) + ldsw + _i * 8192), 16, 0, 0); } while (0)
#define PG8_LDA(dst, b, h) do { _Pragma("unroll") for (int m = 0; m < 4; ++m) _Pragma("unroll") for (int k = 0; k < 2; ++k) dst[m][k] = *(const PG8_LAS bf16x8*)(lds + PG8_SA(b, h) + aoff + m * 2048 + k * 1024); } while (0)
#define PG8_LDB(dst, b, h) do { _Pragma("unroll") for (int n = 0; n < 2; ++n) _Pragma("unroll") for (int k = 0; k < 2; ++k) dst[n][k] = *(const PG8_LAS bf16x8*)(lds + PG8_SB(b, h) + boff + n * 2048 + k * 1024); } while (0)
#define PG8_MMA(ai, bj, At, Bt) do { __builtin_amdgcn_s_setprio(1); _Pragma("unroll") for (int m = 0; m < 4; ++m) _Pragma("unroll") for (int n = 0; n < 2; ++n) _Pragma("unroll") for (int k = 0; k < 2; ++k) \
        acc[ai][bj][m][n] = __builtin_amdgcn_mfma_f32_16x16x32_bf16(Bt[n][k], At[m][k], acc[ai][bj][m][n], 0, 0, 0); __builtin_amdgcn_s_setprio(0); } while (0)
#define PG8_WAIT_V(n) asm volatile("s_waitcnt vmcnt(" #n ")" ::: "memory")
#define PG8_WAIT_L(n) asm volatile("s_waitcnt lgkmcnt(" #n ")" ::: "memory")
#define PG8_BAR __builtin_amdgcn_s_barrier()
#define PG8_SCHED __builtin_amdgcn_sched_barrier(0)
    Unit cur, nxt; int ui = 0;
    if (!S.next(0, cur)) return;
    f32x4 acc[2][2][4][2];
#pragma unroll
    for (int a = 0; a < 2; ++a)
#pragma unroll
        for (int b = 0; b < 2; ++b)
#pragma unroll
            for (int m = 0; m < 4; ++m)
#pragma unroll
                for (int n = 0; n < 2; ++n) acc[a][b][m][n] = (f32x4){0.f, 0.f, 0.f, 0.f};
    bf16x8 At[4][2], B0[2][2], B1[2][2];
    const char* cA = (const char*)g.A + (size_t)cur.pm * tstepA; const char* cB = (const char*)g.Bt + (size_t)cur.pn * tstepB;
    S.a_ready(cur);
    if constexpr (SP2) {
        PG8_STAGE(PG8_SB(0, 0), cB, voffB); PG8_STAGE(PG8_SB(0, 1), cB + hstepB, voffB); PG8_STAGE(PG8_SA(0, 0), cA, voffA); PG8_STAGE(PG8_SA(0, 1), cA + hstepA, voffA);
        if (wr == 1) PG8_BAR;
        PG8_WAIT_V(2); PG8_BAR;
        PG8_STAGE(PG8_SB(1, 0), cB + kstep, voffB); PG8_STAGE(PG8_SA(1, 0), cA + kstep, voffA); PG8_STAGE(PG8_SB(1, 1), cB + hstepB + kstep, voffB);
        PG8_WAIT_V(6); PG8_BAR;
    } else {
        PG8_STAGE(PG8_SB(0, 0), cB, voffB); PG8_STAGE(PG8_SA(0, 0), cA, voffA); PG8_STAGE(PG8_SB(0, 1), cB + hstepB, voffB); PG8_STAGE(PG8_SA(0, 1), cA + hstepA, voffA);
        if (wr == 1) PG8_BAR;
        PG8_WAIT_V(4); PG8_BAR;
        PG8_STAGE(PG8_SB(1, 0), cB + kstep, voffB); PG8_STAGE(PG8_SA(1, 0), cA + kstep, voffA); PG8_STAGE(PG8_SB(1, 1), cB + hstepB + kstep, voffB);
        PG8_WAIT_V(6); PG8_BAR;
    }
    for (;;) {
        const bool has_next = S.next(ui + 1, nxt);
        const char* nA = has_next ? (const char*)g.A + (size_t)nxt.pm * tstepA : cA; const char* nB = has_next ? (const char*)g.Bt + (size_t)nxt.pn * tstepB : cB;
        for (int t = 0; t < nt; t += 2) {
            const bool last = (t == nt - 2);
            const char* a1 = cA + (size_t)(t + 1) * kstep;
            const char* a2 = last ? nA : cA + (size_t)(t + 2) * kstep; const char* b2 = last ? nB : cB + (size_t)(t + 2) * kstep;
            const char* a3 = a2 + kstep; const char* b3 = b2 + kstep;
            if (last && has_next) S.a_ready(nxt);
            if constexpr (SP2) {
            PG8_LDB(B0, 0, 0); PG8_LDB(B1, 0, 1); PG8_SCHED; PG8_LDA(At, 0, 0); PG8_STAGE(PG8_SA(1, 1), a1 + hstepA, voffA);
            PG8_WAIT_V(8); PG8_WAIT_L(0); PG8_BAR; PG8_MMA(0, 0, At, B0); PG8_MMA(0, 1, At, B1); PG8_BAR; PG8_SCHED;
            PG8_LDA(At, 0, 1); PG8_STAGE(PG8_SB(0, 0), b2, voffB); PG8_STAGE(PG8_SB(0, 1), b2 + hstepB, voffB); PG8_STAGE(PG8_SA(0, 0), a2, voffA);
            PG8_WAIT_V(8); PG8_WAIT_L(0); PG8_BAR; PG8_MMA(1, 0, At, B0); PG8_MMA(1, 1, At, B1); PG8_BAR; PG8_SCHED;
            PG8_LDB(B0, 1, 0); PG8_LDB(B1, 1, 1); PG8_SCHED; PG8_LDA(At, 1, 0); PG8_STAGE(PG8_SA(0, 1), a2 + hstepA, voffA);
            PG8_WAIT_V(8); PG8_WAIT_L(0); PG8_BAR; PG8_MMA(0, 0, At, B0); PG8_MMA(0, 1, At, B1); PG8_BAR; PG8_SCHED;
            PG8_LDA(At, 1, 1); PG8_STAGE(PG8_SB(1, 0), b3, voffB); PG8_STAGE(PG8_SB(1, 1), b3 + hstepB, voffB); PG8_STAGE(PG8_SA(1, 0), a3, voffA);
            PG8_WAIT_V(8); PG8_WAIT_L(0); PG8_BAR; PG8_MMA(1, 0, At, B0); PG8_MMA(1, 1, At, B1); PG8_BAR; PG8_SCHED;
            } else {
            PG8_LDB(B0, 0, 0); PG8_SCHED; PG8_LDA(At, 0, 0); PG8_STAGE(PG8_SA(1, 1), a1 + hstepA, voffA);
            PG8_WAIT_L(8); PG8_BAR; PG8_WAIT_L(0); PG8_MMA(0, 0, At, B0); PG8_BAR; PG8_SCHED;
            PG8_LDB(B1, 0, 1); PG8_STAGE(PG8_SB(0, 0), b2, voffB);
            PG8_BAR; PG8_WAIT_L(0); PG8_MMA(0, 1, At, B1); PG8_BAR;
            PG8_LDA(At, 0, 1); PG8_STAGE(PG8_SA(0, 0), a2, voffA);
            PG8_BAR; PG8_WAIT_L(0); PG8_MMA(1, 0, At, B0); PG8_BAR; PG8_SCHED;
            PG8_STAGE(PG8_SB(0, 1), b2 + hstepB, voffB);
            PG8_WAIT_V(6); PG8_BAR; PG8_MMA(1, 1, At, B1); PG8_BAR;
            PG8_LDB(B0, 1, 0); PG8_SCHED; PG8_LDA(At, 1, 0); PG8_STAGE(PG8_SA(0, 1), a2 + hstepA, voffA);
            PG8_WAIT_L(8); PG8_BAR; PG8_WAIT_L(0); PG8_MMA(0, 0, At, B0); PG8_BAR; PG8_SCHED;
            PG8_LDB(B1, 1, 1); PG8_STAGE(PG8_SB(1, 0), b3, voffB);
            PG8_BAR; PG8_WAIT_L(0); PG8_MMA(0, 1, At, B1); PG8_BAR;
            PG8_LDA(At, 1, 1); PG8_STAGE(PG8_SA(1, 0), a3, voffA);
            PG8_BAR; PG8_WAIT_L(0); PG8_MMA(1, 0, At, B0); PG8_BAR; PG8_SCHED;
            PG8_STAGE(PG8_SB(1, 1), b3 + hstepB, voffB);
            PG8_WAIT_V(6); PG8_BAR; PG8_MMA(1, 1, At, B1); PG8_BAR;
            }
        }
        if constexpr (ALIGN_EPI) { if (wr == 0) PG8_BAR; }
        if constexpr (!Epi::AFTER_DRAIN) { E(acc, cur, wr, wc, fr, fq); S.done(cur); }
        if (!has_next) break;
#pragma unroll
        for (int a = 0; a < 2; ++a)
#pragma unroll
            for (int b = 0; b < 2; ++b)
#pragma unroll
                for (int m = 0; m < 4; ++m)
#pragma unroll
                    for (int n = 0; n < 2; ++n) acc[a][b][m][n] = (f32x4){0.f, 0.f, 0.f, 0.f};
        cur = nxt; cA = nA; cB = nB; ++ui;
        if constexpr (ALIGN_EPI) { if (wr == 1) PG8_BAR; }
    }
    PG8_WAIT_V(0);
    if constexpr (!ALIGN_EPI) { if (wr == 0) PG8_BAR; }
    PG8_BAR;
    if constexpr (Epi::AFTER_DRAIN) { E.fused(acc, cur, wr, wc, fr, fq, lds, wid, lane); S.done(cur); }
#undef PG8_SA
#undef PG8_SB
#undef PG8_STAGE
#undef PG8_LDA
#undef PG8_LDB
#undef PG8_MMA
#undef PG8_WAIT_V
#undef PG8_WAIT_L
#undef PG8_BAR
#undef PG8_SCHED
}
}

#define LAS __attribute__((address_space(3)))
using pg8::bf16_t; using pg8::bf16x8; using pg8::f32x4; using pg8::u32x4;
typedef float f32x2 __attribute__((ext_vector_type(2)));
typedef unsigned u32x2 __attribute__((ext_vector_type(2)));
typedef short v4i16 __attribute__((ext_vector_type(4)));

constexpr int MP = 16384, MS = 512, M = MP + MS, D = 1024, DIN = 5888, F2 = 6144, DFF = 3072, TSEQ = 4096;
constexpr int C_QA = 0, C_KA = 512, C_VA = 640, C_QR = 768, C_KR = 1280, C_VR = 1792, C_GATE = 2816, C_GMA = 3840, C_GMR = 4864;
constexpr float EPS = 1e-6f;
constexpr int NTHREADS = 512, NWAVES = 8;
constexpr int LDS_BYTES = 147456;

constexpr size_t MiB = 1u << 20;
constexpr size_t WS_BAR = 41 * 65536;
constexpr size_t WS_TABA = 0, WS_TABR = 512 * 1024;
constexpr size_t WS_WIN = 3 * MiB;
constexpr size_t WS_WUP = WS_WIN + (size_t)DIN * D * 2;
constexpr size_t WS_WDN = WS_WUP + (size_t)F2 * D * 2;
constexpr size_t WS_XN = WS_WDN + (size_t)D * DFF * 2;
constexpr size_t WS_R1 = WS_XN + (size_t)M * D * 2;
constexpr size_t R1_G = 0, R1_F = (size_t)M * DFF * 2, R1_UH = R1_F + (size_t)M * D * 2, R1_US = R1_UH + (size_t)264 * 4 * F2 * 2, R1_X1 = R1_US + (size_t)MS * F2 * 2, R1_END = R1_X1 + (size_t)M * D * 2;
static_assert(R1_END <= (size_t)M * DIN * 2, "R1 overlay");
static_assert(WS_R1 + (size_t)M * DIN * 2 <= 256 * MiB, "ws map");
constexpr size_t O_Y = 0, O_KP = (size_t)M * D, O_VP = O_KP + 65536, O_RP = O_VP + 65536, O_CP = O_RP + 524288, O_KS = O_CP + 49152, O_VS = O_KS + 2097152, O_RS = O_VS + 2097152, O_CS = O_RS + 16777216, O_END = O_CS + 1572864;

struct Args {
    const float *x_prompt, *x_sample, *cache_k, *cache_v, *state_ret, *state_conv, *w_in, *sinks, *w_a, *w_r, *w_o, *g_pre_mix, *g_post_mix, *g_pre_ffn, *g_post_ffn, *w_up, *conv_w, *conv_b, *w_down;
    float* out; unsigned char* ws; int ph_lo, ph_hi;
};

__device__ __forceinline__ float bf2f(bf16_t h) { return __uint_as_float((unsigned)h << 16); }
__device__ __forceinline__ float bflo(unsigned w) { return __uint_as_float(w << 16); }
__device__ __forceinline__ float bfhi(unsigned w) { return __uint_as_float(w & 0xffff0000u); }
__device__ __forceinline__ unsigned pk2(float lo, float hi) { return pg8::cvt_pk_bf16(lo, hi); }
__device__ __forceinline__ float wave_sum(float v) {
#pragma unroll
    for (int o = 1; o < 64; o <<= 1) v += __shfl_xor(v, o);
    return v;
}
__device__ __forceinline__ float wave_max(float v) {
#pragma unroll
    for (int o = 1; o < 64; o <<= 1) v = fmaxf(v, __shfl_xor(v, o));
    return v;
}
__device__ __forceinline__ float ret_log2g(int h) { return log2f(1.0f - exp2f(-5.0f - (float)h)); }
__device__ __forceinline__ bf16x8 tr_pair(const LAS unsigned char* p0, const LAS unsigned char* p1) {
    const v4i16 a = __builtin_amdgcn_ds_read_tr16_b64_v4i16((LAS v4i16*)p0), b = __builtin_amdgcn_ds_read_tr16_b64_v4i16((LAS v4i16*)p1);
    return (bf16x8){a[0], a[1], a[2], a[3], b[0], b[1], b[2], b[3]};
}
__device__ __forceinline__ bf16x8 cat8(u32x2 a, u32x2 b) { const u32x4 w = {a.x, a.y, b.x, b.y}; return __builtin_bit_cast(bf16x8, w); }

__device__ __forceinline__ void p0_transpose_item(const float* W, int K, int N, bf16_t* WT, int k0, int n0, int drow0, LAS float* scr, int lane) {
    f32x4 wv[8];
#pragma unroll
    for (int i = 0; i < 8; ++i) wv[i] = *(const f32x4*)(W + (size_t)(k0 + 8 * i + (lane >> 3)) * N + n0 + 4 * (lane & 7));
#pragma unroll
    for (int i = 0; i < 8; ++i) { LAS float* d = scr + (8 * i + (lane >> 3)) * 33 + 4 * (lane & 7); d[0] = wv[i].x; d[1] = wv[i].y; d[2] = wv[i].z; d[3] = wv[i].w; }
    asm volatile("s_waitcnt lgkmcnt(0)" ::: "memory");
    const int c = lane & 7;
#pragma unroll
    for (int j = 0; j < 4; ++j) { const int n = (lane >> 3) + 8 * j; const LAS float* s = scr + (8 * c) * 33 + n;
        u32x4 o; o.x = pk2(s[0 * 33], s[1 * 33]); o.y = pk2(s[2 * 33], s[3 * 33]); o.z = pk2(s[4 * 33], s[5 * 33]); o.w = pk2(s[6 * 33], s[7 * 33]);
        *(u32x4*)(WT + (size_t)(drow0 + n) * K + k0 + 8 * c) = o; }
    asm volatile("s_waitcnt lgkmcnt(0)" ::: "memory");
}
__device__ __forceinline__ void rms_row_to_bf16(const float* xrow, const float* g, bf16_t* orow, int lane) {
    f32x4 v[4]; float s = 0.f;
#pragma unroll
    for (int j = 0; j < 4; ++j) { v[j] = *((const f32x4*)xrow + lane + 64 * j); s += (v[j].x * v[j].x + v[j].y * v[j].y) + (v[j].z * v[j].z + v[j].w * v[j].w); }
    const float rstd = rsqrtf(wave_sum(s) * (1.f / D) + EPS);
#pragma unroll
    for (int j = 0; j < 4; ++j) { const f32x4 gg = *((const f32x4*)g + lane + 64 * j);
        u32x2 w; w.x = pk2(v[j].x * rstd * gg.x, v[j].y * rstd * gg.y); w.y = pk2(v[j].z * rstd * gg.z, v[j].w * rstd * gg.w);
        *((u32x2*)orow + lane + 64 * j) = w; }
}
__device__ __forceinline__ void p0_prologue(const Args& a, LAS unsigned char* lds, int tid, int lane, int wave) {
    unsigned char* ws = a.ws;
    LAS float* scr = (LAS float*)(lds + wave * 16384);
    const int gw = blockIdx.x * NWAVES + wave, NGW = gridDim.x * NWAVES;
    bf16_t* WinT = (bf16_t*)(ws + WS_WIN); bf16_t* WupT = (bf16_t*)(ws + WS_WUP); bf16_t* WdnT = (bf16_t*)(ws + WS_WDN);
    bf16_t* WoT = (bf16_t*)(a.out + O_CS); bf16_t* WaT = WoT + 1024 * 1024; bf16_t* WrT = WaT + 1024 * 512;
    constexpr int I_IN = 16 * (DIN / 32), I_A = 8 * 32, I_R = 16 * 32, I_O = 16 * 32, I_UP = 16 * (F2 / 32), I_DN = 48 * 32;
    constexpr int NITEMS = I_IN + I_A + I_R + I_O + I_UP + I_DN;
    for (int it = gw; it < NITEMS; it += NGW) {
        int r = it;
        if (r < I_IN) { const int nb = r % (DIN / 32), kb = r / (DIN / 32); p0_transpose_item(a.w_in, D, DIN, WinT, 64 * kb, 32 * nb, 32 * nb, scr, lane); continue; } r -= I_IN;
        if (r < I_A) { const int nb = r % 32, kb = r / 32; p0_transpose_item(a.w_a, 512, D, WaT, 64 * kb, 32 * nb, 32 * nb, scr, lane); continue; } r -= I_A;
        if (r < I_R) { const int nb = r % 32, kb = r / 32; p0_transpose_item(a.w_r, D, D, WrT, 64 * kb, 32 * nb, 32 * nb, scr, lane); continue; } r -= I_R;
        if (r < I_O) { const int nb = r % 32, kb = r / 32; p0_transpose_item(a.w_o, D, D, WoT, 64 * kb, 32 * nb, 32 * nb, scr, lane); continue; } r -= I_O;
        if (r < I_UP) { const int nb = r % (F2 / 32), kb = r / (F2 / 32); const int n0 = 32 * nb;
            const int drow = n0 < DFF ? (n0 / 128) * 256 + (n0 % 128) : ((n0 - DFF) / 128) * 256 + 128 + ((n0 - DFF) % 128);
            p0_transpose_item(a.w_up, D, F2, WupT, 64 * kb, n0, drow, scr, lane); continue; } r -= I_UP;
        { const int nb = r % 32, kb = r / 32; p0_transpose_item(a.w_down, DFF, D, WdnT, 64 * kb, 32 * nb, 32 * nb, scr, lane); }
    }
    bf16_t* XN = (bf16_t*)(ws + WS_XN);
    for (int m = gw; m < M; m += NGW) { const float* xr = m < MP ? a.x_prompt + (size_t)m * D : a.x_sample + (size_t)(m - MP) * D; rms_row_to_bf16(xr, a.g_pre_mix, XN + (size_t)m * D, lane); }
    f32x2* tabA = (f32x2*)(ws + WS_TABA); f32x2* tabR = (f32x2*)(ws + WS_TABR);
    __syncthreads();
    LAS float* invs = (LAS float*)lds;
    if (tid < 72) invs[tid] = tid < 8 ? (float)(1.0 / pow(500000.0, (double)((float)tid / 8.0f))) : (float)(1.0 / pow(10000.0, (double)((float)(tid - 8) / 63.0f)));
    __syncthreads();
    const int gt = blockIdx.x * NTHREADS + tid, NGT = gridDim.x * NTHREADS;
    for (int e = gt; e < 4100 * 72; e += NGT) {
        const int tp = e / 72, i = e % 72; const int pos = tp < 4096 ? tp : 16384 + (tp - 4096);
        const float ang = (float)pos * invs[i];
        const double rev = (double)ang * 0.15915494309189535; const float fr = (float)(rev - rint(rev));
        const f32x2 cs = {__builtin_amdgcn_cosf(fr), __builtin_amdgcn_sinf(fr)};
        if (i < 8) tabA[tp * 8 + i] = cs; else tabR[tp * 64 + (i - 8)] = cs;
    }
}

__device__ __forceinline__ void attn_prompt_unit(bf16_t* H, const float* sinks, LAS unsigned char* lds, int b, int qb, int head, int tid, int lane, int wave) {
    const int g = head >> 2, fr = lane & 15, fq = lane >> 4;
    const size_t rowbase = (size_t)b * TSEQ + (size_t)qb * 128;
    LAS unsigned char* Kimg = lds; LAS unsigned char* Vimg = lds + 36864;
#pragma unroll
    for (int i = 0; i < 4; ++i) {
        const int id = tid + NTHREADS * i, kidx = id >> 3, ch = id & 7;
        u32x4 kv = {0u, 0u, 0u, 0u}, vv = {0u, 0u, 0u, 0u};
        if (qb > 0 || kidx >= 128) { const bf16_t* src = H + (rowbase - 128 + kidx) * DIN; kv = *(const u32x4*)(src + C_KA + g * 64 + ch * 8); vv = *(const u32x4*)(src + C_VA + g * 64 + ch * 8); }
        *(LAS u32x4*)(Kimg + kidx * 144 + ch * 16) = kv; *(LAS u32x4*)(Vimg + kidx * 144 + ch * 16) = vv;
    }
    const size_t qrow = rowbase + 16 * wave + fr;
    bf16x8 qf[2];
#pragma unroll
    for (int ks = 0; ks < 2; ++ks) qf[ks] = *(const bf16x8*)(H + qrow * DIN + C_QA + head * 64 + 32 * ks + 8 * fq);
    __syncthreads();
    f32x4 s[10];
#pragma unroll
    for (int nn = 0; nn < 9; ++nn) {
        s[nn] = (f32x4){0.f, 0.f, 0.f, 0.f};
        const int krow = 16 * (wave + nn) + fr;
#pragma unroll
        for (int ks = 0; ks < 2; ++ks) { const bf16x8 kf = *(const LAS bf16x8*)(Kimg + krow * 144 + (32 * ks + 8 * fq) * 2); s[nn] = __builtin_amdgcn_mfma_f32_16x16x32_bf16(kf, qf[ks], s[nn], 0, 0, 0); }
    }
    s[9] = (f32x4){0.f, 0.f, 0.f, 0.f};
    const int qi = 16 * wave + fr; const float sink = sinks[head];
    float mx = sink;
#pragma unroll
    for (int nn = 0; nn < 9; ++nn)
#pragma unroll
        for (int r = 0; r < 4; ++r) { const int kidx = 16 * (wave + nn) + 4 * fq + r; const bool valid = (kidx > qi) && (kidx <= qi + 128) && (qb > 0 || kidx >= 128);
            s[nn][r] = valid ? s[nn][r] : -1e30f; mx = fmaxf(mx, s[nn][r]); }
    mx = fmaxf(mx, __shfl_xor(mx, 16)); mx = fmaxf(mx, __shfl_xor(mx, 32));
    float sum = 0.f;
#pragma unroll
    for (int nn = 0; nn < 9; ++nn)
#pragma unroll
        for (int r = 0; r < 4; ++r) { const float p = s[nn][r] > -1e29f ? __expf(s[nn][r] - mx) : 0.f; s[nn][r] = p; sum += p; }
    sum += __shfl_xor(sum, 16); sum += __shfl_xor(sum, 32);
    sum += __expf(sink - mx);
    f32x4 o[4];
#pragma unroll
    for (int db = 0; db < 4; ++db) o[db] = (f32x4){0.f, 0.f, 0.f, 0.f};
    const int tq = (lane & 15) >> 2, tpp = lane & 3;
#pragma unroll
    for (int G = 0; G < 5; ++G) {
        const u32x4 pw = {pk2(s[2 * G][0], s[2 * G][1]), pk2(s[2 * G][2], s[2 * G][3]), pk2(s[2 * G + 1][0], s[2 * G + 1][1]), pk2(s[2 * G + 1][2], s[2 * G + 1][3])};
        const bf16x8 pf = __builtin_bit_cast(bf16x8, pw);
        int k0 = 16 * (wave + 2 * G) + 4 * fq + tq, k1 = k0 + 16; k0 = k0 > 255 ? 255 : k0; k1 = k1 > 255 ? 255 : k1;
#pragma unroll
        for (int db = 0; db < 4; ++db) {
            const int colb = (32 * (db >> 1) + 8 * tpp + 4 * (db & 1)) * 2; const bf16x8 vf = tr_pair(Vimg + k0 * 144 + colb, Vimg + k1 * 144 + colb);
            o[db] = __builtin_amdgcn_mfma_f32_16x16x32_bf16(vf, pf, o[db], 0, 0, 0);
        }
    }
    const float inv = 1.0f / sum;
#pragma unroll
    for (int dp = 0; dp < 2; ++dp) { u32x4 w; w.x = pk2(o[2 * dp][0] * inv, o[2 * dp][1] * inv); w.y = pk2(o[2 * dp][2] * inv, o[2 * dp][3] * inv); w.z = pk2(o[2 * dp + 1][0] * inv, o[2 * dp + 1][1] * inv); w.w = pk2(o[2 * dp + 1][2] * inv, o[2 * dp + 1][3] * inv);
        *(u32x4*)(H + qrow * DIN + C_QA + head * 64 + 32 * dp + 8 * fq) = w; }
    __syncthreads();
}

__device__ __forceinline__ void attn_sample_unit(const Args& a, bf16_t* H, LAS unsigned char* lds, int b, int tid, int lane, int wave) {
    const int head = wave, g = head >> 2; const size_t r0 = (size_t)MP + 4 * b;
    LAS float* qs = (LAS float*)(lds + wave * 4096); LAS float* ps = qs + 256;
#pragma unroll
    for (int t = 0; t < 4; ++t) qs[t * 64 + lane] = bf2f(H[(r0 + t) * DIN + C_QA + head * 64 + lane]);
    asm volatile("s_waitcnt lgkmcnt(0)" ::: "memory");
    float sc[3][4];
    {
        const float* kp0 = a.cache_k + ((size_t)(b * 128 + lane) * 2 + g) * 64; const float* kp1 = kp0 + (size_t)64 * 128;
        const bf16_t* kpn = H + (r0 + (lane & 3)) * DIN + C_KA + g * 64;
#pragma unroll
        for (int t = 0; t < 4; ++t) { sc[0][t] = 0.f; sc[1][t] = 0.f; sc[2][t] = 0.f; }
#pragma nounroll
        for (int hf = 0; hf < 2; ++hf) {
            f32x4 kv0[8], kv1[8]; u32x4 kw[4];
#pragma unroll
            for (int d4 = 0; d4 < 8; ++d4) { kv0[d4] = *(const f32x4*)(kp0 + 32 * hf + 4 * d4); kv1[d4] = *(const f32x4*)(kp1 + 32 * hf + 4 * d4); }
#pragma unroll
            for (int c8 = 0; c8 < 4; ++c8) kw[c8] = *(const u32x4*)(kpn + 32 * hf + 8 * c8);
#pragma unroll
            for (int d4 = 0; d4 < 8; ++d4)
#pragma unroll
                for (int e = 0; e < 4; ++e) { const int d = 4 * d4 + e; const unsigned w = kw[d >> 3][(d & 7) >> 1]; const float kn = (d & 1) ? bfhi(w) : bflo(w);
#pragma unroll
                    for (int t = 0; t < 4; ++t) { const float q = qs[t * 64 + 32 * hf + d]; sc[0][t] += q * kv0[d4][e]; sc[1][t] += q * kv1[d4][e]; sc[2][t] += q * kn; } }
        }
    }
    const float sink = a.sinks[head];
    float inv[4];
#pragma unroll
    for (int t = 0; t < 4; ++t) {
        const bool v0 = lane > t, v1 = true, v2 = (lane < 4) && (lane <= t);
        const float s0 = v0 ? sc[0][t] : -1e30f, s1 = v1 ? sc[1][t] : -1e30f, s2 = v2 ? sc[2][t] : -1e30f;
        const float mx = fmaxf(wave_max(fmaxf(fmaxf(s0, s1), s2)), sink);
        const float p0 = v0 ? __expf(s0 - mx) : 0.f, p1 = __expf(s1 - mx), p2 = v2 ? __expf(s2 - mx) : 0.f;
        const float sum = wave_sum(p0 + p1 + p2) + __expf(sink - mx);
        inv[t] = 1.0f / sum;
        ps[t * 136 + lane] = p0; ps[t * 136 + 64 + lane] = p1; if (lane < 4) ps[t * 136 + 128 + lane] = p2;
    }
    asm volatile("s_waitcnt lgkmcnt(0)" ::: "memory");
    float o0 = 0.f, o1 = 0.f, o2 = 0.f, o3 = 0.f;
    const float* vp = a.cache_v + ((size_t)(b * 128) * 2 + g) * 64 + lane;
#pragma nounroll
    for (int rb = 0; rb < 2; ++rb) {
        float vx[64];
#pragma unroll
        for (int r = 0; r < 64; ++r) vx[r] = vp[(size_t)(64 * rb + r) * 128];
#pragma unroll
        for (int r = 0; r < 64; ++r) { const int rr = 64 * rb + r; o0 += ps[0 * 136 + rr] * vx[r]; o1 += ps[1 * 136 + rr] * vx[r]; o2 += ps[2 * 136 + rr] * vx[r]; o3 += ps[3 * 136 + rr] * vx[r]; }
    }
#pragma unroll
    for (int tn = 0; tn < 4; ++tn) { const float vx = bf2f(H[(r0 + tn) * DIN + C_VA + g * 64 + lane]); o0 += ps[0 * 136 + 128 + tn] * vx; o1 += ps[1 * 136 + 128 + tn] * vx; o2 += ps[2 * 136 + 128 + tn] * vx; o3 += ps[3 * 136 + 128 + tn] * vx; }
    H[(r0 + 0) * DIN + C_QA + head * 64 + lane] = (bf16_t)(pk2(o0 * inv[0], 0.f) & 0xffffu);
    H[(r0 + 1) * DIN + C_QA + head * 64 + lane] = (bf16_t)(pk2(o1 * inv[1], 0.f) & 0xffffu);
    H[(r0 + 2) * DIN + C_QA + head * 64 + lane] = (bf16_t)(pk2(o2 * inv[2], 0.f) & 0xffffu);
    H[(r0 + 3) * DIN + C_QA + head * 64 + lane] = (bf16_t)(pk2(o3 * inv[3], 0.f) & 0xffffu);
    float* ko = a.out + O_KS + (size_t)b * 128 * 128; float* vo = a.out + O_VS + (size_t)b * 128 * 128;
    const float* ki = a.cache_k + (size_t)b * 128 * 128 + 4 * 128; const float* vi = a.cache_v + (size_t)b * 128 * 128 + 4 * 128;
    for (int i = tid; i < 124 * 32; i += NTHREADS) { ((f32x4*)ko)[i] = ((const f32x4*)ki)[i]; ((f32x4*)vo)[i] = ((const f32x4*)vi)[i]; }
    { const int t = tid >> 7, gd = tid & 127;
      ko[(size_t)(124 + t) * 128 + gd] = bf2f(H[(r0 + t) * DIN + C_KA + gd]); vo[(size_t)(124 + t) * 128 + gd] = bf2f(H[(r0 + t) * DIN + C_VA + gd]); }
}

__device__ __forceinline__ void ret_u_unit(const bf16_t* H, bf16_t* ST, LAS unsigned char* lds, int b, int c, int h, int tid, int lane, int wave) {
    const size_t rowc = (size_t)b * TSEQ + (size_t)c * 128; const float l2g = ret_log2g(h);
    LAS unsigned char* Kimg = lds; LAS unsigned char* Vimg = lds + 36864;
#pragma unroll
    for (int i = 0; i < 4; ++i) { const int id = tid + NTHREADS * i, j = id >> 4, ch = id & 15;
        const u32x4 kv = *(const u32x4*)(H + (rowc + j) * DIN + C_KR + h * 128 + ch * 8); const float kd = exp2f(l2g * (float)(127 - j));
        u32x4 w; w.x = pk2(bflo(kv.x) * kd, bfhi(kv.x) * kd); w.y = pk2(bflo(kv.y) * kd, bfhi(kv.y) * kd); w.z = pk2(bflo(kv.z) * kd, bfhi(kv.z) * kd); w.w = pk2(bflo(kv.w) * kd, bfhi(kv.w) * kd);
        *(LAS u32x4*)(Kimg + j * 288 + ch * 16) = w; }
#pragma unroll
    for (int i = 0; i < 8; ++i) { const int id = tid + NTHREADS * i, j = id >> 5, ch = id & 31;
        *(LAS u32x4*)(Vimg + j * 544 + ch * 16) = *(const u32x4*)(H + (rowc + j) * DIN + C_VR + h * 256 + ch * 8); }
    __syncthreads();
    const int fr = lane & 15, fq = lane >> 4, tq = fr >> 2, tpp = lane & 3;
    f32x4 acc[2][8];
#pragma unroll
    for (int i = 0; i < 2; ++i)
#pragma unroll
        for (int j = 0; j < 8; ++j) acc[i][j] = (f32x4){0.f, 0.f, 0.f, 0.f};
#pragma unroll
    for (int ks = 0; ks < 4; ++ks) {
        const int j0 = 32 * ks + 4 * fq + tq, j1 = j0 + 16;
        bf16x8 vf[2];
#pragma unroll
        for (int i = 0; i < 2; ++i) { const int col = 32 * wave + 8 * tpp + 4 * i; vf[i] = tr_pair(Vimg + j0 * 544 + col * 2, Vimg + j1 * 544 + col * 2); }
#pragma unroll
        for (int kb = 0; kb < 8; ++kb) { const int col = 16 * kb + 4 * tpp; const bf16x8 kf = tr_pair(Kimg + j0 * 288 + col * 2, Kimg + j1 * 288 + col * 2);
#pragma unroll
            for (int i = 0; i < 2; ++i) acc[i][kb] = __builtin_amdgcn_mfma_f32_16x16x32_bf16(vf[i], kf, acc[i][kb], 0, 0, 0); }
    }
    bf16_t* U = ST + ((size_t)(b * 32 + c) * 4 + h) * 32768;
#pragma unroll
    for (int kb = 0; kb < 8; ++kb) { u32x4 w; w.x = pk2(acc[0][kb][0], acc[0][kb][1]); w.y = pk2(acc[0][kb][2], acc[0][kb][3]); w.z = pk2(acc[1][kb][0], acc[1][kb][1]); w.w = pk2(acc[1][kb][2], acc[1][kb][3]);
        *(u32x4*)(U + (size_t)(16 * kb + fr) * 256 + 32 * wave + 8 * fq) = w; }
    __syncthreads();
}

__device__ __forceinline__ void ret_sample_unit(const Args& a, bf16_t* H, LAS unsigned char* lds, int b, int h, int tid, int lane, int wave) {
    const size_t r0 = (size_t)MP + 4 * b; const float g = 1.0f - exp2f(-5.0f - (float)h);
    LAS float* qs = (LAS float*)lds; LAS float* ks = qs + 512; LAS float* po = ks + 512; LAS float* red = po + 2048;
    const int dv = tid & 255, half = tid >> 8;
    for (int i = tid; i < 1024; i += NTHREADS) { const int which = i >> 9, t = (i >> 7) & 3, d = i & 127;
        const float v = bf2f(H[(r0 + t) * DIN + (which ? C_KR : C_QR) + h * 128 + d]); if (which) ks[t * 128 + d] = v; else qs[t * 128 + d] = v; }
    float vt[4], gt[4];
#pragma unroll
    for (int t = 0; t < 4; ++t) { vt[t] = bf2f(H[(r0 + t) * DIN + C_VR + h * 256 + dv]); gt[t] = bf2f(H[(r0 + t) * DIN + C_GATE + h * 256 + dv]); }
    float S[64];
    const float* sp = a.state_ret + ((size_t)(b * 4 + h) * 128 + 64 * half) * 256 + dv;
#pragma unroll
    for (int d = 0; d < 64; ++d) S[d] = sp[(size_t)d * 256];
    __syncthreads();
#pragma unroll
    for (int t = 0; t < 4; ++t) { float o = 0.f;
#pragma unroll
        for (int d = 0; d < 64; ++d) { S[d] = g * S[d] + ks[t * 128 + 64 * half + d] * vt[t]; o += qs[t * 128 + 64 * half + d] * S[d]; }
        po[(half * 4 + t) * 256 + dv] = o; }
    float* so = a.out + O_RS + ((size_t)(b * 4 + h) * 128 + 64 * half) * 256 + dv;
#pragma unroll
    for (int d = 0; d < 64; ++d) so[(size_t)d * 256] = S[d];
    __syncthreads();
    float ot[4];
#pragma unroll
    for (int t = 0; t < 4; ++t) { ot[t] = po[t * 256 + dv] + po[(4 + t) * 256 + dv]; const float sq = wave_sum(half == 0 ? ot[t] * ot[t] : 0.f); if (lane == 0) red[wave * 4 + t] = sq; }
    __syncthreads();
    if (half == 0) {
#pragma unroll
        for (int t = 0; t < 4; ++t) { float ss = 0.f;
#pragma unroll
            for (int w = 0; w < 8; ++w) ss += red[w * 4 + t];
            const float rstd = rsqrtf(ss * (1.f / 256.f) + EPS); const float gv = gt[t]; const float sil = gv / (1.0f + __expf(-gv));
            H[(r0 + t) * DIN + C_VR + h * 256 + dv] = (bf16_t)(pk2(ot[t] * rstd * sil, 0.f) & 0xffffu); }
    }
    __syncthreads();
}

__device__ __forceinline__ void ret_out_unit(bf16_t* H, const bf16_t* ST, LAS unsigned char* lds, int b, int c, int h, int tid, int lane, int wave) {
    const size_t rowc = (size_t)b * TSEQ + (size_t)c * 128; const float l2g = ret_log2g(h);
    LAS unsigned char* Kimg = lds; LAS unsigned char* BIG = lds + 36864;
    const int fr = lane & 15, fq = lane >> 4, tq = fr >> 2, tpp = lane & 3;
    const int qi = 16 * wave + fr; const size_t qrow = rowc + qi;
    u32x4 kreg[4], sreg[8], vreg[8]; u32x4 greg[8];
#pragma unroll
    for (int i = 0; i < 4; ++i) { const int id = tid + NTHREADS * i, j = id >> 4, ch = id & 15; kreg[i] = *(const u32x4*)(H + (rowc + j) * DIN + C_KR + h * 128 + ch * 8); }
    if (c > 0) {
        const bf16_t* S = ST + ((size_t)(b * 32 + c) * 4 + h) * 32768;
#pragma unroll
        for (int i = 0; i < 8; ++i) { const int id = tid + NTHREADS * i, dk = id >> 5, ch = id & 31; sreg[i] = *(const u32x4*)(S + (size_t)dk * 256 + ch * 8); }
    }
    bf16x8 qf[4];
#pragma unroll
    for (int ks = 0; ks < 4; ++ks) { const bf16_t* qp = H + qrow * DIN + C_QR + h * 128 + 32 * ks + 4 * fq; qf[ks] = cat8(*(const u32x2*)qp, *(const u32x2*)(qp + 16)); }
#pragma unroll
    for (int i = 0; i < 8; ++i) { const int id = tid + NTHREADS * i, j = id >> 5, ch = id & 31; vreg[i] = *(const u32x4*)(H + (rowc + j) * DIN + C_VR + h * 256 + ch * 8); }
#pragma unroll
    for (int i = 0; i < 4; ++i) { const int id = tid + NTHREADS * i, j = id >> 4, ch = id & 15; *(LAS u32x4*)(Kimg + j * 288 + ch * 16) = kreg[i]; }
    if (c > 0) {
#pragma unroll
        for (int i = 0; i < 8; ++i) { const int id = tid + NTHREADS * i, dk = id >> 5, ch = id & 31; *(LAS u32x4*)(BIG + dk * 544 + ch * 16) = sreg[i]; }
    }
    __syncthreads();
    f32x4 acc[16];
#pragma unroll
    for (int k = 0; k < 16; ++k) acc[k] = (f32x4){0.f, 0.f, 0.f, 0.f};
    if (c > 0) {
#pragma unroll
        for (int ks = 0; ks < 4; ++ks) { const int d0 = 32 * ks + 4 * fq + tq, d1 = d0 + 16;
#pragma unroll
            for (int blk = 0; blk < 16; ++blk) { const int colb = (32 * (blk >> 1) + 8 * tpp + 4 * (blk & 1)) * 2; const bf16x8 sf = tr_pair(BIG + d0 * 544 + colb, BIG + d1 * 544 + colb);
                acc[blk] = __builtin_amdgcn_mfma_f32_16x16x32_bf16(sf, qf[ks], acc[blk], 0, 0, 0); } }
        const float qd = exp2f(l2g * (float)(qi + 1));
#pragma unroll
        for (int blk = 0; blk < 16; ++blk) acc[blk] = acc[blk] * qd;
    }
    bf16x8 pf[4];
#pragma unroll
    for (int G = 0; G < 4; ++G) {
        f32x4 sc[2];
#pragma unroll
        for (int e = 0; e < 2; ++e) { const int jb = 2 * G + e; sc[e] = (f32x4){0.f, 0.f, 0.f, 0.f};
            if (jb <= wave) {
#pragma unroll
                for (int ks = 0; ks < 4; ++ks) { const LAS unsigned char* kp = Kimg + (16 * jb + fr) * 288 + (32 * ks + 4 * fq) * 2;
                    const bf16x8 kf = cat8(*(const LAS u32x2*)kp, *(const LAS u32x2*)(kp + 32)); sc[e] = __builtin_amdgcn_mfma_f32_16x16x32_bf16(kf, qf[ks], sc[e], 0, 0, 0); }
#pragma unroll
                for (int r = 0; r < 4; ++r) { const int j = 16 * jb + 4 * fq + r; sc[e][r] = (j <= qi) ? sc[e][r] * exp2f(l2g * (float)(qi - j)) : 0.f; }
            } }
        const u32x4 pw = {pk2(sc[0][0], sc[0][1]), pk2(sc[0][2], sc[0][3]), pk2(sc[1][0], sc[1][1]), pk2(sc[1][2], sc[1][3])};
        pf[G] = __builtin_bit_cast(bf16x8, pw);
    }
    __syncthreads();
#pragma unroll
    for (int i = 0; i < 8; ++i) { const int id = tid + NTHREADS * i, j = id >> 5, ch = id & 31; *(LAS u32x4*)(BIG + j * 544 + ch * 16) = vreg[i]; }
#pragma unroll
    for (int k = 0; k < 8; ++k) greg[k] = *(const u32x4*)(H + qrow * DIN + C_GATE + h * 256 + 32 * k + 8 * fq);
    __syncthreads();
#pragma unroll
    for (int G = 0; G < 4; ++G) {
        if (2 * G <= wave) { const int j0 = 32 * G + 4 * fq + tq, j1 = j0 + 16;
#pragma unroll
            for (int blk = 0; blk < 16; ++blk) { const int colb = (32 * (blk >> 1) + 8 * tpp + 4 * (blk & 1)) * 2; const bf16x8 vf = tr_pair(BIG + j0 * 544 + colb, BIG + j1 * 544 + colb);
                acc[blk] = __builtin_amdgcn_mfma_f32_16x16x32_bf16(vf, pf[G], acc[blk], 0, 0, 0); } }
    }
    float ss = 0.f;
#pragma unroll
    for (int blk = 0; blk < 16; ++blk) ss += (acc[blk][0] * acc[blk][0] + acc[blk][1] * acc[blk][1]) + (acc[blk][2] * acc[blk][2] + acc[blk][3] * acc[blk][3]);
    ss += __shfl_xor(ss, 16); ss += __shfl_xor(ss, 32);
    const float rstd = rsqrtf(ss * (1.f / 256.f) + EPS);
#pragma unroll
    for (int k = 0; k < 8; ++k) {
        const u32x4 gw = greg[k]; u32x4 w;
#pragma unroll
        for (int q = 0; q < 4; ++q) { const float g0 = bflo(gw[q]), g1 = bfhi(gw[q]); const f32x4 av = acc[2 * k + (q >> 1)];
            const float a0 = av[(2 * q) & 3], a1 = av[(2 * q + 1) & 3];
            w[q] = pk2(a0 * rstd * g0 / (1.f + __expf(-g0)), a1 * rstd * g1 / (1.f + __expf(-g1))); }
        *(u32x4*)(H + qrow * DIN + C_VR + h * 256 + 32 * k + 8 * fq) = w;
    }
    __syncthreads();
}

__device__ __forceinline__ f32x4 tail_gemm(const bf16_t* A, int lda, const bf16_t* Bt, int K, LAS unsigned char* lds, int tid, int lane, int wave, f32x4 acc) {
    const int fr = lane & 15, fq = lane >> 4, nc = K / 512;
    LAS unsigned char* Ai = lds; LAS unsigned char* Bi = lds + 33280;
    u32x4 ra[4], rb[8];
#pragma unroll
    for (int i = 0; i < 4; ++i) { const int id = tid + NTHREADS * i; ra[i] = *(const u32x4*)(A + (size_t)(id >> 6) * lda + (id & 63) * 8); }
#pragma unroll
    for (int i = 0; i < 8; ++i) { const int id = tid + NTHREADS * i; rb[i] = *(const u32x4*)(Bt + (size_t)(id >> 6) * K + (id & 63) * 8); }
#pragma nounroll
    for (int c = 0; c < nc; ++c) {
#pragma unroll
        for (int i = 0; i < 4; ++i) { const int id = tid + NTHREADS * i; *(LAS u32x4*)(Ai + (id >> 6) * 1040 + (id & 63) * 16) = ra[i]; }
#pragma unroll
        for (int i = 0; i < 8; ++i) { const int id = tid + NTHREADS * i; *(LAS u32x4*)(Bi + (id >> 6) * 1040 + (id & 63) * 16) = rb[i]; }
        __syncthreads();
        if (c + 1 < nc) {
#pragma unroll
            for (int i = 0; i < 4; ++i) { const int id = tid + NTHREADS * i; ra[i] = *(const u32x4*)(A + (size_t)(id >> 6) * lda + (c + 1) * 512 + (id & 63) * 8); }
#pragma unroll
            for (int i = 0; i < 8; ++i) { const int id = tid + NTHREADS * i; rb[i] = *(const u32x4*)(Bt + (size_t)(id >> 6) * K + (c + 1) * 512 + (id & 63) * 8); }
        }
        const LAS unsigned char* ap = Ai + (16 * (wave >> 2) + fr) * 1040 + fq * 16; const LAS unsigned char* bp = Bi + (16 * (wave & 3) + fr) * 1040 + fq * 16;
#pragma unroll
        for (int ks = 0; ks < 16; ++ks) { const bf16x8 av = *(const LAS bf16x8*)(ap + ks * 64), bv = *(const LAS bf16x8*)(bp + ks * 64); acc = __builtin_amdgcn_mfma_f32_16x16x32_bf16(bv, av, acc, 0, 0, 0); }
        __syncthreads();
    }
    return acc;
}

#define XB_TMO      128
#define XB_XCNT(j)  (256  + 64 * (j))
#define XB_XSUB(j)  (1280 + 64 * (j))
#define XB_XGEN(j)  (2304 + 64 * (j))
#define XB_TOP      3328
#define XB_TOPGEN   3392
#define XCD_BAR_WORDS 3456
#define XB_SPIN_CAP (1u << 18)

__device__ __forceinline__ unsigned xb_ld(unsigned* p)              { return __hip_atomic_load(p, __ATOMIC_RELAXED, __HIP_MEMORY_SCOPE_AGENT); }
__device__ __forceinline__ unsigned xb_add(unsigned* p, unsigned v) { return __hip_atomic_fetch_add(p, v, __ATOMIC_RELAXED, __HIP_MEMORY_SCOPE_AGENT); }
__device__ __forceinline__ unsigned xb_xcc_id() { return (unsigned)__builtin_amdgcn_s_getreg((3 << 11) | 20) & 0xFu; }
#define XB_SPIN(cond, bar) do { unsigned _sp = 0; while (cond) { __builtin_amdgcn_s_sleep(1); \
    if ((++_sp & 255u) == 0u) { if (xb_ld(&(bar)[XB_TMO])) break; if (_sp > XB_SPIN_CAP) { atomicAdd(&(bar)[XB_TMO], 1u); break; } } } } while (0)

struct XcdBarrier {
    unsigned* bar; unsigned x;
    volatile LAS unsigned* st;
};

__device__ __forceinline__ XcdBarrier xcd_barrier_post(unsigned* bar, volatile LAS unsigned* st) {
    XcdBarrier b; b.bar = bar; b.x = xb_xcc_id(); b.st = st;
    if (threadIdx.x == 0) (void)xb_add(&bar[XB_XCNT(b.x)], 1u);
    return b;
}
__device__ __forceinline__ void xcd_barrier_complete(unsigned* bar, unsigned x, unsigned& nloc, unsigned& nx) {
    const unsigned G = gridDim.x * gridDim.y * gridDim.z;
    unsigned sum, cnt, mine, sp = 0u;
    for (;;) {
        sum = 0u; cnt = 0u; mine = 0u;
#pragma unroll
        for (unsigned j = 0; j < 16; ++j) { const unsigned c = xb_ld(&bar[XB_XCNT(j)]); sum += c; cnt += (c > 0u) ? 1u : 0u; mine = (j == x) ? c : mine; }
        if (sum == G) break;
        __builtin_amdgcn_s_sleep(1);
        if ((++sp & 255u) == 0u) { if (xb_ld(&bar[XB_TMO])) break; if (sp > XB_SPIN_CAP) { atomicAdd(&bar[XB_TMO], 1u); break; } }
    }
    nloc = mine > 0u ? mine : 1u; nx = cnt > 0u ? cnt : 1u;
}

__device__ __forceinline__ void xcd_barrier(const XcdBarrier& b) {
    asm volatile("s_waitcnt vmcnt(0)" ::: "memory");
    __syncthreads();
    if (threadIdx.x == 0) {
        unsigned* bar = b.bar;
        __builtin_amdgcn_s_waitcnt(0);
        unsigned nloc = b.st[0], nx = b.st[1];
        if (nloc == 0u) { xcd_barrier_complete(bar, b.x, nloc, nx); b.st[0] = nloc; b.st[1] = nx; }
        const unsigned old = xb_add(&bar[XB_XSUB(b.x)], 1u);
        const unsigned gen = old / nloc;
        if (old + 1u == (gen + 1u) * nloc) {
            __builtin_amdgcn_fence(__ATOMIC_RELEASE, "agent");
            asm volatile("s_waitcnt vmcnt(0)" ::: "memory");
            const unsigned og = xb_add(&bar[XB_TOP], 1u);
            const unsigned tg = og / nx;
            if (og + 1u == (tg + 1u) * nx) xb_add(&bar[XB_TOPGEN], 1u);
            else XB_SPIN(xb_ld(&bar[XB_TOPGEN]) == tg, bar);
            __builtin_amdgcn_fence(__ATOMIC_ACQUIRE, "agent");
            xb_add(&bar[XB_XGEN(b.x)], 1u);
            asm volatile("s_waitcnt vmcnt(0)" ::: "memory");
        } else {
            XB_SPIN(xb_ld(&bar[XB_XGEN(b.x)]) == gen, bar);
            __builtin_amdgcn_fence(__ATOMIC_ACQUIRE, "agent");
            asm volatile("s_waitcnt vmcnt(0)" ::: "memory");
        }
    }
    __syncthreads();
}


__global__ void __launch_bounds__(NTHREADS, 2) fwd_megakernel(Args a) {
    extern __shared__ __attribute__((aligned(16))) unsigned char lds_raw[];
    LAS unsigned char* lds = (LAS unsigned char*)lds_raw;
    cg::grid_group grid = cg::this_grid();
    const int tid = threadIdx.x, lane = tid & 63, wave = __builtin_amdgcn_readfirstlane(tid >> 6);
    const int nblk = gridDim.x, blk = blockIdx.x;
    unsigned char* ws = a.ws;
    bf16_t* WinT = (bf16_t*)(ws + WS_WIN); bf16_t* WupT = (bf16_t*)(ws + WS_WUP); bf16_t* WdnT = (bf16_t*)(ws + WS_WDN);
    bf16_t* WoT = (bf16_t*)(a.out + O_CS); bf16_t* WaT = WoT + 1024 * 1024; bf16_t* WrT = WaT + 1024 * 512;
    bf16_t* XN = (bf16_t*)(ws + WS_XN); bf16_t* H = (bf16_t*)(ws + WS_R1);
    bf16_t* MIXb = (bf16_t*)(ws + WS_R1);
    bf16_t* G = (bf16_t*)(ws + WS_R1 + R1_G); bf16_t* Fb = (bf16_t*)(ws + WS_R1 + R1_F); bf16_t* X1b = (bf16_t*)(ws + WS_R1 + R1_X1); bf16_t* UH = (bf16_t*)(ws + WS_R1 + R1_UH); bf16_t* US = (bf16_t*)(ws + WS_R1 + R1_US);
    bf16_t* ST = (bf16_t*)(a.out + O_Y);
    float* Y = a.out + O_Y;
    const int lo = a.ph_lo, hi = a.ph_hi;
    volatile LAS unsigned* xst = (volatile LAS unsigned*)(lds + 131072 + 64);
    if (tid == 0) { xst[0] = 0u; xst[1] = 0u; }
    __syncthreads();
    XcdBarrier xbar; xbar.bar = (unsigned*)(ws + WS_BAR); xbar.x = 0; xbar.st = nullptr;
    if (hi - lo > 1) xbar = xcd_barrier_post((unsigned*)(ws + WS_BAR), xst);
#ifndef PROBE_REP_MASK
#define PROBE_REP_MASK 0
#endif
#define IN(k) (lo <= (k) && (k) < hi)
#define REPS(k) (((PROBE_REP_MASK >> (k)) & 1) ? 2 : 1)
#define SEAM(k) do { if (IN(k) && IN((k) + 1)) { if ((k) == 0) { asm volatile("s_waitcnt vmcnt(0)" ::: "memory"); __syncthreads(); grid.sync(); } else xcd_barrier(xbar); } } while (0)

    if (IN(0)) { p0_prologue(a, lds, tid, lane, wave); }
    SEAM(0);
    if (IN(1)) {
        pg8::Gemm g{XN, WinT, M, DIN, D, D}; pg8::StaticOrder S; S.init(M, DIN, nblk, blk);
        pg8::EpiH E{H, (const pg8::f32x2e*)(ws + WS_TABA), (const pg8::f32x2e*)(ws + WS_TABR)};
        pg8::gemm_phase<pg8::EpiH, pg8::StaticOrder, true, true>(lds, g, S, E);
    }
    SEAM(1);
    if (IN(2)) {
        for (int u = blk; u < 1024; u += nblk) { const int head = u & 7, qb = (u >> 3) & 31, b = u >> 8; attn_prompt_unit(H, a.sinks, lds, b, qb, head, tid, lane, wave); }
        for (int u = blk; u < 512; u += nblk) { const int h = u & 3, c = (u >> 2) & 31, b = u >> 7; ret_u_unit(H, ST, lds, b, c, h, tid, lane, wave); }
        for (int u = blk; u < 128; u += nblk) { attn_sample_unit(a, H, lds, u, tid, lane, wave); __syncthreads(); }
        for (int u = blk; u < 512; u += nblk) { ret_sample_unit(a, H, lds, u >> 2, u & 3, tid, lane, wave); }
        for (int e = blk * NTHREADS + tid; e < 4 * 128 * 128; e += nblk * NTHREADS) { const int gd = e & 127, r = (e >> 7) & 127, b = e >> 14; const size_t row = (size_t)b * TSEQ + TSEQ - 128 + r;
            a.out[O_KP + e] = bf2f(H[row * DIN + C_KA + gd]); a.out[O_VP + e] = bf2f(H[row * DIN + C_VA + gd]); }
    }
    SEAM(2);
    if (IN(3)) {
        for (int e4 = blk * NTHREADS + tid; e4 < 16 * 8192; e4 += nblk * NTHREADS) {
            const int bh = e4 >> 13, idx = (e4 & 8191) * 4, b = bh >> 2, h = bh & 3;
            const float gL = exp2f(128.f * ret_log2g(h));
            f32x4 S = {0.f, 0.f, 0.f, 0.f};
#pragma unroll 8
            for (int c = 0; c < 32; ++c) { bf16_t* p = ST + ((size_t)(b * 32 + c) * 4 + h) * 32768 + idx; const u32x2 uw = *(const u32x2*)p; u32x2 sw; sw.x = pk2(S.x, S.y); sw.y = pk2(S.z, S.w); *(u32x2*)p = sw;
                const f32x4 uu = {bflo(uw.x), bfhi(uw.x), bflo(uw.y), bfhi(uw.y)}; S = S * gL + uu; }
            *(f32x4*)(a.out + O_RP + (size_t)bh * 32768 + idx) = S;
        }
    }
    SEAM(3);
    if (IN(4)) {
        for (int u = blk; u < 512; u += nblk) { const int h = u & 3, c = (u >> 2) & 31, b = u >> 7; ret_out_unit(H, ST, lds, b, c, h, tid, lane, wave); }
    }
    SEAM(4);
    if (IN(5)) {
        { pg8::Gemm g{H + C_QA, WaT, MP, D, 512, DIN}; pg8::StaticOrder S; S.init(MP, D, nblk, blk);
          pg8::EpiGate<false> E{XN, H + C_GMA, DIN}; pg8::gemm_phase<pg8::EpiGate<false>, pg8::StaticOrder, true, true>(lds, g, S, E); }
        __syncthreads();
        { pg8::Gemm g{H + C_VR, WrT, MP, D, D, DIN}; pg8::StaticOrder S; S.init(MP, D, nblk, blk);
          pg8::EpiGate<true> E{XN, H + C_GMR, DIN}; pg8::gemm_phase<pg8::EpiGate<true>, pg8::StaticOrder, true, true>(lds, g, S, E); }
        for (int piece = blk; piece < 256; piece += nblk) {
            const int fr = lane & 15, fq = lane >> 4; const size_t prow = (size_t)MP + 32 * (piece >> 4); const size_t row = prow + 16 * (wave >> 2) + fr; const int pcol = 64 * (piece & 15), col0 = pcol + 16 * (wave & 3);
            const f32x4 aa = tail_gemm(H + prow * DIN + C_QA, DIN, WaT + (size_t)pcol * 512, 512, lds, tid, lane, wave, (f32x4){0.f, 0.f, 0.f, 0.f});
            const f32x4 ar = tail_gemm(H + prow * DIN + C_VR, DIN, WrT + (size_t)pcol * 1024, 1024, lds, tid, lane, wave, (f32x4){0.f, 0.f, 0.f, 0.f});
            const int cb = col0 + 4 * fq;
            const u32x2 ga = *(const u32x2*)(H + row * DIN + C_GMA + cb), gr = *(const u32x2*)(H + row * DIN + C_GMR + cb);
            u32x2 w; w.x = pk2(pg8::sigmoidf_(bflo(ga.x)) * aa[0] + pg8::sigmoidf_(bflo(gr.x)) * ar[0], pg8::sigmoidf_(bfhi(ga.x)) * aa[1] + pg8::sigmoidf_(bfhi(gr.x)) * ar[1]);
            w.y = pk2(pg8::sigmoidf_(bflo(ga.y)) * aa[2] + pg8::sigmoidf_(bflo(gr.y)) * ar[2], pg8::sigmoidf_(bfhi(ga.y)) * aa[3] + pg8::sigmoidf_(bfhi(gr.y)) * ar[3]);
            *(u32x2*)(XN + row * D + cb) = w;
        }
    }
    SEAM(5);
    if (IN(6)) {
        pg8::Gemm g{XN, WoT, MP, D, D, D}; pg8::StaticOrder S; S.init(MP, D, nblk, blk);
        pg8::EpiBf16<0> E{MIXb, D, nullptr, 0, 0, 1.f}; pg8::gemm_phase<pg8::EpiBf16<0>, pg8::StaticOrder, true, true>(lds, g, S, E);
        for (int piece = blk; piece < 256; piece += nblk) {
            const int fr = lane & 15, fq = lane >> 4; const size_t prow = (size_t)MP + 32 * (piece >> 4); const size_t row = prow + 16 * (wave >> 2) + fr; const int pcol = 64 * (piece & 15), col0 = pcol + 16 * (wave & 3);
            const f32x4 ac = tail_gemm(XN + prow * D, D, WoT + (size_t)pcol * 1024, 1024, lds, tid, lane, wave, (f32x4){0.f, 0.f, 0.f, 0.f});
            u32x2 w; w.x = pk2(ac[0], ac[1]); w.y = pk2(ac[2], ac[3]); *(u32x2*)(MIXb + row * D + col0 + 4 * fq) = w;
        }
    }
    SEAM(6);
    if (IN(7)) {
        f32x4 gpm[2][2], gpf[2][2];
#pragma unroll
        for (int j = 0; j < 2; ++j)
#pragma unroll
            for (int e = 0; e < 2; ++e) { gpm[j][e] = *((const f32x4*)a.g_post_mix + 2 * (lane + 64 * j) + e); gpf[j][e] = *((const f32x4*)a.g_pre_ffn + 2 * (lane + 64 * j) + e); }
        for (int p = blk * NWAVES + wave; p < M / 2; p += nblk * NWAVES) {
            u32x4 mb[2][2]; f32x4 xx[2][2][2];
#pragma unroll
            for (int rr = 0; rr < 2; ++rr) { const int m = 2 * p + rr; const float* xr = m < MP ? a.x_prompt + (size_t)m * D : a.x_sample + (size_t)(m - MP) * D;
#pragma unroll
                for (int j = 0; j < 2; ++j) { mb[rr][j] = *((const u32x4*)(MIXb + (size_t)m * D) + lane + 64 * j); xx[rr][j][0] = *((const f32x4*)xr + 2 * (lane + 64 * j)); xx[rr][j][1] = *((const f32x4*)xr + 2 * (lane + 64 * j) + 1); } }
            float mv[2][2][8]; float ss[2];
#pragma unroll
            for (int rr = 0; rr < 2; ++rr) { ss[rr] = 0.f;
#pragma unroll
                for (int j = 0; j < 2; ++j)
#pragma unroll
                    for (int q = 0; q < 4; ++q) { const unsigned w = mb[rr][j][q]; mv[rr][j][2 * q] = bflo(w); mv[rr][j][2 * q + 1] = bfhi(w); ss[rr] += mv[rr][j][2 * q] * mv[rr][j][2 * q] + mv[rr][j][2 * q + 1] * mv[rr][j][2 * q + 1]; } }
            ss[0] = wave_sum(ss[0]); ss[1] = wave_sum(ss[1]);
            float s2[2];
#pragma unroll
            for (int rr = 0; rr < 2; ++rr) { const float rstd = rsqrtf(ss[rr] * (1.f / D) + EPS); s2[rr] = 0.f;
#pragma unroll
                for (int j = 0; j < 2; ++j)
#pragma unroll
                    for (int q = 0; q < 8; ++q) { const float x1 = xx[rr][j][q >> 2][q & 3] + mv[rr][j][q] * rstd * gpm[j][q >> 2][q & 3]; mv[rr][j][q] = x1; s2[rr] += x1 * x1; } }
            s2[0] = wave_sum(s2[0]); s2[1] = wave_sum(s2[1]);
#pragma unroll
            for (int rr = 0; rr < 2; ++rr) { const int m = 2 * p + rr; const float rstd2 = rsqrtf(s2[rr] * (1.f / D) + EPS);
#pragma unroll
                for (int j = 0; j < 2; ++j) { u32x4 w1, w2;
#pragma unroll
                    for (int q = 0; q < 4; ++q) { const float a0 = mv[rr][j][2 * q], a1 = mv[rr][j][2 * q + 1]; w1[q] = pk2(a0, a1);
                        w2[q] = pk2(a0 * rstd2 * gpf[j][(2 * q) >> 2][(2 * q) & 3], a1 * rstd2 * gpf[j][(2 * q + 1) >> 2][(2 * q + 1) & 3]); }
                    *((u32x4*)(X1b + (size_t)m * D) + lane + 64 * j) = w1; *((u32x4*)(XN + (size_t)m * D) + lane + 64 * j) = w2; } }
        }
    }
    SEAM(7);
    if (IN(8)) {
        pg8::Gemm g{XN, WupT, M, F2, D, D}; pg8::StaticOrder S; S.init(M, F2, nblk, blk);
        pg8::EpiUp E{G, UH, US, a.out + O_CP, a.out + O_CS, a.conv_w, a.conv_b};
        pg8::gemm_phase<pg8::EpiUp, pg8::StaticOrder, true, true>(lds, g, S, E);
    }
    SEAM(8);
    if (IN(9)) {
        for (int task = blk * NWAVES + wave; task < 1024 * 6; task += nblk * NWAVES) {
            const int rt = task / 6, chunk = task % 6; const int ch = chunk * 512 + lane * 8;
            float ua[3][8], ub[3][8];
            int row;
#define LD8BF(dst, ptr) do { const u32x4 _w = *(const u32x4*)(ptr); dst[0] = bflo(_w.x); dst[1] = bfhi(_w.x); dst[2] = bflo(_w.y); dst[3] = bfhi(_w.y); dst[4] = bflo(_w.z); dst[5] = bfhi(_w.z); dst[6] = bflo(_w.w); dst[7] = bfhi(_w.w); } while (0)
#define LD8F(dst, ptr) do { const f32x4 _a = *(const f32x4*)(ptr), _b = *(const f32x4*)((ptr) + 4); dst[0] = _a.x; dst[1] = _a.y; dst[2] = _a.z; dst[3] = _a.w; dst[4] = _b.x; dst[5] = _b.y; dst[6] = _b.z; dst[7] = _b.w; } while (0)
#define ZERO8(dst) do { _Pragma("unroll") for (int _i = 0; _i < 8; ++_i) dst[_i] = 0.f; } while (0)
            if (rt < 512) {
                const int grp = rt >> 1, k = rt & 1; row = grp * 64 + k; const int t = row & 4095;
                const bf16_t* u0 = UH + (size_t)(grp * 4 + 2 + k) * F2;
                LD8BF(ua[2], u0 + ch); LD8BF(ub[2], u0 + DFF + ch);
                if (t >= 1) { const bf16_t* u1 = (k == 0) ? UH + (size_t)((grp - 1) * 4 + 1) * F2 : UH + (size_t)(grp * 4 + 2) * F2; LD8BF(ua[1], u1 + ch); LD8BF(ub[1], u1 + DFF + ch); } else { ZERO8(ua[1]); ZERO8(ub[1]); }
                if (t >= 2) { const bf16_t* u2 = UH + (size_t)((grp - 1) * 4 + k) * F2; LD8BF(ua[0], u2 + ch); LD8BF(ub[0], u2 + DFF + ch); } else { ZERO8(ua[0]); ZERO8(ub[0]); }
            } else {
                const int sr = rt - 512, b = sr >> 2, t = sr & 3; row = MP + sr;
#pragma unroll
                for (int tap = 0; tap < 3; ++tap) { const int e = t + tap;
                    if (e < 2) { const float* cp = a.state_conv + ((size_t)b * 2 + e) * F2; LD8F(ua[tap], cp + ch); LD8F(ub[tap], cp + DFF + ch); }
                    else { const bf16_t* up = US + (size_t)(b * 4 + e - 2) * F2; LD8BF(ua[tap], up + ch); LD8BF(ub[tap], up + DFF + ch); } }
            }
            float wa[3][8], wb[3][8], ba[8], bb[8];
#pragma unroll
            for (int tap = 0; tap < 3; ++tap) { LD8F(wa[tap], a.conv_w + (size_t)tap * F2 + ch); LD8F(wb[tap], a.conv_w + (size_t)tap * F2 + DFF + ch); }
            LD8F(ba, a.conv_b + ch); LD8F(bb, a.conv_b + DFF + ch);
            float gg[8];
#pragma unroll
            for (int i = 0; i < 8; ++i) { const float ca = ba[i] + wa[0][i] * ua[0][i] + wa[1][i] * ua[1][i] + wa[2][i] * ua[2][i], cb = bb[i] + wb[0][i] * ub[0][i] + wb[1][i] * ub[1][i] + wb[2][i] * ub[2][i];
                gg[i] = pg8::gelu_tanh(ca) * cb; }
            u32x4 w; w.x = pk2(gg[0], gg[1]); w.y = pk2(gg[2], gg[3]); w.z = pk2(gg[4], gg[5]); w.w = pk2(gg[6], gg[7]);
            *(u32x4*)(G + (size_t)row * DFF + ch) = w;
        }
    }
    SEAM(9);
    if (IN(10)) {
        pg8::Gemm g{G, WdnT, MP, D, DFF, DFF}; pg8::StaticOrder S; S.init(MP, D, nblk, blk);
        pg8::EpiBf16<0> E{Fb, D, nullptr, 0, 0, 1.f}; pg8::gemm_phase<pg8::EpiBf16<0>, pg8::StaticOrder, true, true>(lds, g, S, E);
        for (int piece = blk; piece < 256; piece += nblk) {
            const int fr = lane & 15, fq = lane >> 4; const size_t prow = (size_t)MP + 32 * (piece >> 4); const size_t row = prow + 16 * (wave >> 2) + fr; const int pcol = 64 * (piece & 15), col0 = pcol + 16 * (wave & 3);
            const f32x4 ac = tail_gemm(G + prow * DFF, DFF, WdnT + (size_t)pcol * DFF, DFF, lds, tid, lane, wave, (f32x4){0.f, 0.f, 0.f, 0.f});
            u32x2 w; w.x = pk2(ac[0], ac[1]); w.y = pk2(ac[2], ac[3]); *(u32x2*)(Fb + row * D + col0 + 4 * fq) = w;
        }
    }
    SEAM(10);
    if (IN(11)) {
        f32x4 gpo[2][2];
#pragma unroll
        for (int j = 0; j < 2; ++j)
#pragma unroll
            for (int e = 0; e < 2; ++e) gpo[j][e] = *((const f32x4*)a.g_post_ffn + 2 * (lane + 64 * j) + e);
        for (int p = blk * NWAVES + wave; p < M / 2; p += nblk * NWAVES) {
            u32x4 fb[2][2], xb[2][2];
#pragma unroll
            for (int rr = 0; rr < 2; ++rr) { const int m = 2 * p + rr;
#pragma unroll
                for (int j = 0; j < 2; ++j) { fb[rr][j] = *((const u32x4*)(Fb + (size_t)m * D) + lane + 64 * j); xb[rr][j] = *((const u32x4*)(X1b + (size_t)m * D) + lane + 64 * j); } }
            float ss[2];
#pragma unroll
            for (int rr = 0; rr < 2; ++rr) { ss[rr] = 0.f;
#pragma unroll
                for (int j = 0; j < 2; ++j)
#pragma unroll
                    for (int q = 0; q < 4; ++q) { const unsigned w = fb[rr][j][q]; ss[rr] += bflo(w) * bflo(w) + bfhi(w) * bfhi(w); } }
            ss[0] = wave_sum(ss[0]); ss[1] = wave_sum(ss[1]);
#pragma unroll
            for (int rr = 0; rr < 2; ++rr) { const int m = 2 * p + rr; const float rstd = rsqrtf(ss[rr] * (1.f / D) + EPS);
#pragma unroll
                for (int j = 0; j < 2; ++j)
#pragma unroll
                    for (int e = 0; e < 2; ++e) { f32x4 y;
#pragma unroll
                        for (int q = 0; q < 2; ++q) { const unsigned fw = fb[rr][j][2 * e + q], xw = xb[rr][j][2 * e + q];
                            y[2 * q] = bflo(xw) + bflo(fw) * rstd * gpo[j][e][2 * q]; y[2 * q + 1] = bfhi(xw) + bfhi(fw) * rstd * gpo[j][e][2 * q + 1]; }
                        *((f32x4*)(Y + (size_t)m * D) + 2 * (lane + 64 * j) + e) = y; } }
        }
    }
#undef IN
#undef SEAM
}

#ifndef MK_SPLIT
#define MK_SPLIT 0
#endif
extern "C" void kernel_launch(void* const* d_in, const int* in_sizes, int n_in, void* d_out, int out_size, void* d_ws, size_t ws_size, hipStream_t stream) {
    static int grid = 0;
    if (grid == 0) {
        int dev = 0, cus = 0, per_cu = 0;
        if (hipGetDevice(&dev) != hipSuccess || hipDeviceGetAttribute(&cus, hipDeviceAttributeMultiprocessorCount, dev) != hipSuccess) { fprintf(stderr, "kernel_launch: device query failed\n"); grid = -1; return; }
        if (hipFuncSetAttribute((const void*)fwd_megakernel, hipFuncAttributeMaxDynamicSharedMemorySize, LDS_BYTES) != hipSuccess) { fprintf(stderr, "kernel_launch: hipFuncSetAttribute failed\n"); grid = -1; return; }
        if (hipOccupancyMaxActiveBlocksPerMultiprocessor(&per_cu, (const void*)fwd_megakernel, NTHREADS, LDS_BYTES) != hipSuccess || per_cu < 1) { fprintf(stderr, "kernel_launch: occupancy query says %d\n", per_cu); per_cu = 1; }
        (void)hipGetLastError();
        grid = cus * 1;
        if (ws_size < 256 * MiB || out_size != (int)O_END || n_in != 19) fprintf(stderr, "kernel_launch: unexpected sizes ws %zu out %d n_in %d\n", ws_size, out_size, n_in);
    }
    if (grid < 0) return;
    Args a{};
    a.x_prompt = (const float*)d_in[0]; a.x_sample = (const float*)d_in[1]; a.cache_k = (const float*)d_in[2]; a.cache_v = (const float*)d_in[3]; a.state_ret = (const float*)d_in[4];
    a.state_conv = (const float*)d_in[5]; a.w_in = (const float*)d_in[6]; a.sinks = (const float*)d_in[7]; a.w_a = (const float*)d_in[8]; a.w_r = (const float*)d_in[9]; a.w_o = (const float*)d_in[10];
    a.g_pre_mix = (const float*)d_in[11]; a.g_post_mix = (const float*)d_in[12]; a.g_pre_ffn = (const float*)d_in[13]; a.g_post_ffn = (const float*)d_in[14];
    a.w_up = (const float*)d_in[15]; a.conv_w = (const float*)d_in[16]; a.conv_b = (const float*)d_in[17]; a.w_down = (const float*)d_in[18];
    a.out = (float*)d_out; a.ws = (unsigned char*)d_ws;
#if MK_SPLIT
    for (int ph = 0; ph < 12; ++ph) { a.ph_lo = ph; a.ph_hi = ph + 1; hipLaunchKernelGGL(fwd_megakernel, dim3(grid), dim3(NTHREADS), LDS_BYTES, stream, a); }
#else
    a.ph_lo = 0; a.ph_hi = 12;
    if (hipMemsetAsync((unsigned char*)d_ws + WS_BAR, 0, 16384, stream) != hipSuccess) { fprintf(stderr, "kernel_launch: memset of the barrier words failed\n"); return; }
    void* args[] = {&a};
    const hipError_t e = hipLaunchCooperativeKernel((const void*)fwd_megakernel, dim3(grid), dim3(NTHREADS), args, LDS_BYTES, stream);
    if (e != hipSuccess) fprintf(stderr, "kernel_launch: cooperative launch failed: %s (grid %d)\n", hipGetErrorString(e), grid);
#endif
}
```

```cpp
#include <hip/hip_runtime.h>
#include <hip/hip_cooperative_groups.h>
#include <cstdio>
#include <cstdint>
#include <cmath>
namespace cg = cooperative_groups;
namespace pg8 {
#define PG8_LAS __attribute__((address_space(3)))
typedef unsigned short bf16_t;
typedef short bf16x8 __attribute__((ext_vector_type(8)));
typedef float f32x4 __attribute__((ext_vector_type(4)));
typedef unsigned u32x4 __attribute__((ext_vector_type(4)));
constexpr int BM = 256, BK = 64, HALF = 128, HTB = HALF * BK * 2  , STAGE_BYTES = 8 * HTB, NXCD = 8, WGM = 8;

__host__ __device__ __forceinline__ int lds_byte(int r, int c) { const int st = (r >> 4) * 2 + (c >> 5), rr = r & 15, cc = c & 31, ob = rr * 64 + cc * 2; return st * 1024 + (ob ^ (((ob >> 9) & 1) << 5)); }
__host__ __device__ __forceinline__ void stage_rc(int b, int& R, int& C) { const int st = b / 1024, sb = b % 1024, swz = sb ^ (((sb >> 9) & 1) << 5); R = (st >> 1) * 16 + swz / 64; C = (st & 1) * 32 + (swz % 64) / 2; }
__host__ __device__ __forceinline__ int perm32(int rho) { const int n = rho >> 4, i = rho & 15; return 8 * (i >> 2) + 4 * n + (i & 3); }

struct Unit { int pm, pn; };
struct Gemm { const bf16_t* A; const bf16_t* Bt; int M, N, K, lda; };

struct StaticOrder {
    int nM, nN, nwg, G, c;
    __host__ __device__ void init(int M, int N, int G_, int c_) { nM = M / BM; nN = N / BM; nwg = nM * nN; G = G_; c = c_; }
    __host__ __device__ bool next(int i, Unit& u) const {
        const long L = (long)i * G + c; if (L >= nwg) return false;
        int wgid = (int)L; { const int q = nwg / NXCD, r = nwg % NXCD, xcd = wgid % NXCD, off = wgid / NXCD; wgid = (xcd < r ? xcd * (q + 1) : r * (q + 1) + (xcd - r) * q) + off; }
        const int nig = WGM * nN, gid = wgid / nig, fm = gid * WGM, gsz = (nM - fm) < WGM ? (nM - fm) : WGM;
        u.pm = fm + ((wgid % nig) % gsz); u.pn = (wgid % nig) / gsz; return true;
    }
    __device__ __forceinline__ void a_ready(const Unit&) const {}
    __device__ __forceinline__ void done(const Unit&) const {}
};

__device__ __forceinline__ unsigned cvt_pk_bf16(float lo, float hi) { unsigned r; asm volatile("v_cvt_pk_bf16_f32 %0, %1, %2" : "=v"(r) : "v"(lo), "v"(hi)); return r; }
typedef float f32x2 __attribute__((ext_vector_type(2)));
__device__ __forceinline__ f32x2 gelu_pk(f32x2 v) {
    const f32x2 av = __builtin_elementwise_abs(v), d = av * 0.2316418882f + 1.0f;
    f32x2 t; t.x = __builtin_amdgcn_rcpf(d.x); t.y = __builtin_amdgcn_rcpf(d.y);
    f32x2 q = t * 0.5307027145f + (-0.7265760135f); q = q * t + 0.7107068705f; q = q * t + (-0.142248368f); q = q * t + 0.127414796f; q = q * t;
    const f32x2 s = (v * v) * (-0.72134752044f);
    f32x2 e; e.x = __builtin_amdgcn_exp2f(s.x); e.y = __builtin_amdgcn_exp2f(s.y);
    const f32x2 m = v * (q * e), r = v - m;
    f32x2 o; o.x = v.x < 0.f ? m.x : r.x; o.y = v.y < 0.f ? m.y : r.y; return o;
}

template <int ACT  > struct EpiBf16 {
    static constexpr bool PERM = true, AFTER_DRAIN = false; static_assert(ACT == 0 || ACT == 1, "EpiBf16: ACT is 0 (none) or 1 (gelu_pk)");
    bf16_t* O; int ldc; const float* bias; int split_cols; size_t split_stride; float scale0;
    __device__ __forceinline__ void operator()(const f32x4 (&acc)[2][2][4][2], const Unit& u, int wr, int wc, int fr, int fq) const {
        const int row0 = u.pm * BM + wr * 64 + fr; int colt = u.pn * BM; bf16_t* base = O;
        float sc = 1.f; if (split_cols) { const int t = colt / split_cols; base += (size_t)t * split_stride; colt -= t * split_cols; if (t == 0) sc = scale0; }
        const int col0 = colt + wc * 32 + 8 * fq, bcol0 = u.pn * BM + wc * 32 + 8 * fq;
        f32x4 bv[2][2];
#pragma unroll
        for (int bj = 0; bj < 2; ++bj)
#pragma unroll
            for (int n = 0; n < 2; ++n) bv[bj][n] = bias ? *(const f32x4*)(bias + bcol0 + bj * HALF + 4 * n) : (f32x4){0.f, 0.f, 0.f, 0.f};
#pragma unroll
        for (int ai = 0; ai < 2; ++ai)
#pragma unroll
            for (int m = 0; m < 4; ++m) { bf16_t* rowp = base + (size_t)(row0 + ai * HALF + m * 16) * ldc + col0;
#pragma unroll
                for (int bj = 0; bj < 2; ++bj) { f32x4 v0 = acc[ai][bj][m][0] + bv[bj][0], v1 = acc[ai][bj][m][1] + bv[bj][1];
                    if (ACT == 1) { f32x2 a = gelu_pk((f32x2){v0[0], v0[1]}), b = gelu_pk((f32x2){v0[2], v0[3]}), c = gelu_pk((f32x2){v1[0], v1[1]}), d = gelu_pk((f32x2){v1[2], v1[3]});
                        v0 = (f32x4){a.x, a.y, b.x, b.y}; v1 = (f32x4){c.x, c.y, d.x, d.y}; }
                    v0 = v0 * sc; v1 = v1 * sc; u32x4 w; w.x = cvt_pk_bf16(v0[0], v0[1]); w.y = cvt_pk_bf16(v0[2], v0[3]); w.z = cvt_pk_bf16(v1[0], v1[1]); w.w = cvt_pk_bf16(v1[2], v1[3]);
                    *(u32x4*)(rowp + bj * HALF) = w; } }
    }
};

typedef float f32x2e __attribute__((ext_vector_type(2)));
typedef unsigned u32x2e __attribute__((ext_vector_type(2)));
__device__ __forceinline__ float bf_lo(unsigned w) { return __uint_as_float(w << 16); }
__device__ __forceinline__ float bf_hi(unsigned w) { return __uint_as_float(w & 0xffff0000u); }
__device__ __forceinline__ float sigmoidf_(float x) { return __builtin_amdgcn_rcpf(1.0f + __expf(-x)); }
constexpr int E_MP = 16384, E_DIN = 5888;

struct EpiH {
    static constexpr bool PERM = true, AFTER_DRAIN = false;
    bf16_t* H; const f32x2e* tabA; const f32x2e* tabR;
    __device__ __forceinline__ void operator()(const f32x4 (&acc)[2][2][4][2], const Unit& u, int wr, int wc, int fr, int fq) const {
        const int pn = u.pn;
        const int row0 = u.pm * BM + wr * 64 + fr;
        const int colt = pn * BM + wc * 32 + 8 * fq;
#pragma unroll
        for (int ai = 0; ai < 2; ++ai)
#pragma unroll
            for (int m = 0; m < 4; ++m) {
                const int row = row0 + ai * HALF + m * 16;
                const int tp = row < E_MP ? (row & 4095) : 4096 + (row & 3);
#pragma unroll
                for (int bj = 0; bj < 2; ++bj) {
                    float v[8];
#pragma unroll
                    for (int j = 0; j < 4; ++j) { v[j] = acc[ai][bj][m][0][j]; v[4 + j] = acc[ai][bj][m][1][j]; }
                    int mode = 0; float sc = 1.f;
                    if (pn < 2) { mode = 1; sc = 0.125f; }
                    else if (pn == 2) { mode = (bj == 0) ? 1 : 0; }
                    else if (pn < 5) { mode = 2; }
                    else if (pn < 7) { mode = 2; sc = 0.08838834764831845f; }
                    if (mode == 1) {
                        const bool rot = ((wc & 1) == 0) && (fq < 2);
                        const float sgn = (fq == 0) ? -1.f : 1.f;
#pragma unroll
                        for (int j = 0; j < 8; ++j) {
                            const float partner = __shfl_xor(v[j], 16);
                            const f32x2e cs = tabA[tp * 8 + j];
                            const float o = v[j] * cs.x + sgn * partner * cs.y;
                            v[j] = (rot ? o : v[j]) * sc;
                        }
                    } else if (mode == 2) {
                        const int pi = ((bj * HALF + wc * 32 + 8 * fq) & 127) >> 1;
#pragma unroll
                        for (int p = 0; p < 4; ++p) {
                            const f32x2e cs = tabR[tp * 64 + pi + p];
                            const float x0 = v[2 * p], x1 = v[2 * p + 1];
                            v[2 * p] = (x0 * cs.x - x1 * cs.y) * sc; v[2 * p + 1] = (x1 * cs.x + x0 * cs.y) * sc;
                        }
                    }
                    u32x4 w; w.x = cvt_pk_bf16(v[0], v[1]); w.y = cvt_pk_bf16(v[2], v[3]); w.z = cvt_pk_bf16(v[4], v[5]); w.w = cvt_pk_bf16(v[6], v[7]);
                    *(u32x4*)(H + (size_t)row * E_DIN + colt + bj * HALF) = w;
                }
            }
    }
};

template <bool ADD> struct EpiGate {
    static constexpr bool PERM = true, AFTER_DRAIN = false;
    bf16_t* T; const bf16_t* gate; int ldg;
    __device__ __forceinline__ void operator()(const f32x4 (&acc)[2][2][4][2], const Unit& u, int wr, int wc, int fr, int fq) const {
        const int row0 = u.pm * BM + wr * 64 + fr, col0 = u.pn * BM + wc * 32 + 8 * fq;
#pragma unroll
        for (int ai = 0; ai < 2; ++ai)
#pragma unroll
            for (int m = 0; m < 4; ++m) {
                const int row = row0 + ai * HALF + m * 16;
#pragma unroll
                for (int bj = 0; bj < 2; ++bj) {
                    const u32x4 gw = *(const u32x4*)(gate + (size_t)row * ldg + col0 + bj * HALF);
                    bf16_t* tp = T + (size_t)row * 1024 + col0 + bj * HALF;
                    u32x4 old = (u32x4){0u, 0u, 0u, 0u}; if (ADD) old = *(const u32x4*)tp;
                    float o[8];
#pragma unroll
                    for (int j = 0; j < 4; ++j) {
                        const unsigned g2 = gw[j], o2 = old[j];
                        const float a0 = acc[ai][bj][m][j >> 1][(j & 1) * 2], a1 = acc[ai][bj][m][j >> 1][(j & 1) * 2 + 1];
                        o[2 * j] = bf_lo(o2) + sigmoidf_(bf_lo(g2)) * a0; o[2 * j + 1] = bf_hi(o2) + sigmoidf_(bf_hi(g2)) * a1;
                    }
                    u32x4 w; w.x = cvt_pk_bf16(o[0], o[1]); w.y = cvt_pk_bf16(o[2], o[3]); w.z = cvt_pk_bf16(o[4], o[5]); w.w = cvt_pk_bf16(o[6], o[7]);
                    *(u32x4*)tp = w;
                }
            }
    }
};

struct EpiF32 {
    static constexpr bool PERM = true, AFTER_DRAIN = false;
    float* O;
    __device__ __forceinline__ void operator()(const f32x4 (&acc)[2][2][4][2], const Unit& u, int wr, int wc, int fr, int fq) const {
        const int row0 = u.pm * BM + wr * 64 + fr, col0 = u.pn * BM + wc * 32 + 8 * fq;
#pragma unroll
        for (int ai = 0; ai < 2; ++ai)
#pragma unroll
            for (int m = 0; m < 4; ++m) {
                float* rp = O + (size_t)(row0 + ai * HALF + m * 16) * 1024 + col0;
#pragma unroll
                for (int bj = 0; bj < 2; ++bj) { *(f32x4*)(rp + bj * HALF) = acc[ai][bj][m][0]; *(f32x4*)(rp + bj * HALF + 4) = acc[ai][bj][m][1]; }
            }
    }
};

__device__ __forceinline__ float dpp_ror1(float x) { return __builtin_bit_cast(float, __builtin_amdgcn_update_dpp(0, __builtin_bit_cast(int, x), 0x121, 0xf, 0xf, false)); }
__device__ __forceinline__ float dpp_ror2(float x) { return __builtin_bit_cast(float, __builtin_amdgcn_update_dpp(0, __builtin_bit_cast(int, x), 0x122, 0xf, 0xf, false)); }
__device__ __forceinline__ float gelu_tanh(float x) { const float u2 = 1.5957691216057308f * (x + 0.044715f * x * x * x); return x * __builtin_amdgcn_rcpf(1.0f + __expf(-u2)); }
struct EpiUp {
    static constexpr bool PERM = true, AFTER_DRAIN = false;
    bf16_t* G; bf16_t* UH; bf16_t* US; float* conv_prompt; float* conv_sample; const float* conv_w; const float* conv_b;
    __device__ __forceinline__ void operator()(const f32x4 (&acc)[2][2][4][2], const Unit& u, int wr, int wc, int fr, int fq) const {
        const int row0 = u.pm * BM + wr * 64 + fr;
        const bool sample = u.pm >= 64;
        u32x2e keep[2][4];
#pragma unroll
        for (int n = 0; n < 2; ++n) {
            const int ch = u.pn * HALF + wc * 32 + 8 * fq + 4 * n;
            const f32x4 wa0 = *(const f32x4*)(conv_w + ch), wa1 = *(const f32x4*)(conv_w + 6144 + ch), wa2 = *(const f32x4*)(conv_w + 12288 + ch), ba = *(const f32x4*)(conv_b + ch);
            const f32x4 wb0 = *(const f32x4*)(conv_w + 3072 + ch), wb1 = *(const f32x4*)(conv_w + 6144 + 3072 + ch), wb2 = *(const f32x4*)(conv_w + 12288 + 3072 + ch), bb = *(const f32x4*)(conv_b + 3072 + ch);
#pragma unroll
            for (int ai = 0; ai < 2; ++ai)
#pragma unroll
                for (int m = 0; m < 4; ++m) {
                    const int row = row0 + ai * HALF + m * 16;
                    const f32x4 ua = acc[ai][0][m][n], ub = acc[ai][1][m][n];
                    const f32x4 pa = acc[ai][0][m > 0 ? m - 1 : 0][n], pb = acc[ai][1][m > 0 ? m - 1 : 0][n];
                    float g[4];
#pragma unroll
                    for (int rp = 0; rp < 2; ++rp) {
                        f32x2e a0v, a1v, a2v, b0v, b1v, b2v;
#pragma unroll
                        for (int e = 0; e < 2; ++e) { const int r = 2 * rp + e;
                            a0v[e] = ua[r]; b0v[e] = ub[r];
                            a1v[e] = dpp_ror1(fr == 15 ? pa[r] : ua[r]); a2v[e] = dpp_ror2(fr >= 14 ? pa[r] : ua[r]);
                            b1v[e] = dpp_ror1(fr == 15 ? pb[r] : ub[r]); b2v[e] = dpp_ror2(fr >= 14 ? pb[r] : ub[r]); }
                        const f32x2e wa0v = {wa0[2 * rp], wa0[2 * rp + 1]}, wa1v = {wa1[2 * rp], wa1[2 * rp + 1]}, wa2v = {wa2[2 * rp], wa2[2 * rp + 1]}, bav = {ba[2 * rp], ba[2 * rp + 1]};
                        const f32x2e wb0v = {wb0[2 * rp], wb0[2 * rp + 1]}, wb1v = {wb1[2 * rp], wb1[2 * rp + 1]}, wb2v = {wb2[2 * rp], wb2[2 * rp + 1]}, bbv = {bb[2 * rp], bb[2 * rp + 1]};
                        const f32x2e ca = bav + wa0v * a2v + wa1v * a1v + wa2v * a0v;
                        const f32x2e cb = bbv + wb0v * b2v + wb1v * b1v + wb2v * b0v;
                        const f32x2e u2 = ca * (ca * ca * (-0.044715f * 1.5957691216057308f * 1.4426950408889634f) + (-1.5957691216057308f * 1.4426950408889634f));
                        f32x2e den; den.x = __builtin_amdgcn_rcpf(1.0f + __builtin_amdgcn_exp2f(u2.x)); den.y = __builtin_amdgcn_rcpf(1.0f + __builtin_amdgcn_exp2f(u2.y));
                        const f32x2e gv = ca * den * cb;
                        g[2 * rp] = gv.x; g[2 * rp + 1] = gv.y;
                    }
                    if (!sample) {
                        { u32x2e w; w.x = cvt_pk_bf16(g[0], g[1]); w.y = cvt_pk_bf16(g[2], g[3]);
                          if (n == 0) keep[ai][m] = w;
                          else if (!(m == 0 && fr < 2)) { u32x4 w4; w4.x = keep[ai][m].x; w4.y = keep[ai][m].y; w4.z = w.x; w4.w = w.y; *(u32x4*)(G + (size_t)row * 3072 + ch - 4) = w4; } }
                        if ((m == 0 && fr < 2) || (m == 3 && fr >= 14)) {
                            const int hrow = (row >> 6) * 4 + ((row + 2) & 63);
                            u32x2e w; w.x = cvt_pk_bf16(ua[0], ua[1]); w.y = cvt_pk_bf16(ua[2], ua[3]); *(u32x2e*)(UH + (size_t)hrow * 6144 + ch) = w;
                            w.x = cvt_pk_bf16(ub[0], ub[1]); w.y = cvt_pk_bf16(ub[2], ub[3]); *(u32x2e*)(UH + (size_t)hrow * 6144 + 3072 + ch) = w;
                        }
                        if ((row & 4095) >= 4094) {
                            float* cp = conv_prompt + ((size_t)(row >> 12) * 2 + ((row & 4095) - 4094)) * 6144;
                            *(f32x4*)(cp + ch) = ua; *(f32x4*)(cp + 3072 + ch) = ub;
                        }
                    } else {
                        const int sr = row - E_MP;
                        u32x2e w; w.x = cvt_pk_bf16(ua[0], ua[1]); w.y = cvt_pk_bf16(ua[2], ua[3]); *(u32x2e*)(US + (size_t)sr * 6144 + ch) = w;
                        w.x = cvt_pk_bf16(ub[0], ub[1]); w.y = cvt_pk_bf16(ub[2], ub[3]); *(u32x2e*)(US + (size_t)sr * 6144 + 3072 + ch) = w;
                        if ((sr & 3) >= 2) {
                            float* cp = conv_sample + ((size_t)(sr >> 2) * 2 + ((sr & 3) - 2)) * 6144;
                            *(f32x4*)(cp + ch) = ua; *(f32x4*)(cp + 3072 + ch) = ub;
                        }
                    }
                }
        }
    }
};

template <class Epi, class Sched, bool ALIGN_EPI = false, bool SP2 = false>
__device__ __forceinline__ void gemm_phase(PG8_LAS unsigned char* lds, const Gemm g, const Sched& S, const Epi& E) {
    const int tid = threadIdx.x, wid = __builtin_amdgcn_readfirstlane(tid >> 6), lane = tid & 63, wr = wid >> 2, wc = wid & 3, fr = lane & 15, fq = lane >> 4;
    const int K = g.K, nt = K / BK, lda = g.lda;
    unsigned voffA[2], voffB[2];
#pragma unroll
    for (int i = 0; i < 2; ++i) { int R, C; stage_rc(tid * 16 + i * 8192, R, C); const int Rb = Epi::PERM ? ((R & ~31) + perm32(R & 31)) : R;
        voffA[i] = (unsigned)(R * lda + C) * 2u; voffB[i] = (unsigned)(Rb * K + C) * 2u; }
    const size_t kstep = (size_t)(BK * 2);
    const size_t hstepA = (size_t)HALF * lda * 2, hstepB = (size_t)HALF * K * 2;
    const size_t tstepA = 2 * hstepA, tstepB = 2 * hstepB;
    const unsigned ldsw = (unsigned)wid * 1024u;
    const int aoff = lds_byte(wr * 64 + fr, fq * 8), boff = lds_byte(wc * 32 + fr, fq * 8);
#define PG8_SA(b, h) (((b) * 2 + (h)) * HTB)
#define PG8_SB(b, h) ((4 + (b) * 2 + (h)) * HTB)
#define PG8_STAGE(bufoff, gbase, voff) do { _Pragma("unroll") for (int _i = 0; _i < 2; ++_i) \
        __builtin_amdgcn_global_load_lds((const unsigned*)((const char*)(gbase) + (voff)[_i]), (PG8_LAS unsigned*)(lds + (bufoff) + ldsw + _i * 8192), 16, 0, 0); } while (0)
#define PG8_LDA(dst, b, h) do { _Pragma("unroll") for (int m = 0; m < 4; ++m) _Pragma("unroll") for (int k = 0; k < 2; ++k) dst[m][k] = *(const PG8_LAS bf16x8*)(lds + PG8_SA(b, h) + aoff + m * 2048 + k * 1024); } while (0)
#define PG8_LDB(dst, b, h) do { _Pragma("unroll") for (int n = 0; n < 2; ++n) _Pragma("unroll") for (int k = 0; k < 2; ++k) dst[n][k] = *(const PG8_LAS bf16x8*)(lds + PG8_SB(b, h) + boff + n * 2048 + k * 1024); } while (0)
#define PG8_MMA(ai, bj, At, Bt) do { __builtin_amdgcn_s_setprio(1); _Pragma("unroll") for (int m = 0; m < 4; ++m) _Pragma("unroll") for (int n = 0; n < 2; ++n) _Pragma("unroll") for (int k = 0; k < 2; ++k) \
        acc[ai][bj][m][n] = __builtin_amdgcn_mfma_f32_16x16x32_bf16(Bt[n][k], At[m][k], acc[ai][bj][m][n], 0, 0, 0); __builtin_amdgcn_s_setprio(0); } while (0)
#define PG8_WAIT_V(n) asm volatile("s_waitcnt vmcnt(" #n ")" ::: "memory")
#define PG8_WAIT_L(n) asm volatile("s_waitcnt lgkmcnt(" #n ")" ::: "memory")
#define PG8_BAR __builtin_amdgcn_s_barrier()
#define PG8_SCHED __builtin_amdgcn_sched_barrier(0)
    Unit cur, nxt; int ui = 0;
    if (!S.next(0, cur)) return;
    f32x4 acc[2][2][4][2];
#pragma unroll
    for (int a = 0; a < 2; ++a)
#pragma unroll
        for (int b = 0; b < 2; ++b)
#pragma unroll
            for (int m = 0; m < 4; ++m)
#pragma unroll
                for (int n = 0; n < 2; ++n) acc[a][b][m][n] = (f32x4){0.f, 0.f, 0.f, 0.f};
    bf16x8 At[4][2], B0[2][2], B1[2][2];
    const char* cA = (const char*)g.A + (size_t)cur.pm * tstepA; const char* cB = (const char*)g.Bt + (size_t)cur.pn * tstepB;
    S.a_ready(cur);
    if constexpr (SP2) {
        PG8_STAGE(PG8_SB(0, 0), cB, voffB); PG8_STAGE(PG8_SB(0, 1), cB + hstepB, voffB); PG8_STAGE(PG8_SA(0, 0), cA, voffA); PG8_STAGE(PG8_SA(0, 1), cA + hstepA, voffA);
        if (wr == 1) PG8_BAR;
        PG8_WAIT_V(2); PG8_BAR;
        PG8_STAGE(PG8_SB(1, 0), cB + kstep, voffB); PG8_STAGE(PG8_SA(1, 0), cA + kstep, voffA); PG8_STAGE(PG8_SB(1, 1), cB + hstepB + kstep, voffB);
        PG8_WAIT_V(6); PG8_BAR;
    } else {
        PG8_STAGE(PG8_SB(0, 0), cB, voffB); PG8_STAGE(PG8_SA(0, 0), cA, voffA); PG8_STAGE(PG8_SB(0, 1), cB + hstepB, voffB); PG8_STAGE(PG8_SA(0, 1), cA + hstepA, voffA);
        if (wr == 1) PG8_BAR;
        PG8_WAIT_V(4); PG8_BAR;
        PG8_STAGE(PG8_SB(1, 0), cB + kstep, voffB); PG8_STAGE(PG8_SA(1, 0), cA + kstep, voffA); PG8_STAGE(PG8_SB(1, 1), cB + hstepB + kstep, voffB);
        PG8_WAIT_V(6); PG8_BAR;
    }
    for (;;) {
        const bool has_next = S.next(ui + 1, nxt);
        const char* nA = has_next ? (const char*)g.A + (size_t)nxt.pm * tstepA : cA; const char* nB = has_next ? (const char*)g.Bt + (size_t)nxt.pn * tstepB : cB;
        for (int t = 0; t < nt; t += 2) {
            const bool last = (t == nt - 2);
            const char* a1 = cA + (size_t)(t + 1) * kstep;
            const char* a2 = last ? nA : cA + (size_t)(t + 2) * kstep; const char* b2 = last ? nB : cB + (size_t)(t + 2) * kstep;
            const char* a3 = a2 + kstep; const char* b3 = b2 + kstep;
            if (last && has_next) S.a_ready(nxt);
            if constexpr (SP2) {
            PG8_LDB(B0, 0, 0); PG8_LDB(B1, 0, 1); PG8_SCHED; PG8_LDA(At, 0, 0); PG8_STAGE(PG8_SA(1, 1), a1 + hstepA, voffA);
            PG8_WAIT_V(8); PG8_WAIT_L(0); PG8_BAR; PG8_MMA(0, 0, At, B0); PG8_MMA(0, 1, At, B1); PG8_BAR; PG8_SCHED;
            PG8_LDA(At, 0, 1); PG8_STAGE(PG8_SB(0, 0), b2, voffB); PG8_STAGE(PG8_SB(0, 1), b2 + hstepB, voffB); PG8_STAGE(PG8_SA(0, 0), a2, voffA);
            PG8_WAIT_V(8); PG8_WAIT_L(0); PG8_BAR; PG8_MMA(1, 0, At, B0); PG8_MMA(1, 1, At, B1); PG8_BAR; PG8_SCHED;
            PG8_LDB(B0, 1, 0); PG8_LDB(B1, 1, 1); PG8_SCHED; PG8_LDA(At, 1, 0); PG8_STAGE(PG8_SA(0, 1), a2 + hstepA, voffA);
            PG8_WAIT_V(8); PG8_WAIT_L(0); PG8_BAR; PG8_MMA(0, 0, At, B0); PG8_MMA(0, 1, At, B1); PG8_BAR; PG8_SCHED;
            PG8_LDA(At, 1, 1); PG8_STAGE(PG8_SB(1, 0), b3, voffB); PG8_STAGE(PG8_SB(1, 1), b3 + hstepB, voffB); PG8_STAGE(PG8_SA(1, 0), a3, voffA);
            PG8_WAIT_V(8); PG8_WAIT_L(0); PG8_BAR; PG8_MMA(1, 0, At, B0); PG8_MMA(1, 1, At, B1); PG8_BAR; PG8_SCHED;
            } else {
            PG8_LDB(B0, 0, 0); PG8_SCHED; PG8_LDA(At, 0, 0); PG8_STAGE(PG8_SA(1, 1), a1 + hstepA, voffA);
            PG8_WAIT_L(8); PG8_BAR; PG8_WAIT_L(0); PG8_MMA(0, 0, At, B0); PG8_BAR; PG8_SCHED;
            PG8_LDB(B1, 0, 1); PG8_STAGE(PG8_SB(0, 0), b2, voffB);
            PG8_BAR; PG8_WAIT_L(0); PG8_MMA(0, 1, At, B1); PG8_BAR;
            PG8_LDA(At, 0, 1); PG8_STAGE(PG8_SA(0, 0), a2, voffA);
            PG8_BAR; PG8_WAIT_L(0); PG8_MMA(1, 0, At, B0); PG8_BAR; PG8_SCHED;
            PG8_STAGE(PG8_SB(0, 1), b2 + hstepB, voffB);
            PG8_WAIT_V(6); PG8_BAR; PG8_MMA(1, 1, At, B1); PG8_BAR;
            PG8_LDB(B0, 1, 0); PG8_SCHED; PG8_LDA(At, 1, 0); PG8_STAGE(PG8_SA(0, 1), a2 + hstepA, voffA);
            PG8_WAIT_L(8); PG8_BAR; PG8_WAIT_L(0); PG8_MMA(0, 0, At, B0); PG8_BAR; PG8_SCHED;
            PG8_LDB(B1, 1, 1); PG8_STAGE(PG8_SB(1, 0), b3, voffB);
            PG8_BAR; PG8_WAIT_L(0); PG8_MMA(0, 1, At, B1); PG8_BAR;
            PG8_LDA(At, 1, 1); PG8_STAGE(PG8_SA(1, 0), a3, voffA);
            PG8_BAR; PG8_WAIT_L(0); PG8_MMA(1, 0, At, B0); PG8_BAR; PG8_SCHED;
            PG8_STAGE(PG8_SB(1, 1), b3 + hstepB, voffB);
            PG8_WAIT_V(6); PG8_BAR; PG8_MMA(1, 1, At, B1); PG8_BAR;
            }
        }
        if constexpr (ALIGN_EPI) { if (wr == 0) PG8_BAR; }
        if constexpr (!Epi::AFTER_DRAIN) { E(acc, cur, wr, wc, fr, fq); S.done(cur); }
        if (!has_next) break;
#pragma unroll
        for (int a = 0; a < 2; ++a)
#pragma unroll
            for (int b = 0; b < 2; ++b)
#pragma unroll
                for (int m = 0; m < 4; ++m)
#pragma unroll
                    for (int n = 0; n < 2; ++n) acc[a][b][m][n] = (f32x4){0.f, 0.f, 0.f, 0.f};
        cur = nxt; cA = nA; cB = nB; ++ui;
        if constexpr (ALIGN_EPI) { if (wr == 1) PG8_BAR; }
    }
    PG8_WAIT_V(0);
    if constexpr (!ALIGN_EPI) { if (wr == 0) PG8_BAR; }
    PG8_BAR;
    if constexpr (Epi::AFTER_DRAIN) { E.fused(acc, cur, wr, wc, fr, fq, lds, wid, lane); S.done(cur); }
#undef PG8_SA
#undef PG8_SB
#undef PG8_STAGE
#undef PG8_LDA
#undef PG8_LDB
#undef PG8_MMA
#undef PG8_WAIT_V
#undef PG8_WAIT_L
#undef PG8_BAR
#undef PG8_SCHED
}
}

#define LAS __attribute__((address_space(3)))
using pg8::bf16_t; using pg8::bf16x8; using pg8::f32x4; using pg8::u32x4;
typedef float f32x2 __attribute__((ext_vector_type(2)));
typedef unsigned u32x2 __attribute__((ext_vector_type(2)));
typedef short v4i16 __attribute__((ext_vector_type(4)));

constexpr int MP = 16384, MS = 512, M = MP + MS, D = 1024, DIN = 5888, F2 = 6144, DFF = 3072, TSEQ = 4096;
constexpr int C_QA = 0, C_KA = 512, C_VA = 640, C_QR = 768, C_KR = 1280, C_VR = 1792, C_GATE = 2816, C_GMA = 3840, C_GMR = 4864;
constexpr float EPS = 1e-6f;
constexpr int NTHREADS = 512, NWAVES = 8;
constexpr int LDS_BYTES = 147456;

constexpr size_t MiB = 1u << 20;
constexpr size_t WS_BAR = 41 * 65536;
constexpr size_t WS_TABA = 0, WS_TABR = 512 * 1024;
constexpr size_t WS_WIN = 3 * MiB;
constexpr size_t WS_WUP = WS_WIN + (size_t)DIN * D * 2;
constexpr size_t WS_WDN = WS_WUP + (size_t)F2 * D * 2;
constexpr size_t WS_XN = WS_WDN + (size_t)D * DFF * 2;
constexpr size_t WS_R1 = WS_XN + (size_t)M * D * 2;
constexpr size_t R1_G = 0, R1_F = (size_t)M * DFF * 2, R1_UH = R1_F + (size_t)M * D * 2, R1_US = R1_UH + (size_t)264 * 4 * F2 * 2, R1_X1 = R1_US + (size_t)MS * F2 * 2, R1_END = R1_X1 + (size_t)M * D * 2;
static_assert(R1_END <= (size_t)M * DIN * 2, "R1 overlay");
static_assert(WS_R1 + (size_t)M * DIN * 2 <= 256 * MiB, "ws map");
constexpr size_t O_Y = 0, O_KP = (size_t)M * D, O_VP = O_KP + 65536, O_RP = O_VP + 65536, O_CP = O_RP + 524288, O_KS = O_CP + 49152, O_VS = O_KS + 2097152, O_RS = O_VS + 2097152, O_CS = O_RS + 16777216, O_END = O_CS + 1572864;

struct Args {
    const float *x_prompt, *x_sample, *cache_k, *cache_v, *state_ret, *state_conv, *w_in, *sinks, *w_a, *w_r, *w_o, *g_pre_mix, *g_post_mix, *g_pre_ffn, *g_post_ffn, *w_up, *conv_w, *conv_b, *w_down;
    float* out; unsigned char* ws; int ph_lo, ph_hi;
};

__device__ __forceinline__ float bf2f(bf16_t h) { return __uint_as_float((unsigned)h << 16); }
__device__ __forceinline__ float bflo(unsigned w) { return __uint_as_float(w << 16); }
__device__ __forceinline__ float bfhi(unsigned w) { return __uint_as_float(w & 0xffff0000u); }
__device__ __forceinline__ unsigned pk2(float lo, float hi) { return pg8::cvt_pk_bf16(lo, hi); }
__device__ __forceinline__ float wave_sum(float v) {
#pragma unroll
    for (int o = 1; o < 64; o <<= 1) v += __shfl_xor(v, o);
    return v;
}
__device__ __forceinline__ float wave_max(float v) {
#pragma unroll
    for (int o = 1; o < 64; o <<= 1) v = fmaxf(v, __shfl_xor(v, o));
    return v;
}
__device__ __forceinline__ float ret_log2g(int h) { return log2f(1.0f - exp2f(-5.0f - (float)h)); }
__device__ __forceinline__ bf16x8 tr_pair(const LAS unsigned char* p0, const LAS unsigned char* p1) {
    const v4i16 a = __builtin_amdgcn_ds_read_tr16_b64_v4i16((LAS v4i16*)p0), b = __builtin_amdgcn_ds_read_tr16_b64_v4i16((LAS v4i16*)p1);
    return (bf16x8){a[0], a[1], a[2], a[3], b[0], b[1], b[2], b[3]};
}
__device__ __forceinline__ bf16x8 cat8(u32x2 a, u32x2 b) { const u32x4 w = {a.x, a.y, b.x, b.y}; return __builtin_bit_cast(bf16x8, w); }

__device__ __forceinline__ void p0_transpose_item(const float* W, int K, int N, bf16_t* WT, int k0, int n0, int drow0, LAS float* scr, int lane) {
    f32x4 wv[8];
#pragma unroll
    for (int i = 0; i < 8; ++i) wv[i] = *(const f32x4*)(W + (size_t)(k0 + 8 * i + (lane >> 3)) * N + n0 + 4 * (lane & 7));
#pragma unroll
    for (int i = 0; i < 8; ++i) { LAS float* d = scr + (8 * i + (lane >> 3)) * 33 + 4 * (lane & 7); d[0] = wv[i].x; d[1] = wv[i].y; d[2] = wv[i].z; d[3] = wv[i].w; }
    asm volatile("s_waitcnt lgkmcnt(0)" ::: "memory");
    const int c = lane & 7;
#pragma unroll
    for (int j = 0; j < 4; ++j) { const int n = (lane >> 3) + 8 * j; const LAS float* s = scr + (8 * c) * 33 + n;
        u32x4 o; o.x = pk2(s[0 * 33], s[1 * 33]); o.y = pk2(s[2 * 33], s[3 * 33]); o.z = pk2(s[4 * 33], s[5 * 33]); o.w = pk2(s[6 * 33], s[7 * 33]);
        *(u32x4*)(WT + (size_t)(drow0 + n) * K + k0 + 8 * c) = o; }
    asm volatile("s_waitcnt lgkmcnt(0)" ::: "memory");
}
__device__ __forceinline__ void rms_row_to_bf16(const float* xrow, const float* g, bf16_t* orow, int lane) {
    f32x4 v[4]; float s = 0.f;
#pragma unroll
    for (int j = 0; j < 4; ++j) { v[j] = *((const f32x4*)xrow + lane + 64 * j); s += (v[j].x * v[j].x + v[j].y * v[j].y) + (v[j].z * v[j].z + v[j].w * v[j].w); }
    const float rstd = rsqrtf(wave_sum(s) * (1.f / D) + EPS);
#pragma unroll
    for (int j = 0; j < 4; ++j) { const f32x4 gg = *((const f32x4*)g + lane + 64 * j);
        u32x2 w; w.x = pk2(v[j].x * rstd * gg.x, v[j].y * rstd * gg.y); w.y = pk2(v[j].z * rstd * gg.z, v[j].w * rstd * gg.w);
        *((u32x2*)orow + lane + 64 * j) = w; }
}
__device__ __forceinline__ void p0_prologue(const Args& a, LAS unsigned char* lds, int tid, int lane, int wave) {
    unsigned char* ws = a.ws;
    LAS float* scr = (LAS float*)(lds + wave * 16384);
    const int gw = blockIdx.x * NWAVES + wave, NGW = gridDim.x * NWAVES;
    bf16_t* WinT = (bf16_t*)(ws + WS_WIN); bf16_t* WupT = (bf16_t*)(ws + WS_WUP); bf16_t* WdnT = (bf16_t*)(ws + WS_WDN);
    bf16_t* WoT = (bf16_t*)(a.out + O_CS); bf16_t* WaT = WoT + 1024 * 1024; bf16_t* WrT = WaT + 1024 * 512;
    constexpr int I_IN = 16 * (DIN / 32), I_A = 8 * 32, I_R = 16 * 32, I_O = 16 * 32, I_UP = 16 * (F2 / 32), I_DN = 48 * 32;
    constexpr int NITEMS = I_IN + I_A + I_R + I_O + I_UP + I_DN;
    for (int it = gw; it < NITEMS; it += NGW) {
        int r = it;
        if (r < I_IN) { const int nb = r % (DIN / 32), kb = r / (DIN / 32); p0_transpose_item(a.w_in, D, DIN, WinT, 64 * kb, 32 * nb, 32 * nb, scr, lane); continue; } r -= I_IN;
        if (r < I_A) { const int nb = r % 32, kb = r / 32; p0_transpose_item(a.w_a, 512, D, WaT, 64 * kb, 32 * nb, 32 * nb, scr, lane); continue; } r -= I_A;
        if (r < I_R) { const int nb = r % 32, kb = r / 32; p0_transpose_item(a.w_r, D, D, WrT, 64 * kb, 32 * nb, 32 * nb, scr, lane); continue; } r -= I_R;
        if (r < I_O) { const int nb = r % 32, kb = r / 32; p0_transpose_item(a.w_o, D, D, WoT, 64 * kb, 32 * nb, 32 * nb, scr, lane); continue; } r -= I_O;
        if (r < I_UP) { const int nb = r % (F2 / 32), kb = r / (F2 / 32); const int n0 = 32 * nb;
            const int drow = n0 < DFF ? (n0 / 128) * 256 + (n0 % 128) : ((n0 - DFF) / 128) * 256 + 128 + ((n0 - DFF) % 128);
            p0_transpose_item(a.w_up, D, F2, WupT, 64 * kb, n0, drow, scr, lane); continue; } r -= I_UP;
        { const int nb = r % 32, kb = r / 32; p0_transpose_item(a.w_down, DFF, D, WdnT, 64 * kb, 32 * nb, 32 * nb, scr, lane); }
    }
    bf16_t* XN = (bf16_t*)(ws + WS_XN);
    for (int m = gw; m < M; m += NGW) { const float* xr = m < MP ? a.x_prompt + (size_t)m * D : a.x_sample + (size_t)(m - MP) * D; rms_row_to_bf16(xr, a.g_pre_mix, XN + (size_t)m * D, lane); }
    f32x2* tabA = (f32x2*)(ws + WS_TABA); f32x2* tabR = (f32x2*)(ws + WS_TABR);
    __syncthreads();
    LAS float* invs = (LAS float*)lds;
    if (tid < 72) invs[tid] = tid < 8 ? (float)(1.0 / pow(500000.0, (double)((float)tid / 8.0f))) : (float)(1.0 / pow(10000.0, (double)((float)(tid - 8) / 63.0f)));
    __syncthreads();
    const int gt = blockIdx.x * NTHREADS + tid, NGT = gridDim.x * NTHREADS;
    for (int e = gt; e < 4100 * 72; e += NGT) {
        const int tp = e / 72, i = e % 72; const int pos = tp < 4096 ? tp : 16384 + (tp - 4096);
        const float ang = (float)pos * invs[i];
        const double rev = (double)ang * 0.15915494309189535; const float fr = (float)(rev - rint(rev));
        const f32x2 cs = {__builtin_amdgcn_cosf(fr), __builtin_amdgcn_sinf(fr)};
        if (i < 8) tabA[tp * 8 + i] = cs; else tabR[tp * 64 + (i - 8)] = cs;
    }
}

__device__ __forceinline__ void attn_prompt_unit(bf16_t* H, const float* sinks, LAS unsigned char* lds, int b, int qb, int head, int tid, int lane, int wave) {
    const int g = head >> 2, fr = lane & 15, fq = lane >> 4;
    const size_t rowbase = (size_t)b * TSEQ + (size_t)qb * 128;
    LAS unsigned char* Kimg = lds; LAS unsigned char* Vimg = lds + 36864;
#pragma unroll
    for (int i = 0; i < 4; ++i) {
        const int id = tid + NTHREADS * i, kidx = id >> 3, ch = id & 7;
        u32x4 kv = {0u, 0u, 0u, 0u}, vv = {0u, 0u, 0u, 0u};
        if (qb > 0 || kidx >= 128) { const bf16_t* src = H + (rowbase - 128 + kidx) * DIN; kv = *(const u32x4*)(src + C_KA + g * 64 + ch * 8); vv = *(const u32x4*)(src + C_VA + g * 64 + ch * 8); }
        *(LAS u32x4*)(Kimg + kidx * 144 + ch * 16) = kv; *(LAS u32x4*)(Vimg + kidx * 144 + ch * 16) = vv;
    }
    const size_t qrow = rowbase + 16 * wave + fr;
    bf16x8 qf[2];
#pragma unroll
    for (int ks = 0; ks < 2; ++ks) qf[ks] = *(const bf16x8*)(H + qrow * DIN + C_QA + head * 64 + 32 * ks + 8 * fq);
    __syncthreads();
    f32x4 s[10];
#pragma unroll
    for (int nn = 0; nn < 9; ++nn) {
        s[nn] = (f32x4){0.f, 0.f, 0.f, 0.f};
        const int krow = 16 * (wave + nn) + fr;
#pragma unroll
        for (int ks = 0; ks < 2; ++ks) { const bf16x8 kf = *(const LAS bf16x8*)(Kimg + krow * 144 + (32 * ks + 8 * fq) * 2); s[nn] = __builtin_amdgcn_mfma_f32_16x16x32_bf16(kf, qf[ks], s[nn], 0, 0, 0); }
    }
    s[9] = (f32x4){0.f, 0.f, 0.f, 0.f};
    const int qi = 16 * wave + fr; const float sink = sinks[head];
    float mx = sink;
#pragma unroll
    for (int nn = 0; nn < 9; ++nn)
#pragma unroll
        for (int r = 0; r < 4; ++r) { const int kidx = 16 * (wave + nn) + 4 * fq + r; const bool valid = (kidx > qi) && (kidx <= qi + 128) && (qb > 0 || kidx >= 128);
            s[nn][r] = valid ? s[nn][r] : -1e30f; mx = fmaxf(mx, s[nn][r]); }
    mx = fmaxf(mx, __shfl_xor(mx, 16)); mx = fmaxf(mx, __shfl_xor(mx, 32));
    float sum = 0.f;
#pragma unroll
    for (int nn = 0; nn < 9; ++nn)
#pragma unroll
        for (int r = 0; r < 4; ++r) { const float p = s[nn][r] > -1e29f ? __expf(s[nn][r] - mx) : 0.f; s[nn][r] = p; sum += p; }
    sum += __shfl_xor(sum, 16); sum += __shfl_xor(sum, 32);
    sum += __expf(sink - mx);
    f32x4 o[4];
#pragma unroll
    for (int db = 0; db < 4; ++db) o[db] = (f32x4){0.f, 0.f, 0.f, 0.f};
    const int tq = (lane & 15) >> 2, tpp = lane & 3;
#pragma unroll
    for (int G = 0; G < 5; ++G) {
        const u32x4 pw = {pk2(s[2 * G][0], s[2 * G][1]), pk2(s[2 * G][2], s[2 * G][3]), pk2(s[2 * G + 1][0], s[2 * G + 1][1]), pk2(s[2 * G + 1][2], s[2 * G + 1][3])};
        const bf16x8 pf = __builtin_bit_cast(bf16x8, pw);
        int k0 = 16 * (wave + 2 * G) + 4 * fq + tq, k1 = k0 + 16; k0 = k0 > 255 ? 255 : k0; k1 = k1 > 255 ? 255 : k1;
#pragma unroll
        for (int db = 0; db < 4; ++db) {
            const int colb = (32 * (db >> 1) + 8 * tpp + 4 * (db & 1)) * 2; const bf16x8 vf = tr_pair(Vimg + k0 * 144 + colb, Vimg + k1 * 144 + colb);
            o[db] = __builtin_amdgcn_mfma_f32_16x16x32_bf16(vf, pf, o[db], 0, 0, 0);
        }
    }
    const float inv = 1.0f / sum;
#pragma unroll
    for (int dp = 0; dp < 2; ++dp) { u32x4 w; w.x = pk2(o[2 * dp][0] * inv, o[2 * dp][1] * inv); w.y = pk2(o[2 * dp][2] * inv, o[2 * dp][3] * inv); w.z = pk2(o[2 * dp + 1][0] * inv, o[2 * dp + 1][1] * inv); w.w = pk2(o[2 * dp + 1][2] * inv, o[2 * dp + 1][3] * inv);
        *(u32x4*)(H + qrow * DIN + C_QA + head * 64 + 32 * dp + 8 * fq) = w; }
    __syncthreads();
}

__device__ __forceinline__ void attn_sample_unit(const Args& a, bf16_t* H, LAS unsigned char* lds, int b, int tid, int lane, int wave) {
    const int head = wave, g = head >> 2; const size_t r0 = (size_t)MP + 4 * b;
    LAS float* qs = (LAS float*)(lds + wave * 4096); LAS float* ps = qs + 256;
#pragma unroll
    for (int t = 0; t < 4; ++t) qs[t * 64 + lane] = bf2f(H[(r0 + t) * DIN + C_QA + head * 64 + lane]);
    asm volatile("s_waitcnt lgkmcnt(0)" ::: "memory");
    float sc[3][4];
    {
        const float* kp0 = a.cache_k + ((size_t)(b * 128 + lane) * 2 + g) * 64; const float* kp1 = kp0 + (size_t)64 * 128;
        const bf16_t* kpn = H + (r0 + (lane & 3)) * DIN + C_KA + g * 64;
#pragma unroll
        for (int t = 0; t < 4; ++t) { sc[0][t] = 0.f; sc[1][t] = 0.f; sc[2][t] = 0.f; }
#pragma nounroll
        for (int hf = 0; hf < 2; ++hf) {
            f32x4 kv0[8], kv1[8]; u32x4 kw[4];
#pragma unroll
            for (int d4 = 0; d4 < 8; ++d4) { kv0[d4] = *(const f32x4*)(kp0 + 32 * hf + 4 * d4); kv1[d4] = *(const f32x4*)(kp1 + 32 * hf + 4 * d4); }
#pragma unroll
            for (int c8 = 0; c8 < 4; ++c8) kw[c8] = *(const u32x4*)(kpn + 32 * hf + 8 * c8);
#pragma unroll
            for (int d4 = 0; d4 < 8; ++d4)
#pragma unroll
                for (int e = 0; e < 4; ++e) { const int d = 4 * d4 + e; const unsigned w = kw[d >> 3][(d & 7) >> 1]; const float kn = (d & 1) ? bfhi(w) : bflo(w);
#pragma unroll
                    for (int t = 0; t < 4; ++t) { const float q = qs[t * 64 + 32 * hf + d]; sc[0][t] += q * kv0[d4][e]; sc[1][t] += q * kv1[d4][e]; sc[2][t] += q * kn; } }
        }
    }
    const float sink = a.sinks[head];
    float inv[4];
#pragma unroll
    for (int t = 0; t < 4; ++t) {
        const bool v0 = lane > t, v1 = true, v2 = (lane < 4) && (lane <= t);
        const float s0 = v0 ? sc[0][t] : -1e30f, s1 = v1 ? sc[1][t] : -1e30f, s2 = v2 ? sc[2][t] : -1e30f;
        const float mx = fmaxf(wave_max(fmaxf(fmaxf(s0, s1), s2)), sink);
        const float p0 = v0 ? __expf(s0 - mx) : 0.f, p1 = __expf(s1 - mx), p2 = v2 ? __expf(s2 - mx) : 0.f;
        const float sum = wave_sum(p0 + p1 + p2) + __expf(sink - mx);
        inv[t] = 1.0f / sum;
        ps[t * 136 + lane] = p0; ps[t * 136 + 64 + lane] = p1; if (lane < 4) ps[t * 136 + 128 + lane] = p2;
    }
    asm volatile("s_waitcnt lgkmcnt(0)" ::: "memory");
    float o0 = 0.f, o1 = 0.f, o2 = 0.f, o3 = 0.f;
    const float* vp = a.cache_v + ((size_t)(b * 128) * 2 + g) * 64 + lane;
#pragma nounroll
    for (int rb = 0; rb < 2; ++rb) {
        float vx[64];
#pragma unroll
        for (int r = 0; r < 64; ++r) vx[r] = vp[(size_t)(64 * rb + r) * 128];
#pragma unroll
        for (int r = 0; r < 64; ++r) { const int rr = 64 * rb + r; o0 += ps[0 * 136 + rr] * vx[r]; o1 += ps[1 * 136 + rr] * vx[r]; o2 += ps[2 * 136 + rr] * vx[r]; o3 += ps[3 * 136 + rr] * vx[r]; }
    }
#pragma unroll
    for (int tn = 0; tn < 4; ++tn) { const float vx = bf2f(H[(r0 + tn) * DIN + C_VA + g * 64 + lane]); o0 += ps[0 * 136 + 128 + tn] * vx; o1 += ps[1 * 136 + 128 + tn] * vx; o2 += ps[2 * 136 + 128 + tn] * vx; o3 += ps[3 * 136 + 128 + tn] * vx; }
    H[(r0 + 0) * DIN + C_QA + head * 64 + lane] = (bf16_t)(pk2(o0 * inv[0], 0.f) & 0xffffu);
    H[(r0 + 1) * DIN + C_QA + head * 64 + lane] = (bf16_t)(pk2(o1 * inv[1], 0.f) & 0xffffu);
    H[(r0 + 2) * DIN + C_QA + head * 64 + lane] = (bf16_t)(pk2(o2 * inv[2], 0.f) & 0xffffu);
    H[(r0 + 3) * DIN + C_QA + head * 64 + lane] = (bf16_t)(pk2(o3 * inv[3], 0.f) & 0xffffu);
    float* ko = a.out + O_KS + (size_t)b * 128 * 128; float* vo = a.out + O_VS + (size_t)b * 128 * 128;
    const float* ki = a.cache_k + (size_t)b * 128 * 128 + 4 * 128; const float* vi = a.cache_v + (size_t)b * 128 * 128 + 4 * 128;
    for (int i = tid; i < 124 * 32; i += NTHREADS) { ((f32x4*)ko)[i] = ((const f32x4*)ki)[i]; ((f32x4*)vo)[i] = ((const f32x4*)vi)[i]; }
    { const int t = tid >> 7, gd = tid & 127;
      ko[(size_t)(124 + t) * 128 + gd] = bf2f(H[(r0 + t) * DIN + C_KA + gd]); vo[(size_t)(124 + t) * 128 + gd] = bf2f(H[(r0 + t) * DIN + C_VA + gd]); }
}

__device__ __forceinline__ void ret_u_unit(const bf16_t* H, bf16_t* ST, LAS unsigned char* lds, int b, int c, int h, int tid, int lane, int wave) {
    const size_t rowc = (size_t)b * TSEQ + (size_t)c * 128; const float l2g = ret_log2g(h);
    LAS unsigned char* Kimg = lds; LAS unsigned char* Vimg = lds + 36864;
#pragma unroll
    for (int i = 0; i < 4; ++i) { const int id = tid + NTHREADS * i, j = id >> 4, ch = id & 15;
        const u32x4 kv = *(const u32x4*)(H + (rowc + j) * DIN + C_KR + h * 128 + ch * 8); const float kd = exp2f(l2g * (float)(127 - j));
        u32x4 w; w.x = pk2(bflo(kv.x) * kd, bfhi(kv.x) * kd); w.y = pk2(bflo(kv.y) * kd, bfhi(kv.y) * kd); w.z = pk2(bflo(kv.z) * kd, bfhi(kv.z) * kd); w.w = pk2(bflo(kv.w) * kd, bfhi(kv.w) * kd);
        *(LAS u32x4*)(Kimg + j * 288 + ch * 16) = w; }
#pragma unroll
    for (int i = 0; i < 8; ++i) { const int id = tid + NTHREADS * i, j = id >> 5, ch = id & 31;
        *(LAS u32x4*)(Vimg + j * 544 + ch * 16) = *(const u32x4*)(H + (rowc + j) * DIN + C_VR + h * 256 + ch * 8); }
    __syncthreads();
    const int fr = lane & 15, fq = lane >> 4, tq = fr >> 2, tpp = lane & 3;
    f32x4 acc[2][8];
#pragma unroll
    for (int i = 0; i < 2; ++i)
#pragma unroll
        for (int j = 0; j < 8; ++j) acc[i][j] = (f32x4){0.f, 0.f, 0.f, 0.f};
#pragma unroll
    for (int ks = 0; ks < 4; ++ks) {
        const int j0 = 32 * ks + 4 * fq + tq, j1 = j0 + 16;
        bf16x8 vf[2];
#pragma unroll
        for (int i = 0; i < 2; ++i) { const int col = 32 * wave + 8 * tpp + 4 * i; vf[i] = tr_pair(Vimg + j0 * 544 + col * 2, Vimg + j1 * 544 + col * 2); }
#pragma unroll
        for (int kb = 0; kb < 8; ++kb) { const int col = 16 * kb + 4 * tpp; const bf16x8 kf = tr_pair(Kimg + j0 * 288 + col * 2, Kimg + j1 * 288 + col * 2);
#pragma unroll
            for (int i = 0; i < 2; ++i) acc[i][kb] = __builtin_amdgcn_mfma_f32_16x16x32_bf16(vf[i], kf, acc[i][kb], 0, 0, 0); }
    }
    bf16_t* U = ST + ((size_t)(b * 32 + c) * 4 + h) * 32768;
#pragma unroll
    for (int kb = 0; kb < 8; ++kb) { u32x4 w; w.x = pk2(acc[0][kb][0], acc[0][kb][1]); w.y = pk2(acc[0][kb][2], acc[0][kb][3]); w.z = pk2(acc[1][kb][0], acc[1][kb][1]); w.w = pk2(acc[1][kb][2], acc[1][kb][3]);
        *(u32x4*)(U + (size_t)(16 * kb + fr) * 256 + 32 * wave + 8 * fq) = w; }
    __syncthreads();
}

__device__ __forceinline__ void ret_sample_unit(const Args& a, bf16_t* H, LAS unsigned char* lds, int b, int h, int tid, int lane, int wave) {
    const size_t r0 = (size_t)MP + 4 * b; const float g = 1.0f - exp2f(-5.0f - (float)h);
    LAS float* qs = (LAS float*)lds; LAS float* ks = qs + 512; LAS float* po = ks + 512; LAS float* red = po + 2048;
    const int dv = tid & 255, half = tid >> 8;
    for (int i = tid; i < 1024; i += NTHREADS) { const int which = i >> 9, t = (i >> 7) & 3, d = i & 127;
        const float v = bf2f(H[(r0 + t) * DIN + (which ? C_KR : C_QR) + h * 128 + d]); if (which) ks[t * 128 + d] = v; else qs[t * 128 + d] = v; }
    float vt[4], gt[4];
#pragma unroll
    for (int t = 0; t < 4; ++t) { vt[t] = bf2f(H[(r0 + t) * DIN + C_VR + h * 256 + dv]); gt[t] = bf2f(H[(r0 + t) * DIN + C_GATE + h * 256 + dv]); }
    float S[64];
    const float* sp = a.state_ret + ((size_t)(b * 4 + h) * 128 + 64 * half) * 256 + dv;
#pragma unroll
    for (int d = 0; d < 64; ++d) S[d] = sp[(size_t)d * 256];
    __syncthreads();
#pragma unroll
    for (int t = 0; t < 4; ++t) { float o = 0.f;
#pragma unroll
        for (int d = 0; d < 64; ++d) { S[d] = g * S[d] + ks[t * 128 + 64 * half + d] * vt[t]; o += qs[t * 128 + 64 * half + d] * S[d]; }
        po[(half * 4 + t) * 256 + dv] = o; }
    float* so = a.out + O_RS + ((size_t)(b * 4 + h) * 128 + 64 * half) * 256 + dv;
#pragma unroll
    for (int d = 0; d < 64; ++d) so[(size_t)d * 256] = S[d];
    __syncthreads();
    float ot[4];
#pragma unroll
    for (int t = 0; t < 4; ++t) { ot[t] = po[t * 256 + dv] + po[(4 + t) * 256 + dv]; const float sq = wave_sum(half == 0 ? ot[t] * ot[t] : 0.f); if (lane == 0) red[wave * 4 + t] = sq; }
    __syncthreads();
    if (half == 0) {
#pragma unroll
        for (int t = 0; t < 4; ++t) { float ss = 0.f;
#pragma unroll
            for (int w = 0; w < 8; ++w) ss += red[w * 4 + t];
            const float rstd = rsqrtf(ss * (1.f / 256.f) + EPS); const float gv = gt[t]; const float sil = gv / (1.0f + __expf(-gv));
            H[(r0 + t) * DIN + C_VR + h * 256 + dv] = (bf16_t)(pk2(ot[t] * rstd * sil, 0.f) & 0xffffu); }
    }
    __syncthreads();
}

__device__ __forceinline__ void ret_out_unit(bf16_t* H, const bf16_t* ST, LAS unsigned char* lds, int b, int c, int h, int tid, int lane, int wave) {
    const size_t rowc = (size_t)b * TSEQ + (size_t)c * 128; const float l2g = ret_log2g(h);
    LAS unsigned char* Kimg = lds; LAS unsigned char* BIG = lds + 36864;
    const int fr = lane & 15, fq = lane >> 4, tq = fr >> 2, tpp = lane & 3;
    const int qi = 16 * wave + fr; const size_t qrow = rowc + qi;
    u32x4 kreg[4], sreg[8], vreg[8]; u32x4 greg[8];
#pragma unroll
    for (int i = 0; i < 4; ++i) { const int id = tid + NTHREADS * i, j = id >> 4, ch = id & 15; kreg[i] = *(const u32x4*)(H + (rowc + j) * DIN + C_KR + h * 128 + ch * 8); }
    if (c > 0) {
        const bf16_t* S = ST + ((size_t)(b * 32 + c) * 4 + h) * 32768;
#pragma unroll
        for (int i = 0; i < 8; ++i) { const int id = tid + NTHREADS * i, dk = id >> 5, ch = id & 31; sreg[i] = *(const u32x4*)(S + (size_t)dk * 256 + ch * 8); }
    }
    bf16x8 qf[4];
#pragma unroll
    for (int ks = 0; ks < 4; ++ks) { const bf16_t* qp = H + qrow * DIN + C_QR + h * 128 + 32 * ks + 4 * fq; qf[ks] = cat8(*(const u32x2*)qp, *(const u32x2*)(qp + 16)); }
#pragma unroll
    for (int i = 0; i < 8; ++i) { const int id = tid + NTHREADS * i, j = id >> 5, ch = id & 31; vreg[i] = *(const u32x4*)(H + (rowc + j) * DIN + C_VR + h * 256 + ch * 8); }
#pragma unroll
    for (int i = 0; i < 4; ++i) { const int id = tid + NTHREADS * i, j = id >> 4, ch = id & 15; *(LAS u32x4*)(Kimg + j * 288 + ch * 16) = kreg[i]; }
    if (c > 0) {
#pragma unroll
        for (int i = 0; i < 8; ++i) { const int id = tid + NTHREADS * i, dk = id >> 5, ch = id & 31; *(LAS u32x4*)(BIG + dk * 544 + ch * 16) = sreg[i]; }
    }
    __syncthreads();
    f32x4 acc[16];
#pragma unroll
    for (int k = 0; k < 16; ++k) acc[k] = (f32x4){0.f, 0.f, 0.f, 0.f};
    if (c > 0) {
#pragma unroll
        for (int ks = 0; ks < 4; ++ks) { const int d0 = 32 * ks + 4 * fq + tq, d1 = d0 + 16;
#pragma unroll
            for (int blk = 0; blk < 16; ++blk) { const int colb = (32 * (blk >> 1) + 8 * tpp + 4 * (blk & 1)) * 2; const bf16x8 sf = tr_pair(BIG + d0 * 544 + colb, BIG + d1 * 544 + colb);
                acc[blk] = __builtin_amdgcn_mfma_f32_16x16x32_bf16(sf, qf[ks], acc[blk], 0, 0, 0); } }
        const float qd = exp2f(l2g * (float)(qi + 1));
#pragma unroll
        for (int blk = 0; blk < 16; ++blk) acc[blk] = acc[blk] * qd;
    }
    bf16x8 pf[4];
#pragma unroll
    for (int G = 0; G < 4; ++G) {
        f32x4 sc[2];
#pragma unroll
        for (int e = 0; e < 2; ++e) { const int jb = 2 * G + e; sc[e] = (f32x4){0.f, 0.f, 0.f, 0.f};
            if (jb <= wave) {
#pragma unroll
                for (int ks = 0; ks < 4; ++ks) { const LAS unsigned char* kp = Kimg + (16 * jb + fr) * 288 + (32 * ks + 4 * fq) * 2;
                    const bf16x8 kf = cat8(*(const LAS u32x2*)kp, *(const LAS u32x2*)(kp + 32)); sc[e] = __builtin_amdgcn_mfma_f32_16x16x32_bf16(kf, qf[ks], sc[e], 0, 0, 0); }
#pragma unroll
                for (int r = 0; r < 4; ++r) { const int j = 16 * jb + 4 * fq + r; sc[e][r] = (j <= qi) ? sc[e][r] * exp2f(l2g * (float)(qi - j)) : 0.f; }
            } }
        const u32x4 pw = {pk2(sc[0][0], sc[0][1]), pk2(sc[0][2], sc[0][3]), pk2(sc[1][0], sc[1][1]), pk2(sc[1][2], sc[1][3])};
        pf[G] = __builtin_bit_cast(bf16x8, pw);
    }
    __syncthreads();
#pragma unroll
    for (int i = 0; i < 8; ++i) { const int id = tid + NTHREADS * i, j = id >> 5, ch = id & 31; *(LAS u32x4*)(BIG + j * 544 + ch * 16) = vreg[i]; }
#pragma unroll
    for (int k = 0; k < 8; ++k) greg[k] = *(const u32x4*)(H + qrow * DIN + C_GATE + h * 256 + 32 * k + 8 * fq);
    __syncthreads();
#pragma unroll
    for (int G = 0; G < 4; ++G) {
        if (2 * G <= wave) { const int j0 = 32 * G + 4 * fq + tq, j1 = j0 + 16;
#pragma unroll
            for (int blk = 0; blk < 16; ++blk) { const int colb = (32 * (blk >> 1) + 8 * tpp + 4 * (blk & 1)) * 2; const bf16x8 vf = tr_pair(BIG + j0 * 544 + colb, BIG + j1 * 544 + colb);
                acc[blk] = __builtin_amdgcn_mfma_f32_16x16x32_bf16(vf, pf[G], acc[blk], 0, 0, 0); } }
    }
    float ss = 0.f;
#pragma unroll
    for (int blk = 0; blk < 16; ++blk) ss += (acc[blk][0] * acc[blk][0] + acc[blk][1] * acc[blk][1]) + (acc[blk][2] * acc[blk][2] + acc[blk][3] * acc[blk][3]);
    ss += __shfl_xor(ss, 16); ss += __shfl_xor(ss, 32);
    const float rstd = rsqrtf(ss * (1.f / 256.f) + EPS);
#pragma unroll
    for (int k = 0; k < 8; ++k) {
        const u32x4 gw = greg[k]; u32x4 w;
#pragma unroll
        for (int q = 0; q < 4; ++q) { const float g0 = bflo(gw[q]), g1 = bfhi(gw[q]); const f32x4 av = acc[2 * k + (q >> 1)];
            const float a0 = av[(2 * q) & 3], a1 = av[(2 * q + 1) & 3];
            w[q] = pk2(a0 * rstd * g0 / (1.f + __expf(-g0)), a1 * rstd * g1 / (1.f + __expf(-g1))); }
        *(u32x4*)(H + qrow * DIN + C_VR + h * 256 + 32 * k + 8 * fq) = w;
    }
    __syncthreads();
}

__device__ __forceinline__ f32x4 tail_gemm(const bf16_t* A, int lda, const bf16_t* Bt, int K, LAS unsigned char* lds, int tid, int lane, int wave, f32x4 acc) {
    const int fr = lane & 15, fq = lane >> 4, nc = K / 512;
    LAS unsigned char* Ai = lds; LAS unsigned char* Bi = lds + 33280;
    u32x4 ra[4], rb[8];
#pragma unroll
    for (int i = 0; i < 4; ++i) { const int id = tid + NTHREADS * i; ra[i] = *(const u32x4*)(A + (size_t)(id >> 6) * lda + (id & 63) * 8); }
#pragma unroll
    for (int i = 0; i < 8; ++i) { const int id = tid + NTHREADS * i; rb[i] = *(const u32x4*)(Bt + (size_t)(id >> 6) * K + (id & 63) * 8); }
#pragma nounroll
    for (int c = 0; c < nc; ++c) {
#pragma unroll
        for (int i = 0; i < 4; ++i) { const int id = tid + NTHREADS * i; *(LAS u32x4*)(Ai + (id >> 6) * 1040 + (id & 63) * 16) = ra[i]; }
#pragma unroll
        for (int i = 0; i < 8; ++i) { const int id = tid + NTHREADS * i; *(LAS u32x4*)(Bi + (id >> 6) * 1040 + (id & 63) * 16) = rb[i]; }
        __syncthreads();
        if (c + 1 < nc) {
#pragma unroll
            for (int i = 0; i < 4; ++i) { const int id = tid + NTHREADS * i; ra[i] = *(const u32x4*)(A + (size_t)(id >> 6) * lda + (c + 1) * 512 + (id & 63) * 8); }
#pragma unroll
            for (int i = 0; i < 8; ++i) { const int id = tid + NTHREADS * i; rb[i] = *(const u32x4*)(Bt + (size_t)(id >> 6) * K + (c + 1) * 512 + (id & 63) * 8); }
        }
        const LAS unsigned char* ap = Ai + (16 * (wave >> 2) + fr) * 1040 + fq * 16; const LAS unsigned char* bp = Bi + (16 * (wave & 3) + fr) * 1040 + fq * 16;
#pragma unroll
        for (int ks = 0; ks < 16; ++ks) { const bf16x8 av = *(const LAS bf16x8*)(ap + ks * 64), bv = *(const LAS bf16x8*)(bp + ks * 64); acc = __builtin_amdgcn_mfma_f32_16x16x32_bf16(bv, av, acc, 0, 0, 0); }
        __syncthreads();
    }
    return acc;
}

#define XB_TMO      128
#define XB_XCNT(j)  (256  + 64 * (j))
#define XB_XSUB(j)  (1280 + 64 * (j))
#define XB_XGEN(j)  (2304 + 64 * (j))
#define XB_TOP      3328
#define XB_TOPGEN   3392
#define XCD_BAR_WORDS 3456
#define XB_SPIN_CAP (1u << 18)

__device__ __forceinline__ unsigned xb_ld(unsigned* p)              { return __hip_atomic_load(p, __ATOMIC_RELAXED, __HIP_MEMORY_SCOPE_AGENT); }
__device__ __forceinline__ unsigned xb_add(unsigned* p, unsigned v) { return __hip_atomic_fetch_add(p, v, __ATOMIC_RELAXED, __HIP_MEMORY_SCOPE_AGENT); }
__device__ __forceinline__ unsigned xb_xcc_id() { return (unsigned)__builtin_amdgcn_s_getreg((3 << 11) | 20) & 0xFu; }
#define XB_SPIN(cond, bar) do { unsigned _sp = 0; while (cond) { __builtin_amdgcn_s_sleep(1); \
    if ((++_sp & 255u) == 0u) { if (xb_ld(&(bar)[XB_TMO])) break; if (_sp > XB_SPIN_CAP) { atomicAdd(&(bar)[XB_TMO], 1u); break; } } } } while (0)

struct XcdBarrier {
    unsigned* bar; unsigned x;
    volatile LAS unsigned* st;
};

__device__ __forceinline__ XcdBarrier xcd_barrier_post(unsigned* bar, volatile LAS unsigned* st) {
    XcdBarrier b; b.bar = bar; b.x = xb_xcc_id(); b.st = st;
    if (threadIdx.x == 0) (void)xb_add(&bar[XB_XCNT(b.x)], 1u);
    return b;
}
__device__ __forceinline__ void xcd_barrier_complete(unsigned* bar, unsigned x, unsigned& nloc, unsigned& nx) {
    const unsigned G = gridDim.x * gridDim.y * gridDim.z;
    unsigned sum, cnt, mine, sp = 0u;
    for (;;) {
        sum = 0u; cnt = 0u; mine = 0u;
#pragma unroll
        for (unsigned j = 0; j < 16; ++j) { const unsigned c = xb_ld(&bar[XB_XCNT(j)]); sum += c; cnt += (c > 0u) ? 1u : 0u; mine = (j == x) ? c : mine; }
        if (sum == G) break;
        __builtin_amdgcn_s_sleep(1);
        if ((++sp & 255u) == 0u) { if (xb_ld(&bar[XB_TMO])) break; if (sp > XB_SPIN_CAP) { atomicAdd(&bar[XB_TMO], 1u); break; } }
    }
    nloc = mine > 0u ? mine : 1u; nx = cnt > 0u ? cnt : 1u;
}

__device__ __forceinline__ void xcd_barrier(const XcdBarrier& b) {
    asm volatile("s_waitcnt vmcnt(0)" ::: "memory");
    __syncthreads();
    if (threadIdx.x == 0) {
        unsigned* bar = b.bar;
        __builtin_amdgcn_s_waitcnt(0);
        unsigned nloc = b.st[0], nx = b.st[1];
        if (nloc == 0u) { xcd_barrier_complete(bar, b.x, nloc, nx); b.st[0] = nloc; b.st[1] = nx; }
        const unsigned old = xb_add(&bar[XB_XSUB(b.x)], 1u);
        const unsigned gen = old / nloc;
        if (old + 1u == (gen + 1u) * nloc) {
            __builtin_amdgcn_fence(__ATOMIC_RELEASE, "agent");
            asm volatile("s_waitcnt vmcnt(0)" ::: "memory");
            const unsigned og = xb_add(&bar[XB_TOP], 1u);
            const unsigned tg = og / nx;
            if (og + 1u == (tg + 1u) * nx) xb_add(&bar[XB_TOPGEN], 1u);
            else XB_SPIN(xb_ld(&bar[XB_TOPGEN]) == tg, bar);
            __builtin_amdgcn_fence(__ATOMIC_ACQUIRE, "agent");
            xb_add(&bar[XB_XGEN(b.x)], 1u);
            asm volatile("s_waitcnt vmcnt(0)" ::: "memory");
        } else {
            XB_SPIN(xb_ld(&bar[XB_XGEN(b.x)]) == gen, bar);
            __builtin_amdgcn_fence(__ATOMIC_ACQUIRE, "agent");
            asm volatile("s_waitcnt vmcnt(0)" ::: "memory");
        }
    }
    __syncthreads();
}


__global__ void __launch_bounds__(NTHREADS, 2) fwd_megakernel(Args a) {
    extern __shared__ __attribute__((aligned(16))) unsigned char lds_raw[];
    LAS unsigned char* lds = (LAS unsigned char*)lds_raw;
    cg::grid_group grid = cg::this_grid();
    const int tid = threadIdx.x, lane = tid & 63, wave = __builtin_amdgcn_readfirstlane(tid >> 6);
    const int nblk = gridDim.x, blk = blockIdx.x;
    unsigned char* ws = a.ws;
    bf16_t* WinT = (bf16_t*)(ws + WS_WIN); bf16_t* WupT = (bf16_t*)(ws + WS_WUP); bf16_t* WdnT = (bf16_t*)(ws + WS_WDN);
    bf16_t* WoT = (bf16_t*)(a.out + O_CS); bf16_t* WaT = WoT + 1024 * 1024; bf16_t* WrT = WaT + 1024 * 512;
    bf16_t* XN = (bf16_t*)(ws + WS_XN); bf16_t* H = (bf16_t*)(ws + WS_R1);
    bf16_t* MIXb = (bf16_t*)(ws + WS_R1);
    bf16_t* G = (bf16_t*)(ws + WS_R1 + R1_G); bf16_t* Fb = (bf16_t*)(ws + WS_R1 + R1_F); bf16_t* X1b = (bf16_t*)(ws + WS_R1 + R1_X1); bf16_t* UH = (bf16_t*)(ws + WS_R1 + R1_UH); bf16_t* US = (bf16_t*)(ws + WS_R1 + R1_US);
    bf16_t* ST = (bf16_t*)(a.out + O_Y);
    float* Y = a.out + O_Y;
    const int lo = a.ph_lo, hi = a.ph_hi;
    volatile LAS unsigned* xst = (volatile LAS unsigned*)(lds + 131072 + 64);
    if (tid == 0) { xst[0] = 0u; xst[1] = 0u; }
    __syncthreads();
    XcdBarrier xbar; xbar.bar = (unsigned*)(ws + WS_BAR); xbar.x = 0; xbar.st = nullptr;
    if (hi - lo > 1) { xbar = xcd_barrier_post((unsigned*)(ws + WS_BAR), xst);
        grid.sync(); }
#ifndef PROBE_REP_MASK
#define PROBE_REP_MASK 0
#endif
#define IN(k) (lo <= (k) && (k) < hi)
#define REPS(k) (((PROBE_REP_MASK >> (k)) & 1) ? 2 : 1)
#define SEAM(k) do { if (IN(k) && IN((k) + 1)) xcd_barrier(xbar); } while (0)

    if (IN(0)) { p0_prologue(a, lds, tid, lane, wave); }
    SEAM(0);
    if (IN(1)) {
        pg8::Gemm g{XN, WinT, M, DIN, D, D}; pg8::StaticOrder S; S.init(M, DIN, nblk, blk);
        pg8::EpiH E{H, (const pg8::f32x2e*)(ws + WS_TABA), (const pg8::f32x2e*)(ws + WS_TABR)};
        pg8::gemm_phase<pg8::EpiH, pg8::StaticOrder, true, true>(lds, g, S, E);
    }
    SEAM(1);
    if (IN(2)) {
        for (int u = blk; u < 1024; u += nblk) { const int head = u & 7, qb = (u >> 3) & 31, b = u >> 8; attn_prompt_unit(H, a.sinks, lds, b, qb, head, tid, lane, wave); }
        for (int u = blk; u < 512; u += nblk) { const int h = u & 3, c = (u >> 2) & 31, b = u >> 7; ret_u_unit(H, ST, lds, b, c, h, tid, lane, wave); }
        for (int u = blk; u < 128; u += nblk) { attn_sample_unit(a, H, lds, u, tid, lane, wave); __syncthreads(); }
        for (int u = blk; u < 512; u += nblk) { ret_sample_unit(a, H, lds, u >> 2, u & 3, tid, lane, wave); }
        for (int e = blk * NTHREADS + tid; e < 4 * 128 * 128; e += nblk * NTHREADS) { const int gd = e & 127, r = (e >> 7) & 127, b = e >> 14; const size_t row = (size_t)b * TSEQ + TSEQ - 128 + r;
            a.out[O_KP + e] = bf2f(H[row * DIN + C_KA + gd]); a.out[O_VP + e] = bf2f(H[row * DIN + C_VA + gd]); }
    }
    SEAM(2);
    if (IN(3)) {
        for (int e4 = blk * NTHREADS + tid; e4 < 16 * 8192; e4 += nblk * NTHREADS) {
            const int bh = e4 >> 13, idx = (e4 & 8191) * 4, b = bh >> 2, h = bh & 3;
            const float gL = exp2f(128.f * ret_log2g(h));
            f32x4 S = {0.f, 0.f, 0.f, 0.f};
#pragma unroll 8
            for (int c = 0; c < 32; ++c) { bf16_t* p = ST + ((size_t)(b * 32 + c) * 4 + h) * 32768 + idx; const u32x2 uw = *(const u32x2*)p; u32x2 sw; sw.x = pk2(S.x, S.y); sw.y = pk2(S.z, S.w); *(u32x2*)p = sw;
                const f32x4 uu = {bflo(uw.x), bfhi(uw.x), bflo(uw.y), bfhi(uw.y)}; S = S * gL + uu; }
            *(f32x4*)(a.out + O_RP + (size_t)bh * 32768 + idx) = S;
        }
    }
    SEAM(3);
    if (IN(4)) {
        for (int u = blk; u < 512; u += nblk) { const int h = u & 3, c = (u >> 2) & 31, b = u >> 7; ret_out_unit(H, ST, lds, b, c, h, tid, lane, wave); }
    }
    SEAM(4);
    if (IN(5)) {
        { pg8::Gemm g{H + C_QA, WaT, MP, D, 512, DIN}; pg8::StaticOrder S; S.init(MP, D, nblk, blk);
          pg8::EpiGate<false> E{XN, H + C_GMA, DIN}; pg8::gemm_phase<pg8::EpiGate<false>, pg8::StaticOrder, true, true>(lds, g, S, E); }
        __syncthreads();
        { pg8::Gemm g{H + C_VR, WrT, MP, D, D, DIN}; pg8::StaticOrder S; S.init(MP, D, nblk, blk);
          pg8::EpiGate<true> E{XN, H + C_GMR, DIN}; pg8::gemm_phase<pg8::EpiGate<true>, pg8::StaticOrder, true, true>(lds, g, S, E); }
        for (int piece = blk; piece < 256; piece += nblk) {
            const int fr = lane & 15, fq = lane >> 4; const size_t prow = (size_t)MP + 32 * (piece >> 4); const size_t row = prow + 16 * (wave >> 2) + fr; const int pcol = 64 * (piece & 15), col0 = pcol + 16 * (wave & 3);
            const f32x4 aa = tail_gemm(H + prow * DIN + C_QA, DIN, WaT + (size_t)pcol * 512, 512, lds, tid, lane, wave, (f32x4){0.f, 0.f, 0.f, 0.f});
            const f32x4 ar = tail_gemm(H + prow * DIN + C_VR, DIN, WrT + (size_t)pcol * 1024, 1024, lds, tid, lane, wave, (f32x4){0.f, 0.f, 0.f, 0.f});
            const int cb = col0 + 4 * fq;
            const u32x2 ga = *(const u32x2*)(H + row * DIN + C_GMA + cb), gr = *(const u32x2*)(H + row * DIN + C_GMR + cb);
            u32x2 w; w.x = pk2(pg8::sigmoidf_(bflo(ga.x)) * aa[0] + pg8::sigmoidf_(bflo(gr.x)) * ar[0], pg8::sigmoidf_(bfhi(ga.x)) * aa[1] + pg8::sigmoidf_(bfhi(gr.x)) * ar[1]);
            w.y = pk2(pg8::sigmoidf_(bflo(ga.y)) * aa[2] + pg8::sigmoidf_(bflo(gr.y)) * ar[2], pg8::sigmoidf_(bfhi(ga.y)) * aa[3] + pg8::sigmoidf_(bfhi(gr.y)) * ar[3]);
            *(u32x2*)(XN + row * D + cb) = w;
        }
    }
    SEAM(5);
    if (IN(6)) {
        pg8::Gemm g{XN, WoT, MP, D, D, D}; pg8::StaticOrder S; S.init(MP, D, nblk, blk);
        pg8::EpiBf16<0> E{MIXb, D, nullptr, 0, 0, 1.f}; pg8::gemm_phase<pg8::EpiBf16<0>, pg8::StaticOrder, true, true>(lds, g, S, E);
        for (int piece = blk; piece < 256; piece += nblk) {
            const int fr = lane & 15, fq = lane >> 4; const size_t prow = (size_t)MP + 32 * (piece >> 4); const size_t row = prow + 16 * (wave >> 2) + fr; const int pcol = 64 * (piece & 15), col0 = pcol + 16 * (wave & 3);
            const f32x4 ac = tail_gemm(XN + prow * D, D, WoT + (size_t)pcol * 1024, 1024, lds, tid, lane, wave, (f32x4){0.f, 0.f, 0.f, 0.f});
            u32x2 w; w.x = pk2(ac[0], ac[1]); w.y = pk2(ac[2], ac[3]); *(u32x2*)(MIXb + row * D + col0 + 4 * fq) = w;
        }
    }
    SEAM(6);
    if (IN(7)) {
        f32x4 gpm[2][2], gpf[2][2];
#pragma unroll
        for (int j = 0; j < 2; ++j)
#pragma unroll
            for (int e = 0; e < 2; ++e) { gpm[j][e] = *((const f32x4*)a.g_post_mix + 2 * (lane + 64 * j) + e); gpf[j][e] = *((const f32x4*)a.g_pre_ffn + 2 * (lane + 64 * j) + e); }
        for (int p = blk * NWAVES + wave; p < M / 2; p += nblk * NWAVES) {
            u32x4 mb[2][2]; f32x4 xx[2][2][2];
#pragma unroll
            for (int rr = 0; rr < 2; ++rr) { const int m = 2 * p + rr; const float* xr = m < MP ? a.x_prompt + (size_t)m * D : a.x_sample + (size_t)(m - MP) * D;
#pragma unroll
                for (int j = 0; j < 2; ++j) { mb[rr][j] = *((const u32x4*)(MIXb + (size_t)m * D) + lane + 64 * j); xx[rr][j][0] = *((const f32x4*)xr + 2 * (lane + 64 * j)); xx[rr][j][1] = *((const f32x4*)xr + 2 * (lane + 64 * j) + 1); } }
            float mv[2][2][8]; float ss[2];
#pragma unroll
            for (int rr = 0; rr < 2; ++rr) { ss[rr] = 0.f;
#pragma unroll
                for (int j = 0; j < 2; ++j)
#pragma unroll
                    for (int q = 0; q < 4; ++q) { const unsigned w = mb[rr][j][q]; mv[rr][j][2 * q] = bflo(w); mv[rr][j][2 * q + 1] = bfhi(w); ss[rr] += mv[rr][j][2 * q] * mv[rr][j][2 * q] + mv[rr][j][2 * q + 1] * mv[rr][j][2 * q + 1]; } }
            ss[0] = wave_sum(ss[0]); ss[1] = wave_sum(ss[1]);
            float s2[2];
#pragma unroll
            for (int rr = 0; rr < 2; ++rr) { const float rstd = rsqrtf(ss[rr] * (1.f / D) + EPS); s2[rr] = 0.f;
#pragma unroll
                for (int j = 0; j < 2; ++j)
#pragma unroll
                    for (int q = 0; q < 8; ++q) { const float x1 = xx[rr][j][q >> 2][q & 3] + mv[rr][j][q] * rstd * gpm[j][q >> 2][q & 3]; mv[rr][j][q] = x1; s2[rr] += x1 * x1; } }
            s2[0] = wave_sum(s2[0]); s2[1] = wave_sum(s2[1]);
#pragma unroll
            for (int rr = 0; rr < 2; ++rr) { const int m = 2 * p + rr; const float rstd2 = rsqrtf(s2[rr] * (1.f / D) + EPS);
#pragma unroll
                for (int j = 0; j < 2; ++j) { u32x4 w1, w2;
#pragma unroll
                    for (int q = 0; q < 4; ++q) { const float a0 = mv[rr][j][2 * q], a1 = mv[rr][j][2 * q + 1]; w1[q] = pk2(a0, a1);
                        w2[q] = pk2(a0 * rstd2 * gpf[j][(2 * q) >> 2][(2 * q) & 3], a1 * rstd2 * gpf[j][(2 * q + 1) >> 2][(2 * q + 1) & 3]); }
                    *((u32x4*)(X1b + (size_t)m * D) + lane + 64 * j) = w1; *((u32x4*)(XN + (size_t)m * D) + lane + 64 * j) = w2; } }
        }
    }
    SEAM(7);
    if (IN(8)) {
        pg8::Gemm g{XN, WupT, M, F2, D, D}; pg8::StaticOrder S; S.init(M, F2, nblk, blk);
        pg8::EpiUp E{G, UH, US, a.out + O_CP, a.out + O_CS, a.conv_w, a.conv_b};
        pg8::gemm_phase<pg8::EpiUp, pg8::StaticOrder, true, true>(lds, g, S, E);
    }
    SEAM(8);
    if (IN(9)) {
        for (int task = blk * NWAVES + wave; task < 1024 * 6; task += nblk * NWAVES) {
            const int rt = task / 6, chunk = task % 6; const int ch = chunk * 512 + lane * 8;
            float ua[3][8], ub[3][8];
            int row;
#define LD8BF(dst, ptr) do { const u32x4 _w = *(const u32x4*)(ptr); dst[0] = bflo(_w.x); dst[1] = bfhi(_w.x); dst[2] = bflo(_w.y); dst[3] = bfhi(_w.y); dst[4] = bflo(_w.z); dst[5] = bfhi(_w.z); dst[6] = bflo(_w.w); dst[7] = bfhi(_w.w); } while (0)
#define LD8F(dst, ptr) do { const f32x4 _a = *(const f32x4*)(ptr), _b = *(const f32x4*)((ptr) + 4); dst[0] = _a.x; dst[1] = _a.y; dst[2] = _a.z; dst[3] = _a.w; dst[4] = _b.x; dst[5] = _b.y; dst[6] = _b.z; dst[7] = _b.w; } while (0)
#define ZERO8(dst) do { _Pragma("unroll") for (int _i = 0; _i < 8; ++_i) dst[_i] = 0.f; } while (0)
            if (rt < 512) {
                const int grp = rt >> 1, k = rt & 1; row = grp * 64 + k; const int t = row & 4095;
                const bf16_t* u0 = UH + (size_t)(grp * 4 + 2 + k) * F2;
                LD8BF(ua[2], u0 + ch); LD8BF(ub[2], u0 + DFF + ch);
                if (t >= 1) { const bf16_t* u1 = (k == 0) ? UH + (size_t)((grp - 1) * 4 + 1) * F2 : UH + (size_t)(grp * 4 + 2) * F2; LD8BF(ua[1], u1 + ch); LD8BF(ub[1], u1 + DFF + ch); } else { ZERO8(ua[1]); ZERO8(ub[1]); }
                if (t >= 2) { const bf16_t* u2 = UH + (size_t)((grp - 1) * 4 + k) * F2; LD8BF(ua[0], u2 + ch); LD8BF(ub[0], u2 + DFF + ch); } else { ZERO8(ua[0]); ZERO8(ub[0]); }
            } else {
                const int sr = rt - 512, b = sr >> 2, t = sr & 3; row = MP + sr;
#pragma unroll
                for (int tap = 0; tap < 3; ++tap) { const int e = t + tap;
                    if (e < 2) { const float* cp = a.state_conv + ((size_t)b * 2 + e) * F2; LD8F(ua[tap], cp + ch); LD8F(ub[tap], cp + DFF + ch); }
                    else { const bf16_t* up = US + (size_t)(b * 4 + e - 2) * F2; LD8BF(ua[tap], up + ch); LD8BF(ub[tap], up + DFF + ch); } }
            }
            float wa[3][8], wb[3][8], ba[8], bb[8];
#pragma unroll
            for (int tap = 0; tap < 3; ++tap) { LD8F(wa[tap], a.conv_w + (size_t)tap * F2 + ch); LD8F(wb[tap], a.conv_w + (size_t)tap * F2 + DFF + ch); }
            LD8F(ba, a.conv_b + ch); LD8F(bb, a.conv_b + DFF + ch);
            float gg[8];
#pragma unroll
            for (int i = 0; i < 8; ++i) { const float ca = ba[i] + wa[0][i] * ua[0][i] + wa[1][i] * ua[1][i] + wa[2][i] * ua[2][i], cb = bb[i] + wb[0][i] * ub[0][i] + wb[1][i] * ub[1][i] + wb[2][i] * ub[2][i];
                gg[i] = pg8::gelu_tanh(ca) * cb; }
            u32x4 w; w.x = pk2(gg[0], gg[1]); w.y = pk2(gg[2], gg[3]); w.z = pk2(gg[4], gg[5]); w.w = pk2(gg[6], gg[7]);
            *(u32x4*)(G + (size_t)row * DFF + ch) = w;
        }
    }
    SEAM(9);
    if (IN(10)) {
        pg8::Gemm g{G, WdnT, MP, D, DFF, DFF}; pg8::StaticOrder S; S.init(MP, D, nblk, blk);
        pg8::EpiBf16<0> E{Fb, D, nullptr, 0, 0, 1.f}; pg8::gemm_phase<pg8::EpiBf16<0>, pg8::StaticOrder, true, true>(lds, g, S, E);
        for (int piece = blk; piece < 256; piece += nblk) {
            const int fr = lane & 15, fq = lane >> 4; const size_t prow = (size_t)MP + 32 * (piece >> 4); const size_t row = prow + 16 * (wave >> 2) + fr; const int pcol = 64 * (piece & 15), col0 = pcol + 16 * (wave & 3);
            const f32x4 ac = tail_gemm(G + prow * DFF, DFF, WdnT + (size_t)pcol * DFF, DFF, lds, tid, lane, wave, (f32x4){0.f, 0.f, 0.f, 0.f});
            u32x2 w; w.x = pk2(ac[0], ac[1]); w.y = pk2(ac[2], ac[3]); *(u32x2*)(Fb + row * D + col0 + 4 * fq) = w;
        }
    }
    SEAM(10);
    if (IN(11)) {
        f32x4 gpo[2][2];
#pragma unroll
        for (int j = 0; j < 2; ++j)
#pragma unroll
            for (int e = 0; e < 2; ++e) gpo[j][e] = *((const f32x4*)a.g_post_ffn + 2 * (lane + 64 * j) + e);
        for (int p = blk * NWAVES + wave; p < M / 2; p += nblk * NWAVES) {
            u32x4 fb[2][2], xb[2][2];
#pragma unroll
            for (int rr = 0; rr < 2; ++rr) { const int m = 2 * p + rr;
#pragma unroll
                for (int j = 0; j < 2; ++j) { fb[rr][j] = *((const u32x4*)(Fb + (size_t)m * D) + lane + 64 * j); xb[rr][j] = *((const u32x4*)(X1b + (size_t)m * D) + lane + 64 * j); } }
            float ss[2];
#pragma unroll
            for (int rr = 0; rr < 2; ++rr) { ss[rr] = 0.f;
#pragma unroll
                for (int j = 0; j < 2; ++j)
#pragma unroll
                    for (int q = 0; q < 4; ++q) { const unsigned w = fb[rr][j][q]; ss[rr] += bflo(w) * bflo(w) + bfhi(w) * bfhi(w); } }
            ss[0] = wave_sum(ss[0]); ss[1] = wave_sum(ss[1]);
#pragma unroll
            for (int rr = 0; rr < 2; ++rr) { const int m = 2 * p + rr; const float rstd = rsqrtf(ss[rr] * (1.f / D) + EPS);
#pragma unroll
                for (int j = 0; j < 2; ++j)
#pragma unroll
                    for (int e = 0; e < 2; ++e) { f32x4 y;
#pragma unroll
                        for (int q = 0; q < 2; ++q) { const unsigned fw = fb[rr][j][2 * e + q], xw = xb[rr][j][2 * e + q];
                            y[2 * q] = bflo(xw) + bflo(fw) * rstd * gpo[j][e][2 * q]; y[2 * q + 1] = bfhi(xw) + bfhi(fw) * rstd * gpo[j][e][2 * q + 1]; }
                        *((f32x4*)(Y + (size_t)m * D) + 2 * (lane + 64 * j) + e) = y; } }
        }
    }
#undef IN
#undef SEAM
}

#ifndef MK_SPLIT
#define MK_SPLIT 0
#endif
extern "C" void kernel_launch(void* const* d_in, const int* in_sizes, int n_in, void* d_out, int out_size, void* d_ws, size_t ws_size, hipStream_t stream) {
    static int grid = 0;
    if (grid == 0) {
        int dev = 0, cus = 0, per_cu = 0;
        if (hipGetDevice(&dev) != hipSuccess || hipDeviceGetAttribute(&cus, hipDeviceAttributeMultiprocessorCount, dev) != hipSuccess) { fprintf(stderr, "kernel_launch: device query failed\n"); grid = -1; return; }
        if (hipFuncSetAttribute((const void*)fwd_megakernel, hipFuncAttributeMaxDynamicSharedMemorySize, LDS_BYTES) != hipSuccess) { fprintf(stderr, "kernel_launch: hipFuncSetAttribute failed\n"); grid = -1; return; }
        if (hipOccupancyMaxActiveBlocksPerMultiprocessor(&per_cu, (const void*)fwd_megakernel, NTHREADS, LDS_BYTES) != hipSuccess || per_cu < 1) { fprintf(stderr, "kernel_launch: occupancy query says %d\n", per_cu); per_cu = 1; }
        (void)hipGetLastError();
        grid = cus * 1;
        if (ws_size < 256 * MiB || out_size != (int)O_END || n_in != 19) fprintf(stderr, "kernel_launch: unexpected sizes ws %zu out %d n_in %d\n", ws_size, out_size, n_in);
    }
    if (grid < 0) return;
    Args a{};
    a.x_prompt = (const float*)d_in[0]; a.x_sample = (const float*)d_in[1]; a.cache_k = (const float*)d_in[2]; a.cache_v = (const float*)d_in[3]; a.state_ret = (const float*)d_in[4];
    a.state_conv = (const float*)d_in[5]; a.w_in = (const float*)d_in[6]; a.sinks = (const float*)d_in[7]; a.w_a = (const float*)d_in[8]; a.w_r = (const float*)d_in[9]; a.w_o = (const float*)d_in[10];
    a.g_pre_mix = (const float*)d_in[11]; a.g_post_mix = (const float*)d_in[12]; a.g_pre_ffn = (const float*)d_in[13]; a.g_post_ffn = (const float*)d_in[14];
    a.w_up = (const float*)d_in[15]; a.conv_w = (const float*)d_in[16]; a.conv_b = (const float*)d_in[17]; a.w_down = (const float*)d_in[18];
    a.out = (float*)d_out; a.ws = (unsigned char*)d_ws;
#if MK_SPLIT
    for (int ph = 0; ph < 12; ++ph) { a.ph_lo = ph; a.ph_hi = ph + 1; hipLaunchKernelGGL(fwd_megakernel, dim3(grid), dim3(NTHREADS), LDS_BYTES, stream, a); }
#else
    a.ph_lo = 0; a.ph_hi = 12;
    if (hipMemsetAsync((unsigned char*)d_ws + WS_BAR, 0, 16384, stream) != hipSuccess) { fprintf(stderr, "kernel_launch: memset of the barrier words failed\n"); return; }
    void* args[] = {&a};
    const hipError_t e = hipLaunchCooperativeKernel((const void*)fwd_megakernel, dim3(grid), dim3(NTHREADS), args, LDS_BYTES, stream);
    if (e != hipSuccess) fprintf(stderr, "kernel_launch: cooperative launch failed: %s (grid %d)\n", hipGetErrorString(e), grid);
#endif
}
```

```cpp
#include <hip/hip_runtime.h>
#include <hip/hip_cooperative_groups.h>
#include <cstdio>
#include <cstdint>
#include <cmath>
namespace cg = cooperative_groups;
namespace pg8 {
#define PG8_LAS __attribute__((address_space(3)))
typedef unsigned short bf16_t;
typedef short bf16x8 __attribute__((ext_vector_type(8)));
typedef float f32x4 __attribute__((ext_vector_type(4)));
typedef unsigned u32x4 __attribute__((ext_vector_type(4)));
constexpr int BM = 256, BK = 64, HALF = 128, HTB = HALF * BK * 2  , STAGE_BYTES = 8 * HTB, NXCD = 8, WGM = 8;

__host__ __device__ __forceinline__ int lds_byte(int r, int c) { const int st = (r >> 4) * 2 + (c >> 5), rr = r & 15, cc = c & 31, ob = rr * 64 + cc * 2; return st * 1024 + (ob ^ (((ob >> 9) & 1) << 5)); }
__host__ __device__ __forceinline__ void stage_rc(int b, int& R, int& C) { const int st = b / 1024, sb = b % 1024, swz = sb ^ (((sb >> 9) & 1) << 5); R = (st >> 1) * 16 + swz / 64; C = (st & 1) * 32 + (swz % 64) / 2; }
__host__ __device__ __forceinline__ int perm32(int rho) { const int n = rho >> 4, i = rho & 15; return 8 * (i >> 2) + 4 * n + (i & 3); }

struct Unit { int pm, pn, seg; };
struct Gemm { const bf16_t* A; const bf16_t* Bt; int M, N, K, lda; int ldb = 0; const bf16_t* A2 = nullptr; const bf16_t* Bt2 = nullptr; int K2 = 0; };

struct StaticOrder {
    int nM, nN, nwg, G, c;
    __host__ __device__ void init(int M, int N, int G_, int c_) { nM = M / BM; nN = N / BM; nwg = nM * nN; G = G_; c = c_; }
    __host__ __device__ bool next(int i, Unit& u) const {
        const long L = (long)i * G + c; if (L >= nwg) return false;
        int wgid = (int)L; { const int q = nwg / NXCD, r = nwg % NXCD, xcd = wgid % NXCD, off = wgid / NXCD; wgid = (xcd < r ? xcd * (q + 1) : r * (q + 1) + (xcd - r) * q) + off; }
        const int nig = WGM * nN, gid = wgid / nig, fm = gid * WGM, gsz = (nM - fm) < WGM ? (nM - fm) : WGM;
        u.pm = fm + ((wgid % nig) % gsz); u.pn = (wgid % nig) / gsz; u.seg = 0; return true;
    }
    __device__ __forceinline__ void a_ready(const Unit&) const {}
    __device__ __forceinline__ void done(const Unit&) const {}
};
struct TwoSegOrder { StaticOrder so;
    __host__ __device__ bool next(int i, Unit& u) const { const bool ok = so.next(i >> 1, u); u.seg = i & 1; return ok; }
    __device__ __forceinline__ void a_ready(const Unit&) const {}
    __device__ __forceinline__ void done(const Unit&) const {} };


__device__ __forceinline__ unsigned cvt_pk_bf16(float lo, float hi) { unsigned r; asm volatile("v_cvt_pk_bf16_f32 %0, %1, %2" : "=v"(r) : "v"(lo), "v"(hi)); return r; }
typedef float f32x2 __attribute__((ext_vector_type(2)));
__device__ __forceinline__ f32x2 gelu_pk(f32x2 v) {
    const f32x2 av = __builtin_elementwise_abs(v), d = av * 0.2316418882f + 1.0f;
    f32x2 t; t.x = __builtin_amdgcn_rcpf(d.x); t.y = __builtin_amdgcn_rcpf(d.y);
    f32x2 q = t * 0.5307027145f + (-0.7265760135f); q = q * t + 0.7107068705f; q = q * t + (-0.142248368f); q = q * t + 0.127414796f; q = q * t;
    const f32x2 s = (v * v) * (-0.72134752044f);
    f32x2 e; e.x = __builtin_amdgcn_exp2f(s.x); e.y = __builtin_amdgcn_exp2f(s.y);
    const f32x2 m = v * (q * e), r = v - m;
    f32x2 o; o.x = v.x < 0.f ? m.x : r.x; o.y = v.y < 0.f ? m.y : r.y; return o;
}

template <int ACT  > struct EpiBf16 {
    static constexpr bool PERM = true, AFTER_DRAIN = false, TWO_SEG = false; static_assert(ACT == 0 || ACT == 1, "EpiBf16: ACT is 0 (none) or 1 (gelu_pk)");
    bf16_t* O; int ldc; const float* bias; int split_cols; size_t split_stride; float scale0;
    __device__ __forceinline__ void operator()(const f32x4 (&acc)[2][2][4][2], const Unit& u, int wr, int wc, int fr, int fq) const {
        const int row0 = u.pm * BM + wr * 64 + fr; int colt = u.pn * BM; bf16_t* base = O;
        float sc = 1.f; if (split_cols) { const int t = colt / split_cols; base += (size_t)t * split_stride; colt -= t * split_cols; if (t == 0) sc = scale0; }
        const int col0 = colt + wc * 32 + 8 * fq, bcol0 = u.pn * BM + wc * 32 + 8 * fq;
        f32x4 bv[2][2];
#pragma unroll
        for (int bj = 0; bj < 2; ++bj)
#pragma unroll
            for (int n = 0; n < 2; ++n) bv[bj][n] = bias ? *(const f32x4*)(bias + bcol0 + bj * HALF + 4 * n) : (f32x4){0.f, 0.f, 0.f, 0.f};
#pragma unroll
        for (int ai = 0; ai < 2; ++ai)
#pragma unroll
            for (int m = 0; m < 4; ++m) { bf16_t* rowp = base + (size_t)(row0 + ai * HALF + m * 16) * ldc + col0;
#pragma unroll
                for (int bj = 0; bj < 2; ++bj) { f32x4 v0 = acc[ai][bj][m][0] + bv[bj][0], v1 = acc[ai][bj][m][1] + bv[bj][1];
                    if (ACT == 1) { f32x2 a = gelu_pk((f32x2){v0[0], v0[1]}), b = gelu_pk((f32x2){v0[2], v0[3]}), c = gelu_pk((f32x2){v1[0], v1[1]}), d = gelu_pk((f32x2){v1[2], v1[3]});
                        v0 = (f32x4){a.x, a.y, b.x, b.y}; v1 = (f32x4){c.x, c.y, d.x, d.y}; }
                    v0 = v0 * sc; v1 = v1 * sc; u32x4 w; w.x = cvt_pk_bf16(v0[0], v0[1]); w.y = cvt_pk_bf16(v0[2], v0[3]); w.z = cvt_pk_bf16(v1[0], v1[1]); w.w = cvt_pk_bf16(v1[2], v1[3]);
                    *(u32x4*)(rowp + bj * HALF) = w; } }
    }
};

typedef float f32x2e __attribute__((ext_vector_type(2)));
typedef unsigned u32x2e __attribute__((ext_vector_type(2)));
__device__ __forceinline__ float bf_lo(unsigned w) { return __uint_as_float(w << 16); }
__device__ __forceinline__ float bf_hi(unsigned w) { return __uint_as_float(w & 0xffff0000u); }
__device__ __forceinline__ float sigmoidf_(float x) { return __builtin_amdgcn_rcpf(1.0f + __expf(-x)); }
constexpr int E_MP = 16384, E_DIN = 5888;

struct EpiH {
    static constexpr bool PERM = true, AFTER_DRAIN = false, TWO_SEG = false;
    bf16_t* H; const f32x2e* tabA; const f32x2e* tabR;
    __device__ __forceinline__ void operator()(const f32x4 (&acc)[2][2][4][2], const Unit& u, int wr, int wc, int fr, int fq) const {
        const int pn = u.pn;
        const int row0 = u.pm * BM + wr * 64 + fr;
        const int colt = pn * BM + wc * 32 + 8 * fq;
#pragma unroll
        for (int ai = 0; ai < 2; ++ai)
#pragma unroll
            for (int m = 0; m < 4; ++m) {
                const int row = row0 + ai * HALF + m * 16;
                const int tp = row < E_MP ? (row & 4095) : 4096 + (row & 3);
#pragma unroll
                for (int bj = 0; bj < 2; ++bj) {
                    float v[8];
#pragma unroll
                    for (int j = 0; j < 4; ++j) { v[j] = acc[ai][bj][m][0][j]; v[4 + j] = acc[ai][bj][m][1][j]; }
                    int mode = 0; float sc = 1.f;
                    if (pn < 2) { mode = 1; sc = 0.125f; }
                    else if (pn == 2) { mode = (bj == 0) ? 1 : 0; }
                    else if (pn < 5) { mode = 2; }
                    else if (pn < 7) { mode = 2; sc = 0.08838834764831845f; }
                    if (mode == 1) {
                        const bool rot = ((wc & 1) == 0) && (fq < 2);
                        const float sgn = (fq == 0) ? -1.f : 1.f;
#pragma unroll
                        for (int j = 0; j < 8; ++j) {
                            const float partner = __shfl_xor(v[j], 16);
                            const f32x2e cs = tabA[tp * 8 + j];
                            const float o = v[j] * cs.x + sgn * partner * cs.y;
                            v[j] = (rot ? o : v[j]) * sc;
                        }
                    } else if (mode == 2) {
                        const int pi = ((bj * HALF + wc * 32 + 8 * fq) & 127) >> 1;
#pragma unroll
                        for (int p = 0; p < 4; ++p) {
                            const f32x2e cs = tabR[tp * 64 + pi + p];
                            const float x0 = v[2 * p], x1 = v[2 * p + 1];
                            v[2 * p] = (x0 * cs.x - x1 * cs.y) * sc; v[2 * p + 1] = (x1 * cs.x + x0 * cs.y) * sc;
                        }
                    }
                    u32x4 w; w.x = cvt_pk_bf16(v[0], v[1]); w.y = cvt_pk_bf16(v[2], v[3]); w.z = cvt_pk_bf16(v[4], v[5]); w.w = cvt_pk_bf16(v[6], v[7]);
                    *(u32x4*)(H + (size_t)row * E_DIN + colt + bj * HALF) = w;
                }
            }
    }
};

template <bool ADD> struct EpiGate {
    static constexpr bool PERM = true, AFTER_DRAIN = false, TWO_SEG = false;
    bf16_t* T; const bf16_t* gate; int ldg;
    __device__ __forceinline__ void operator()(const f32x4 (&acc)[2][2][4][2], const Unit& u, int wr, int wc, int fr, int fq) const {
        const int row0 = u.pm * BM + wr * 64 + fr, col0 = u.pn * BM + wc * 32 + 8 * fq;
#pragma unroll
        for (int ai = 0; ai < 2; ++ai)
#pragma unroll
            for (int m = 0; m < 4; ++m) {
                const int row = row0 + ai * HALF + m * 16;
#pragma unroll
                for (int bj = 0; bj < 2; ++bj) {
                    const u32x4 gw = *(const u32x4*)(gate + (size_t)row * ldg + col0 + bj * HALF);
                    bf16_t* tp = T + (size_t)row * 1024 + col0 + bj * HALF;
                    u32x4 old = (u32x4){0u, 0u, 0u, 0u}; if (ADD) old = *(const u32x4*)tp;
                    float o[8];
#pragma unroll
                    for (int j = 0; j < 4; ++j) {
                        const unsigned g2 = gw[j], o2 = old[j];
                        const float a0 = acc[ai][bj][m][j >> 1][(j & 1) * 2], a1 = acc[ai][bj][m][j >> 1][(j & 1) * 2 + 1];
                        o[2 * j] = bf_lo(o2) + sigmoidf_(bf_lo(g2)) * a0; o[2 * j + 1] = bf_hi(o2) + sigmoidf_(bf_hi(g2)) * a1;
                    }
                    u32x4 w; w.x = cvt_pk_bf16(o[0], o[1]); w.y = cvt_pk_bf16(o[2], o[3]); w.z = cvt_pk_bf16(o[4], o[5]); w.w = cvt_pk_bf16(o[6], o[7]);
                    *(u32x4*)tp = w;
                }
            }
    }
};

struct EpiGate2 {
    static constexpr bool PERM = true, AFTER_DRAIN = false, TWO_SEG = true;
    bf16_t* T; const bf16_t* ga; const bf16_t* gr; int ldg;
    __device__ __forceinline__ void mid(f32x4 (&acc)[2][2][4][2], const Unit& u, int wr, int wc, int fr, int fq) const {
        const int row0 = u.pm * BM + wr * 64 + fr, col0 = u.pn * BM + wc * 32 + 8 * fq;
#pragma unroll
        for (int ai = 0; ai < 2; ++ai)
#pragma unroll
            for (int m = 0; m < 4; ++m) {
                const int row = row0 + ai * HALF + m * 16;
#pragma unroll
                for (int bj = 0; bj < 2; ++bj) {
                    const u32x4 aw = *(const u32x4*)(ga + (size_t)row * ldg + col0 + bj * HALF), rw = *(const u32x4*)(gr + (size_t)row * ldg + col0 + bj * HALF);
#pragma unroll
                    for (int j = 0; j < 4; ++j) {
                        const float a0 = fminf(fmaxf(bf_lo(aw[j]), -30.f), 30.f), a1 = fminf(fmaxf(bf_hi(aw[j]), -30.f), 30.f), r0 = fminf(fmaxf(bf_lo(rw[j]), -30.f), 30.f), r1 = fminf(fmaxf(bf_hi(rw[j]), -30.f), 30.f);
                        const float q0 = (1.0f + __expf(-r0)) * __builtin_amdgcn_rcpf(1.0f + __expf(-a0)), q1 = (1.0f + __expf(-r1)) * __builtin_amdgcn_rcpf(1.0f + __expf(-a1));
                        acc[ai][bj][m][j >> 1][(j & 1) * 2] *= q0; acc[ai][bj][m][j >> 1][(j & 1) * 2 + 1] *= q1;
                    }
                }
            }
    }
    __device__ __forceinline__ void operator()(const f32x4 (&acc)[2][2][4][2], const Unit& u, int wr, int wc, int fr, int fq) const {
        const int row0 = u.pm * BM + wr * 64 + fr, col0 = u.pn * BM + wc * 32 + 8 * fq;
#pragma unroll
        for (int ai = 0; ai < 2; ++ai)
#pragma unroll
            for (int m = 0; m < 4; ++m) {
                const int row = row0 + ai * HALF + m * 16;
#pragma unroll
                for (int bj = 0; bj < 2; ++bj) {
                    const u32x4 rw = *(const u32x4*)(gr + (size_t)row * ldg + col0 + bj * HALF);
                    float o[8];
#pragma unroll
                    for (int j = 0; j < 4; ++j) {
                        const float r0 = fminf(fmaxf(bf_lo(rw[j]), -30.f), 30.f), r1 = fminf(fmaxf(bf_hi(rw[j]), -30.f), 30.f);
                        o[2 * j] = acc[ai][bj][m][j >> 1][(j & 1) * 2] * __builtin_amdgcn_rcpf(1.0f + __expf(-r0)); o[2 * j + 1] = acc[ai][bj][m][j >> 1][(j & 1) * 2 + 1] * __builtin_amdgcn_rcpf(1.0f + __expf(-r1));
                    }
                    u32x4 w; w.x = cvt_pk_bf16(o[0], o[1]); w.y = cvt_pk_bf16(o[2], o[3]); w.z = cvt_pk_bf16(o[4], o[5]); w.w = cvt_pk_bf16(o[6], o[7]);
                    *(u32x4*)(T + (size_t)row * 1024 + col0 + bj * HALF) = w;
                }
            }
    }
};

struct EpiF32 {
    static constexpr bool PERM = true, AFTER_DRAIN = false, TWO_SEG = false;
    float* O;
    __device__ __forceinline__ void operator()(const f32x4 (&acc)[2][2][4][2], const Unit& u, int wr, int wc, int fr, int fq) const {
        const int row0 = u.pm * BM + wr * 64 + fr, col0 = u.pn * BM + wc * 32 + 8 * fq;
#pragma unroll
        for (int ai = 0; ai < 2; ++ai)
#pragma unroll
            for (int m = 0; m < 4; ++m) {
                float* rp = O + (size_t)(row0 + ai * HALF + m * 16) * 1024 + col0;
#pragma unroll
                for (int bj = 0; bj < 2; ++bj) { *(f32x4*)(rp + bj * HALF) = acc[ai][bj][m][0]; *(f32x4*)(rp + bj * HALF + 4) = acc[ai][bj][m][1]; }
            }
    }
};

__device__ __forceinline__ float dpp_ror1(float x) { return __builtin_bit_cast(float, __builtin_amdgcn_update_dpp(0, __builtin_bit_cast(int, x), 0x121, 0xf, 0xf, false)); }
__device__ __forceinline__ float dpp_ror2(float x) { return __builtin_bit_cast(float, __builtin_amdgcn_update_dpp(0, __builtin_bit_cast(int, x), 0x122, 0xf, 0xf, false)); }
__device__ __forceinline__ float gelu_tanh(float x) { const float u2 = 1.5957691216057308f * (x + 0.044715f * x * x * x); return x * __builtin_amdgcn_rcpf(1.0f + __expf(-u2)); }
struct EpiUp {
    static constexpr bool PERM = true, AFTER_DRAIN = false, TWO_SEG = false;
    bf16_t* G; bf16_t* UH; bf16_t* US; float* conv_prompt; float* conv_sample; const float* conv_w; const float* conv_b;
    __device__ __forceinline__ void operator()(const f32x4 (&acc)[2][2][4][2], const Unit& u, int wr, int wc, int fr, int fq) const {
        const int row0 = u.pm * BM + wr * 64 + fr;
        const bool sample = u.pm >= 64;
        u32x2e keep[2][4];
#pragma unroll
        for (int n = 0; n < 2; ++n) {
            const int ch = u.pn * HALF + wc * 32 + 8 * fq + 4 * n;
            const f32x4 wa0 = *(const f32x4*)(conv_w + ch), wa1 = *(const f32x4*)(conv_w + 6144 + ch), wa2 = *(const f32x4*)(conv_w + 12288 + ch), ba = *(const f32x4*)(conv_b + ch);
            const f32x4 wb0 = *(const f32x4*)(conv_w + 3072 + ch), wb1 = *(const f32x4*)(conv_w + 6144 + 3072 + ch), wb2 = *(const f32x4*)(conv_w + 12288 + 3072 + ch), bb = *(const f32x4*)(conv_b + 3072 + ch);
#pragma unroll
            for (int ai = 0; ai < 2; ++ai)
#pragma unroll
                for (int m = 0; m < 4; ++m) {
                    const int row = row0 + ai * HALF + m * 16;
                    const f32x4 ua = acc[ai][0][m][n], ub = acc[ai][1][m][n];
                    const f32x4 pa = acc[ai][0][m > 0 ? m - 1 : 0][n], pb = acc[ai][1][m > 0 ? m - 1 : 0][n];
                    float g[4];
#pragma unroll
                    for (int rp = 0; rp < 2; ++rp) {
                        f32x2e a0v, a1v, a2v, b0v, b1v, b2v;
#pragma unroll
                        for (int e = 0; e < 2; ++e) { const int r = 2 * rp + e;
                            a0v[e] = ua[r]; b0v[e] = ub[r];
                            a1v[e] = dpp_ror1(fr == 15 ? pa[r] : ua[r]); a2v[e] = dpp_ror2(fr >= 14 ? pa[r] : ua[r]);
                            b1v[e] = dpp_ror1(fr == 15 ? pb[r] : ub[r]); b2v[e] = dpp_ror2(fr >= 14 ? pb[r] : ub[r]); }
                        const f32x2e wa0v = {wa0[2 * rp], wa0[2 * rp + 1]}, wa1v = {wa1[2 * rp], wa1[2 * rp + 1]}, wa2v = {wa2[2 * rp], wa2[2 * rp + 1]}, bav = {ba[2 * rp], ba[2 * rp + 1]};
                        const f32x2e wb0v = {wb0[2 * rp], wb0[2 * rp + 1]}, wb1v = {wb1[2 * rp], wb1[2 * rp + 1]}, wb2v = {wb2[2 * rp], wb2[2 * rp + 1]}, bbv = {bb[2 * rp], bb[2 * rp + 1]};
                        const f32x2e ca = bav + wa0v * a2v + wa1v * a1v + wa2v * a0v;
                        const f32x2e cb = bbv + wb0v * b2v + wb1v * b1v + wb2v * b0v;
                        const f32x2e u2 = ca * (ca * ca * (-0.044715f * 1.5957691216057308f * 1.4426950408889634f) + (-1.5957691216057308f * 1.4426950408889634f));
                        f32x2e den; den.x = __builtin_amdgcn_rcpf(1.0f + __builtin_amdgcn_exp2f(u2.x)); den.y = __builtin_amdgcn_rcpf(1.0f + __builtin_amdgcn_exp2f(u2.y));
                        const f32x2e gv = ca * den * cb;
                        g[2 * rp] = gv.x; g[2 * rp + 1] = gv.y;
                    }
                    if (!sample) {
                        { u32x2e w; w.x = cvt_pk_bf16(g[0], g[1]); w.y = cvt_pk_bf16(g[2], g[3]);
                          if (n == 0) keep[ai][m] = w;
                          else if (!(m == 0 && fr < 2)) { u32x4 w4; w4.x = keep[ai][m].x; w4.y = keep[ai][m].y; w4.z = w.x; w4.w = w.y; *(u32x4*)(G + (size_t)row * 3072 + ch - 4) = w4; } }
                        if ((m == 0 && fr < 2) || (m == 3 && fr >= 14)) {
                            const int hrow = (row >> 6) * 4 + ((row + 2) & 63);
                            u32x2e w; w.x = cvt_pk_bf16(ua[0], ua[1]); w.y = cvt_pk_bf16(ua[2], ua[3]); *(u32x2e*)(UH + (size_t)hrow * 6144 + ch) = w;
                            w.x = cvt_pk_bf16(ub[0], ub[1]); w.y = cvt_pk_bf16(ub[2], ub[3]); *(u32x2e*)(UH + (size_t)hrow * 6144 + 3072 + ch) = w;
                        }
                        if ((row & 4095) >= 4094) {
                            float* cp = conv_prompt + ((size_t)(row >> 12) * 2 + ((row & 4095) - 4094)) * 6144;
                            *(f32x4*)(cp + ch) = ua; *(f32x4*)(cp + 3072 + ch) = ub;
                        }
                    } else {
                        const int sr = row - E_MP;
                        u32x2e w; w.x = cvt_pk_bf16(ua[0], ua[1]); w.y = cvt_pk_bf16(ua[2], ua[3]); *(u32x2e*)(US + (size_t)sr * 6144 + ch) = w;
                        w.x = cvt_pk_bf16(ub[0], ub[1]); w.y = cvt_pk_bf16(ub[2], ub[3]); *(u32x2e*)(US + (size_t)sr * 6144 + 3072 + ch) = w;
                        if ((sr & 3) >= 2) {
                            float* cp = conv_sample + ((size_t)(sr >> 2) * 2 + ((sr & 3) - 2)) * 6144;
                            *(f32x4*)(cp + ch) = ua; *(f32x4*)(cp + 3072 + ch) = ub;
                        }
                    }
                }
        }
    }
};

template <class Epi, class Sched, bool ALIGN_EPI = false, bool SP2 = false>
__device__ __forceinline__ void gemm_phase(PG8_LAS unsigned char* lds, const Gemm g, const Sched& S, const Epi& E) {
    const int tid = threadIdx.x, wid = __builtin_amdgcn_readfirstlane(tid >> 6), lane = tid & 63, wr = wid >> 2, wc = wid & 3, fr = lane & 15, fq = lane >> 4;
    const int K = g.K, lda = g.lda, ldb = g.ldb ? g.ldb : g.K;
    unsigned voffA[2], voffB[2];
#pragma unroll
    for (int i = 0; i < 2; ++i) { int R, C; stage_rc(tid * 16 + i * 8192, R, C); const int Rb = Epi::PERM ? ((R & ~31) + perm32(R & 31)) : R;
        voffA[i] = (unsigned)(R * lda + C) * 2u; voffB[i] = (unsigned)(Rb * ldb + C) * 2u; }
    const size_t kstep = (size_t)(BK * 2);
    const size_t hstepA = (size_t)HALF * lda * 2, hstepB = (size_t)HALF * ldb * 2;
    const size_t tstepA = 2 * hstepA, tstepB = 2 * hstepB;
    const unsigned ldsw = (unsigned)wid * 1024u;
    const int aoff = lds_byte(wr * 64 + fr, fq * 8), boff = lds_byte(wc * 32 + fr, fq * 8);
#define PG8_SA(b, h) (((b) * 2 + (h)) * HTB)
#define PG8_SB(b, h) ((4 + (b) * 2 + (h)) * HTB)
#define PG8_STAGE(bufoff, gbase, voff) do { _Pragma("unroll") for (int _i = 0; _i < 2; ++_i) \
        __builtin_amdgcn_global_load_lds((const unsigned*)((const char*)(gbase) + (voff)[_i]), (PG8_LAS unsigned*)(lds + (bufoff) + ldsw + _i * 8192), 16, 0, 0); } while (0)
#define PG8_LDA(dst, b, h) do { _Pragma("unroll") for (int m = 0; m < 4; ++m) _Pragma("unroll") for (int k = 0; k < 2; ++k) dst[m][k] = *(const PG8_LAS bf16x8*)(lds + PG8_SA(b, h) + aoff + m * 2048 + k * 1024); } while (0)
#define PG8_LDB(dst, b, h) do { _Pragma("unroll") for (int n = 0; n < 2; ++n) _Pragma("unroll") for (int k = 0; k < 2; ++k) dst[n][k] = *(const PG8_LAS bf16x8*)(lds + PG8_SB(b, h) + boff + n * 2048 + k * 1024); } while (0)
#define PG8_MMA(ai, bj, At, Bt) do { __builtin_amdgcn_s_setprio(1); _Pragma("unroll") for (int m = 0; m < 4; ++m) _Pragma("unroll") for (int n = 0; n < 2; ++n) _Pragma("unroll") for (int k = 0; k < 2; ++k) \
        acc[ai][bj][m][n] = __builtin_amdgcn_mfma_f32_16x16x32_bf16(Bt[n][k], At[m][k], acc[ai][bj][m][n], 0, 0, 0); __builtin_amdgcn_s_setprio(0); } while (0)
#define PG8_WAIT_V(n) asm volatile("s_waitcnt vmcnt(" #n ")" ::: "memory")
#define PG8_WAIT_L(n) asm volatile("s_waitcnt lgkmcnt(" #n ")" ::: "memory")
#define PG8_BAR __builtin_amdgcn_s_barrier()
#define PG8_SCHED __builtin_amdgcn_sched_barrier(0)
    Unit cur, nxt; int ui = 0;
    if (!S.next(0, cur)) return;
    f32x4 acc[2][2][4][2];
#pragma unroll
    for (int a = 0; a < 2; ++a)
#pragma unroll
        for (int b = 0; b < 2; ++b)
#pragma unroll
            for (int m = 0; m < 4; ++m)
#pragma unroll
                for (int n = 0; n < 2; ++n) acc[a][b][m][n] = (f32x4){0.f, 0.f, 0.f, 0.f};
    bf16x8 At[4][2], B0[2][2], B1[2][2];
    const char* cA = (const char*)(cur.seg ? g.A2 : g.A) + (size_t)cur.pm * tstepA; const char* cB = (const char*)(cur.seg ? g.Bt2 : g.Bt) + (size_t)cur.pn * tstepB;
    S.a_ready(cur);
    if constexpr (SP2) {
        PG8_STAGE(PG8_SB(0, 0), cB, voffB); PG8_STAGE(PG8_SB(0, 1), cB + hstepB, voffB); PG8_STAGE(PG8_SA(0, 0), cA, voffA); PG8_STAGE(PG8_SA(0, 1), cA + hstepA, voffA);
        if (wr == 1) PG8_BAR;
        PG8_WAIT_V(2); PG8_BAR;
        PG8_STAGE(PG8_SB(1, 0), cB + kstep, voffB); PG8_STAGE(PG8_SA(1, 0), cA + kstep, voffA); PG8_STAGE(PG8_SB(1, 1), cB + hstepB + kstep, voffB);
        PG8_WAIT_V(6); PG8_BAR;
    } else {
        PG8_STAGE(PG8_SB(0, 0), cB, voffB); PG8_STAGE(PG8_SA(0, 0), cA, voffA); PG8_STAGE(PG8_SB(0, 1), cB + hstepB, voffB); PG8_STAGE(PG8_SA(0, 1), cA + hstepA, voffA);
        if (wr == 1) PG8_BAR;
        PG8_WAIT_V(4); PG8_BAR;
        PG8_STAGE(PG8_SB(1, 0), cB + kstep, voffB); PG8_STAGE(PG8_SA(1, 0), cA + kstep, voffA); PG8_STAGE(PG8_SB(1, 1), cB + hstepB + kstep, voffB);
        PG8_WAIT_V(6); PG8_BAR;
    }
    for (;;) {
        const bool has_next = S.next(ui + 1, nxt);
        const char* nA = has_next ? (const char*)(nxt.seg ? g.A2 : g.A) + (size_t)nxt.pm * tstepA : cA; const char* nB = has_next ? (const char*)(nxt.seg ? g.Bt2 : g.Bt) + (size_t)nxt.pn * tstepB : cB;
        const int nt = (cur.seg ? g.K2 : K) / BK;
        for (int t = 0; t < nt; t += 2) {
            const bool last = (t == nt - 2);
            const char* a1 = cA + (size_t)(t + 1) * kstep;
            const char* a2 = last ? nA : cA + (size_t)(t + 2) * kstep; const char* b2 = last ? nB : cB + (size_t)(t + 2) * kstep;
            const char* a3 = a2 + kstep; const char* b3 = b2 + kstep;
            if (last && has_next) S.a_ready(nxt);
            if constexpr (SP2) {
            PG8_LDB(B0, 0, 0); PG8_LDB(B1, 0, 1); PG8_SCHED; PG8_LDA(At, 0, 0); PG8_STAGE(PG8_SA(1, 1), a1 + hstepA, voffA);
            PG8_WAIT_V(8); PG8_WAIT_L(0); PG8_BAR; PG8_MMA(0, 0, At, B0); PG8_MMA(0, 1, At, B1); PG8_BAR; PG8_SCHED;
            PG8_LDA(At, 0, 1); PG8_STAGE(PG8_SB(0, 0), b2, voffB); PG8_STAGE(PG8_SB(0, 1), b2 + hstepB, voffB); PG8_STAGE(PG8_SA(0, 0), a2, voffA);
            PG8_WAIT_V(8); PG8_WAIT_L(0); PG8_BAR; PG8_MMA(1, 0, At, B0); PG8_MMA(1, 1, At, B1); PG8_BAR; PG8_SCHED;
            PG8_LDB(B0, 1, 0); PG8_LDB(B1, 1, 1); PG8_SCHED; PG8_LDA(At, 1, 0); PG8_STAGE(PG8_SA(0, 1), a2 + hstepA, voffA);
            PG8_WAIT_V(8); PG8_WAIT_L(0); PG8_BAR; PG8_MMA(0, 0, At, B0); PG8_MMA(0, 1, At, B1); PG8_BAR; PG8_SCHED;
            PG8_LDA(At, 1, 1); PG8_STAGE(PG8_SB(1, 0), b3, voffB); PG8_STAGE(PG8_SB(1, 1), b3 + hstepB, voffB); PG8_STAGE(PG8_SA(1, 0), a3, voffA);
            PG8_WAIT_V(8); PG8_WAIT_L(0); PG8_BAR; PG8_MMA(1, 0, At, B0); PG8_MMA(1, 1, At, B1); PG8_BAR; PG8_SCHED;
            } else {
            PG8_LDB(B0, 0, 0); PG8_SCHED; PG8_LDA(At, 0, 0); PG8_STAGE(PG8_SA(1, 1), a1 + hstepA, voffA);
            PG8_WAIT_L(8); PG8_BAR; PG8_WAIT_L(0); PG8_MMA(0, 0, At, B0); PG8_BAR; PG8_SCHED;
            PG8_LDB(B1, 0, 1); PG8_STAGE(PG8_SB(0, 0), b2, voffB);
            PG8_BAR; PG8_WAIT_L(0); PG8_MMA(0, 1, At, B1); PG8_BAR;
            PG8_LDA(At, 0, 1); PG8_STAGE(PG8_SA(0, 0), a2, voffA);
            PG8_BAR; PG8_WAIT_L(0); PG8_MMA(1, 0, At, B0); PG8_BAR; PG8_SCHED;
            PG8_STAGE(PG8_SB(0, 1), b2 + hstepB, voffB);
            PG8_WAIT_V(6); PG8_BAR; PG8_MMA(1, 1, At, B1); PG8_BAR;
            PG8_LDB(B0, 1, 0); PG8_SCHED; PG8_LDA(At, 1, 0); PG8_STAGE(PG8_SA(0, 1), a2 + hstepA, voffA);
            PG8_WAIT_L(8); PG8_BAR; PG8_WAIT_L(0); PG8_MMA(0, 0, At, B0); PG8_BAR; PG8_SCHED;
            PG8_LDB(B1, 1, 1); PG8_STAGE(PG8_SB(1, 0), b3, voffB);
            PG8_BAR; PG8_WAIT_L(0); PG8_MMA(0, 1, At, B1); PG8_BAR;
            PG8_LDA(At, 1, 1); PG8_STAGE(PG8_SA(1, 0), a3, voffA);
            PG8_BAR; PG8_WAIT_L(0); PG8_MMA(1, 0, At, B0); PG8_BAR; PG8_SCHED;
            PG8_STAGE(PG8_SB(1, 1), b3 + hstepB, voffB);
            PG8_WAIT_V(6); PG8_BAR; PG8_MMA(1, 1, At, B1); PG8_BAR;
            }
        }
        if constexpr (ALIGN_EPI) { if (wr == 0) PG8_BAR; }
        bool keep_acc = false;
        if constexpr (Epi::TWO_SEG) { if (cur.seg == 0) { E.mid(acc, cur, wr, wc, fr, fq); keep_acc = true; } else { E(acc, cur, wr, wc, fr, fq); } }
        else if constexpr (!Epi::AFTER_DRAIN) { E(acc, cur, wr, wc, fr, fq); S.done(cur); }
        if (!has_next) break;
        if (!keep_acc) {
#pragma unroll
        for (int a = 0; a < 2; ++a)
#pragma unroll
            for (int b = 0; b < 2; ++b)
#pragma unroll
                for (int m = 0; m < 4; ++m)
#pragma unroll
                    for (int n = 0; n < 2; ++n) acc[a][b][m][n] = (f32x4){0.f, 0.f, 0.f, 0.f};
        }
        cur = nxt; cA = nA; cB = nB; ++ui;
        if constexpr (ALIGN_EPI) { if (wr == 1) PG8_BAR; }
    }
    PG8_WAIT_V(0);
    if constexpr (!ALIGN_EPI) { if (wr == 0) PG8_BAR; }
    PG8_BAR;
    if constexpr (Epi::AFTER_DRAIN) { E.fused(acc, cur, wr, wc, fr, fq, lds, wid, lane); S.done(cur); }
#undef PG8_SA
#undef PG8_SB
#undef PG8_STAGE
#undef PG8_LDA
#undef PG8_LDB
#undef PG8_MMA
#undef PG8_WAIT_V
#undef PG8_WAIT_L
#undef PG8_BAR
#undef PG8_SCHED
}
}

#define LAS __attribute__((address_space(3)))
using pg8::bf16_t; using pg8::bf16x8; using pg8::f32x4; using pg8::u32x4;
typedef float f32x2 __attribute__((ext_vector_type(2)));
typedef unsigned u32x2 __attribute__((ext_vector_type(2)));
typedef short v4i16 __attribute__((ext_vector_type(4)));

constexpr int MP = 16384, MS = 512, M = MP + MS, D = 1024, DIN = 5888, F2 = 6144, DFF = 3072, TSEQ = 4096;
constexpr int C_QA = 0, C_KA = 512, C_VA = 640, C_QR = 768, C_KR = 1280, C_VR = 1792, C_GATE = 2816, C_GMA = 3840, C_GMR = 4864;
constexpr float EPS = 1e-6f;
constexpr int NTHREADS = 512, NWAVES = 8;
constexpr int LDS_BYTES = 147456;

constexpr size_t MiB = 1u << 20;
constexpr size_t WS_BAR = 41 * 65536;
constexpr size_t WS_TABA = 0, WS_TABR = 512 * 1024;
constexpr size_t WS_WIN = 3 * MiB;
constexpr size_t WS_WUP = WS_WIN + (size_t)DIN * D * 2;
constexpr size_t WS_WDN = WS_WUP + (size_t)F2 * D * 2;
constexpr size_t WS_XN = WS_WDN + (size_t)D * DFF * 2;
constexpr size_t WS_R1 = WS_XN + (size_t)M * D * 2;
constexpr size_t R1_G = 0, R1_F = (size_t)M * DFF * 2, R1_UH = R1_F + (size_t)M * D * 2, R1_US = R1_UH + (size_t)264 * 4 * F2 * 2, R1_X1 = R1_US + (size_t)MS * F2 * 2, R1_END = R1_X1 + (size_t)M * D * 2;
static_assert(R1_END <= (size_t)M * DIN * 2, "R1 overlay");
static_assert(WS_R1 + (size_t)M * DIN * 2 <= 256 * MiB, "ws map");
constexpr size_t O_Y = 0, O_KP = (size_t)M * D, O_VP = O_KP + 65536, O_RP = O_VP + 65536, O_CP = O_RP + 524288, O_KS = O_CP + 49152, O_VS = O_KS + 2097152, O_RS = O_VS + 2097152, O_CS = O_RS + 16777216, O_END = O_CS + 1572864;

struct Args {
    const float *x_prompt, *x_sample, *cache_k, *cache_v, *state_ret, *state_conv, *w_in, *sinks, *w_a, *w_r, *w_o, *g_pre_mix, *g_post_mix, *g_pre_ffn, *g_post_ffn, *w_up, *conv_w, *conv_b, *w_down;
    float* out; unsigned char* ws; int ph_lo, ph_hi;
};

__device__ __forceinline__ float bf2f(bf16_t h) { return __uint_as_float((unsigned)h << 16); }
__device__ __forceinline__ float bflo(unsigned w) { return __uint_as_float(w << 16); }
__device__ __forceinline__ float bfhi(unsigned w) { return __uint_as_float(w & 0xffff0000u); }
__device__ __forceinline__ unsigned pk2(float lo, float hi) { return pg8::cvt_pk_bf16(lo, hi); }
__device__ __forceinline__ float wave_sum(float v) {
#pragma unroll
    for (int o = 1; o < 64; o <<= 1) v += __shfl_xor(v, o);
    return v;
}
__device__ __forceinline__ float wave_max(float v) {
#pragma unroll
    for (int o = 1; o < 64; o <<= 1) v = fmaxf(v, __shfl_xor(v, o));
    return v;
}
__device__ __forceinline__ float ret_log2g(int h) { return log2f(1.0f - exp2f(-5.0f - (float)h)); }
__device__ __forceinline__ bf16x8 tr_pair(const LAS unsigned char* p0, const LAS unsigned char* p1) {
    const v4i16 a = __builtin_amdgcn_ds_read_tr16_b64_v4i16((LAS v4i16*)p0), b = __builtin_amdgcn_ds_read_tr16_b64_v4i16((LAS v4i16*)p1);
    return (bf16x8){a[0], a[1], a[2], a[3], b[0], b[1], b[2], b[3]};
}
__device__ __forceinline__ bf16x8 cat8(u32x2 a, u32x2 b) { const u32x4 w = {a.x, a.y, b.x, b.y}; return __builtin_bit_cast(bf16x8, w); }

__device__ __forceinline__ void p0_transpose_item(const float* W, int K, int N, bf16_t* WT, int k0, int n0, int drow0, LAS float* scr, int lane, int ldk = 0) {
    if (ldk == 0) ldk = K;
    f32x4 wv[8];
#pragma unroll
    for (int i = 0; i < 8; ++i) wv[i] = *(const f32x4*)(W + (size_t)(k0 + 8 * i + (lane >> 3)) * N + n0 + 4 * (lane & 7));
#pragma unroll
    for (int i = 0; i < 8; ++i) { LAS float* d = scr + (8 * i + (lane >> 3)) * 33 + 4 * (lane & 7); d[0] = wv[i].x; d[1] = wv[i].y; d[2] = wv[i].z; d[3] = wv[i].w; }
    asm volatile("s_waitcnt lgkmcnt(0)" ::: "memory");
    const int c = lane & 7;
#pragma unroll
    for (int j = 0; j < 4; ++j) { const int n = (lane >> 3) + 8 * j; const LAS float* s = scr + (8 * c) * 33 + n;
        u32x4 o; o.x = pk2(s[0 * 33], s[1 * 33]); o.y = pk2(s[2 * 33], s[3 * 33]); o.z = pk2(s[4 * 33], s[5 * 33]); o.w = pk2(s[6 * 33], s[7 * 33]);
        *(u32x4*)(WT + (size_t)(drow0 + n) * ldk + k0 + 8 * c) = o; }
    asm volatile("s_waitcnt lgkmcnt(0)" ::: "memory");
}
__device__ __forceinline__ void rms_row_to_bf16(const float* xrow, const float* g, bf16_t* orow, int lane) {
    f32x4 v[4]; float s = 0.f;
#pragma unroll
    for (int j = 0; j < 4; ++j) { v[j] = *((const f32x4*)xrow + lane + 64 * j); s += (v[j].x * v[j].x + v[j].y * v[j].y) + (v[j].z * v[j].z + v[j].w * v[j].w); }
    const float rstd = rsqrtf(wave_sum(s) * (1.f / D) + EPS);
#pragma unroll
    for (int j = 0; j < 4; ++j) { const f32x4 gg = *((const f32x4*)g + lane + 64 * j);
        u32x2 w; w.x = pk2(v[j].x * rstd * gg.x, v[j].y * rstd * gg.y); w.y = pk2(v[j].z * rstd * gg.z, v[j].w * rstd * gg.w);
        *((u32x2*)orow + lane + 64 * j) = w; }
}
__device__ __forceinline__ void p0_prologue(const Args& a, LAS unsigned char* lds, int tid, int lane, int wave) {
    unsigned char* ws = a.ws;
    LAS float* scr = (LAS float*)(lds + wave * 16384);
    const int gw = blockIdx.x * NWAVES + wave, NGW = gridDim.x * NWAVES;
    bf16_t* WinT = (bf16_t*)(ws + WS_WIN); bf16_t* WupT = (bf16_t*)(ws + WS_WUP); bf16_t* WdnT = (bf16_t*)(ws + WS_WDN);
    bf16_t* WoT = (bf16_t*)(a.out + O_CS); bf16_t* WaT = WoT + 1024 * 1024; bf16_t* WrT = WaT + 1024 * 1024;
    constexpr int I_IN = 16 * (DIN / 32), I_A = 8 * 32, I_R = 16 * 32, I_O = 16 * 32, I_UP = 16 * (F2 / 32), I_DN = 48 * 32;
    constexpr int NITEMS = I_IN + I_A + I_R + I_O + I_UP + I_DN;
    for (int it = gw; it < NITEMS; it += NGW) {
        int r = it;
        if (r < I_IN) { const int nb = r % (DIN / 32), kb = r / (DIN / 32); p0_transpose_item(a.w_in, D, DIN, WinT, 64 * kb, 32 * nb, 32 * nb, scr, lane); continue; } r -= I_IN;
        if (r < I_A) { const int nb = r % 32, kb = r / 32; p0_transpose_item(a.w_a, 512, D, WaT, 64 * kb, 32 * nb, 32 * nb, scr, lane, 1024); continue; } r -= I_A;
        if (r < I_R) { const int nb = r % 32, kb = r / 32; p0_transpose_item(a.w_r, D, D, WrT, 64 * kb, 32 * nb, 32 * nb, scr, lane); continue; } r -= I_R;
        if (r < I_O) { const int nb = r % 32, kb = r / 32; p0_transpose_item(a.w_o, D, D, WoT, 64 * kb, 32 * nb, 32 * nb, scr, lane); continue; } r -= I_O;
        if (r < I_UP) { const int nb = r % (F2 / 32), kb = r / (F2 / 32); const int n0 = 32 * nb;
            const int drow = n0 < DFF ? (n0 / 128) * 256 + (n0 % 128) : ((n0 - DFF) / 128) * 256 + 128 + ((n0 - DFF) % 128);
            p0_transpose_item(a.w_up, D, F2, WupT, 64 * kb, n0, drow, scr, lane); continue; } r -= I_UP;
        { const int nb = r % 32, kb = r / 32; p0_transpose_item(a.w_down, DFF, D, WdnT, 64 * kb, 32 * nb, 32 * nb, scr, lane); }
    }
    bf16_t* XN = (bf16_t*)(ws + WS_XN);
    for (int m = gw; m < M; m += NGW) { const float* xr = m < MP ? a.x_prompt + (size_t)m * D : a.x_sample + (size_t)(m - MP) * D; rms_row_to_bf16(xr, a.g_pre_mix, XN + (size_t)m * D, lane); }
    f32x2* tabA = (f32x2*)(ws + WS_TABA); f32x2* tabR = (f32x2*)(ws + WS_TABR);
    __syncthreads();
    LAS float* invs = (LAS float*)lds;
    if (tid < 72) invs[tid] = tid < 8 ? (float)(1.0 / pow(500000.0, (double)((float)tid / 8.0f))) : (float)(1.0 / pow(10000.0, (double)((float)(tid - 8) / 63.0f)));
    __syncthreads();
    const int gt = blockIdx.x * NTHREADS + tid, NGT = gridDim.x * NTHREADS;
    for (int e = gt; e < 4100 * 72; e += NGT) {
        const int tp = e / 72, i = e % 72; const int pos = tp < 4096 ? tp : 16384 + (tp - 4096);
        const float ang = (float)pos * invs[i];
        const double rev = (double)ang * 0.15915494309189535; const float fr = (float)(rev - rint(rev));
        const f32x2 cs = {__builtin_amdgcn_cosf(fr), __builtin_amdgcn_sinf(fr)};
        if (i < 8) tabA[tp * 8 + i] = cs; else tabR[tp * 64 + (i - 8)] = cs;
    }
}

__device__ __forceinline__ void attn_prompt_unit(bf16_t* H, const float* sinks, LAS unsigned char* lds, int b, int qb, int head, int tid, int lane, int wave) {
    const int g = head >> 2, fr = lane & 15, fq = lane >> 4;
    const size_t rowbase = (size_t)b * TSEQ + (size_t)qb * 128;
    LAS unsigned char* Kimg = lds; LAS unsigned char* Vimg = lds + 36864;
#pragma unroll
    for (int i = 0; i < 4; ++i) {
        const int id = tid + NTHREADS * i, kidx = id >> 3, ch = id & 7;
        u32x4 kv = {0u, 0u, 0u, 0u}, vv = {0u, 0u, 0u, 0u};
        if (qb > 0 || kidx >= 128) { const bf16_t* src = H + (rowbase - 128 + kidx) * DIN; kv = *(const u32x4*)(src + C_KA + g * 64 + ch * 8); vv = *(const u32x4*)(src + C_VA + g * 64 + ch * 8); }
        *(LAS u32x4*)(Kimg + kidx * 144 + ch * 16) = kv; *(LAS u32x4*)(Vimg + kidx * 144 + ch * 16) = vv;
    }
    const size_t qrow = rowbase + 16 * wave + fr;
    bf16x8 qf[2];
#pragma unroll
    for (int ks = 0; ks < 2; ++ks) qf[ks] = *(const bf16x8*)(H + qrow * DIN + C_QA + head * 64 + 32 * ks + 8 * fq);
    __syncthreads();
    f32x4 s[10];
#pragma unroll
    for (int nn = 0; nn < 9; ++nn) {
        s[nn] = (f32x4){0.f, 0.f, 0.f, 0.f};
        const int krow = 16 * (wave + nn) + fr;
#pragma unroll
        for (int ks = 0; ks < 2; ++ks) { const bf16x8 kf = *(const LAS bf16x8*)(Kimg + krow * 144 + (32 * ks + 8 * fq) * 2); s[nn] = __builtin_amdgcn_mfma_f32_16x16x32_bf16(kf, qf[ks], s[nn], 0, 0, 0); }
    }
    s[9] = (f32x4){0.f, 0.f, 0.f, 0.f};
    const int qi = 16 * wave + fr; const float sink = sinks[head];
    float mx = sink;
#pragma unroll
    for (int nn = 0; nn < 9; ++nn)
#pragma unroll
        for (int r = 0; r < 4; ++r) { const int kidx = 16 * (wave + nn) + 4 * fq + r; const bool valid = (kidx > qi) && (kidx <= qi + 128) && (qb > 0 || kidx >= 128);
            s[nn][r] = valid ? s[nn][r] : -1e30f; mx = fmaxf(mx, s[nn][r]); }
    mx = fmaxf(mx, __shfl_xor(mx, 16)); mx = fmaxf(mx, __shfl_xor(mx, 32));
    float sum = 0.f;
#pragma unroll
    for (int nn = 0; nn < 9; ++nn)
#pragma unroll
        for (int r = 0; r < 4; ++r) { const float p = s[nn][r] > -1e29f ? __expf(s[nn][r] - mx) : 0.f; s[nn][r] = p; sum += p; }
    sum += __shfl_xor(sum, 16); sum += __shfl_xor(sum, 32);
    sum += __expf(sink - mx);
    f32x4 o[4];
#pragma unroll
    for (int db = 0; db < 4; ++db) o[db] = (f32x4){0.f, 0.f, 0.f, 0.f};
    const int tq = (lane & 15) >> 2, tpp = lane & 3;
#pragma unroll
    for (int G = 0; G < 5; ++G) {
        const u32x4 pw = {pk2(s[2 * G][0], s[2 * G][1]), pk2(s[2 * G][2], s[2 * G][3]), pk2(s[2 * G + 1][0], s[2 * G + 1][1]), pk2(s[2 * G + 1][2], s[2 * G + 1][3])};
        const bf16x8 pf = __builtin_bit_cast(bf16x8, pw);
        int k0 = 16 * (wave + 2 * G) + 4 * fq + tq, k1 = k0 + 16; k0 = k0 > 255 ? 255 : k0; k1 = k1 > 255 ? 255 : k1;
#pragma unroll
        for (int db = 0; db < 4; ++db) {
            const int colb = (32 * (db >> 1) + 8 * tpp + 4 * (db & 1)) * 2; const bf16x8 vf = tr_pair(Vimg + k0 * 144 + colb, Vimg + k1 * 144 + colb);
            o[db] = __builtin_amdgcn_mfma_f32_16x16x32_bf16(vf, pf, o[db], 0, 0, 0);
        }
    }
    const float inv = 1.0f / sum;
#pragma unroll
    for (int dp = 0; dp < 2; ++dp) { u32x4 w; w.x = pk2(o[2 * dp][0] * inv, o[2 * dp][1] * inv); w.y = pk2(o[2 * dp][2] * inv, o[2 * dp][3] * inv); w.z = pk2(o[2 * dp + 1][0] * inv, o[2 * dp + 1][1] * inv); w.w = pk2(o[2 * dp + 1][2] * inv, o[2 * dp + 1][3] * inv);
        *(u32x4*)(H + qrow * DIN + C_QA + head * 64 + 32 * dp + 8 * fq) = w; }
    __syncthreads();
}

__device__ __forceinline__ void attn_sample_unit(const Args& a, bf16_t* H, LAS unsigned char* lds, int b, int tid, int lane, int wave) {
    const int head = wave, g = head >> 2; const size_t r0 = (size_t)MP + 4 * b;
    LAS float* qs = (LAS float*)(lds + wave * 4096); LAS float* ps = qs + 256;
#pragma unroll
    for (int t = 0; t < 4; ++t) qs[t * 64 + lane] = bf2f(H[(r0 + t) * DIN + C_QA + head * 64 + lane]);
    asm volatile("s_waitcnt lgkmcnt(0)" ::: "memory");
    float sc[3][4];
    {
        const float* kp0 = a.cache_k + ((size_t)(b * 128 + lane) * 2 + g) * 64; const float* kp1 = kp0 + (size_t)64 * 128;
        const bf16_t* kpn = H + (r0 + (lane & 3)) * DIN + C_KA + g * 64;
#pragma unroll
        for (int t = 0; t < 4; ++t) { sc[0][t] = 0.f; sc[1][t] = 0.f; sc[2][t] = 0.f; }
#pragma nounroll
        for (int hf = 0; hf < 2; ++hf) {
            f32x4 kv0[8], kv1[8]; u32x4 kw[4];
#pragma unroll
            for (int d4 = 0; d4 < 8; ++d4) { kv0[d4] = *(const f32x4*)(kp0 + 32 * hf + 4 * d4); kv1[d4] = *(const f32x4*)(kp1 + 32 * hf + 4 * d4); }
#pragma unroll
            for (int c8 = 0; c8 < 4; ++c8) kw[c8] = *(const u32x4*)(kpn + 32 * hf + 8 * c8);
#pragma unroll
            for (int d4 = 0; d4 < 8; ++d4)
#pragma unroll
                for (int e = 0; e < 4; ++e) { const int d = 4 * d4 + e; const unsigned w = kw[d >> 3][(d & 7) >> 1]; const float kn = (d & 1) ? bfhi(w) : bflo(w);
#pragma unroll
                    for (int t = 0; t < 4; ++t) { const float q = qs[t * 64 + 32 * hf + d]; sc[0][t] += q * kv0[d4][e]; sc[1][t] += q * kv1[d4][e]; sc[2][t] += q * kn; } }
        }
    }
    const float sink = a.sinks[head];
    float inv[4];
#pragma unroll
    for (int t = 0; t < 4; ++t) {
        const bool v0 = lane > t, v1 = true, v2 = (lane < 4) && (lane <= t);
        const float s0 = v0 ? sc[0][t] : -1e30f, s1 = v1 ? sc[1][t] : -1e30f, s2 = v2 ? sc[2][t] : -1e30f;
        const float mx = fmaxf(wave_max(fmaxf(fmaxf(s0, s1), s2)), sink);
        const float p0 = v0 ? __expf(s0 - mx) : 0.f, p1 = __expf(s1 - mx), p2 = v2 ? __expf(s2 - mx) : 0.f;
        const float sum = wave_sum(p0 + p1 + p2) + __expf(sink - mx);
        inv[t] = 1.0f / sum;
        ps[t * 136 + lane] = p0; ps[t * 136 + 64 + lane] = p1; if (lane < 4) ps[t * 136 + 128 + lane] = p2;
    }
    asm volatile("s_waitcnt lgkmcnt(0)" ::: "memory");
    float o0 = 0.f, o1 = 0.f, o2 = 0.f, o3 = 0.f;
    const float* vp = a.cache_v + ((size_t)(b * 128) * 2 + g) * 64 + lane;
#pragma nounroll
    for (int rb = 0; rb < 2; ++rb) {
        float vx[64];
#pragma unroll
        for (int r = 0; r < 64; ++r) vx[r] = vp[(size_t)(64 * rb + r) * 128];
#pragma unroll
        for (int r = 0; r < 64; ++r) { const int rr = 64 * rb + r; o0 += ps[0 * 136 + rr] * vx[r]; o1 += ps[1 * 136 + rr] * vx[r]; o2 += ps[2 * 136 + rr] * vx[r]; o3 += ps[3 * 136 + rr] * vx[r]; }
    }
#pragma unroll
    for (int tn = 0; tn < 4; ++tn) { const float vx = bf2f(H[(r0 + tn) * DIN + C_VA + g * 64 + lane]); o0 += ps[0 * 136 + 128 + tn] * vx; o1 += ps[1 * 136 + 128 + tn] * vx; o2 += ps[2 * 136 + 128 + tn] * vx; o3 += ps[3 * 136 + 128 + tn] * vx; }
    H[(r0 + 0) * DIN + C_QA + head * 64 + lane] = (bf16_t)(pk2(o0 * inv[0], 0.f) & 0xffffu);
    H[(r0 + 1) * DIN + C_QA + head * 64 + lane] = (bf16_t)(pk2(o1 * inv[1], 0.f) & 0xffffu);
    H[(r0 + 2) * DIN + C_QA + head * 64 + lane] = (bf16_t)(pk2(o2 * inv[2], 0.f) & 0xffffu);
    H[(r0 + 3) * DIN + C_QA + head * 64 + lane] = (bf16_t)(pk2(o3 * inv[3], 0.f) & 0xffffu);
    float* ko = a.out + O_KS + (size_t)b * 128 * 128; float* vo = a.out + O_VS + (size_t)b * 128 * 128;
    const float* ki = a.cache_k + (size_t)b * 128 * 128 + 4 * 128; const float* vi = a.cache_v + (size_t)b * 128 * 128 + 4 * 128;
    for (int i = tid; i < 124 * 32; i += NTHREADS) { ((f32x4*)ko)[i] = ((const f32x4*)ki)[i]; ((f32x4*)vo)[i] = ((const f32x4*)vi)[i]; }
    { const int t = tid >> 7, gd = tid & 127;
      ko[(size_t)(124 + t) * 128 + gd] = bf2f(H[(r0 + t) * DIN + C_KA + gd]); vo[(size_t)(124 + t) * 128 + gd] = bf2f(H[(r0 + t) * DIN + C_VA + gd]); }
}

__device__ __forceinline__ void ret_u_unit(const bf16_t* H, bf16_t* ST, LAS unsigned char* lds, int b, int c, int h, int tid, int lane, int wave) {
    const size_t rowc = (size_t)b * TSEQ + (size_t)c * 128; const float l2g = ret_log2g(h);
    LAS unsigned char* Kimg = lds; LAS unsigned char* Vimg = lds + 36864;
#pragma unroll
    for (int i = 0; i < 4; ++i) { const int id = tid + NTHREADS * i, j = id >> 4, ch = id & 15;
        const u32x4 kv = *(const u32x4*)(H + (rowc + j) * DIN + C_KR + h * 128 + ch * 8); const float kd = exp2f(l2g * (float)(127 - j));
        u32x4 w; w.x = pk2(bflo(kv.x) * kd, bfhi(kv.x) * kd); w.y = pk2(bflo(kv.y) * kd, bfhi(kv.y) * kd); w.z = pk2(bflo(kv.z) * kd, bfhi(kv.z) * kd); w.w = pk2(bflo(kv.w) * kd, bfhi(kv.w) * kd);
        *(LAS u32x4*)(Kimg + j * 288 + ch * 16) = w; }
#pragma unroll
    for (int i = 0; i < 8; ++i) { const int id = tid + NTHREADS * i, j = id >> 5, ch = id & 31;
        *(LAS u32x4*)(Vimg + j * 544 + ch * 16) = *(const u32x4*)(H + (rowc + j) * DIN + C_VR + h * 256 + ch * 8); }
    __syncthreads();
    const int fr = lane & 15, fq = lane >> 4, tq = fr >> 2, tpp = lane & 3;
    f32x4 acc[2][8];
#pragma unroll
    for (int i = 0; i < 2; ++i)
#pragma unroll
        for (int j = 0; j < 8; ++j) acc[i][j] = (f32x4){0.f, 0.f, 0.f, 0.f};
#pragma unroll
    for (int ks = 0; ks < 4; ++ks) {
        const int j0 = 32 * ks + 4 * fq + tq, j1 = j0 + 16;
        bf16x8 vf[2];
#pragma unroll
        for (int i = 0; i < 2; ++i) { const int col = 32 * wave + 8 * tpp + 4 * i; vf[i] = tr_pair(Vimg + j0 * 544 + col * 2, Vimg + j1 * 544 + col * 2); }
#pragma unroll
        for (int kb = 0; kb < 8; ++kb) { const int col = 16 * kb + 4 * tpp; const bf16x8 kf = tr_pair(Kimg + j0 * 288 + col * 2, Kimg + j1 * 288 + col * 2);
#pragma unroll
            for (int i = 0; i < 2; ++i) acc[i][kb] = __builtin_amdgcn_mfma_f32_16x16x32_bf16(vf[i], kf, acc[i][kb], 0, 0, 0); }
    }
    bf16_t* U = ST + ((size_t)(b * 32 + c) * 4 + h) * 32768;
#pragma unroll
    for (int kb = 0; kb < 8; ++kb) { u32x4 w; w.x = pk2(acc[0][kb][0], acc[0][kb][1]); w.y = pk2(acc[0][kb][2], acc[0][kb][3]); w.z = pk2(acc[1][kb][0], acc[1][kb][1]); w.w = pk2(acc[1][kb][2], acc[1][kb][3]);
        *(u32x4*)(U + (size_t)(16 * kb + fr) * 256 + 32 * wave + 8 * fq) = w; }
    __syncthreads();
}

__device__ __forceinline__ void ret_sample_unit(const Args& a, bf16_t* H, LAS unsigned char* lds, int b, int h, int tid, int lane, int wave) {
    const size_t r0 = (size_t)MP + 4 * b; const float g = 1.0f - exp2f(-5.0f - (float)h);
    LAS float* qs = (LAS float*)lds; LAS float* ks = qs + 512; LAS float* po = ks + 512; LAS float* red = po + 2048;
    const int dv = tid & 255, half = tid >> 8;
    for (int i = tid; i < 1024; i += NTHREADS) { const int which = i >> 9, t = (i >> 7) & 3, d = i & 127;
        const float v = bf2f(H[(r0 + t) * DIN + (which ? C_KR : C_QR) + h * 128 + d]); if (which) ks[t * 128 + d] = v; else qs[t * 128 + d] = v; }
    float vt[4], gt[4];
#pragma unroll
    for (int t = 0; t < 4; ++t) { vt[t] = bf2f(H[(r0 + t) * DIN + C_VR + h * 256 + dv]); gt[t] = bf2f(H[(r0 + t) * DIN + C_GATE + h * 256 + dv]); }
    float S[64];
    const float* sp = a.state_ret + ((size_t)(b * 4 + h) * 128 + 64 * half) * 256 + dv;
#pragma unroll
    for (int d = 0; d < 64; ++d) S[d] = sp[(size_t)d * 256];
    __syncthreads();
#pragma unroll
    for (int t = 0; t < 4; ++t) { float o = 0.f;
#pragma unroll
        for (int d = 0; d < 64; ++d) { S[d] = g * S[d] + ks[t * 128 + 64 * half + d] * vt[t]; o += qs[t * 128 + 64 * half + d] * S[d]; }
        po[(half * 4 + t) * 256 + dv] = o; }
    float* so = a.out + O_RS + ((size_t)(b * 4 + h) * 128 + 64 * half) * 256 + dv;
#pragma unroll
    for (int d = 0; d < 64; ++d) so[(size_t)d * 256] = S[d];
    __syncthreads();
    float ot[4];
#pragma unroll
    for (int t = 0; t < 4; ++t) { ot[t] = po[t * 256 + dv] + po[(4 + t) * 256 + dv]; const float sq = wave_sum(half == 0 ? ot[t] * ot[t] : 0.f); if (lane == 0) red[wave * 4 + t] = sq; }
    __syncthreads();
    if (half == 0) {
#pragma unroll
        for (int t = 0; t < 4; ++t) { float ss = 0.f;
#pragma unroll
            for (int w = 0; w < 8; ++w) ss += red[w * 4 + t];
            const float rstd = rsqrtf(ss * (1.f / 256.f) + EPS); const float gv = gt[t]; const float sil = gv / (1.0f + __expf(-gv));
            H[(r0 + t) * DIN + C_VR + h * 256 + dv] = (bf16_t)(pk2(ot[t] * rstd * sil, 0.f) & 0xffffu); }
    }
    __syncthreads();
}

__device__ __forceinline__ void ret_out_unit(bf16_t* H, const bf16_t* ST, LAS unsigned char* lds, int b, int c, int h, int tid, int lane, int wave) {
    const size_t rowc = (size_t)b * TSEQ + (size_t)c * 128; const float l2g = ret_log2g(h);
    LAS unsigned char* Kimg = lds; LAS unsigned char* BIG = lds + 36864;
    const int fr = lane & 15, fq = lane >> 4, tq = fr >> 2, tpp = lane & 3;
    const int qi = 16 * wave + fr; const size_t qrow = rowc + qi;
    u32x4 kreg[4], sreg[8], vreg[8]; u32x4 greg[8];
#pragma unroll
    for (int i = 0; i < 4; ++i) { const int id = tid + NTHREADS * i, j = id >> 4, ch = id & 15; kreg[i] = *(const u32x4*)(H + (rowc + j) * DIN + C_KR + h * 128 + ch * 8); }
    if (c > 0) {
        const bf16_t* S = ST + ((size_t)(b * 32 + c) * 4 + h) * 32768;
#pragma unroll
        for (int i = 0; i < 8; ++i) { const int id = tid + NTHREADS * i, dk = id >> 5, ch = id & 31; sreg[i] = *(const u32x4*)(S + (size_t)dk * 256 + ch * 8); }
    }
    bf16x8 qf[4];
#pragma unroll
    for (int ks = 0; ks < 4; ++ks) { const bf16_t* qp = H + qrow * DIN + C_QR + h * 128 + 32 * ks + 4 * fq; qf[ks] = cat8(*(const u32x2*)qp, *(const u32x2*)(qp + 16)); }
#pragma unroll
    for (int i = 0; i < 8; ++i) { const int id = tid + NTHREADS * i, j = id >> 5, ch = id & 31; vreg[i] = *(const u32x4*)(H + (rowc + j) * DIN + C_VR + h * 256 + ch * 8); }
#pragma unroll
    for (int i = 0; i < 4; ++i) { const int id = tid + NTHREADS * i, j = id >> 4, ch = id & 15; *(LAS u32x4*)(Kimg + j * 288 + ch * 16) = kreg[i]; }
    if (c > 0) {
#pragma unroll
        for (int i = 0; i < 8; ++i) { const int id = tid + NTHREADS * i, dk = id >> 5, ch = id & 31; *(LAS u32x4*)(BIG + dk * 544 + ch * 16) = sreg[i]; }
    }
    __syncthreads();
    f32x4 acc[16];
#pragma unroll
    for (int k = 0; k < 16; ++k) acc[k] = (f32x4){0.f, 0.f, 0.f, 0.f};
    if (c > 0) {
#pragma unroll
        for (int ks = 0; ks < 4; ++ks) { const int d0 = 32 * ks + 4 * fq + tq, d1 = d0 + 16;
#pragma unroll
            for (int blk = 0; blk < 16; ++blk) { const int colb = (32 * (blk >> 1) + 8 * tpp + 4 * (blk & 1)) * 2; const bf16x8 sf = tr_pair(BIG + d0 * 544 + colb, BIG + d1 * 544 + colb);
                acc[blk] = __builtin_amdgcn_mfma_f32_16x16x32_bf16(sf, qf[ks], acc[blk], 0, 0, 0); } }
        const float qd = exp2f(l2g * (float)(qi + 1));
#pragma unroll
        for (int blk = 0; blk < 16; ++blk) acc[blk] = acc[blk] * qd;
    }
    bf16x8 pf[4];
#pragma unroll
    for (int G = 0; G < 4; ++G) {
        f32x4 sc[2];
#pragma unroll
        for (int e = 0; e < 2; ++e) { const int jb = 2 * G + e; sc[e] = (f32x4){0.f, 0.f, 0.f, 0.f};
            if (jb <= wave) {
#pragma unroll
                for (int ks = 0; ks < 4; ++ks) { const LAS unsigned char* kp = Kimg + (16 * jb + fr) * 288 + (32 * ks + 4 * fq) * 2;
                    const bf16x8 kf = cat8(*(const LAS u32x2*)kp, *(const LAS u32x2*)(kp + 32)); sc[e] = __builtin_amdgcn_mfma_f32_16x16x32_bf16(kf, qf[ks], sc[e], 0, 0, 0); }
#pragma unroll
                for (int r = 0; r < 4; ++r) { const int j = 16 * jb + 4 * fq + r; sc[e][r] = (j <= qi) ? sc[e][r] * exp2f(l2g * (float)(qi - j)) : 0.f; }
            } }
        const u32x4 pw = {pk2(sc[0][0], sc[0][1]), pk2(sc[0][2], sc[0][3]), pk2(sc[1][0], sc[1][1]), pk2(sc[1][2], sc[1][3])};
        pf[G] = __builtin_bit_cast(bf16x8, pw);
    }
    __syncthreads();
#pragma unroll
    for (int i = 0; i < 8; ++i) { const int id = tid + NTHREADS * i, j = id >> 5, ch = id & 31; *(LAS u32x4*)(BIG + j * 544 + ch * 16) = vreg[i]; }
#pragma unroll
    for (int k = 0; k < 8; ++k) greg[k] = *(const u32x4*)(H + qrow * DIN + C_GATE + h * 256 + 32 * k + 8 * fq);
    __syncthreads();
#pragma unroll
    for (int G = 0; G < 4; ++G) {
        if (2 * G <= wave) { const int j0 = 32 * G + 4 * fq + tq, j1 = j0 + 16;
#pragma unroll
            for (int blk = 0; blk < 16; ++blk) { const int colb = (32 * (blk >> 1) + 8 * tpp + 4 * (blk & 1)) * 2; const bf16x8 vf = tr_pair(BIG + j0 * 544 + colb, BIG + j1 * 544 + colb);
                acc[blk] = __builtin_amdgcn_mfma_f32_16x16x32_bf16(vf, pf[G], acc[blk], 0, 0, 0); } }
    }
    float ss = 0.f;
#pragma unroll
    for (int blk = 0; blk < 16; ++blk) ss += (acc[blk][0] * acc[blk][0] + acc[blk][1] * acc[blk][1]) + (acc[blk][2] * acc[blk][2] + acc[blk][3] * acc[blk][3]);
    ss += __shfl_xor(ss, 16); ss += __shfl_xor(ss, 32);
    const float rstd = rsqrtf(ss * (1.f / 256.f) + EPS);
#pragma unroll
    for (int k = 0; k < 8; ++k) {
        const u32x4 gw = greg[k]; u32x4 w;
#pragma unroll
        for (int q = 0; q < 4; ++q) { const float g0 = bflo(gw[q]), g1 = bfhi(gw[q]); const f32x4 av = acc[2 * k + (q >> 1)];
            const float a0 = av[(2 * q) & 3], a1 = av[(2 * q + 1) & 3];
            w[q] = pk2(a0 * rstd * g0 / (1.f + __expf(-g0)), a1 * rstd * g1 / (1.f + __expf(-g1))); }
        *(u32x4*)(H + qrow * DIN + C_VR + h * 256 + 32 * k + 8 * fq) = w;
    }
    __syncthreads();
}

__device__ __forceinline__ f32x4 tail_gemm(const bf16_t* A, int lda, const bf16_t* Bt, int K, LAS unsigned char* lds, int tid, int lane, int wave, f32x4 acc, int ldb = 0) {
    if (ldb == 0) ldb = K;
    const int fr = lane & 15, fq = lane >> 4, nc = K / 512;
    LAS unsigned char* Ai = lds; LAS unsigned char* Bi = lds + 33280;
    u32x4 ra[4], rb[8];
#pragma unroll
    for (int i = 0; i < 4; ++i) { const int id = tid + NTHREADS * i; ra[i] = *(const u32x4*)(A + (size_t)(id >> 6) * lda + (id & 63) * 8); }
#pragma unroll
    for (int i = 0; i < 8; ++i) { const int id = tid + NTHREADS * i; rb[i] = *(const u32x4*)(Bt + (size_t)(id >> 6) * ldb + (id & 63) * 8); }
#pragma nounroll
    for (int c = 0; c < nc; ++c) {
#pragma unroll
        for (int i = 0; i < 4; ++i) { const int id = tid + NTHREADS * i; *(LAS u32x4*)(Ai + (id >> 6) * 1040 + (id & 63) * 16) = ra[i]; }
#pragma unroll
        for (int i = 0; i < 8; ++i) { const int id = tid + NTHREADS * i; *(LAS u32x4*)(Bi + (id >> 6) * 1040 + (id & 63) * 16) = rb[i]; }
        __syncthreads();
        if (c + 1 < nc) {
#pragma unroll
            for (int i = 0; i < 4; ++i) { const int id = tid + NTHREADS * i; ra[i] = *(const u32x4*)(A + (size_t)(id >> 6) * lda + (c + 1) * 512 + (id & 63) * 8); }
#pragma unroll
            for (int i = 0; i < 8; ++i) { const int id = tid + NTHREADS * i; rb[i] = *(const u32x4*)(Bt + (size_t)(id >> 6) * ldb + (c + 1) * 512 + (id & 63) * 8); }
        }
        const LAS unsigned char* ap = Ai + (16 * (wave >> 2) + fr) * 1040 + fq * 16; const LAS unsigned char* bp = Bi + (16 * (wave & 3) + fr) * 1040 + fq * 16;
#pragma unroll
        for (int ks = 0; ks < 16; ++ks) { const bf16x8 av = *(const LAS bf16x8*)(ap + ks * 64), bv = *(const LAS bf16x8*)(bp + ks * 64); acc = __builtin_amdgcn_mfma_f32_16x16x32_bf16(bv, av, acc, 0, 0, 0); }
        __syncthreads();
    }
    return acc;
}

#define XB_TMO      128
#define XB_XCNT(j)  (256  + 64 * (j))
#define XB_XSUB(j)  (1280 + 64 * (j))
#define XB_XGEN(j)  (2304 + 64 * (j))
#define XB_TOP      3328
#define XB_TOPGEN   3392
#define XCD_BAR_WORDS 3456
#define XB_SPIN_CAP (1u << 18)

__device__ __forceinline__ unsigned xb_ld(unsigned* p)              { return __hip_atomic_load(p, __ATOMIC_RELAXED, __HIP_MEMORY_SCOPE_AGENT); }
__device__ __forceinline__ unsigned xb_add(unsigned* p, unsigned v) { return __hip_atomic_fetch_add(p, v, __ATOMIC_RELAXED, __HIP_MEMORY_SCOPE_AGENT); }
__device__ __forceinline__ unsigned xb_xcc_id() { return (unsigned)__builtin_amdgcn_s_getreg((3 << 11) | 20) & 0xFu; }
#define XB_SPIN(cond, bar) do { unsigned _sp = 0; while (cond) { __builtin_amdgcn_s_sleep(1); \
    if ((++_sp & 255u) == 0u) { if (xb_ld(&(bar)[XB_TMO])) break; if (_sp > XB_SPIN_CAP) { atomicAdd(&(bar)[XB_TMO], 1u); break; } } } } while (0)

struct XcdBarrier {
    unsigned* bar; unsigned x;
    volatile LAS unsigned* st;
};

__device__ __forceinline__ XcdBarrier xcd_barrier_post(unsigned* bar, volatile LAS unsigned* st) {
    XcdBarrier b; b.bar = bar; b.x = xb_xcc_id(); b.st = st;
    if (threadIdx.x == 0) (void)xb_add(&bar[XB_XCNT(b.x)], 1u);
    return b;
}
__device__ __forceinline__ void xcd_barrier_complete(unsigned* bar, unsigned x, unsigned& nloc, unsigned& nx) {
    const unsigned G = gridDim.x * gridDim.y * gridDim.z;
    unsigned sum, cnt, mine, sp = 0u;
    for (;;) {
        sum = 0u; cnt = 0u; mine = 0u;
#pragma unroll
        for (unsigned j = 0; j < 16; ++j) { const unsigned c = xb_ld(&bar[XB_XCNT(j)]); sum += c; cnt += (c > 0u) ? 1u : 0u; mine = (j == x) ? c : mine; }
        if (sum == G) break;
        __builtin_amdgcn_s_sleep(1);
        if ((++sp & 255u) == 0u) { if (xb_ld(&bar[XB_TMO])) break; if (sp > XB_SPIN_CAP) { atomicAdd(&bar[XB_TMO], 1u); break; } }
    }
    nloc = mine > 0u ? mine : 1u; nx = cnt > 0u ? cnt : 1u;
}

__device__ __forceinline__ void xcd_barrier(const XcdBarrier& b) {
    asm volatile("s_waitcnt vmcnt(0)" ::: "memory");
    __syncthreads();
    if (threadIdx.x == 0) {
        unsigned* bar = b.bar;
        __builtin_amdgcn_s_waitcnt(0);
        unsigned nloc = b.st[0], nx = b.st[1];
        if (nloc == 0u) { xcd_barrier_complete(bar, b.x, nloc, nx); b.st[0] = nloc; b.st[1] = nx; }
        const unsigned old = xb_add(&bar[XB_XSUB(b.x)], 1u);
        const unsigned gen = old / nloc;
        if (old + 1u == (gen + 1u) * nloc) {
            __builtin_amdgcn_fence(__ATOMIC_RELEASE, "agent");
            asm volatile("s_waitcnt vmcnt(0)" ::: "memory");
            const unsigned og = xb_add(&bar[XB_TOP], 1u);
            const unsigned tg = og / nx;
            if (og + 1u == (tg + 1u) * nx) xb_add(&bar[XB_TOPGEN], 1u);
            else XB_SPIN(xb_ld(&bar[XB_TOPGEN]) == tg, bar);
            __builtin_amdgcn_fence(__ATOMIC_ACQUIRE, "agent");
            xb_add(&bar[XB_XGEN(b.x)], 1u);
            asm volatile("s_waitcnt vmcnt(0)" ::: "memory");
        } else {
            XB_SPIN(xb_ld(&bar[XB_XGEN(b.x)]) == gen, bar);
            __builtin_amdgcn_fence(__ATOMIC_ACQUIRE, "agent");
            asm volatile("s_waitcnt vmcnt(0)" ::: "memory");
        }
    }
    __syncthreads();
}


__global__ void __launch_bounds__(NTHREADS, 2) fwd_megakernel(Args a) {
    extern __shared__ __attribute__((aligned(16))) unsigned char lds_raw[];
    LAS unsigned char* lds = (LAS unsigned char*)lds_raw;
    cg::grid_group grid = cg::this_grid();
    const int tid = threadIdx.x, lane = tid & 63, wave = __builtin_amdgcn_readfirstlane(tid >> 6);
    const int nblk = gridDim.x, blk = blockIdx.x;
    unsigned char* ws = a.ws;
    bf16_t* WinT = (bf16_t*)(ws + WS_WIN); bf16_t* WupT = (bf16_t*)(ws + WS_WUP); bf16_t* WdnT = (bf16_t*)(ws + WS_WDN);
    bf16_t* WoT = (bf16_t*)(a.out + O_CS); bf16_t* WaT = WoT + 1024 * 1024; bf16_t* WrT = WaT + 1024 * 1024;
    bf16_t* XN = (bf16_t*)(ws + WS_XN); bf16_t* H = (bf16_t*)(ws + WS_R1);
    bf16_t* MIXb = (bf16_t*)(ws + WS_R1);
    bf16_t* G = (bf16_t*)(ws + WS_R1 + R1_G); bf16_t* Fb = (bf16_t*)(ws + WS_R1 + R1_F); bf16_t* X1b = (bf16_t*)(ws + WS_R1 + R1_X1); bf16_t* UH = (bf16_t*)(ws + WS_R1 + R1_UH); bf16_t* US = (bf16_t*)(ws + WS_R1 + R1_US);
    bf16_t* ST = (bf16_t*)(a.out + O_Y);
    float* Y = a.out + O_Y;
    const int lo = a.ph_lo, hi = a.ph_hi;
    volatile LAS unsigned* xst = (volatile LAS unsigned*)(lds + 131072 + 64);
    if (tid == 0) { xst[0] = 0u; xst[1] = 0u; }
    __syncthreads();
    XcdBarrier xbar; xbar.bar = (unsigned*)(ws + WS_BAR); xbar.x = 0; xbar.st = nullptr;
    if (hi - lo > 1) { xbar = xcd_barrier_post((unsigned*)(ws + WS_BAR), xst);
        grid.sync(); }
#ifndef PROBE_REP_MASK
#define PROBE_REP_MASK 0
#endif
#define IN(k) (lo <= (k) && (k) < hi)
#define REPS(k) (((PROBE_REP_MASK >> (k)) & 1) ? 2 : 1)
#define SEAM(k) do { if (IN(k) && IN((k) + 1)) xcd_barrier(xbar); } while (0)

    if (IN(0)) { p0_prologue(a, lds, tid, lane, wave); }
    SEAM(0);
    if (IN(1)) {
        pg8::Gemm g{XN, WinT, M, DIN, D, D}; pg8::StaticOrder S; S.init(M, DIN, nblk, blk);
        pg8::EpiH E{H, (const pg8::f32x2e*)(ws + WS_TABA), (const pg8::f32x2e*)(ws + WS_TABR)};
        pg8::gemm_phase<pg8::EpiH, pg8::StaticOrder, true, true>(lds, g, S, E);
    }
    SEAM(1);
    if (IN(2)) {
        for (int u = blk; u < 1024; u += nblk) { const int head = u & 7, qb = (u >> 3) & 31, b = u >> 8; attn_prompt_unit(H, a.sinks, lds, b, qb, head, tid, lane, wave); }
        for (int u = blk; u < 512; u += nblk) { const int h = u & 3, c = (u >> 2) & 31, b = u >> 7; ret_u_unit(H, ST, lds, b, c, h, tid, lane, wave); }
        for (int u = blk; u < 128; u += nblk) { attn_sample_unit(a, H, lds, u, tid, lane, wave); __syncthreads(); }
        for (int u = blk; u < 512; u += nblk) { ret_sample_unit(a, H, lds, u >> 2, u & 3, tid, lane, wave); }
        for (int e = blk * NTHREADS + tid; e < 4 * 128 * 128; e += nblk * NTHREADS) { const int gd = e & 127, r = (e >> 7) & 127, b = e >> 14; const size_t row = (size_t)b * TSEQ + TSEQ - 128 + r;
            a.out[O_KP + e] = bf2f(H[row * DIN + C_KA + gd]); a.out[O_VP + e] = bf2f(H[row * DIN + C_VA + gd]); }
    }
    SEAM(2);
    if (IN(3)) {
        for (int e4 = blk * NTHREADS + tid; e4 < 16 * 8192; e4 += nblk * NTHREADS) {
            const int bh = e4 >> 13, idx = (e4 & 8191) * 4, b = bh >> 2, h = bh & 3;
            const float gL = exp2f(128.f * ret_log2g(h));
            f32x4 S = {0.f, 0.f, 0.f, 0.f};
#pragma unroll 8
            for (int c = 0; c < 32; ++c) { bf16_t* p = ST + ((size_t)(b * 32 + c) * 4 + h) * 32768 + idx; const u32x2 uw = *(const u32x2*)p; u32x2 sw; sw.x = pk2(S.x, S.y); sw.y = pk2(S.z, S.w); *(u32x2*)p = sw;
                const f32x4 uu = {bflo(uw.x), bfhi(uw.x), bflo(uw.y), bfhi(uw.y)}; S = S * gL + uu; }
            *(f32x4*)(a.out + O_RP + (size_t)bh * 32768 + idx) = S;
        }
    }
    SEAM(3);
    if (IN(4)) {
        for (int u = blk; u < 512; u += nblk) { const int h = u & 3, c = (u >> 2) & 31, b = u >> 7; ret_out_unit(H, ST, lds, b, c, h, tid, lane, wave); }
    }
    SEAM(4);
    if (IN(5)) {
        { pg8::Gemm g{H + C_QA, WaT, MP, D, 512, DIN, 1024, H + C_VR, WrT, 1024}; pg8::TwoSegOrder S; S.so.init(MP, D, nblk, blk);
          pg8::EpiGate2 E{XN, H + C_GMA, H + C_GMR, DIN}; pg8::gemm_phase<pg8::EpiGate2, pg8::TwoSegOrder, true, true>(lds, g, S, E); }
        __syncthreads();
        for (int piece = blk; piece < 256; piece += nblk) {
            const int fr = lane & 15, fq = lane >> 4; const size_t prow = (size_t)MP + 32 * (piece >> 4); const size_t row = prow + 16 * (wave >> 2) + fr; const int pcol = 64 * (piece & 15), col0 = pcol + 16 * (wave & 3);
            const f32x4 aa = tail_gemm(H + prow * DIN + C_QA, DIN, WaT + (size_t)pcol * 1024, 512, lds, tid, lane, wave, (f32x4){0.f, 0.f, 0.f, 0.f}, 1024);
            const f32x4 ar = tail_gemm(H + prow * DIN + C_VR, DIN, WrT + (size_t)pcol * 1024, 1024, lds, tid, lane, wave, (f32x4){0.f, 0.f, 0.f, 0.f});
            const int cb = col0 + 4 * fq;
            const u32x2 ga = *(const u32x2*)(H + row * DIN + C_GMA + cb), gr = *(const u32x2*)(H + row * DIN + C_GMR + cb);
            u32x2 w; w.x = pk2(pg8::sigmoidf_(bflo(ga.x)) * aa[0] + pg8::sigmoidf_(bflo(gr.x)) * ar[0], pg8::sigmoidf_(bfhi(ga.x)) * aa[1] + pg8::sigmoidf_(bfhi(gr.x)) * ar[1]);
            w.y = pk2(pg8::sigmoidf_(bflo(ga.y)) * aa[2] + pg8::sigmoidf_(bflo(gr.y)) * ar[2], pg8::sigmoidf_(bfhi(ga.y)) * aa[3] + pg8::sigmoidf_(bfhi(gr.y)) * ar[3]);
            *(u32x2*)(XN + row * D + cb) = w;
        }
    }
    SEAM(5);
    if (IN(6)) {
        pg8::Gemm g{XN, WoT, MP, D, D, D}; pg8::StaticOrder S; S.init(MP, D, nblk, blk);
        pg8::EpiBf16<0> E{MIXb, D, nullptr, 0, 0, 1.f}; pg8::gemm_phase<pg8::EpiBf16<0>, pg8::StaticOrder, true, true>(lds, g, S, E);
        for (int piece = blk; piece < 256; piece += nblk) {
            const int fr = lane & 15, fq = lane >> 4; const size_t prow = (size_t)MP + 32 * (piece >> 4); const size_t row = prow + 16 * (wave >> 2) + fr; const int pcol = 64 * (piece & 15), col0 = pcol + 16 * (wave & 3);
            const f32x4 ac = tail_gemm(XN + prow * D, D, WoT + (size_t)pcol * 1024, 1024, lds, tid, lane, wave, (f32x4){0.f, 0.f, 0.f, 0.f});
            u32x2 w; w.x = pk2(ac[0], ac[1]); w.y = pk2(ac[2], ac[3]); *(u32x2*)(MIXb + row * D + col0 + 4 * fq) = w;
        }
    }
    SEAM(6);
    if (IN(7)) {
        f32x4 gpm[2][2], gpf[2][2];
#pragma unroll
        for (int j = 0; j < 2; ++j)
#pragma unroll
            for (int e = 0; e < 2; ++e) { gpm[j][e] = *((const f32x4*)a.g_post_mix + 2 * (lane + 64 * j) + e); gpf[j][e] = *((const f32x4*)a.g_pre_ffn + 2 * (lane + 64 * j) + e); }
        for (int p = blk * NWAVES + wave; p < M / 2; p += nblk * NWAVES) {
            u32x4 mb[2][2]; f32x4 xx[2][2][2];
#pragma unroll
            for (int rr = 0; rr < 2; ++rr) { const int m = 2 * p + rr; const float* xr = m < MP ? a.x_prompt + (size_t)m * D : a.x_sample + (size_t)(m - MP) * D;
#pragma unroll
                for (int j = 0; j < 2; ++j) { mb[rr][j] = *((const u32x4*)(MIXb + (size_t)m * D) + lane + 64 * j); xx[rr][j][0] = *((const f32x4*)xr + 2 * (lane + 64 * j)); xx[rr][j][1] = *((const f32x4*)xr + 2 * (lane + 64 * j) + 1); } }
            float mv[2][2][8]; float ss[2];
#pragma unroll
            for (int rr = 0; rr < 2; ++rr) { ss[rr] = 0.f;
#pragma unroll
                for (int j = 0; j < 2; ++j)
#pragma unroll
                    for (int q = 0; q < 4; ++q) { const unsigned w = mb[rr][j][q]; mv[rr][j][2 * q] = bflo(w); mv[rr][j][2 * q + 1] = bfhi(w); ss[rr] += mv[rr][j][2 * q] * mv[rr][j][2 * q] + mv[rr][j][2 * q + 1] * mv[rr][j][2 * q + 1]; } }
            ss[0] = wave_sum(ss[0]); ss[1] = wave_sum(ss[1]);
            float s2[2];
#pragma unroll
            for (int rr = 0; rr < 2; ++rr) { const float rstd = rsqrtf(ss[rr] * (1.f / D) + EPS); s2[rr] = 0.f;
#pragma unroll
                for (int j = 0; j < 2; ++j)
#pragma unroll
                    for (int q = 0; q < 8; ++q) { const float x1 = xx[rr][j][q >> 2][q & 3] + mv[rr][j][q] * rstd * gpm[j][q >> 2][q & 3]; mv[rr][j][q] = x1; s2[rr] += x1 * x1; } }
            s2[0] = wave_sum(s2[0]); s2[1] = wave_sum(s2[1]);
#pragma unroll
            for (int rr = 0; rr < 2; ++rr) { const int m = 2 * p + rr; const float rstd2 = rsqrtf(s2[rr] * (1.f / D) + EPS);
#pragma unroll
                for (int j = 0; j < 2; ++j) { u32x4 w1, w2;
#pragma unroll
                    for (int q = 0; q < 4; ++q) { const float a0 = mv[rr][j][2 * q], a1 = mv[rr][j][2 * q + 1]; w1[q] = pk2(a0, a1);
                        w2[q] = pk2(a0 * rstd2 * gpf[j][(2 * q) >> 2][(2 * q) & 3], a1 * rstd2 * gpf[j][(2 * q + 1) >> 2][(2 * q + 1) & 3]); }
                    *((u32x4*)(X1b + (size_t)m * D) + lane + 64 * j) = w1; *((u32x4*)(XN + (size_t)m * D) + lane + 64 * j) = w2; } }
        }
    }
    SEAM(7);
    if (IN(8)) {
        pg8::Gemm g{XN, WupT, M, F2, D, D}; pg8::StaticOrder S; S.init(M, F2, nblk, blk);
        pg8::EpiUp E{G, UH, US, a.out + O_CP, a.out + O_CS, a.conv_w, a.conv_b};
        pg8::gemm_phase<pg8::EpiUp, pg8::StaticOrder, true, true>(lds, g, S, E);
    }
    SEAM(8);
    if (IN(9)) {
        for (int task = blk * NWAVES + wave; task < 1024 * 6; task += nblk * NWAVES) {
            const int rt = task / 6, chunk = task % 6; const int ch = chunk * 512 + lane * 8;
            float ua[3][8], ub[3][8];
            int row;
#define LD8BF(dst, ptr) do { const u32x4 _w = *(const u32x4*)(ptr); dst[0] = bflo(_w.x); dst[1] = bfhi(_w.x); dst[2] = bflo(_w.y); dst[3] = bfhi(_w.y); dst[4] = bflo(_w.z); dst[5] = bfhi(_w.z); dst[6] = bflo(_w.w); dst[7] = bfhi(_w.w); } while (0)
#define LD8F(dst, ptr) do { const f32x4 _a = *(const f32x4*)(ptr), _b = *(const f32x4*)((ptr) + 4); dst[0] = _a.x; dst[1] = _a.y; dst[2] = _a.z; dst[3] = _a.w; dst[4] = _b.x; dst[5] = _b.y; dst[6] = _b.z; dst[7] = _b.w; } while (0)
#define ZERO8(dst) do { _Pragma("unroll") for (int _i = 0; _i < 8; ++_i) dst[_i] = 0.f; } while (0)
            if (rt < 512) {
                const int grp = rt >> 1, k = rt & 1; row = grp * 64 + k; const int t = row & 4095;
                const bf16_t* u0 = UH + (size_t)(grp * 4 + 2 + k) * F2;
                LD8BF(ua[2], u0 + ch); LD8BF(ub[2], u0 + DFF + ch);
                if (t >= 1) { const bf16_t* u1 = (k == 0) ? UH + (size_t)((grp - 1) * 4 + 1) * F2 : UH + (size_t)(grp * 4 + 2) * F2; LD8BF(ua[1], u1 + ch); LD8BF(ub[1], u1 + DFF + ch); } else { ZERO8(ua[1]); ZERO8(ub[1]); }
                if (t >= 2) { const bf16_t* u2 = UH + (size_t)((grp - 1) * 4 + k) * F2; LD8BF(ua[0], u2 + ch); LD8BF(ub[0], u2 + DFF + ch); } else { ZERO8(ua[0]); ZERO8(ub[0]); }
            } else {
                const int sr = rt - 512, b = sr >> 2, t = sr & 3; row = MP + sr;
#pragma unroll
                for (int tap = 0; tap < 3; ++tap) { const int e = t + tap;
                    if (e < 2) { const float* cp = a.state_conv + ((size_t)b * 2 + e) * F2; LD8F(ua[tap], cp + ch); LD8F(ub[tap], cp + DFF + ch); }
                    else { const bf16_t* up = US + (size_t)(b * 4 + e - 2) * F2; LD8BF(ua[tap], up + ch); LD8BF(ub[tap], up + DFF + ch); } }
            }
            float wa[3][8], wb[3][8], ba[8], bb[8];
#pragma unroll
            for (int tap = 0; tap < 3; ++tap) { LD8F(wa[tap], a.conv_w + (size_t)tap * F2 + ch); LD8F(wb[tap], a.conv_w + (size_t)tap * F2 + DFF + ch); }
            LD8F(ba, a.conv_b + ch); LD8F(bb, a.conv_b + DFF + ch);
            float gg[8];
#pragma unroll
            for (int i = 0; i < 8; ++i) { const float ca = ba[i] + wa[0][i] * ua[0][i] + wa[1][i] * ua[1][i] + wa[2][i] * ua[2][i], cb = bb[i] + wb[0][i] * ub[0][i] + wb[1][i] * ub[1][i] + wb[2][i] * ub[2][i];
                gg[i] = pg8::gelu_tanh(ca) * cb; }
            u32x4 w; w.x = pk2(gg[0], gg[1]); w.y = pk2(gg[2], gg[3]); w.z = pk2(gg[4], gg[5]); w.w = pk2(gg[6], gg[7]);
            *(u32x4*)(G + (size_t)row * DFF + ch) = w;
        }
    }
    SEAM(9);
    if (IN(10)) {
        pg8::Gemm g{G, WdnT, MP, D, DFF, DFF}; pg8::StaticOrder S; S.init(MP, D, nblk, blk);
        pg8::EpiBf16<0> E{Fb, D, nullptr, 0, 0, 1.f}; pg8::gemm_phase<pg8::EpiBf16<0>, pg8::StaticOrder, true, true>(lds, g, S, E);
        for (int piece = blk; piece < 256; piece += nblk) {
            const int fr = lane & 15, fq = lane >> 4; const size_t prow = (size_t)MP + 32 * (piece >> 4); const size_t row = prow + 16 * (wave >> 2) + fr; const int pcol = 64 * (piece & 15), col0 = pcol + 16 * (wave & 3);
            const f32x4 ac = tail_gemm(G + prow * DFF, DFF, WdnT + (size_t)pcol * DFF, DFF, lds, tid, lane, wave, (f32x4){0.f, 0.f, 0.f, 0.f});
            u32x2 w; w.x = pk2(ac[0], ac[1]); w.y = pk2(ac[2], ac[3]); *(u32x2*)(Fb + row * D + col0 + 4 * fq) = w;
        }
    }
    SEAM(10);
    if (IN(11)) {
        f32x4 gpo[2][2];
#pragma unroll
        for (int j = 0; j < 2; ++j)
#pragma unroll
            for (int e = 0; e < 2; ++e) gpo[j][e] = *((const f32x4*)a.g_post_ffn + 2 * (lane + 64 * j) + e);
        for (int p = blk * NWAVES + wave; p < M / 2; p += nblk * NWAVES) {
            u32x4 fb[2][2], xb[2][2];
#pragma unroll
            for (int rr = 0; rr < 2; ++rr) { const int m = 2 * p + rr;
#pragma unroll
                for (int j = 0; j < 2; ++j) { fb[rr][j] = *((const u32x4*)(Fb + (size_t)m * D) + lane + 64 * j); xb[rr][j] = *((const u32x4*)(X1b + (size_t)m * D) + lane + 64 * j); } }
            float ss[2];
#pragma unroll
            for (int rr = 0; rr < 2; ++rr) { ss[rr] = 0.f;
#pragma unroll
                for (int j = 0; j < 2; ++j)
#pragma unroll
                    for (int q = 0; q < 4; ++q) { const unsigned w = fb[rr][j][q]; ss[rr] += bflo(w) * bflo(w) + bfhi(w) * bfhi(w); } }
            ss[0] = wave_sum(ss[0]); ss[1] = wave_sum(ss[1]);
#pragma unroll
            for (int rr = 0; rr < 2; ++rr) { const int m = 2 * p + rr; const float rstd = rsqrtf(ss[rr] * (1.f / D) + EPS);
#pragma unroll
                for (int j = 0; j < 2; ++j)
#pragma unroll
                    for (int e = 0; e < 2; ++e) { f32x4 y;
#pragma unroll
                        for (int q = 0; q < 2; ++q) { const unsigned fw = fb[rr][j][2 * e + q], xw = xb[rr][j][2 * e + q];
                            y[2 * q] = bflo(xw) + bflo(fw) * rstd * gpo[j][e][2 * q]; y[2 * q + 1] = bfhi(xw) + bfhi(fw) * rstd * gpo[j][e][2 * q + 1]; }
                        *((f32x4*)(Y + (size_t)m * D) + 2 * (lane + 64 * j) + e) = y; } }
        }
    }
#undef IN
#undef SEAM
}

#ifndef MK_SPLIT
#define MK_SPLIT 0
#endif
extern "C" void kernel_launch(void* const* d_in, const int* in_sizes, int n_in, void* d_out, int out_size, void* d_ws, size_t ws_size, hipStream_t stream) {
    static int grid = 0;
    if (grid == 0) {
        int dev = 0, cus = 0, per_cu = 0;
        if (hipGetDevice(&dev) != hipSuccess || hipDeviceGetAttribute(&cus, hipDeviceAttributeMultiprocessorCount, dev) != hipSuccess) { fprintf(stderr, "kernel_launch: device query failed\n"); grid = -1; return; }
        if (hipFuncSetAttribute((const void*)fwd_megakernel, hipFuncAttributeMaxDynamicSharedMemorySize, LDS_BYTES) != hipSuccess) { fprintf(stderr, "kernel_launch: hipFuncSetAttribute failed\n"); grid = -1; return; }
        if (hipOccupancyMaxActiveBlocksPerMultiprocessor(&per_cu, (const void*)fwd_megakernel, NTHREADS, LDS_BYTES) != hipSuccess || per_cu < 1) { fprintf(stderr, "kernel_launch: occupancy query says %d\n", per_cu); per_cu = 1; }
        (void)hipGetLastError();
        grid = cus * 1;
        if (ws_size < 256 * MiB || out_size != (int)O_END || n_in != 19) fprintf(stderr, "kernel_launch: unexpected sizes ws %zu out %d n_in %d\n", ws_size, out_size, n_in);
    }
    if (grid < 0) return;
    Args a{};
    a.x_prompt = (const float*)d_in[0]; a.x_sample = (const float*)d_in[1]; a.cache_k = (const float*)d_in[2]; a.cache_v = (const float*)d_in[3]; a.state_ret = (const float*)d_in[4];
    a.state_conv = (const float*)d_in[5]; a.w_in = (const float*)d_in[6]; a.sinks = (const float*)d_in[7]; a.w_a = (const float*)d_in[8]; a.w_r = (const float*)d_in[9]; a.w_o = (const float*)d_in[10];
    a.g_pre_mix = (const float*)d_in[11]; a.g_post_mix = (const float*)d_in[12]; a.g_pre_ffn = (const float*)d_in[13]; a.g_post_ffn = (const float*)d_in[14];
    a.w_up = (const float*)d_in[15]; a.conv_w = (const float*)d_in[16]; a.conv_b = (const float*)d_in[17]; a.w_down = (const float*)d_in[18];
    a.out = (float*)d_out; a.ws = (unsigned char*)d_ws;
#if MK_SPLIT
    for (int ph = 0; ph < 12; ++ph) { a.ph_lo = ph; a.ph_hi = ph + 1; hipLaunchKernelGGL(fwd_megakernel, dim3(grid), dim3(NTHREADS), LDS_BYTES, stream, a); }
#else
    a.ph_lo = 0; a.ph_hi = 12;
    if (hipMemsetAsync((unsigned char*)d_ws + WS_BAR, 0, 16384, stream) != hipSuccess) { fprintf(stderr, "kernel_launch: memset of the barrier words failed\n"); return; }
    void* args[] = {&a};
    const hipError_t e = hipLaunchCooperativeKernel((const void*)fwd_megakernel, dim3(grid), dim3(NTHREADS), args, LDS_BYTES, stream);
    if (e != hipSuccess) fprintf(stderr, "kernel_launch: cooperative launch failed: %s (grid %d)\n", hipGetErrorString(e), grid);
#endif
}
```
